# Optimizing an MI355X kernel written in HIP

```python
import jax, jax.numpy as jnp
from jax import lax
import numpy as np

D_MODEL = 1024
BATCH = 8
SEQ = 8192
DEPTH = 4

N_MIXERS = 3
RMS_EPS = 1e-6
NEG_INF = -1e30
CONV_WIDTH = 3
MLA_HEADS = 8
MLA_Q_LORA = 384
MLA_KV_LORA = 256
MLA_NOPE = 128
MLA_ROPE = 64
MLA_V = 128
ROPE_THETA = 10000.0
Q_BLOCK = 128
SWA_Q_HEADS = 16
SWA_KV_HEADS = 2
SWA_GROUP = SWA_Q_HEADS // SWA_KV_HEADS
SWA_HEAD_DIM = 64
WINDOW = 128
D_FF = 2816
N_EXPERTS = 8
TOP_K = 2
D_FF_EXPERT = 3584
N_CONV_LAYERS = (DEPTH + 2) // 3
N_MLA_LAYERS = (DEPTH + 1) // 3
N_SWA_LAYERS = DEPTH // 3
N_DENSE_LAYERS = (DEPTH + 1) // 2
N_MOE_LAYERS = DEPTH // 2

kernel_name = 'hybrid_conv_mla_swa_moe_trunk'


def rmsnorm(x, g):
    xf = x.astype(jnp.float32)
    y = xf * lax.rsqrt(jnp.mean(xf * xf, axis=-1, keepdims=True) + RMS_EPS)
    return (y * g.astype(jnp.float32)).astype(x.dtype)


def short_conv(h, w_in, w_conv, w_out):
    S = h.shape[1]
    b_gate, c_gate, u = jnp.split(h @ w_in, 3, axis=-1)
    vp = jnp.pad(c_gate * u, ((0, 0), (CONV_WIDTH - 1, 0), (0, 0)))
    conv = vp[:, 0:S] * w_conv[0]
    for j in range(1, CONV_WIDTH):
        conv = conv + vp[:, j:j + S] * w_conv[j]
    return (b_gate * conv) @ w_out


def rope_angles(positions, dim):
    inv = ROPE_THETA ** (-jnp.arange(0, dim, 2, dtype=jnp.float32) / dim)
    ang = positions.astype(jnp.float32)[..., None] * inv
    return jnp.cos(ang), jnp.sin(ang)


def apply_rope(x, cos, sin):
    x1, x2 = jnp.split(x, 2, axis=-1)
    cos = cos.astype(x.dtype)
    sin = sin.astype(x.dtype)
    return jnp.concatenate([x1 * cos - x2 * sin, x2 * cos + x1 * sin], axis=-1)


def mla_attention(h, positions, w_down, q_norm, w_uq, kv_norm, w_ukv, w_o):
    B, S, _ = h.shape
    c_q, c_kv, k_pe = jnp.split(h @ w_down, [MLA_Q_LORA, MLA_Q_LORA + MLA_KV_LORA], axis=-1)
    q = (rmsnorm(c_q, q_norm) @ w_uq).reshape(B, S, MLA_HEADS, MLA_NOPE + MLA_ROPE)
    kv = (rmsnorm(c_kv, kv_norm) @ w_ukv).reshape(B, S, MLA_HEADS, MLA_NOPE + MLA_V)
    q_nope, q_pe = jnp.split(q, [MLA_NOPE], axis=-1)
    k_nope, v = jnp.split(kv, [MLA_NOPE], axis=-1)
    cos, sin = rope_angles(positions, MLA_ROPE)
    q_pe = apply_rope(q_pe, cos[:, :, None], sin[:, :, None])
    k_pe = apply_rope(k_pe, cos, sin)
    scale = (MLA_NOPE + MLA_ROPE) ** -0.5
    nb = S // Q_BLOCK

    def to_blocks(t):
        return t.reshape((B, nb, Q_BLOCK) + t.shape[2:]).swapaxes(0, 1)

    k_idx = jnp.arange(S)

    def block(args):
        qn, qp, start = args
        s = (jnp.einsum('bqhd,bkhd->bhqk', qn, k_nope)
             + jnp.einsum('bqhr,bkr->bhqk', qp, k_pe)).astype(jnp.float32) * scale
        q_idx = start + jnp.arange(Q_BLOCK)
        s = jnp.where(k_idx[None, :] <= q_idx[:, None], s, NEG_INF)
        p = jax.nn.softmax(s, axis=-1).astype(v.dtype)
        return jnp.einsum('bhqk,bkhd->bqhd', p, v)

    starts = jnp.arange(nb, dtype=jnp.int32) * Q_BLOCK
    o = lax.map(block, (to_blocks(q_nope), to_blocks(q_pe), starts))
    o = o.swapaxes(0, 1).reshape(B, S, MLA_HEADS * MLA_V)
    return o @ w_o


def alibi_slopes(n):
    return 2.0 ** (-8.0 * jnp.arange(1, n + 1, dtype=jnp.float32) / n)


def swa_attention(h, positions, w_qkv, b_qkv, sinks, w_o, b_o):
    B, S, _ = h.shape
    W = WINDOW
    nb = S // W
    qkv = h @ w_qkv + b_qkv
    nq = SWA_Q_HEADS * SWA_HEAD_DIM
    nk = SWA_KV_HEADS * SWA_HEAD_DIM
    q = qkv[..., :nq].reshape(B, nb, W, SWA_KV_HEADS, SWA_GROUP, SWA_HEAD_DIM)
    k = qkv[..., nq:nq + nk].reshape(B, S, SWA_KV_HEADS, SWA_HEAD_DIM)
    v = qkv[..., nq + nk:].reshape(B, S, SWA_KV_HEADS, SWA_HEAD_DIM)

    def band(t):
        tp = jnp.pad(t, ((0, 0), (W, 0)) + ((0, 0),) * (t.ndim - 2))
        tp = tp.reshape((B, nb + 1, W) + t.shape[2:])
        return jnp.concatenate([tp[:, :-1], tp[:, 1:]], axis=2)

    kb, vb = band(k), band(v)
    pk = band(positions)
    pq = positions.reshape(B, nb, W)
    s = jnp.einsum('bnqkgd,bnskd->bnkgqs', q, kb).astype(jnp.float32) * (SWA_HEAD_DIM ** -0.5)
    dist = jnp.abs(pq[:, :, :, None] - pk[:, :, None, :]).astype(jnp.float32)
    slopes = alibi_slopes(SWA_Q_HEADS).reshape(SWA_KV_HEADS, SWA_GROUP, 1, 1)
    s = s - slopes * dist[:, :, None, None]
    qi = W + jnp.arange(W)
    ki = jnp.arange(2 * W)
    diff = qi[:, None] - ki[None, :]
    in_band = (diff >= 0) & (diff < W)
    in_seq = (jnp.arange(nb)[:, None, None] * W - W + ki[None, None, :]) >= 0
    valid = in_band[None] & in_seq
    s = jnp.where(valid[None, :, None, None], s, NEG_INF)
    sink = jnp.broadcast_to(sinks.astype(jnp.float32).reshape(1, 1, SWA_KV_HEADS, SWA_GROUP, 1, 1),
                            s.shape[:-1] + (1,))
    p = jax.nn.softmax(jnp.concatenate([s, sink], axis=-1), axis=-1)[..., :-1].astype(vb.dtype)
    o = jnp.einsum('bnkgqs,bnskd->bnqkgd', p, vb).reshape(B, S, nq)
    return o @ w_o + b_o


def swiglu(h, w_gate_up, w_down):
    g, u = jnp.split(h @ w_gate_up, 2, axis=-1)
    return (jax.nn.silu(g) * u) @ w_down


def moe_swiglu(h, router, w_gate_up, w_down):
    logits = (h @ router).astype(jnp.float32)
    top_v, top_i = lax.top_k(logits, TOP_K)
    top_w = jax.nn.softmax(top_v, axis=-1)
    combine = jnp.sum(jax.nn.one_hot(top_i, N_EXPERTS, dtype=jnp.float32) * top_w[..., None], axis=-2)
    combine = combine.astype(h.dtype)
    out = combine[..., 0:1] * swiglu(h, w_gate_up[0], w_down[0])
    for e in range(1, N_EXPERTS):
        out = out + combine[..., e:e + 1] * swiglu(h, w_gate_up[e], w_down[e])
    return out


def setup_inputs(seed: int = 0) -> dict:
    key = jax.random.key(seed)
    ks = iter(jax.random.split(key, 32))

    def w(shape, fan_in):
        return jax.random.normal(next(ks), shape, jnp.float32) * (fan_in ** -0.5)

    def gain(shape):
        return 1.0 + 0.05 * jax.random.normal(next(ks), shape, jnp.float32)

    def small(shape, scale):
        return scale * jax.random.normal(next(ks), shape, jnp.float32)

    D = D_MODEL
    x = jax.random.normal(next(ks), (BATCH, SEQ, D), jnp.float32)
    offset = jax.random.randint(next(ks), (BATCH, 1), 0, 4096, dtype=jnp.int32)
    positions = offset + jnp.arange(SEQ, dtype=jnp.int32)[None, :]
    n_swa_qkv = (SWA_Q_HEADS + 2 * SWA_KV_HEADS) * SWA_HEAD_DIM
    return {
        'x': x,
        'positions': positions,
        'norm_mix': gain((DEPTH, D)),
        'norm_ffn': gain((DEPTH, D)),
        'norm_final': gain((D,)),
        'conv_w_in': w((N_CONV_LAYERS, D, 3 * D), D),
        'conv_w': w((N_CONV_LAYERS, CONV_WIDTH, D), CONV_WIDTH),
        'conv_w_out': w((N_CONV_LAYERS, D, D), D),
        'mla_w_down': w((N_MLA_LAYERS, D, MLA_Q_LORA + MLA_KV_LORA + MLA_ROPE), D),
        'mla_q_norm': gain((N_MLA_LAYERS, MLA_Q_LORA)),
        'mla_w_uq': w((N_MLA_LAYERS, MLA_Q_LORA, MLA_HEADS * (MLA_NOPE + MLA_ROPE)), MLA_Q_LORA),
        'mla_kv_norm': gain((N_MLA_LAYERS, MLA_KV_LORA)),
        'mla_w_ukv': w((N_MLA_LAYERS, MLA_KV_LORA, MLA_HEADS * (MLA_NOPE + MLA_V)), MLA_KV_LORA),
        'mla_w_o': w((N_MLA_LAYERS, MLA_HEADS * MLA_V, D), MLA_HEADS * MLA_V),
        'swa_w_qkv': w((N_SWA_LAYERS, D, n_swa_qkv), D),
        'swa_b_qkv': small((N_SWA_LAYERS, n_swa_qkv), 0.02),
        'swa_sinks': small((N_SWA_LAYERS, SWA_Q_HEADS), 0.5),
        'swa_w_o': w((N_SWA_LAYERS, SWA_Q_HEADS * SWA_HEAD_DIM, D), SWA_Q_HEADS * SWA_HEAD_DIM),
        'swa_b_o': small((N_SWA_LAYERS, D), 0.02),
        'ffn_w_gate_up': w((N_DENSE_LAYERS, D, 2 * D_FF), D),
        'ffn_w_down': w((N_DENSE_LAYERS, D_FF, D), D_FF),
        'moe_router': w((N_MOE_LAYERS, D, N_EXPERTS), D),
        'moe_w_gate_up': w((N_MOE_LAYERS, N_EXPERTS, D, 2 * D_FF_EXPERT), D),
        'moe_w_down': w((N_MOE_LAYERS, N_EXPERTS, D_FF_EXPERT, D), D_FF_EXPERT),
    }


def reference(x, positions, norm_mix, norm_ffn, norm_final,
              conv_w_in, conv_w, conv_w_out,
              mla_w_down, mla_q_norm, mla_w_uq, mla_kv_norm, mla_w_ukv, mla_w_o,
              swa_w_qkv, swa_b_qkv, swa_sinks, swa_w_o, swa_b_o,
              ffn_w_gate_up, ffn_w_down,
              moe_router, moe_w_gate_up, moe_w_down):
    for i in range(DEPTH):
        h = rmsnorm(x, norm_mix[i])
        kind = i % N_MIXERS
        j = i // N_MIXERS
        if kind == 0:
            m = short_conv(h, conv_w_in[j], conv_w[j], conv_w_out[j])
        elif kind == 1:
            m = mla_attention(h, positions, mla_w_down[j], mla_q_norm[j], mla_w_uq[j],
                              mla_kv_norm[j], mla_w_ukv[j], mla_w_o[j])
        else:
            m = swa_attention(h, positions, swa_w_qkv[j], swa_b_qkv[j], swa_sinks[j],
                              swa_w_o[j], swa_b_o[j])
        x = x + m
        h = rmsnorm(x, norm_ffn[i])
        f_idx = i // 2
        if i % 2 == 0:
            f = swiglu(h, ffn_w_gate_up[f_idx], ffn_w_down[f_idx])
        else:
            f = moe_swiglu(h, moe_router[f_idx], moe_w_gate_up[f_idx], moe_w_down[f_idx])
        x = x + f
    return rmsnorm(x, norm_final)
```

```cpp
#include <hip/hip_runtime.h>
#include <cstdio>
#include <cstdint>

#define LAS __attribute__((address_space(3)))
#define GAS __attribute__((address_space(1)))
typedef unsigned short bf16;
typedef short bf16x8 __attribute__((ext_vector_type(8)));
typedef short s16x4 __attribute__((ext_vector_type(4)));
typedef float f32x2 __attribute__((ext_vector_type(2)));
typedef float f32x4 __attribute__((ext_vector_type(4)));
typedef float f32x16 __attribute__((ext_vector_type(16)));
typedef unsigned u32x2 __attribute__((ext_vector_type(2)));
typedef unsigned u32x4 __attribute__((ext_vector_type(4)));

__device__ __forceinline__ unsigned cvt_pk_bf16(float lo, float hi) { unsigned r; asm volatile("v_cvt_pk_bf16_f32 %0, %1, %2" : "=v"(r) : "v"(lo), "v"(hi)); return r; }
__device__ __forceinline__ float bf2f(unsigned short b) { return __uint_as_float(((unsigned)b) << 16); }
__device__ __forceinline__ float bflo(unsigned w) { return __uint_as_float(w << 16); }
__device__ __forceinline__ float bfhi(unsigned w) { return __uint_as_float(w & 0xffff0000u); }
__device__ __forceinline__ float wave_sum(float v) {
#pragma unroll
    for (int o = 1; o < 64; o <<= 1) v += __shfl_xor(v, o);
    return v;
}
__device__ __forceinline__ float fast_silu(float g) { return g * __builtin_amdgcn_rcpf(1.0f + __builtin_amdgcn_exp2f(-1.4426950408889634f * g)); }

namespace pg8 {
constexpr int BM = 256, BK = 64, HALF = 128, HTB = HALF * BK * 2, STAGE_BYTES = 8 * HTB, NXCD = 8, WGM = 8;
__host__ __device__ __forceinline__ int lds_byte(int r, int c) { const int st = (r >> 4) * 2 + (c >> 5), rr = r & 15, cc = c & 31, ob = rr * 64 + cc * 2; return st * 1024 + (ob ^ (((ob >> 9) & 1) << 5)); }
__host__ __device__ __forceinline__ void stage_rc(int b, int& R, int& C) { const int st = b / 1024, sb = b % 1024, swz = sb ^ (((sb >> 9) & 1) << 5); R = (st >> 1) * 16 + swz / 64; C = (st & 1) * 32 + (swz % 64) / 2; }
__host__ __device__ __forceinline__ int perm32(int rho) { const int n = rho >> 4, i = rho & 15; return 8 * (i >> 2) + 4 * n + (i & 3); }

struct Unit { int pm, pn, e; };
struct Gemm { const bf16* A; const bf16* Bt; int lda, K; size_t estride; };

struct StaticOrder {
    int nM, nN, nwg, G, c;
    __device__ __forceinline__ void init(int M, int N, int G_, int c_) { nM = M / BM; nN = N / BM; nwg = nM * nN; G = G_; c = c_; }
    __device__ __forceinline__ bool next(int i, Unit& u) const {
        const long L = (long)i * G + c; if (L >= nwg) return false;
        int wgid = (int)L; { const int q = nwg / NXCD, r = nwg % NXCD, xcd = wgid % NXCD, off = wgid / NXCD; wgid = (xcd < r ? xcd * (q + 1) : r * (q + 1) + (xcd - r) * q) + off; }
        const int nig = WGM * nN, gid = wgid / nig, fm = gid * WGM, gsz = (nM - fm) < WGM ? (nM - fm) : WGM;
        u.pm = fm + ((wgid % nig) % gsz); u.pn = (wgid % nig) / gsz; u.e = 0; return true;
    }
};
struct GroupedOrder {
    const LAS unsigned* tab;
    __device__ __forceinline__ void init(const unsigned* pbase, int N, int G, int c, LAS unsigned* table, int cap) {
        const int tid = threadIdx.x;
        int pb[9];
#pragma unroll
        for (int i = 0; i < 9; ++i) pb[i] = (int)__hip_atomic_load(pbase + i, __ATOMIC_RELAXED, __HIP_MEMORY_SCOPE_AGENT);
        const int nM = pb[8], nN = N / BM, nwg = nM * nN;
        if (tid < cap) {
            unsigned w = 0u; const long L = (long)tid * G + c;
            if (L < nwg) {
                int wgid = (int)L; { const int q = nwg / NXCD, r = nwg % NXCD, xcd = wgid % NXCD, off = wgid / NXCD; wgid = (xcd < r ? xcd * (q + 1) : r * (q + 1) + (xcd - r) * q) + off; }
                const int nig = WGM * nN, gid = wgid / nig, fm = gid * WGM, gsz = (nM - fm) < WGM ? (nM - fm) : WGM;
                const int pm = fm + ((wgid % nig) % gsz), pn = (wgid % nig) / gsz;
                int e = 0;
#pragma unroll
                for (int j = 1; j < 8; ++j) e += (pm >= pb[j]) ? 1 : 0;
                w = (unsigned)pm | ((unsigned)pn << 12) | ((unsigned)e << 20) | 0x80000000u;
            }
            table[tid] = w;
        }
        tab = table;
        __syncthreads();
    }
    __device__ __forceinline__ bool next(int i, Unit& u) const {
        const unsigned w = (unsigned)__builtin_amdgcn_readfirstlane((int)tab[i]);
        u.pm = (int)(w & 0xfffu); u.pn = (int)((w >> 12) & 0xffu); u.e = (int)((w >> 20) & 0xfu); return (w >> 31) != 0u;
    }
};

struct EpiBf16 {
    static constexpr bool PERM = true;
    bf16* O; int ldc; const float* bias;
    __device__ __forceinline__ void operator()(const f32x4 (&acc)[2][2][4][2], const Unit& u, int wr, int wc, int fr, int fq) const {
        const int row0 = u.pm * BM + wr * 64 + fr, col0 = u.pn * BM + wc * 32 + 8 * fq;
        f32x4 bv[2][2];
#pragma unroll
        for (int bj = 0; bj < 2; ++bj)
#pragma unroll
            for (int n = 0; n < 2; ++n) bv[bj][n] = bias ? *(const f32x4*)(bias + col0 + bj * HALF + 4 * n) : (f32x4){0.f, 0.f, 0.f, 0.f};
#pragma unroll
        for (int ai = 0; ai < 2; ++ai)
#pragma unroll
            for (int m = 0; m < 4; ++m) { bf16* rowp = O + (size_t)(row0 + ai * HALF + m * 16) * ldc + col0;
#pragma unroll
                for (int bj = 0; bj < 2; ++bj) { const f32x4 v0 = acc[ai][bj][m][0] + bv[bj][0], v1 = acc[ai][bj][m][1] + bv[bj][1];
                    u32x4 w; w.x = cvt_pk_bf16(v0[0], v0[1]); w.y = cvt_pk_bf16(v0[2], v0[3]); w.z = cvt_pk_bf16(v1[0], v1[1]); w.w = cvt_pk_bf16(v1[2], v1[3]);
                    *(u32x4*)(rowp + bj * HALF) = w; } }
    }
};
template <int ACT  > struct EpiPair {
    static constexpr bool PERM = true;
    bf16* O; int ldc;
    __device__ __forceinline__ void operator()(const f32x4 (&acc)[2][2][4][2], const Unit& u, int wr, int wc, int fr, int fq) const {
        const int row0 = u.pm * BM + wr * 64 + fr, col0 = u.pn * HALF + wc * 32 + 8 * fq;
#pragma unroll
        for (int ai = 0; ai < 2; ++ai)
#pragma unroll
            for (int m = 0; m < 4; ++m) { bf16* rowp = O + (size_t)(row0 + ai * HALF + m * 16) * ldc + col0;
                f32x4 r[2];
#pragma unroll
                for (int n = 0; n < 2; ++n) { const f32x4 a = acc[ai][0][m][n], b = acc[ai][1][m][n];
                    if (ACT == 1) r[n] = (f32x4){fast_silu(a[0]) * b[0], fast_silu(a[1]) * b[1], fast_silu(a[2]) * b[2], fast_silu(a[3]) * b[3]};
                    else r[n] = a * b; }
                u32x4 w; w.x = cvt_pk_bf16(r[0][0], r[0][1]); w.y = cvt_pk_bf16(r[0][2], r[0][3]); w.z = cvt_pk_bf16(r[1][0], r[1][1]); w.w = cvt_pk_bf16(r[1][2], r[1][3]);
                *(u32x4*)rowp = w; }
    }
};
struct EpiRes {
    static constexpr bool PERM = false;
    const float* src; float* dst; int ldc; const float* bias;
    __device__ __forceinline__ void operator()(const f32x4 (&acc)[2][2][4][2], const Unit& u, int wr, int wc, int fr, int fq) const {
        const int row0 = u.pm * BM + wr * 64 + fr, col0 = u.pn * BM + wc * 32 + 4 * fq;
        f32x4 bv[2][2];
#pragma unroll
        for (int bj = 0; bj < 2; ++bj)
#pragma unroll
            for (int n = 0; n < 2; ++n) bv[bj][n] = bias ? *(const f32x4*)(bias + col0 + bj * HALF + n * 16) : (f32x4){0.f, 0.f, 0.f, 0.f};
#pragma unroll
        for (int ai = 0; ai < 2; ++ai)
#pragma unroll
            for (int m = 0; m < 4; ++m) { const size_t off = (size_t)(row0 + ai * HALF + m * 16) * ldc + col0;
                f32x4 s[2][2];
#pragma unroll
                for (int bj = 0; bj < 2; ++bj)
#pragma unroll
                    for (int n = 0; n < 2; ++n) s[bj][n] = *(const f32x4*)(src + off + bj * HALF + n * 16);
#pragma unroll
                for (int bj = 0; bj < 2; ++bj)
#pragma unroll
                    for (int n = 0; n < 2; ++n) *(f32x4*)(dst + off + bj * HALF + n * 16) = s[bj][n] + acc[ai][bj][m][n] + bv[bj][n];
                asm volatile("" ::: "memory"); }
    }
};
struct EpiF32 {
    static constexpr bool PERM = false;
    float* C; int ldc;
    __device__ __forceinline__ void operator()(const f32x4 (&acc)[2][2][4][2], const Unit& u, int wr, int wc, int fr, int fq) const {
        const int row0 = u.pm * BM + wr * 64 + fr, col0 = u.pn * BM + wc * 32 + 4 * fq;
#pragma unroll
        for (int ai = 0; ai < 2; ++ai)
#pragma unroll
            for (int m = 0; m < 4; ++m) { float* rowp = C + (size_t)(row0 + ai * HALF + m * 16) * ldc + col0;
#pragma unroll
                for (int bj = 0; bj < 2; ++bj)
#pragma unroll
                    for (int n = 0; n < 2; ++n) *(f32x4*)(rowp + bj * HALF + n * 16) = acc[ai][bj][m][n]; }
    }
};
struct EpiKV {
    static constexpr bool PERM = true;
    bf16* Kf; bf16* V;
    __device__ __forceinline__ void operator()(const f32x4 (&acc)[2][2][4][2], const Unit& u, int wr, int wc, int fr, int fq) const {
        const int row0 = u.pm * BM + wr * 64 + fr, col0 = wc * 32 + 8 * fq, h = u.pn;
#pragma unroll
        for (int ai = 0; ai < 2; ++ai)
#pragma unroll
            for (int m = 0; m < 4; ++m) { const int row = row0 + ai * HALF + m * 16, b = row >> 13, s = row & 8191; const size_t hr = (size_t)(b * 8 + h) * 8192 + s;
#pragma unroll
                for (int bj = 0; bj < 2; ++bj) { const f32x4 v0 = acc[ai][bj][m][0], v1 = acc[ai][bj][m][1];
                    u32x4 w; w.x = cvt_pk_bf16(v0[0], v0[1]); w.y = cvt_pk_bf16(v0[2], v0[3]); w.z = cvt_pk_bf16(v1[0], v1[1]); w.w = cvt_pk_bf16(v1[2], v1[3]);
                    if (bj == 0) *(u32x4*)(Kf + hr * 192 + col0) = w; else *(u32x4*)(V + hr * 128 + col0) = w; } }
    }
};

template <class Epi, class Sched>
__device__ __forceinline__ void gemm_phase(LAS unsigned char* lds, const Gemm g, const Sched& S, const Epi& E) {
    const int tid = threadIdx.x, wid = __builtin_amdgcn_readfirstlane(tid >> 6), lane = tid & 63, wr = wid >> 2, wc = wid & 3, fr = lane & 15, fq = lane >> 4;
    const int K = g.K, nt = K / BK, lda = g.lda;
    unsigned voffA[2], voffB[2];
#pragma unroll
    for (int i = 0; i < 2; ++i) { int R, C; stage_rc(tid * 16 + i * 8192, R, C); const int Rb = Epi::PERM ? ((R & ~31) + perm32(R & 31)) : R;
        voffA[i] = (unsigned)(R * lda + C) * 2u; voffB[i] = (unsigned)(Rb * K + C) * 2u; }
    const size_t kstep = (size_t)(BK * 2);
    const size_t hstepA = (size_t)HALF * lda * 2, hstepB = (size_t)HALF * K * 2;
    const size_t tstepA = 2 * hstepA, tstepB = 2 * hstepB;
    const unsigned ldsw = (unsigned)wid * 1024u;
    const int aoff = lds_byte(wr * 64 + fr, fq * 8), boff = lds_byte(wc * 32 + fr, fq * 8);
#define PG8_SA(b, h) (((b) * 2 + (h)) * HTB)
#define PG8_SB(b, h) ((4 + (b) * 2 + (h)) * HTB)
#define PG8_STAGE(bufoff, gbase, voff) do { _Pragma("unroll") for (int _i = 0; _i < 2; ++_i) \
        __builtin_amdgcn_global_load_lds((const unsigned*)((const char*)(gbase) + (voff)[_i]), (LAS unsigned*)(lds + (bufoff) + ldsw + _i * 8192), 16, 0, 0); } while (0)
#define PG8_LDA(dst, b, h) do { _Pragma("unroll") for (int m = 0; m < 4; ++m) _Pragma("unroll") for (int k = 0; k < 2; ++k) dst[m][k] = *(const LAS bf16x8*)(lds + PG8_SA(b, h) + aoff + m * 2048 + k * 1024); } while (0)
#define PG8_LDB(dst, b, h) do { _Pragma("unroll") for (int n = 0; n < 2; ++n) _Pragma("unroll") for (int k = 0; k < 2; ++k) dst[n][k] = *(const LAS bf16x8*)(lds + PG8_SB(b, h) + boff + n * 2048 + k * 1024); } while (0)
#define PG8_MMA(ai, bj, At, Bt) do { __builtin_amdgcn_s_setprio(1); _Pragma("unroll") for (int m = 0; m < 4; ++m) _Pragma("unroll") for (int n = 0; n < 2; ++n) _Pragma("unroll") for (int k = 0; k < 2; ++k) \
        acc[ai][bj][m][n] = __builtin_amdgcn_mfma_f32_16x16x32_bf16(Bt[n][k], At[m][k], acc[ai][bj][m][n], 0, 0, 0); __builtin_amdgcn_s_setprio(0); } while (0)
#define PG8_WAIT_V(n) asm volatile("s_waitcnt vmcnt(" #n ")" ::: "memory")
#define PG8_WAIT_L(n) asm volatile("s_waitcnt lgkmcnt(" #n ")" ::: "memory")
#define PG8_BAR __builtin_amdgcn_s_barrier()
#define PG8_SCHED __builtin_amdgcn_sched_barrier(0)
    Unit cur, nxt; int ui = 0;
    if (!S.next(0, cur)) return;
    f32x4 acc[2][2][4][2];
#pragma unroll
    for (int a = 0; a < 2; ++a)
#pragma unroll
        for (int b = 0; b < 2; ++b)
#pragma unroll
            for (int m = 0; m < 4; ++m)
#pragma unroll
                for (int n = 0; n < 2; ++n) acc[a][b][m][n] = (f32x4){0.f, 0.f, 0.f, 0.f};
    bf16x8 At[4][2], B0[2][2], B1[2][2];
    const char* cA = (const char*)g.A + (size_t)cur.pm * tstepA; const char* cB = (const char*)g.Bt + (size_t)cur.e * g.estride + (size_t)cur.pn * tstepB;
    PG8_STAGE(PG8_SB(0, 0), cB, voffB); PG8_STAGE(PG8_SB(0, 1), cB + hstepB, voffB); PG8_STAGE(PG8_SA(0, 0), cA, voffA); PG8_STAGE(PG8_SA(0, 1), cA + hstepA, voffA);
    if (wr == 1) PG8_BAR;
    PG8_WAIT_V(2); PG8_BAR;
    PG8_STAGE(PG8_SB(1, 0), cB + kstep, voffB); PG8_STAGE(PG8_SA(1, 0), cA + kstep, voffA); PG8_STAGE(PG8_SB(1, 1), cB + hstepB + kstep, voffB);
    PG8_WAIT_V(6); PG8_BAR;
    for (;;) {
        const bool has_next = S.next(ui + 1, nxt);
        const char* nA = has_next ? (const char*)g.A + (size_t)nxt.pm * tstepA : cA; const char* nB = has_next ? (const char*)g.Bt + (size_t)nxt.e * g.estride + (size_t)nxt.pn * tstepB : cB;
#pragma nounroll
        for (int t = 0; t < nt; t += 2) {
            const bool last = (t == nt - 2);
            const char* a1 = cA + (size_t)(t + 1) * kstep;
            const char* a2 = last ? nA : cA + (size_t)(t + 2) * kstep; const char* b2 = last ? nB : cB + (size_t)(t + 2) * kstep;
            const char* a3 = a2 + kstep; const char* b3 = b2 + kstep;
            PG8_LDB(B0, 0, 0); PG8_LDB(B1, 0, 1); PG8_SCHED; PG8_LDA(At, 0, 0); PG8_STAGE(PG8_SA(1, 1), a1 + hstepA, voffA);
            PG8_WAIT_V(8); PG8_WAIT_L(0); PG8_BAR; PG8_MMA(0, 0, At, B0); PG8_MMA(0, 1, At, B1); PG8_BAR; PG8_SCHED;
            PG8_LDA(At, 0, 1); PG8_STAGE(PG8_SB(0, 0), b2, voffB); PG8_STAGE(PG8_SB(0, 1), b2 + hstepB, voffB); PG8_STAGE(PG8_SA(0, 0), a2, voffA);
            PG8_WAIT_V(8); PG8_WAIT_L(0); PG8_BAR; PG8_MMA(1, 0, At, B0); PG8_MMA(1, 1, At, B1); PG8_BAR; PG8_SCHED;
            PG8_LDB(B0, 1, 0); PG8_LDB(B1, 1, 1); PG8_SCHED; PG8_LDA(At, 1, 0); PG8_STAGE(PG8_SA(0, 1), a2 + hstepA, voffA);
            PG8_WAIT_V(8); PG8_WAIT_L(0); PG8_BAR; PG8_MMA(0, 0, At, B0); PG8_MMA(0, 1, At, B1); PG8_BAR; PG8_SCHED;
            PG8_LDA(At, 1, 1); PG8_STAGE(PG8_SB(1, 0), b3, voffB); PG8_STAGE(PG8_SB(1, 1), b3 + hstepB, voffB); PG8_STAGE(PG8_SA(1, 0), a3, voffA);
            PG8_WAIT_V(8); PG8_WAIT_L(0); PG8_BAR; PG8_MMA(1, 0, At, B0); PG8_MMA(1, 1, At, B1); PG8_BAR; PG8_SCHED;
        }
        if (wr == 0) PG8_BAR;
        E(acc, cur, wr, wc, fr, fq);
        if (!has_next) break;
#pragma unroll
        for (int a = 0; a < 2; ++a)
#pragma unroll
            for (int b = 0; b < 2; ++b)
#pragma unroll
                for (int m = 0; m < 4; ++m)
#pragma unroll
                    for (int n = 0; n < 2; ++n) acc[a][b][m][n] = (f32x4){0.f, 0.f, 0.f, 0.f};
        cur = nxt; cA = nA; cB = nB; ++ui;
        if (wr == 1) PG8_BAR;
    }
    PG8_WAIT_V(0);
    PG8_BAR;
#undef PG8_SA
#undef PG8_SB
#undef PG8_STAGE
#undef PG8_LDA
#undef PG8_LDB
#undef PG8_MMA
#undef PG8_WAIT_V
#undef PG8_WAIT_L
#undef PG8_BAR
#undef PG8_SCHED
}
}
namespace att {
constexpr int NW = 8, QBLK = 32, KVBLK = 64, QB = NW * QBLK;
__device__ __forceinline__ int crow(int r, int hi) { return (r & 3) + 8 * (r >> 2) + 4 * hi; }
template <int NCB> __device__ __forceinline__ int v_st(int k, int c) { const int kk = (k & ~0xC) | ((k & 4) << 1) | ((k & 8) >> 1); return ((kk >> 3) * NCB + (c >> 5)) * 512 + ((kk & 7) * 32 + (c & 31)) * 2; }
__device__ __forceinline__ int v_rd_base(int lane) { return ((lane & 3) << 3) | (((lane >> 2) & 3) << 6) | (((lane >> 4) & 1) << 5) | (((lane >> 5) & 1) << 8); }

struct Params {
    const bf16* Q; int ldq;
    const bf16* K; int ldk;
    const bf16* V; int ldv;
    bf16* O; int ldo;
    int P0;
    int j_lo, j_hi;
    const float* rope;
    const int* pos;
    float slope_over_scale, sink_l2;
};

template <int DQK, int DV, int KIND, int W>
__device__ __forceinline__ void attn_block(const Params& p, char* lds) {
    constexpr int NKS = DQK / 64, ND0 = DQK / 16, NCB = DV / 32, NVP = DV / 64;
    constexpr int KT = NKS * 8192, VT = KVBLK * DV * 2;
    constexpr int OFF_K = 2 * VT, OFF_KP = OFF_K + 2 * KT, OFF_WS = OFF_KP + 2 * 256;
    const float SCALE = (DQK == 192) ? 0.07216878364870322f : 0.125f;
    const float C2 = 1.4426950408889634f * SCALE;
    constexpr float THR = 8.f;
    const int tid = threadIdx.x, wid = __builtin_amdgcn_readfirstlane(tid >> 6), lane = tid & 63, r32 = lane & 31, hi = lane >> 5;
    LAS unsigned char* lds3 = (LAS unsigned char*)lds; char* V_lds = lds; char* K_lds = lds + OFF_K; float* kp_lds = (float*)(lds + OFF_KP);
    float* ws = (float*)(lds + OFF_WS) + wid * 64; float* li_l = ws, * al_l = ws + 32;
    const int NT = p.j_hi - p.j_lo;
    const int qlo = p.P0 + wid * QBLK, qm = qlo + r32 - 4 * hi;
    unsigned kofs, vofs[NVP];
    { const int q = wid * 64 + lane, key = q >> 3, c = (q & 7) ^ ((key >> 1) & 7); kofs = (unsigned)(key * p.ldk + c * 8) * 2u; }
#pragma unroll
    for (int i = 0; i < NVP; ++i) { const int bo = (wid + 8 * i) * 1024 + lane * 16, sub = bo >> 9, within = bo & 511, kk = (sub / NCB) * 8 + (within >> 6), c = (sub % NCB) * 32 + ((within & 63) >> 1);
        const int k = (kk & ~0xC) | ((kk & 4) << 1) | ((kk & 8) >> 1); vofs[i] = (unsigned)(k * p.ldv + c) * 2u; }
    float st_p = 0.f;
#define ST_LOAD(kb, bf) do { \
        const char* kb_ = (const char*)p.K + (size_t)(kb) * (size_t)(p.ldk * 2); const char* vb_ = (const char*)p.V + (size_t)(kb) * (size_t)(p.ldv * 2); \
        _Pragma("unroll") for (int s_ = 0; s_ < NKS; ++s_) __builtin_amdgcn_global_load_lds((const unsigned*)(kb_ + kofs + s_ * 128), (LAS unsigned*)(lds3 + OFF_K + (bf) * KT + s_ * 8192 + wid * 1024), 16, 0, 0); \
        _Pragma("unroll") for (int i_ = 0; i_ < NVP; ++i_) __builtin_amdgcn_global_load_lds((const unsigned*)(vb_ + vofs[i_]), (LAS unsigned*)(lds3 + (bf) * VT + (wid + 8 * i_) * 1024), 16, 0, 0); \
        if (KIND == 1 && tid < 64) st_p = (float)p.pos[(kb) + tid]; } while (0)
#define ST_WRITE(bf) do { if (KIND == 1 && tid < 64) kp_lds[(bf) * 64 + tid] = st_p; } while (0)
    bf16x8 qr[ND0];
    ST_LOAD(p.j_lo * KVBLK, 0);
    { const bf16* qrow = p.Q + (size_t)(wid * QBLK + r32) * p.ldq + hi * 8;
#pragma unroll
      for (int d0 = 0; d0 < ND0; ++d0) qr[d0] = *(const bf16x8*)(qrow + d0 * 16); }
    float pq = 0.f;
    if (KIND == 0) {
        const float* rt = p.rope + (size_t)(wid * QBLK + r32) * 64;
#pragma unroll
        for (int dd = 0; dd < 2; ++dd) {
            const int i0 = dd * 16 + hi * 8;
            const f32x4 c0 = *(const f32x4*)(rt + i0), c1 = *(const f32x4*)(rt + i0 + 4), s0 = *(const f32x4*)(rt + 32 + i0), s1 = *(const f32x4*)(rt + 32 + i0 + 4);
            bf16x8 a = qr[8 + dd], b = qr[10 + dd]; u32x4 ra, rb; float x1[8], x2[8], cs[8], sn[8];
#pragma unroll
            for (int j = 0; j < 4; ++j) { cs[j] = c0[j]; cs[4 + j] = c1[j]; sn[j] = s0[j]; sn[4 + j] = s1[j]; }
#pragma unroll
            for (int j = 0; j < 8; ++j) { x1[j] = bf2f((unsigned short)a[j]); x2[j] = bf2f((unsigned short)b[j]); }
#pragma unroll
            for (int j = 0; j < 4; ++j) { ra[j] = cvt_pk_bf16(x1[2 * j] * cs[2 * j] - x2[2 * j] * sn[2 * j], x1[2 * j + 1] * cs[2 * j + 1] - x2[2 * j + 1] * sn[2 * j + 1]);
                                          rb[j] = cvt_pk_bf16(x2[2 * j] * cs[2 * j] + x1[2 * j] * sn[2 * j], x2[2 * j + 1] * cs[2 * j + 1] + x1[2 * j + 1] * sn[2 * j + 1]); }
            qr[8 + dd] = *reinterpret_cast<bf16x8*>(&ra); qr[10 + dd] = *reinterpret_cast<bf16x8*>(&rb);
        }
    } else { pq = (float)p.pos[qlo + r32]; }
    int ka[4];
#pragma unroll
    for (int j = 0; j < 4; ++j) ka[j] = r32 * 128 + (((2 * j + hi) ^ ((r32 >> 1) & 7)) << 4);
    const int vb0 = (int)(uintptr_t)V_lds + v_rd_base(lane);
    float m_reg = -1e30f, l_reg = 0.f; f32x16 o[NCB];
#pragma unroll
    for (int d = 0; d < NCB; ++d) o[d] = f32x16{};
    asm volatile("s_waitcnt vmcnt(0)" ::: "memory");
    ST_WRITE(0);
    __syncthreads();
#define TRRD(dst, off) asm volatile("ds_read_b64_tr_b16 %0, %1 offset:%2" : "=&v"(dst) : "v"(vb0), "i"(off) : "memory")
#define TILE(t, BF) do { \
        const int kb_ = (p.j_lo + (t)) * KVBLK; \
        if ((t) + 1 < NT) { const int kn_ = kb_ + KVBLK; ST_LOAD(kn_, (BF) ^ 1); } \
        const bool act_ = (kb_ <= qlo + QBLK - 1) && (kb_ + KVBLK - 1 >= qlo - W + 1); \
        if (act_) { \
            f32x16 p0 = f32x16{}, p1 = f32x16{}; \
            _Pragma("unroll") for (int d0 = 0; d0 < ND0; ++d0) { const char* a_ = K_lds + (BF) * KT + (d0 >> 2) * 8192 + ka[d0 & 3]; \
                const bf16x8 b0 = *(const bf16x8*)a_, b1 = *(const bf16x8*)(a_ + 4096); \
                p0 = __builtin_amdgcn_mfma_f32_32x32x16_bf16(b0, qr[d0], p0, 0, 0, 0); p1 = __builtin_amdgcn_mfma_f32_32x32x16_bf16(b1, qr[d0], p1, 0, 0, 0); } \
            if (KIND == 1) { const float* kq = kp_lds + (BF) * 64 + 4 * hi; \
                _Pragma("unroll") for (int g_ = 0; g_ < 4; ++g_) { const f32x4 k0 = *(const f32x4*)(kq + 8 * g_), k1 = *(const f32x4*)(kq + 32 + 8 * g_); \
                    _Pragma("unroll") for (int c_ = 0; c_ < 4; ++c_) { p0[4 * g_ + c_] = fmaf(-p.slope_over_scale, fabsf(pq - k0[c_]), p0[4 * g_ + c_]); p1[4 * g_ + c_] = fmaf(-p.slope_over_scale, fabsf(pq - k1[c_]), p1[4 * g_ + c_]); } } } \
            if (kb_ + KVBLK - 1 > qlo || kb_ <= qlo + QBLK - 1 - W) { const int dq_ = qm - kb_; const float NEG = -__builtin_inff(); \
                _Pragma("unroll") for (int r = 0; r < 16; ++r) { const int c_ = (r & 3) + 8 * (r >> 2); \
                    if ((unsigned)(dq_ - c_) >= (unsigned)W) p0[r] = NEG; if ((unsigned)(dq_ - c_ - 32) >= (unsigned)W) p1[r] = NEG; } } \
            float pmax = p0[0]; \
            _Pragma("unroll") for (int r = 1; r < 16; ++r) pmax = fmaxf(pmax, p0[r]); \
            _Pragma("unroll") for (int r = 0; r < 16; ++r) pmax = fmaxf(pmax, p1[r]); \
            { auto rr = __builtin_amdgcn_permlane32_swap(__float_as_uint(pmax), __float_as_uint(pmax), false, false); pmax = fmaxf(__uint_as_float(rr[0]), __uint_as_float(rr[1])); } \
            float mn, alpha; \
            if (__all((pmax - m_reg) * SCALE <= THR)) { mn = m_reg; alpha = 1.f; } \
            else { mn = fmaxf(m_reg, pmax); alpha = __builtin_amdgcn_exp2f((m_reg - mn) * C2); m_reg = mn; } \
            const float mnL = -mn * C2; float ps = 0.f; \
            _Pragma("unroll") for (int r = 0; r < 16; ++r) { p0[r] = __builtin_amdgcn_exp2f(fmaf(p0[r], C2, mnL)); p1[r] = __builtin_amdgcn_exp2f(fmaf(p1[r], C2, mnL)); } \
            _Pragma("unroll") for (int r = 0; r < 16; ++r) ps += p0[r] + p1[r]; \
            { auto rr = __builtin_amdgcn_permlane32_swap(__float_as_uint(ps), __float_as_uint(ps), false, false); ps = __uint_as_float(rr[0]) + __uint_as_float(rr[1]); } \
            l_reg = l_reg * alpha + ps; \
            bf16x8 pa[4]; \
            _Pragma("unroll") for (int q_ = 0; q_ < 4; ++q_) { const f32x16& P = (q_ < 2) ? p0 : p1; const int B_ = (q_ & 1) * 8; \
                const unsigned a0 = cvt_pk_bf16(P[B_ + 0], P[B_ + 1]), a1 = cvt_pk_bf16(P[B_ + 2], P[B_ + 3]), b0 = cvt_pk_bf16(P[B_ + 4], P[B_ + 5]), b1 = cvt_pk_bf16(P[B_ + 6], P[B_ + 7]); \
                auto r0 = __builtin_amdgcn_permlane32_swap(a0, b0, false, false); auto r1 = __builtin_amdgcn_permlane32_swap(a1, b1, false, false); \
                u32x4 w_ = {r0[0], r1[0], r0[1], r1[1]}; pa[q_] = *reinterpret_cast<bf16x8*>(&w_); } \
            if (__any(alpha < 1.f)) { if (hi == 0) al_l[r32] = alpha; asm volatile("s_waitcnt lgkmcnt(0)" ::: "memory"); \
                _Pragma("unroll") for (int r = 0; r < 16; ++r) { const float a_ = al_l[crow(r, hi)]; _Pragma("unroll") for (int d_ = 0; d_ < NCB; ++d_) o[d_][r] *= a_; } } \
            _Pragma("unroll") for (int d0 = 0; d0 < NCB; ++d0) { s16x4 l_[4], h_[4]; constexpr int b_ = (BF) * VT; \
                _Pragma("unroll") for (int ks = 0; ks < 4; ++ks) { TRRD(l_[ks], b_ + d0 * 512 + ks * (1024 * NCB)); TRRD(h_[ks], b_ + d0 * 512 + ks * (1024 * NCB) + 512 * NCB); } \
                asm volatile("s_waitcnt lgkmcnt(0)" ::: "memory"); __builtin_amdgcn_sched_barrier(0); \
                _Pragma("unroll") for (int ks = 0; ks < 4; ++ks) o[d0] = __builtin_amdgcn_mfma_f32_32x32x16_bf16(pa[ks], (bf16x8){l_[ks][0], l_[ks][1], l_[ks][2], l_[ks][3], h_[ks][0], h_[ks][1], h_[ks][2], h_[ks][3]}, o[d0], 0, 0, 0); } \
        } \
        if ((t) + 1 < NT) { asm volatile("s_waitcnt vmcnt(0)" ::: "memory"); ST_WRITE((BF) ^ 1); } \
        __syncthreads(); } while (0)
    for (int t = 0; t < NT; t += 2) {
        TILE(t, 0);
        if (t + 1 < NT) TILE(t + 1, 1);
    }
    if (KIND == 1) l_reg += __builtin_amdgcn_exp2f(p.sink_l2 - m_reg * C2);
    if (hi == 0) li_l[r32] = l_reg;
    asm volatile("s_waitcnt lgkmcnt(0)" ::: "memory");
    bf16* Ow = p.O + (size_t)(wid * QBLK) * p.ldo;
#pragma unroll
    for (int r = 0; r < 16; ++r) { const int orow = crow(r, hi); const float rl = __builtin_amdgcn_rcpf(li_l[orow]);
#pragma unroll
        for (int d0 = 0; d0 < NCB; ++d0) { const float v = o[d0][r] * rl; const float vn = __shfl_xor(v, 1);
            if ((r32 & 1) == 0) *(unsigned*)(Ow + (size_t)orow * p.ldo + d0 * 32 + r32) = cvt_pk_bf16(v, vn); } }
    __syncthreads();
#undef TILE
#undef TRRD
#undef ST_LOAD
#undef ST_WRITE
}
constexpr int LDS_MLA = 2 * (64 * 128 * 2) + 2 * (3 * 8192) + 512 + 8 * 256;
constexpr int LDS_SWA = 2 * (64 * 64 * 2) + 2 * 8192 + 512 + 8 * 256;
}
constexpr int NWAVES = 8, NTHREADS = NWAVES * 64;
constexpr int D = 1024, NB = 8, SEQ = 8192, T = NB * SEQ;
constexpr int FF = 2816, NE = 8, FE = 3584;
constexpr int QL = 384, KVL = 256, MH = 8, DQKM = 192, DVM = 128;
constexpr int MDN = 704, MDNP = 768;
constexpr int SQKV = 1280;
constexpr int MAXPAN = 520, MAXSLOT = MAXPAN * 256;
constexpr float EPS = 1e-6f;
constexpr size_t MiB = 1u << 20;
constexpr size_t WS_CTL = 0, CTL_ZERO_BYTES = 256 * 1024;
constexpr size_t WS_RT = 1 * MiB;
constexpr size_t RT_E = WS_RT, RT_W0 = RT_E + (size_t)T * 4, RT_W1 = RT_W0 + (size_t)T * 4, RT_S0 = RT_W1 + (size_t)T * 4, RT_S1 = RT_S0 + (size_t)T * 4, RT_CNT = RT_S1 + (size_t)T * 4, RT_PB = RT_CNT + 256 * 8 * 4;
constexpr size_t WS_ROPE = 8 * MiB;
constexpr size_t WS_W = 24 * MiB;
constexpr size_t W_CINB = WS_W, W_CINCU = W_CINB + 2 * (size_t)1024 * 1024 * 2, W_COUT = W_CINCU + 2 * (size_t)2048 * 1024 * 2;
constexpr size_t W_MDN = W_COUT + 2 * (size_t)1024 * 1024 * 2, W_MUQ = W_MDN + (size_t)MDNP * 1024 * 2, W_MUKV = W_MUQ + (size_t)1536 * QL * 2, W_MO = W_MUKV + (size_t)2048 * KVL * 2;
constexpr size_t W_SQKV = W_MO + (size_t)1024 * 1024 * 2, W_SO = W_SQKV + (size_t)SQKV * 1024 * 2;
constexpr size_t W_FGU = W_SO + (size_t)1024 * 1024 * 2, W_FD = W_FGU + 2 * (size_t)(2 * FF) * 1024 * 2;
constexpr size_t W_MGU = W_FD + 2 * (size_t)1024 * FF * 2, W_MD = W_MGU + 16 * (size_t)(2 * FE) * 1024 * 2, W_RT = W_MD + 16 * (size_t)1024 * FE * 2;
constexpr size_t W_END = W_RT + 2 * (size_t)8 * 1024 * 4;
constexpr size_t WS_XN = 420 * MiB;
constexpr size_t WS_XG = 548 * MiB;
constexpr size_t WS_BIG = 808 * MiB;
constexpr size_t WS_END = WS_BIG + (size_t)MAXSLOT * FE * 2;
static_assert(W_END <= WS_XN && WS_XN + (size_t)T * D * 2 <= WS_XG && WS_XG + (size_t)MAXSLOT * D * 2 <= WS_BIG, "d_ws map");
constexpr size_t B_CONV_B = 0, B_CONV_V = 128 * MiB, B_CONV_Y = 256 * MiB;
constexpr size_t B_HMID = 0;
constexpr size_t B_MC = 0, B_MO = 0, B_MCQ = 192 * MiB, B_MCKV = 240 * MiB, B_MQ = 272 * MiB, B_MK = 464 * MiB, B_MV = 656 * MiB;
constexpr size_t B_SQKV = 0, B_SO = 160 * MiB;
constexpr int CW_DBG = 8;
constexpr int CW_BAR = 1024;
constexpr int RING_BYTES = 131072, MISC_OFF = RING_BYTES, LDS_BYTES = 147456;

#define RLX_AGENT __ATOMIC_RELAXED, __HIP_MEMORY_SCOPE_AGENT
#define XB_TMO      128
#define XB_XCNT(j)  (256  + 64 * (j))
#define XB_XSUB(j)  (1280 + 64 * (j))
#define XB_XGEN(j)  (2304 + 64 * (j))
#define XB_TOP      3328
#define XB_TOPGEN   3392
#define XCD_BAR_WORDS 3456
#define XB_SPIN_CAP (1u << 18)
__device__ __forceinline__ unsigned xb_ld(unsigned* p)              { return __hip_atomic_load(p, __ATOMIC_RELAXED, __HIP_MEMORY_SCOPE_AGENT); }
__device__ __forceinline__ unsigned xb_add(unsigned* p, unsigned v) { return __hip_atomic_fetch_add(p, v, __ATOMIC_RELAXED, __HIP_MEMORY_SCOPE_AGENT); }
__device__ __forceinline__ unsigned xb_xcc_id() { return (unsigned)__builtin_amdgcn_s_getreg((3 << 11) | 20) & 0xFu; }
#define XB_SPIN(cond, bar) do { unsigned _sp = 0; while (cond) { __builtin_amdgcn_s_sleep(1); \
    if ((++_sp & 255u) == 0u) { if (xb_ld(&(bar)[XB_TMO])) break; if (_sp > XB_SPIN_CAP) { atomicAdd(&(bar)[XB_TMO], 1u); break; } } } } while (0)
struct XcdBarrier { unsigned* bar; unsigned x; volatile LAS unsigned* st; };
__device__ __forceinline__ XcdBarrier xcd_barrier_post(unsigned* bar, volatile LAS unsigned* st) {
    XcdBarrier b; b.bar = bar; b.x = xb_xcc_id(); b.st = st;
    if (threadIdx.x == 0) (void)xb_add(&bar[XB_XCNT(b.x)], 1u);
    return b;
}
__device__ __forceinline__ void xcd_barrier_complete(unsigned* bar, unsigned x, unsigned& nloc, unsigned& nx) {
    const unsigned G = gridDim.x * gridDim.y * gridDim.z;
    unsigned sum, cnt, mine, sp = 0u;
    for (;;) {
        sum = 0u; cnt = 0u; mine = 0u;
#pragma unroll
        for (unsigned j = 0; j < 16; ++j) { const unsigned c = xb_ld(&bar[XB_XCNT(j)]); sum += c; cnt += (c > 0u) ? 1u : 0u; mine = (j == x) ? c : mine; }
        if (sum == G) break;
        __builtin_amdgcn_s_sleep(1);
        if ((++sp & 255u) == 0u) { if (xb_ld(&bar[XB_TMO])) break; if (sp > XB_SPIN_CAP) { atomicAdd(&bar[XB_TMO], 1u); break; } }
    }
    nloc = mine > 0u ? mine : 1u; nx = cnt > 0u ? cnt : 1u;
}
__device__ __forceinline__ void xcd_barrier(const XcdBarrier& b) {
    asm volatile("s_waitcnt vmcnt(0)" ::: "memory");
    __syncthreads();
    if (threadIdx.x == 0) {
        unsigned* bar = b.bar;
        __builtin_amdgcn_s_waitcnt(0);
        unsigned nloc = b.st[0], nx = b.st[1];
        if (nloc == 0u) { xcd_barrier_complete(bar, b.x, nloc, nx); b.st[0] = nloc; b.st[1] = nx; }
        const unsigned old = xb_add(&bar[XB_XSUB(b.x)], 1u);
        const unsigned gen = old / nloc;
        if (old + 1u == (gen + 1u) * nloc) {
            __builtin_amdgcn_fence(__ATOMIC_RELEASE, "agent");
            asm volatile("s_waitcnt vmcnt(0)" ::: "memory");
            const unsigned og = xb_add(&bar[XB_TOP], 1u);
            const unsigned tg = og / nx;
            if (og + 1u == (tg + 1u) * nx) xb_add(&bar[XB_TOPGEN], 1u);
            else XB_SPIN(xb_ld(&bar[XB_TOPGEN]) == tg, bar);
            __builtin_amdgcn_fence(__ATOMIC_ACQUIRE, "agent");
            xb_add(&bar[XB_XGEN(b.x)], 1u);
            asm volatile("s_waitcnt vmcnt(0)" ::: "memory");
        } else {
            XB_SPIN(xb_ld(&bar[XB_XGEN(b.x)]) == gen, bar);
            __builtin_amdgcn_fence(__ATOMIC_ACQUIRE, "agent");
            asm volatile("s_waitcnt vmcnt(0)" ::: "memory");
        }
    }
    __syncthreads();
}

struct TC { int tid, lane, wave; };
__device__ __forceinline__ TC tc_get() { TC t; int x = threadIdx.x; asm volatile("" : "+v"(x)); t.tid = x; t.lane = x & 63; t.wave = __builtin_amdgcn_readfirstlane(x >> 6); return t; }
struct Frame {
    char* lds; int vcu, G;
    unsigned char* ws; float* out;
    const float* const* in;
};
#define LDS_WAIT() asm volatile("s_waitcnt lgkmcnt(0)" ::: "memory")
#define VM_WAIT() asm volatile("s_waitcnt vmcnt(0)" ::: "memory")

template <int MAP>
__device__ __forceinline__ void tr_item(const float* W, int K, int N, int ldw, bf16* WT, float* scr, int item, int lane) {
    const int nblk = N / 32, kb = item / nblk, nb = item % nblk, k0 = 64 * kb, n0 = 32 * nb;
    int r0 = n0;
    if (MAP == 1) { const int F = N / 2; r0 = (n0 < F) ? 256 * (n0 / 128) + (n0 % 128) : 256 * ((n0 - F) / 128) + 128 + ((n0 - F) % 128); }
    const float* src = W + (size_t)(k0 + (lane >> 5)) * ldw + n0 + (lane & 31);
#pragma unroll 16
    for (int i = 0; i < 32; ++i) scr[(2 * i + (lane >> 5)) * 33 + (lane & 31)] = src[(size_t)(2 * i) * ldw];
    LDS_WAIT(); asm volatile("" ::: "memory");
    const int c = lane & 7;
#pragma unroll
    for (int j = 0; j < 4; ++j) { const int n = (lane >> 3) + 8 * j; const float* s = scr + (8 * c) * 33 + n;
        u32x4 o; o.x = cvt_pk_bf16(s[0 * 33], s[1 * 33]); o.y = cvt_pk_bf16(s[2 * 33], s[3 * 33]); o.z = cvt_pk_bf16(s[4 * 33], s[5 * 33]); o.w = cvt_pk_bf16(s[6 * 33], s[7 * 33]);
        *(u32x4*)(WT + (size_t)(r0 + n) * K + k0 + 8 * c) = o; }
    LDS_WAIT(); asm volatile("" ::: "memory");
}
template <int MAP>
__device__ __forceinline__ void tr_matrix(Frame& F, const float* W, int K, int N, int ldw, bf16* WT, int rot) {
    const TC tc = tc_get();
    float* scr = (float*)(F.lds + tc.wave * 8448);
    const int NGW = F.G * NWAVES, gw = (F.vcu * NWAVES + tc.wave + rot) % NGW, nitems = (K / 64) * (N / 32);
    for (int it = gw; it < nitems; it += NGW) tr_item<MAP>(W, K, N, ldw, WT, scr, it, tc.lane);
}

struct RowArgs { const float* Xsrc; float* Xdst; const float* g; bf16* XN; float* outF; const bf16* Y; const int* s0; const int* s1; const float* w0; const float* w1;
                 const float* routerT; unsigned* rt_e; float* rt_w0; float* rt_w1; unsigned* cnt; };
template <int MODE, bool COMBINE>
__device__ __forceinline__ void row_pass(Frame& F, const RowArgs& a) {
    const TC tc = tc_get();
    const int lane = tc.lane;
    float* rtab = (float*)F.lds;
    unsigned* wcnt = (unsigned*)(F.lds + 32768);
    if (MODE == 1) { for (int i = tc.tid; i < 8 * 1024; i += NTHREADS) rtab[i] = a.routerT[i]; }
    f32x4 gv[4];
#pragma unroll
    for (int j = 0; j < 4; ++j) gv[j] = *(const f32x4*)(a.g + 4 * lane + 256 * j);
    for (int tb = blockIdx.x; tb < T / 256; tb += F.G) {
        if (MODE == 1) { if (tc.tid < 64) wcnt[tc.tid] = 0u; __syncthreads(); }
        unsigned myc[8] = {0u, 0u, 0u, 0u, 0u, 0u, 0u, 0u};
        for (int rr = 0; rr < 32; ++rr) {
            const int row = tb * 256 + tc.wave * 32 + rr;
            const f32x4* xr = (const f32x4*)(a.Xsrc + (size_t)row * D) + lane;
            f32x4 v[4];
#pragma unroll
            for (int j = 0; j < 4; ++j) v[j] = xr[64 * j];
            if (COMBINE) {
                const int sa = a.s0[row], sb = a.s1[row]; const float wa = a.w0[row], wb = a.w1[row];
                const u32x2* ya = (const u32x2*)(a.Y + (size_t)sa * D) + lane; const u32x2* yb = (const u32x2*)(a.Y + (size_t)sb * D) + lane;
#pragma unroll
                for (int j = 0; j < 4; ++j) { const u32x2 pa = ya[64 * j], pb = yb[64 * j];
                    v[j].x += wa * bflo(pa.x) + wb * bflo(pb.x); v[j].y += wa * bfhi(pa.x) + wb * bfhi(pb.x);
                    v[j].z += wa * bflo(pa.y) + wb * bflo(pb.y); v[j].w += wa * bfhi(pa.y) + wb * bfhi(pb.y); }
                if (MODE != 2) { f32x4* xd = (f32x4*)(a.Xdst + (size_t)row * D) + lane;
#pragma unroll
                    for (int j = 0; j < 4; ++j) xd[64 * j] = v[j]; }
            }
            float ss = 0.f;
#pragma unroll
            for (int j = 0; j < 4; ++j) ss += (v[j].x * v[j].x + v[j].y * v[j].y) + (v[j].z * v[j].z + v[j].w * v[j].w);
            const float rstd = 1.0f / sqrtf(wave_sum(ss) * (1.f / D) + EPS);
#pragma unroll
            for (int j = 0; j < 4; ++j) v[j] = v[j] * rstd * gv[j];
            if (MODE == 2) { f32x4* od = (f32x4*)(a.outF + (size_t)row * D) + lane;
#pragma unroll
                for (int j = 0; j < 4; ++j) od[64 * j] = v[j];
            } else { u32x2* o8 = (u32x2*)(a.XN + (size_t)row * D) + lane;
#pragma unroll
                for (int j = 0; j < 4; ++j) { u32x2 w; w.x = cvt_pk_bf16(v[j].x, v[j].y); w.y = cvt_pk_bf16(v[j].z, v[j].w); o8[64 * j] = w; } }
            if (MODE == 1) {
                float lg[8];
#pragma unroll
                for (int e = 0; e < 8; ++e) { float s = 0.f;
#pragma unroll
                    for (int j = 0; j < 4; ++j) { const f32x4 r = *(const f32x4*)(rtab + e * 1024 + 256 * j + 4 * lane); s += (v[j].x * r.x + v[j].y * r.y) + (v[j].z * r.z + v[j].w * r.w); }
                    lg[e] = wave_sum(s); }
                int e0 = 0; float v0 = lg[0];
#pragma unroll
                for (int e = 1; e < 8; ++e) if (lg[e] > v0) { v0 = lg[e]; e0 = e; }
                int e1 = -1; float v1 = -3.0e38f;
#pragma unroll
                for (int e = 0; e < 8; ++e) if (e != e0 && lg[e] > v1) { v1 = lg[e]; e1 = e; }
                const float w0 = 1.0f / (1.0f + __expf(v1 - v0)), w1 = 1.0f - w0;
                if (lane == 0) { a.rt_e[row] = (unsigned)e0 | ((unsigned)e1 << 8); a.rt_w0[row] = w0; a.rt_w1[row] = w1; }
#pragma unroll
                for (int e = 0; e < 8; ++e) myc[e] += (e == e0 || e == e1) ? 1u : 0u;
            }
        }
        if (MODE == 1) {
            if (lane < 8) { unsigned c = 0;
#pragma unroll
                for (int e = 0; e < 8; ++e) c = (lane == e) ? myc[e] : c;
                wcnt[tc.wave * 8 + lane] = c; }
            __syncthreads();
            if (tc.tid < 8) { unsigned c = 0; for (int w = 0; w < 8; ++w) c += wcnt[w * 8 + tc.tid]; a.cnt[tb * 8 + tc.tid] = c; }
            __syncthreads();
        }
    }
}

__device__ __forceinline__ void moe_assign(Frame& F, const unsigned* cnt, const unsigned* rt_e, int* s0, int* s1, unsigned* pbase_out, const bf16* XN, bf16* XG) {
    const TC tc = tc_get();
    unsigned* tot = (unsigned*)F.lds;
    unsigned* pre = tot + 64;
    unsigned long long* msk = (unsigned long long*)(F.lds + 1024);
    int* slt = (int*)(F.lds + 2048);
    if (tc.tid < 8) tot[tc.tid] = 0u;
    __syncthreads();
    { unsigned part[8] = {0, 0, 0, 0, 0, 0, 0, 0};
      if (tc.tid < 256) {
#pragma unroll
          for (int e = 0; e < 8; ++e) part[e] = __hip_atomic_load(cnt + tc.tid * 8 + e, RLX_AGENT); }
#pragma unroll
      for (int e = 0; e < 8; ++e) { unsigned s = part[e];
#pragma unroll
          for (int o = 1; o < 64; o <<= 1) s += __shfl_xor(s, o);
          if (tc.lane == 0 && tc.wave < 4) atomicAdd(&tot[e], s); } }
    __syncthreads();
    if (tc.tid == 0) { unsigned p = 0; for (int e = 0; e < 8; ++e) { tot[8 + e] = p; p += (tot[e] + 255u) / 256u; } tot[16] = p;
        if (blockIdx.x == 0) for (int e = 0; e < 9; ++e) __hip_atomic_store(pbase_out + e, tot[8 + e], RLX_AGENT); }
    __syncthreads();
    for (int tb = blockIdx.x; tb < T / 256; tb += F.G) {
        if (tc.tid < 8) { unsigned s = 0; for (int b = 0; b < tb; ++b) s += __hip_atomic_load(cnt + b * 8 + tc.tid, RLX_AGENT); pre[tc.tid] = s; }
        int e0 = 0, e1 = 0;
        if (tc.tid < 256) { const unsigned pe = rt_e[tb * 256 + tc.tid]; e0 = pe & 0xff; e1 = (pe >> 8) & 0xff;
#pragma unroll
            for (int e = 0; e < 8; ++e) { const unsigned long long m = __ballot(e0 == e || e1 == e); if (tc.lane == 0) msk[e * 4 + tc.wave] = m; } }
        __syncthreads();
        if (tc.tid < 256) {
            int sl[2];
#pragma unroll
            for (int k = 0; k < 2; ++k) { const int e = k ? e1 : e0; unsigned rank = 0;
                for (int w = 0; w < tc.wave; ++w) rank += __popcll(msk[e * 4 + w]);
                rank += __popcll(msk[e * 4 + tc.wave] & ((1ull << tc.lane) - 1ull));
                sl[k] = (int)(tot[8 + e] * 256u + pre[e] + rank); }
            s0[tb * 256 + tc.tid] = sl[0]; s1[tb * 256 + tc.tid] = sl[1]; slt[2 * tc.tid] = sl[0]; slt[2 * tc.tid + 1] = sl[1];
        }
        __syncthreads();
        for (int rr = 0; rr < 32; ++rr) { const int i = tc.wave * 32 + rr; const int row = tb * 256 + i; const int sa = slt[2 * i], sb = slt[2 * i + 1];
            const u32x4* src = (const u32x4*)(XN + (size_t)row * D) + tc.lane; const u32x4 a = src[0], b = src[64];
            u32x4* d0 = (u32x4*)(XG + (size_t)sa * D) + tc.lane; u32x4* d1 = (u32x4*)(XG + (size_t)sb * D) + tc.lane;
            d0[0] = a; d0[64] = b; d1[0] = a; d1[64] = b; }
        __syncthreads();
    }
}

__device__ __forceinline__ void conv_pass(Frame& F, const bf16* Bc, const bf16* Vc, const float* wconv, bf16* Yc) {
    const TC tc = tc_get();
    const int sub = tc.tid >> 7, ch = (tc.tid & 127) * 8;
    float w[3][8];
#pragma unroll
    for (int j = 0; j < 3; ++j) { const f32x4 a = *(const f32x4*)(wconv + j * D + ch), b = *(const f32x4*)(wconv + j * D + ch + 4);
#pragma unroll
        for (int c = 0; c < 4; ++c) { w[j][c] = a[c]; w[j][4 + c] = b[c]; } }
    for (int run = blockIdx.x * 4 + sub; run < T / 32; run += F.G * 4) {
        const int t0 = run * 32, s0 = t0 & (SEQ - 1);
        float p2[8], p1[8];
        { u32x4 a = {0, 0, 0, 0}, b = {0, 0, 0, 0};
          if (s0 >= 2) { a = *(const u32x4*)(Vc + (size_t)(t0 - 2) * D + ch); b = *(const u32x4*)(Vc + (size_t)(t0 - 1) * D + ch); }
#pragma unroll
          for (int c = 0; c < 4; ++c) { p2[2 * c] = bflo(a[c]); p2[2 * c + 1] = bfhi(a[c]); p1[2 * c] = bflo(b[c]); p1[2 * c + 1] = bfhi(b[c]); } }
#pragma unroll 4
        for (int i = 0; i < 32; ++i) { const size_t o = (size_t)(t0 + i) * D + ch;
            const u32x4 vv = *(const u32x4*)(Vc + o), bb = *(const u32x4*)(Bc + o); float cur[8], y[8];
#pragma unroll
            for (int c = 0; c < 4; ++c) { cur[2 * c] = bflo(vv[c]); cur[2 * c + 1] = bfhi(vv[c]); }
#pragma unroll
            for (int c = 0; c < 8; ++c) { const float bq = (c & 1) ? bfhi(bb[c >> 1]) : bflo(bb[c >> 1]); y[c] = bq * (w[0][c] * p2[c] + w[1][c] * p1[c] + w[2][c] * cur[c]); p2[c] = p1[c]; p1[c] = cur[c]; }
            u32x4 r; r.x = cvt_pk_bf16(y[0], y[1]); r.y = cvt_pk_bf16(y[2], y[3]); r.z = cvt_pk_bf16(y[4], y[5]); r.w = cvt_pk_bf16(y[6], y[7]);
            *(u32x4*)(Yc + o) = r; }
    }
}

__device__ __forceinline__ void rope_table(Frame& F, const int* pos, float* tab) {
    const TC tc = tc_get();
    const int i = tc.lane & 31; const float inv = __builtin_amdgcn_exp2f(-(float)i * (13.287712379549449f / 32.0f));
    const int NGW = F.G * NWAVES, gw = F.vcu * NWAVES + tc.wave;
    for (int t = gw * 2 + (tc.lane >> 5); t < T; t += NGW * 2) {
        const float ang = (float)pos[t] * inv;
        const float k = rintf(ang * 0.15915494309189535f);
        float r = fmaf(-k, 6.28125f, ang); r = fmaf(-k, 1.9353071795864769e-3f, r);
        tab[(size_t)t * 64 + i] = __cosf(r); tab[(size_t)t * 64 + 32 + i] = __sinf(r);
    }
}

__device__ __forceinline__ void mla_mid(Frame& F, const float* C, const float* gq, const float* gkv, const float* tab, bf16* cqn, bf16* ckvn, bf16* Kf) {
    const TC tc = tc_get();
    const int lane = tc.lane, NGW = F.G * NWAVES, gw = F.vcu * NWAVES + tc.wave;
    f32x2 gqv[3];
#pragma unroll
    for (int j = 0; j < 3; ++j) gqv[j] = *(const f32x2*)(gq + 2 * lane + 128 * j);
    const f32x4 gk = *(const f32x4*)(gkv + 4 * lane);
    for (int t = gw; t < T; t += NGW) {
        const float* c = C + (size_t)t * MDNP;
        f32x2 q[3]; float ss = 0.f;
#pragma unroll
        for (int j = 0; j < 3; ++j) { q[j] = *(const f32x2*)(c + 2 * lane + 128 * j); ss += q[j].x * q[j].x + q[j].y * q[j].y; }
        const f32x4 kv = *(const f32x4*)(c + QL + 4 * lane);
        const float x = c[QL + KVL + lane];
        const float rq = 1.0f / sqrtf(wave_sum(ss) * (1.f / QL) + EPS);
        const float rk = 1.0f / sqrtf(wave_sum((kv.x * kv.x + kv.y * kv.y) + (kv.z * kv.z + kv.w * kv.w)) * (1.f / KVL) + EPS);
#pragma unroll
        for (int j = 0; j < 3; ++j) *(unsigned*)(cqn + (size_t)t * QL + 2 * lane + 128 * j) = cvt_pk_bf16(q[j].x * rq * gqv[j].x, q[j].y * rq * gqv[j].y);
        { u32x2 w; w.x = cvt_pk_bf16(kv.x * rk * gk.x, kv.y * rk * gk.y); w.y = cvt_pk_bf16(kv.z * rk * gk.z, kv.w * rk * gk.w); *(u32x2*)(ckvn + (size_t)t * KVL + 4 * lane) = w; }
        const float other = __shfl_xor(x, 32); const int i = lane & 31;
        const float cs = tab[(size_t)t * 64 + i], sn = tab[(size_t)t * 64 + 32 + i];
        const float r = (lane < 32) ? (x * cs - other * sn) : (x * cs + other * sn);
        const float rn = __shfl_xor(r, 1);
        if ((lane & 1) == 0) { const unsigned pk = cvt_pk_bf16(r, rn); const int b = t >> 13, s = t & (SEQ - 1);
#pragma unroll
            for (int h = 0; h < MH; ++h) *(unsigned*)(Kf + ((size_t)(b * MH + h) * SEQ + s) * DQKM + 128 + lane) = pk; }
    }
}
template <class Epi>
__device__ __forceinline__ void gemm_static(Frame& F, const bf16* A, int lda, int K, const bf16* Bt, int N, const Epi& E) {
    pg8::Gemm g{A, Bt, lda, K, 0}; pg8::StaticOrder S; S.init(T, N, F.G, (int)blockIdx.x);
    pg8::gemm_phase<Epi, pg8::StaticOrder>((LAS unsigned char*)F.lds, g, S, E);
}
template <class Epi>
__device__ __forceinline__ void gemm_grouped(Frame& F, const bf16* A, int lda, int K, const bf16* Bt, size_t estride, int N, const unsigned* pbase, const Epi& E) {
    pg8::Gemm g{A, Bt, lda, K, estride}; pg8::GroupedOrder S; S.init(pbase, N, F.G, (int)blockIdx.x, (LAS unsigned*)((LAS unsigned char*)F.lds + MISC_OFF + 512), 128);
    pg8::gemm_phase<Epi, pg8::GroupedOrder>((LAS unsigned char*)F.lds, g, S, E);
}
__device__ __forceinline__ void prologue(Frame& F) {
    const float* const* in = F.in; unsigned char* ws = F.ws;
    int rot = 0;
#define TRM(MAP, W, K, N, ldw, dst) do { tr_matrix<MAP>(F, (W), (K), (N), (ldw), (bf16*)(ws + (dst)), rot); rot += 37; } while (0)
    for (int j = 0; j < 2; ++j) {
        TRM(0, in[5] + (size_t)j * 1024 * 3072, 1024, 1024, 3072, W_CINB + (size_t)j * 1024 * 1024 * 2);
        TRM(1, in[5] + (size_t)j * 1024 * 3072 + 1024, 1024, 2048, 3072, W_CINCU + (size_t)j * 2048 * 1024 * 2);
        TRM(0, in[7] + (size_t)j * 1024 * 1024, 1024, 1024, 1024, W_COUT + (size_t)j * 1024 * 1024 * 2);
        TRM(1, in[19] + (size_t)j * 1024 * 2 * FF, 1024, 2 * FF, 2 * FF, W_FGU + (size_t)j * 2 * FF * 1024 * 2);
        TRM(0, in[20] + (size_t)j * FF * 1024, FF, 1024, 1024, W_FD + (size_t)j * 1024 * FF * 2);
    }
    TRM(0, in[8], 1024, MDN, MDN, W_MDN);
    TRM(0, in[10], QL, 1536, 1536, W_MUQ);
    TRM(0, in[12], KVL, 2048, 2048, W_MUKV);
    TRM(0, in[13], 1024, 1024, 1024, W_MO);
    TRM(0, in[14], 1024, SQKV, SQKV, W_SQKV);
    TRM(0, in[17], 1024, 1024, 1024, W_SO);
    for (int le = 0; le < 16; ++le) {
        TRM(1, in[22] + (size_t)le * 1024 * 2 * FE, 1024, 2 * FE, 2 * FE, W_MGU + (size_t)le * 2 * FE * 1024 * 2);
        TRM(0, in[23] + (size_t)le * FE * 1024, FE, 1024, 1024, W_MD + (size_t)le * 1024 * FE * 2);
    }
#undef TRM
    const TC tc = tc_get();
    const int gt = F.vcu * NTHREADS + tc.tid, NGT = F.G * NTHREADS;
    for (int i = gt; i < (MDNP - MDN) * 1024 / 2; i += NGT) ((unsigned*)(ws + W_MDN + (size_t)MDN * 1024 * 2))[i] = 0u;
    for (int i = gt; i < 2 * 8 * 1024; i += NGT) { const int l = i >> 13, e = (i >> 10) & 7, k = i & 1023; ((float*)(ws + W_RT))[i] = in[21][(size_t)l * 1024 * 8 + k * 8 + e]; }
    rope_table(F, (const int*)in[1], (float*)(ws + WS_ROPE));
}

__device__ __forceinline__ void mla_attention(Frame& F) {
    unsigned char* big = F.ws + WS_BIG;
    const bf16* Q = (const bf16*)(big + B_MQ); const bf16* Kf = (const bf16*)(big + B_MK); const bf16* V = (const bf16*)(big + B_MV); bf16* O = (bf16*)(big + B_MO);
    const float* tab = (const float*)(F.ws + WS_ROPE);
    for (int L = blockIdx.x; L < NB * MH * 16; L += F.G) {
        const int xcd = L & 7, kk = L >> 3, bh = xcd * 8 + (kk >> 4), x = kk & 15, b = bh >> 3, h = bh & 7;
        for (int pass = 0; pass < 2; ++pass) {
            const int qb = pass ? 31 - x : x; const size_t row0 = (size_t)b * SEQ + qb * 256;
            att::Params p;
            p.Q = Q + row0 * 1536 + h * DQKM; p.ldq = 1536;
            p.K = Kf + (size_t)bh * SEQ * DQKM; p.ldk = DQKM; p.V = V + (size_t)bh * SEQ * DVM; p.ldv = DVM;
            p.O = O + row0 * 1024 + h * DVM; p.ldo = 1024; p.P0 = qb * 256; p.j_lo = 0; p.j_hi = 4 * (qb + 1);
            p.rope = tab + row0 * 64; p.pos = nullptr; p.slope_over_scale = 0.f; p.sink_l2 = 0.f;
            att::attn_block<192, 128, 0, (1 << 30)>(p, F.lds);
        }
    }
}
__device__ __forceinline__ void swa_attention(Frame& F) {
    unsigned char* big = F.ws + WS_BIG;
    const bf16* QKV = (const bf16*)(big + B_SQKV); bf16* O = (bf16*)(big + B_SO);
    const int* pos = (const int*)F.in[1]; const float* sinks = F.in[16];
    for (int L = blockIdx.x; L < NB * 16 * 32; L += F.G) {
        const int xcd = L & 7, kk = L >> 3, pair = xcd * 2 + (kk >> 8), u = kk & 255, qb = u >> 3, g = u & 7, b = pair >> 1, kvh = pair & 1, qh = kvh * 8 + g;
        const size_t row0 = (size_t)b * SEQ + qb * 256;
        att::Params p;
        p.Q = QKV + row0 * SQKV + qh * 64; p.ldq = SQKV;
        p.K = QKV + (size_t)b * SEQ * SQKV + 1024 + kvh * 64; p.ldk = SQKV; p.V = QKV + (size_t)b * SEQ * SQKV + 1152 + kvh * 64; p.ldv = SQKV;
        p.O = O + row0 * 1024 + qh * 64; p.ldo = 1024; p.P0 = qb * 256; p.j_lo = qb ? 4 * qb - 2 : 0; p.j_hi = 4 * qb + 4;
        p.rope = nullptr; p.pos = pos + (size_t)b * SEQ;
        p.slope_over_scale = __builtin_amdgcn_exp2f(-0.5f * (float)(qh + 1)) * 8.0f;
        p.sink_l2 = sinks[qh] * 1.4426950408889634f;
        att::attn_block<64, 64, 1, 128>(p, F.lds);
    }
}

struct Args { const float* in[24]; float* out; unsigned char* ws; int ph_lo, ph_hi; };
constexpr int N_PHASES = 33;
__global__ void __launch_bounds__(NTHREADS, 2) mega(Args args) {
    extern __shared__ __attribute__((aligned(16))) unsigned char lds_raw[];
    Frame F;
    F.lds = (char*)lds_raw;
    F.G = gridDim.x; { const int bx = blockIdx.x; F.vcu = (F.G % 8 == 0) ? (bx % 8) * (F.G / 8) + bx / 8 : bx; }
    F.ws = args.ws; F.out = args.out; F.in = args.in;
    unsigned char* ws = args.ws; unsigned char* big = ws + WS_BIG;
    unsigned* ctl = (unsigned*)(ws + WS_CTL);
    volatile LAS unsigned* misc = (volatile LAS unsigned*)((LAS unsigned char*)lds_raw + MISC_OFF);
    if (threadIdx.x < 32) misc[threadIdx.x] = 0u;
    __syncthreads();
    const int lo = args.ph_lo, hi = args.ph_hi;
    XcdBarrier bar; bar.bar = ctl + CW_BAR; bar.x = 0; bar.st = nullptr;
    if (hi - lo > 1) bar = xcd_barrier_post(ctl + CW_BAR, misc + 8);
#ifndef PH_SEL
#define PH_SEL -1
#endif
#define IN(k) ((PH_SEL < 0 || PH_SEL == (k)) && lo <= (k) && (k) < hi)
#define SEAM(k) do { if (IN(k) && IN((k) + 1)) xcd_barrier(bar); } while (0)
    const float* x_in = args.in[0]; float* X = args.out;
    bf16* XN = (bf16*)(ws + WS_XN); bf16* XG = (bf16*)(ws + WS_XG);
    unsigned* rt_e = (unsigned*)(ws + RT_E); float* rt_w0 = (float*)(ws + RT_W0); float* rt_w1 = (float*)(ws + RT_W1); int* rt_s0 = (int*)(ws + RT_S0); int* rt_s1 = (int*)(ws + RT_S1);
    unsigned* rt_cnt = (unsigned*)(ws + RT_CNT); unsigned* rt_pb = (unsigned*)(ws + RT_PB);
    const float* nmix = args.in[2]; const float* nffn = args.in[3];

    if (IN(0)) { prologue(F); __syncthreads();
        RowArgs a{}; a.Xsrc = x_in; a.g = nmix; a.XN = XN; row_pass<0, false>(F, a); }
    SEAM(0);
    if (IN(1)) { gemm_static(F, XN, D, D, (const bf16*)(ws + W_CINB), 1024, pg8::EpiBf16{(bf16*)(big + B_CONV_B), D, nullptr});
                 gemm_static(F, XN, D, D, (const bf16*)(ws + W_CINCU), 2048, pg8::EpiPair<0>{(bf16*)(big + B_CONV_V), D}); }
    SEAM(1);
    if (IN(2)) conv_pass(F, (const bf16*)(big + B_CONV_B), (const bf16*)(big + B_CONV_V), args.in[6], (bf16*)(big + B_CONV_Y));
    SEAM(2);
    if (IN(3)) gemm_static(F, (const bf16*)(big + B_CONV_Y), D, D, (const bf16*)(ws + W_COUT), 1024, pg8::EpiRes{x_in, X, D, nullptr});
    SEAM(3);
    if (IN(4)) { RowArgs a{}; a.Xsrc = X; a.g = nffn; a.XN = XN; row_pass<0, false>(F, a); }
    SEAM(4);
    if (IN(5)) gemm_static(F, XN, D, D, (const bf16*)(ws + W_FGU), 2 * FF, pg8::EpiPair<1>{(bf16*)(big + B_HMID), FF});
    SEAM(5);
    if (IN(6)) gemm_static(F, (const bf16*)(big + B_HMID), FF, FF, (const bf16*)(ws + W_FD), 1024, pg8::EpiRes{X, X, D, nullptr});
    SEAM(6);
    if (IN(7)) { RowArgs a{}; a.Xsrc = X; a.g = nmix + D; a.XN = XN; row_pass<0, false>(F, a); }
    SEAM(7);
    if (IN(8)) gemm_static(F, XN, D, D, (const bf16*)(ws + W_MDN), MDNP, pg8::EpiF32{(float*)(big + B_MC), MDNP});
    SEAM(8);
    if (IN(9)) mla_mid(F, (const float*)(big + B_MC), args.in[9], args.in[11], (const float*)(ws + WS_ROPE), (bf16*)(big + B_MCQ), (bf16*)(big + B_MCKV), (bf16*)(big + B_MK));
    SEAM(9);
    if (IN(10)) {
#ifndef NO_UQ
 gemm_static(F, (const bf16*)(big + B_MCQ), QL, QL, (const bf16*)(ws + W_MUQ), 1536, pg8::EpiBf16{(bf16*)(big + B_MQ), 1536, nullptr});
#endif
#ifndef NO_UKV
                  gemm_static(F, (const bf16*)(big + B_MCKV), KVL, KVL, (const bf16*)(ws + W_MUKV), 2048, pg8::EpiKV{(bf16*)(big + B_MK), (bf16*)(big + B_MV)});
#endif
 }
    SEAM(10);
    if (IN(11)) mla_attention(F);
    SEAM(11);
    if (IN(12)) gemm_static(F, (const bf16*)(big + B_MO), D, D, (const bf16*)(ws + W_MO), 1024, pg8::EpiRes{X, X, D, nullptr});
    SEAM(12);
    if (IN(13)) { RowArgs a{}; a.Xsrc = X; a.g = nffn + D; a.XN = XN; a.routerT = (const float*)(ws + W_RT); a.rt_e = rt_e; a.rt_w0 = rt_w0; a.rt_w1 = rt_w1; a.cnt = rt_cnt; row_pass<1, false>(F, a); }
    SEAM(13);
    if (IN(14)) moe_assign(F, rt_cnt, rt_e, rt_s0, rt_s1, rt_pb, XN, XG);
    SEAM(14);
    if (IN(15)) gemm_grouped(F, XG, D, D, (const bf16*)(ws + W_MGU), (size_t)2 * FE * 1024 * 2, 2 * FE, rt_pb, pg8::EpiPair<1>{(bf16*)big, FE});
    SEAM(15);
    if (IN(16)) gemm_grouped(F, (const bf16*)big, FE, FE, (const bf16*)(ws + W_MD), (size_t)1024 * FE * 2, 1024, rt_pb, pg8::EpiBf16{XG, D, nullptr});
    SEAM(16);
    if (IN(17)) { RowArgs a{}; a.Xsrc = X; a.Xdst = X; a.g = nmix + 2 * D; a.XN = XN; a.Y = XG; a.s0 = rt_s0; a.s1 = rt_s1; a.w0 = rt_w0; a.w1 = rt_w1; row_pass<0, true>(F, a); }
    SEAM(17);
    if (IN(18)) gemm_static(F, XN, D, D, (const bf16*)(ws + W_SQKV), SQKV, pg8::EpiBf16{(bf16*)(big + B_SQKV), SQKV, args.in[15]});
    SEAM(18);
    if (IN(19)) swa_attention(F);
    SEAM(19);
    if (IN(20)) gemm_static(F, (const bf16*)(big + B_SO), D, D, (const bf16*)(ws + W_SO), 1024, pg8::EpiRes{X, X, D, args.in[18]});
    SEAM(20);
    if (IN(21)) { RowArgs a{}; a.Xsrc = X; a.g = nffn + 2 * D; a.XN = XN; row_pass<0, false>(F, a); }
    SEAM(21);
    if (IN(22)) gemm_static(F, XN, D, D, (const bf16*)(ws + W_FGU + (size_t)2 * FF * 1024 * 2), 2 * FF, pg8::EpiPair<1>{(bf16*)(big + B_HMID), FF});
    SEAM(22);
    if (IN(23)) gemm_static(F, (const bf16*)(big + B_HMID), FF, FF, (const bf16*)(ws + W_FD + (size_t)1024 * FF * 2), 1024, pg8::EpiRes{X, X, D, nullptr});
    SEAM(23);
    if (IN(24)) { RowArgs a{}; a.Xsrc = X; a.g = nmix + 3 * D; a.XN = XN; row_pass<0, false>(F, a); }
    SEAM(24);
    if (IN(25)) { gemm_static(F, XN, D, D, (const bf16*)(ws + W_CINB + (size_t)1024 * 1024 * 2), 1024, pg8::EpiBf16{(bf16*)(big + B_CONV_B), D, nullptr});
                  gemm_static(F, XN, D, D, (const bf16*)(ws + W_CINCU + (size_t)2048 * 1024 * 2), 2048, pg8::EpiPair<0>{(bf16*)(big + B_CONV_V), D}); }
    SEAM(25);
    if (IN(26)) conv_pass(F, (const bf16*)(big + B_CONV_B), (const bf16*)(big + B_CONV_V), args.in[6] + 3 * D, (bf16*)(big + B_CONV_Y));
    SEAM(26);
    if (IN(27)) gemm_static(F, (const bf16*)(big + B_CONV_Y), D, D, (const bf16*)(ws + W_COUT + (size_t)1024 * 1024 * 2), 1024, pg8::EpiRes{X, X, D, nullptr});
    SEAM(27);
    if (IN(28)) { RowArgs a{}; a.Xsrc = X; a.g = nffn + 3 * D; a.XN = XN; a.routerT = (const float*)(ws + W_RT) + 8 * 1024; a.rt_e = rt_e; a.rt_w0 = rt_w0; a.rt_w1 = rt_w1; a.cnt = rt_cnt; row_pass<1, false>(F, a); }
    SEAM(28);
    if (IN(29)) moe_assign(F, rt_cnt, rt_e, rt_s0, rt_s1, rt_pb + 16, XN, XG);
    SEAM(29);
    if (IN(30)) gemm_grouped(F, XG, D, D, (const bf16*)(ws + W_MGU + (size_t)8 * 2 * FE * 1024 * 2), (size_t)2 * FE * 1024 * 2, 2 * FE, rt_pb + 16, pg8::EpiPair<1>{(bf16*)big, FE});
    SEAM(30);
    if (IN(31)) gemm_grouped(F, (const bf16*)big, FE, FE, (const bf16*)(ws + W_MD + (size_t)8 * 1024 * FE * 2), (size_t)1024 * FE * 2, 1024, rt_pb + 16, pg8::EpiBf16{XG, D, nullptr});
    SEAM(31);
    if (IN(32)) { RowArgs a{}; a.Xsrc = X; a.g = args.in[4]; a.outF = X; a.Y = XG; a.s0 = rt_s0; a.s1 = rt_s1; a.w0 = rt_w0; a.w1 = rt_w1; row_pass<2, true>(F, a); }
#undef IN
#undef SEAM
}

#ifndef MK_LAUNCH_PER_PHASE
#define MK_LAUNCH_PER_PHASE 1
#endif
extern "C" void kernel_launch(void* const* d_in, const int* in_sizes, int n_in, void* d_out, int out_size, void* d_ws, size_t ws_size, hipStream_t stream) {
    static int grid = 0;
    if (grid == 0) {
        if (n_in != 24 || in_sizes[0] != T * D || out_size != T * D || ws_size < WS_END) { fprintf(stderr, "kernel_launch: unexpected shapes (n_in %d, in0 %d, out %d, ws %zu < %zu); nothing launched\n", n_in, n_in > 0 ? in_sizes[0] : -1, out_size, ws_size, (size_t)WS_END); grid = -1; return; }
        int dev = 0, cus = 0, per_cu = 0;
        if (hipGetDevice(&dev) != hipSuccess || hipDeviceGetAttribute(&cus, hipDeviceAttributeMultiprocessorCount, dev) != hipSuccess) { grid = -1; return; }
        if (hipFuncSetAttribute((const void*)mega, hipFuncAttributeMaxDynamicSharedMemorySize, LDS_BYTES) != hipSuccess) { fprintf(stderr, "kernel_launch: hipFuncSetAttribute failed\n"); grid = -1; return; }
        if (hipOccupancyMaxActiveBlocksPerMultiprocessor(&per_cu, (const void*)mega, NTHREADS, LDS_BYTES) != hipSuccess || per_cu < 1) fprintf(stderr, "kernel_launch: occupancy query reports %d\n", per_cu);
        (void)hipGetLastError();
        grid = cus;
    }
    if (grid < 0) return;
    (void)hipMemsetAsync((char*)d_ws + WS_CTL, 0, CTL_ZERO_BYTES, stream);
    Args a{};
    for (int i = 0; i < 24; ++i) a.in[i] = (const float*)d_in[i];
    a.out = (float*)d_out; a.ws = (unsigned char*)d_ws;
#if MK_LAUNCH_PER_PHASE
    for (int p = 0; p < N_PHASES; ++p) { a.ph_lo = p; a.ph_hi = p + 1; hipLaunchKernelGGL(mega, dim3(grid), dim3(NTHREADS), LDS_BYTES, stream, a); }
#else
    a.ph_lo = 0; a.ph_hi = N_PHASES; hipLaunchKernelGGL(mega, dim3(grid), dim3(NTHREADS), LDS_BYTES, stream, a);
#endif
}
```

```cpp
#include <hip/hip_runtime.h>
#include <cstdio>
#include <cstdint>

#define LAS __attribute__((address_space(3)))
#define GAS __attribute__((address_space(1)))
typedef unsigned short bf16;
typedef short bf16x8 __attribute__((ext_vector_type(8)));
typedef short s16x4 __attribute__((ext_vector_type(4)));
typedef float f32x2 __attribute__((ext_vector_type(2)));
typedef float f32x4 __attribute__((ext_vector_type(4)));
typedef float f32x16 __attribute__((ext_vector_type(16)));
typedef unsigned u32x2 __attribute__((ext_vector_type(2)));
typedef unsigned u32x4 __attribute__((ext_vector_type(4)));

__device__ __forceinline__ unsigned cvt_pk_bf16(float lo, float hi) { unsigned r; asm volatile("v_cvt_pk_bf16_f32 %0, %1, %2" : "=v"(r) : "v"(lo), "v"(hi)); return r; }
__device__ __forceinline__ float bf2f(unsigned short b) { return __uint_as_float(((unsigned)b) << 16); }
__device__ __forceinline__ float bflo(unsigned w) { return __uint_as_float(w << 16); }
__device__ __forceinline__ float bfhi(unsigned w) { return __uint_as_float(w & 0xffff0000u); }
__device__ __forceinline__ float wave_sum(float v) {
#pragma unroll
    for (int o = 1; o < 64; o <<= 1) v += __shfl_xor(v, o);
    return v;
}
__device__ __forceinline__ float fast_silu(float g) { return g * __builtin_amdgcn_rcpf(1.0f + __builtin_amdgcn_exp2f(-1.4426950408889634f * g)); }

namespace pg8 {
constexpr int BM = 256, BK = 64, HALF = 128, HTB = HALF * BK * 2, STAGE_BYTES = 8 * HTB, NXCD = 8, WGM = 8;
__host__ __device__ __forceinline__ int lds_byte(int r, int c) { const int st = (r >> 4) * 2 + (c >> 5), rr = r & 15, cc = c & 31, ob = rr * 64 + cc * 2; return st * 1024 + (ob ^ (((ob >> 9) & 1) << 5)); }
__host__ __device__ __forceinline__ void stage_rc(int b, int& R, int& C) { const int st = b / 1024, sb = b % 1024, swz = sb ^ (((sb >> 9) & 1) << 5); R = (st >> 1) * 16 + swz / 64; C = (st & 1) * 32 + (swz % 64) / 2; }
__host__ __device__ __forceinline__ int perm32(int rho) { const int n = rho >> 4, i = rho & 15; return 8 * (i >> 2) + 4 * n + (i & 3); }

struct Unit { int pm, pn, e; };
struct Gemm { const bf16* A; const bf16* Bt; int lda, K; size_t estride; };

struct StaticOrder {
    int nM, nN, nwg, G, c;
    __device__ __forceinline__ void init(int M, int N, int G_, int c_) { nM = M / BM; nN = N / BM; nwg = nM * nN; G = G_; c = c_; }
    __device__ __forceinline__ bool next(int i, Unit& u) const {
        const long L = (long)i * G + c; if (L >= nwg) return false;
        int wgid = (int)L; { const int q = nwg / NXCD, r = nwg % NXCD, xcd = wgid % NXCD, off = wgid / NXCD; wgid = (xcd < r ? xcd * (q + 1) : r * (q + 1) + (xcd - r) * q) + off; }
        const int nig = WGM * nN, gid = wgid / nig, fm = gid * WGM, gsz = (nM - fm) < WGM ? (nM - fm) : WGM;
        u.pm = fm + ((wgid % nig) % gsz); u.pn = (wgid % nig) / gsz; u.e = 0; return true;
    }
};
struct GroupedOrder {
    const LAS unsigned* tab;
    __device__ __forceinline__ void init(const unsigned* pbase, int N, int G, int c, LAS unsigned* table, int cap) {
        const int tid = threadIdx.x;
        int pb[9];
#pragma unroll
        for (int i = 0; i < 9; ++i) pb[i] = (int)__hip_atomic_load(pbase + i, __ATOMIC_RELAXED, __HIP_MEMORY_SCOPE_AGENT);
        const int nM = pb[8], nN = N / BM, nwg = nM * nN;
        if (tid < cap) {
            unsigned w = 0u; const long L = (long)tid * G + c;
            if (L < nwg) {
                int wgid = (int)L; { const int q = nwg / NXCD, r = nwg % NXCD, xcd = wgid % NXCD, off = wgid / NXCD; wgid = (xcd < r ? xcd * (q + 1) : r * (q + 1) + (xcd - r) * q) + off; }
                const int nig = WGM * nN, gid = wgid / nig, fm = gid * WGM, gsz = (nM - fm) < WGM ? (nM - fm) : WGM;
                const int pm = fm + ((wgid % nig) % gsz), pn = (wgid % nig) / gsz;
                int e = 0;
#pragma unroll
                for (int j = 1; j < 8; ++j) e += (pm >= pb[j]) ? 1 : 0;
                w = (unsigned)pm | ((unsigned)pn << 12) | ((unsigned)e << 20) | 0x80000000u;
            }
            table[tid] = w;
        }
        tab = table;
        __syncthreads();
    }
    __device__ __forceinline__ bool next(int i, Unit& u) const {
        const unsigned w = (unsigned)__builtin_amdgcn_readfirstlane((int)tab[i]);
        u.pm = (int)(w & 0xfffu); u.pn = (int)((w >> 12) & 0xffu); u.e = (int)((w >> 20) & 0xfu); return (w >> 31) != 0u;
    }
};

struct EpiBf16 {
    static constexpr bool PERM = true;
    bf16* O; int ldc; const float* bias;
    __device__ __forceinline__ void operator()(const f32x4 (&acc)[2][2][4][2], const Unit& u, int wr, int wc, int fr, int fq) const {
        const int row0 = u.pm * BM + wr * 64 + fr, col0 = u.pn * BM + wc * 32 + 8 * fq;
        f32x4 bv[2][2];
#pragma unroll
        for (int bj = 0; bj < 2; ++bj)
#pragma unroll
            for (int n = 0; n < 2; ++n) bv[bj][n] = bias ? *(const f32x4*)(bias + col0 + bj * HALF + 4 * n) : (f32x4){0.f, 0.f, 0.f, 0.f};
#pragma unroll
        for (int ai = 0; ai < 2; ++ai)
#pragma unroll
            for (int m = 0; m < 4; ++m) { bf16* rowp = O + (size_t)(row0 + ai * HALF + m * 16) * ldc + col0;
#pragma unroll
                for (int bj = 0; bj < 2; ++bj) { const f32x4 v0 = acc[ai][bj][m][0] + bv[bj][0], v1 = acc[ai][bj][m][1] + bv[bj][1];
                    u32x4 w; w.x = cvt_pk_bf16(v0[0], v0[1]); w.y = cvt_pk_bf16(v0[2], v0[3]); w.z = cvt_pk_bf16(v1[0], v1[1]); w.w = cvt_pk_bf16(v1[2], v1[3]);
                    *(u32x4*)(rowp + bj * HALF) = w; } }
    }
};
template <int ACT  > struct EpiPair {
    static constexpr bool PERM = true;
    bf16* O; int ldc;
    __device__ __forceinline__ void operator()(const f32x4 (&acc)[2][2][4][2], const Unit& u, int wr, int wc, int fr, int fq) const {
        const int row0 = u.pm * BM + wr * 64 + fr, col0 = u.pn * HALF + wc * 32 + 8 * fq;
#pragma unroll
        for (int ai = 0; ai < 2; ++ai)
#pragma unroll
            for (int m = 0; m < 4; ++m) { bf16* rowp = O + (size_t)(row0 + ai * HALF + m * 16) * ldc + col0;
                f32x4 r[2];
#pragma unroll
                for (int n = 0; n < 2; ++n) { const f32x4 a = acc[ai][0][m][n], b = acc[ai][1][m][n];
                    if (ACT == 1) r[n] = (f32x4){fast_silu(a[0]) * b[0], fast_silu(a[1]) * b[1], fast_silu(a[2]) * b[2], fast_silu(a[3]) * b[3]};
                    else r[n] = a * b; }
                u32x4 w; w.x = cvt_pk_bf16(r[0][0], r[0][1]); w.y = cvt_pk_bf16(r[0][2], r[0][3]); w.z = cvt_pk_bf16(r[1][0], r[1][1]); w.w = cvt_pk_bf16(r[1][2], r[1][3]);
                *(u32x4*)rowp = w; }
    }
};
struct EpiRes {
    static constexpr bool PERM = false;
    const float* src; float* dst; int ldc; const float* bias;
    __device__ __forceinline__ void operator()(const f32x4 (&acc)[2][2][4][2], const Unit& u, int wr, int wc, int fr, int fq) const {
        const int row0 = u.pm * BM + wr * 64 + fr, col0 = u.pn * BM + wc * 32 + 4 * fq;
        f32x4 bv[2][2];
#pragma unroll
        for (int bj = 0; bj < 2; ++bj)
#pragma unroll
            for (int n = 0; n < 2; ++n) bv[bj][n] = bias ? *(const f32x4*)(bias + col0 + bj * HALF + n * 16) : (f32x4){0.f, 0.f, 0.f, 0.f};
#pragma unroll
        for (int ai = 0; ai < 2; ++ai)
#pragma unroll
            for (int m = 0; m < 4; ++m) { const size_t off = (size_t)(row0 + ai * HALF + m * 16) * ldc + col0;
                f32x4 s[2][2];
#pragma unroll
                for (int bj = 0; bj < 2; ++bj)
#pragma unroll
                    for (int n = 0; n < 2; ++n) s[bj][n] = *(const f32x4*)(src + off + bj * HALF + n * 16);
#pragma unroll
                for (int bj = 0; bj < 2; ++bj)
#pragma unroll
                    for (int n = 0; n < 2; ++n) *(f32x4*)(dst + off + bj * HALF + n * 16) = s[bj][n] + acc[ai][bj][m][n] + bv[bj][n];
                asm volatile("" ::: "memory"); }
    }
};
struct EpiF32 {
    static constexpr bool PERM = false;
    float* C; int ldc;
    __device__ __forceinline__ void operator()(const f32x4 (&acc)[2][2][4][2], const Unit& u, int wr, int wc, int fr, int fq) const {
        const int row0 = u.pm * BM + wr * 64 + fr, col0 = u.pn * BM + wc * 32 + 4 * fq;
#pragma unroll
        for (int ai = 0; ai < 2; ++ai)
#pragma unroll
            for (int m = 0; m < 4; ++m) { float* rowp = C + (size_t)(row0 + ai * HALF + m * 16) * ldc + col0;
#pragma unroll
                for (int bj = 0; bj < 2; ++bj)
#pragma unroll
                    for (int n = 0; n < 2; ++n) *(f32x4*)(rowp + bj * HALF + n * 16) = acc[ai][bj][m][n]; }
    }
};
struct EpiKV {
    static constexpr bool PERM = true;
    bf16* Kf; bf16* V;
    __device__ __forceinline__ void operator()(const f32x4 (&acc)[2][2][4][2], const Unit& u, int wr, int wc, int fr, int fq) const {
        const int row0 = u.pm * BM + wr * 64 + fr, col0 = wc * 32 + 8 * fq, h = u.pn;
#pragma unroll
        for (int ai = 0; ai < 2; ++ai)
#pragma unroll
            for (int m = 0; m < 4; ++m) { const int row = row0 + ai * HALF + m * 16, b = row >> 13, s = row & 8191; const size_t hr = (size_t)(b * 8 + h) * 8192 + s;
#pragma unroll
                for (int bj = 0; bj < 2; ++bj) { const f32x4 v0 = acc[ai][bj][m][0], v1 = acc[ai][bj][m][1];
                    u32x4 w; w.x = cvt_pk_bf16(v0[0], v0[1]); w.y = cvt_pk_bf16(v0[2], v0[3]); w.z = cvt_pk_bf16(v1[0], v1[1]); w.w = cvt_pk_bf16(v1[2], v1[3]);
                    if (bj == 0) *(u32x4*)(Kf + hr * 192 + col0) = w; else *(u32x4*)(V + hr * 128 + col0) = w; } }
    }
};

template <class Epi, class Sched>
__device__ __forceinline__ void gemm_phase(LAS unsigned char* lds, const Gemm g, const Sched& S, const Epi& E) {
    const int tid = threadIdx.x, wid = __builtin_amdgcn_readfirstlane(tid >> 6), lane = tid & 63, wr = wid >> 2, wc = wid & 3, fr = lane & 15, fq = lane >> 4;
    const int K = g.K, nt = K / BK, lda = g.lda;
    unsigned voffA[2], voffB[2];
#pragma unroll
    for (int i = 0; i < 2; ++i) { int R, C; stage_rc(tid * 16 + i * 8192, R, C); const int Rb = Epi::PERM ? ((R & ~31) + perm32(R & 31)) : R;
        voffA[i] = (unsigned)(R * lda + C) * 2u; voffB[i] = (unsigned)(Rb * K + C) * 2u; }
    const size_t kstep = (size_t)(BK * 2);
    const size_t hstepA = (size_t)HALF * lda * 2, hstepB = (size_t)HALF * K * 2;
    const size_t tstepA = 2 * hstepA, tstepB = 2 * hstepB;
    const unsigned ldsw = (unsigned)wid * 1024u;
    const int aoff = lds_byte(wr * 64 + fr, fq * 8), boff = lds_byte(wc * 32 + fr, fq * 8);
#define PG8_SA(b, h) (((b) * 2 + (h)) * HTB)
#define PG8_SB(b, h) ((4 + (b) * 2 + (h)) * HTB)
#define PG8_STAGE(bufoff, gbase, voff) do { _Pragma("unroll") for (int _i = 0; _i < 2; ++_i) \
        __builtin_amdgcn_global_load_lds((const unsigned*)((const char*)(gbase) + (voff)[_i]), (LAS unsigned*)(lds + (bufoff) + ldsw + _i * 8192), 16, 0, 0); } while (0)
#define PG8_LDA(dst, b, h) do { _Pragma("unroll") for (int m = 0; m < 4; ++m) _Pragma("unroll") for (int k = 0; k < 2; ++k) dst[m][k] = *(const LAS bf16x8*)(lds + PG8_SA(b, h) + aoff + m * 2048 + k * 1024); } while (0)
#define PG8_LDB(dst, b, h) do { _Pragma("unroll") for (int n = 0; n < 2; ++n) _Pragma("unroll") for (int k = 0; k < 2; ++k) dst[n][k] = *(const LAS bf16x8*)(lds + PG8_SB(b, h) + boff + n * 2048 + k * 1024); } while (0)
#define PG8_MMA(ai, bj, At, Bt) do { __builtin_amdgcn_s_setprio(1); _Pragma("unroll") for (int m = 0; m < 4; ++m) _Pragma("unroll") for (int n = 0; n < 2; ++n) _Pragma("unroll") for (int k = 0; k < 2; ++k) \
        acc[ai][bj][m][n] = __builtin_amdgcn_mfma_f32_16x16x32_bf16(Bt[n][k], At[m][k], acc[ai][bj][m][n], 0, 0, 0); __builtin_amdgcn_s_setprio(0); } while (0)
#define PG8_WAIT_V(n) asm volatile("s_waitcnt vmcnt(" #n ")" ::: "memory")
#define PG8_WAIT_L(n) asm volatile("s_waitcnt lgkmcnt(" #n ")" ::: "memory")
#define PG8_BAR __builtin_amdgcn_s_barrier()
#define PG8_SCHED __builtin_amdgcn_sched_barrier(0)
    Unit cur, nxt; int ui = 0;
    if (!S.next(0, cur)) return;
    f32x4 acc[2][2][4][2];
#pragma unroll
    for (int a = 0; a < 2; ++a)
#pragma unroll
        for (int b = 0; b < 2; ++b)
#pragma unroll
            for (int m = 0; m < 4; ++m)
#pragma unroll
                for (int n = 0; n < 2; ++n) acc[a][b][m][n] = (f32x4){0.f, 0.f, 0.f, 0.f};
    bf16x8 At[4][2], B0[2][2], B1[2][2];
    const char* cA = (const char*)g.A + (size_t)cur.pm * tstepA; const char* cB = (const char*)g.Bt + (size_t)cur.e * g.estride + (size_t)cur.pn * tstepB;
    PG8_STAGE(PG8_SB(0, 0), cB, voffB); PG8_STAGE(PG8_SB(0, 1), cB + hstepB, voffB); PG8_STAGE(PG8_SA(0, 0), cA, voffA); PG8_STAGE(PG8_SA(0, 1), cA + hstepA, voffA);
    if (wr == 1) PG8_BAR;
    PG8_WAIT_V(2); PG8_BAR;
    PG8_STAGE(PG8_SB(1, 0), cB + kstep, voffB); PG8_STAGE(PG8_SA(1, 0), cA + kstep, voffA); PG8_STAGE(PG8_SB(1, 1), cB + hstepB + kstep, voffB);
    PG8_WAIT_V(6); PG8_BAR;
    for (;;) {
        const bool has_next = S.next(ui + 1, nxt);
        const char* nA = has_next ? (const char*)g.A + (size_t)nxt.pm * tstepA : cA; const char* nB = has_next ? (const char*)g.Bt + (size_t)nxt.e * g.estride + (size_t)nxt.pn * tstepB : cB;
#pragma nounroll
        for (int t = 0; t < nt; t += 2) {
            const bool last = (t == nt - 2);
            const char* a1 = cA + (size_t)(t + 1) * kstep;
            const char* a2 = last ? nA : cA + (size_t)(t + 2) * kstep; const char* b2 = last ? nB : cB + (size_t)(t + 2) * kstep;
            const char* a3 = a2 + kstep; const char* b3 = b2 + kstep;
            PG8_LDB(B0, 0, 0); PG8_LDB(B1, 0, 1); PG8_SCHED; PG8_LDA(At, 0, 0); PG8_STAGE(PG8_SA(1, 1), a1 + hstepA, voffA);
            PG8_WAIT_V(8); PG8_WAIT_L(0); PG8_BAR; PG8_MMA(0, 0, At, B0); PG8_MMA(0, 1, At, B1); PG8_BAR; PG8_SCHED;
            PG8_LDA(At, 0, 1); PG8_STAGE(PG8_SB(0, 0), b2, voffB); PG8_STAGE(PG8_SB(0, 1), b2 + hstepB, voffB); PG8_STAGE(PG8_SA(0, 0), a2, voffA);
            PG8_WAIT_V(8); PG8_WAIT_L(0); PG8_BAR; PG8_MMA(1, 0, At, B0); PG8_MMA(1, 1, At, B1); PG8_BAR; PG8_SCHED;
            PG8_LDB(B0, 1, 0); PG8_LDB(B1, 1, 1); PG8_SCHED; PG8_LDA(At, 1, 0); PG8_STAGE(PG8_SA(0, 1), a2 + hstepA, voffA);
            PG8_WAIT_V(8); PG8_WAIT_L(0); PG8_BAR; PG8_MMA(0, 0, At, B0); PG8_MMA(0, 1, At, B1); PG8_BAR; PG8_SCHED;
            PG8_LDA(At, 1, 1); PG8_STAGE(PG8_SB(1, 0), b3, voffB); PG8_STAGE(PG8_SB(1, 1), b3 + hstepB, voffB); PG8_STAGE(PG8_SA(1, 0), a3, voffA);
            PG8_WAIT_V(8); PG8_WAIT_L(0); PG8_BAR; PG8_MMA(1, 0, At, B0); PG8_MMA(1, 1, At, B1); PG8_BAR; PG8_SCHED;
        }
        if (wr == 0) PG8_BAR;
        E(acc, cur, wr, wc, fr, fq);
        if (!has_next) break;
#pragma unroll
        for (int a = 0; a < 2; ++a)
#pragma unroll
            for (int b = 0; b < 2; ++b)
#pragma unroll
                for (int m = 0; m < 4; ++m)
#pragma unroll
                    for (int n = 0; n < 2; ++n) acc[a][b][m][n] = (f32x4){0.f, 0.f, 0.f, 0.f};
        cur = nxt; cA = nA; cB = nB; ++ui;
        if (wr == 1) PG8_BAR;
    }
    PG8_WAIT_V(0);
    PG8_BAR;
#undef PG8_SA
#undef PG8_SB
#undef PG8_STAGE
#undef PG8_LDA
#undef PG8_LDB
#undef PG8_MMA
#undef PG8_WAIT_V
#undef PG8_WAIT_L
#undef PG8_BAR
#undef PG8_SCHED
}
}
namespace att {
constexpr int NW = 8, QBLK = 32, KVBLK = 64, QB = NW * QBLK;
__device__ __forceinline__ int crow(int r, int hi) { return (r & 3) + 8 * (r >> 2) + 4 * hi; }
template <int NCB> __device__ __forceinline__ int v_st(int k, int c) { const int kk = (k & ~0xC) | ((k & 4) << 1) | ((k & 8) >> 1); return ((kk >> 3) * NCB + (c >> 5)) * 512 + ((kk & 7) * 32 + (c & 31)) * 2; }
__device__ __forceinline__ int v_rd_base(int lane) { return ((lane & 3) << 3) | (((lane >> 2) & 3) << 6) | (((lane >> 4) & 1) << 5) | (((lane >> 5) & 1) << 8); }

struct Params {
    const bf16* Q; int ldq;
    const bf16* K; int ldk;
    const bf16* V; int ldv;
    bf16* O; int ldo;
    int P0;
    int j_lo, j_hi;
    const float* rope;
    const int* pos;
    float slope_over_scale, sink_l2;
};

template <int DQK, int DV, int KIND, int W>
__device__ __forceinline__ void attn_block(const Params& p, char* lds) {
    constexpr int NKS = DQK / 64, ND0 = DQK / 16, NCB = DV / 32, NVP = DV / 64;
    constexpr int KT = NKS * 8192, VT = KVBLK * DV * 2;
    constexpr int OFF_K = 2 * VT, OFF_KP = OFF_K + 2 * KT, OFF_WS = OFF_KP + 2 * 256;
    const float SCALE = (DQK == 192) ? 0.07216878364870322f : 0.125f;
    const float C2 = 1.4426950408889634f * SCALE;
    constexpr float THR = 8.f;
    const int tid = threadIdx.x, wid = __builtin_amdgcn_readfirstlane(tid >> 6), lane = tid & 63, r32 = lane & 31, hi = lane >> 5;
    LAS unsigned char* lds3 = (LAS unsigned char*)lds; char* V_lds = lds; char* K_lds = lds + OFF_K; float* kp_lds = (float*)(lds + OFF_KP);
    float* ws = (float*)(lds + OFF_WS) + wid * 64; float* li_l = ws, * al_l = ws + 32;
    const int NT = p.j_hi - p.j_lo;
    const int qlo = p.P0 + wid * QBLK, qm = qlo + r32 - 4 * hi;
    unsigned kofs, vofs[NVP];
    { const int q = wid * 64 + lane, key = q >> 3, c = (q & 7) ^ ((key >> 1) & 7); kofs = (unsigned)(key * p.ldk + c * 8) * 2u; }
#pragma unroll
    for (int i = 0; i < NVP; ++i) { const int bo = (wid + 8 * i) * 1024 + lane * 16, sub = bo >> 9, within = bo & 511, kk = (sub / NCB) * 8 + (within >> 6), c = (sub % NCB) * 32 + ((within & 63) >> 1);
        const int k = (kk & ~0xC) | ((kk & 4) << 1) | ((kk & 8) >> 1); vofs[i] = (unsigned)(k * p.ldv + c) * 2u; }
    float st_p = 0.f;
#define ST_LOAD(kb, bf) do { \
        const char* kb_ = (const char*)p.K + (size_t)(kb) * (size_t)(p.ldk * 2); const char* vb_ = (const char*)p.V + (size_t)(kb) * (size_t)(p.ldv * 2); \
        _Pragma("unroll") for (int s_ = 0; s_ < NKS; ++s_) __builtin_amdgcn_global_load_lds((const unsigned*)(kb_ + kofs + s_ * 128), (LAS unsigned*)(lds3 + OFF_K + (bf) * KT + s_ * 8192 + wid * 1024), 16, 0, 0); \
        _Pragma("unroll") for (int i_ = 0; i_ < NVP; ++i_) __builtin_amdgcn_global_load_lds((const unsigned*)(vb_ + vofs[i_]), (LAS unsigned*)(lds3 + (bf) * VT + (wid + 8 * i_) * 1024), 16, 0, 0); \
        if (KIND == 1 && tid < 64) st_p = (float)p.pos[(kb) + tid]; } while (0)
#define ST_WRITE(bf) do { if (KIND == 1 && tid < 64) kp_lds[(bf) * 64 + tid] = st_p; } while (0)
    bf16x8 qr[ND0];
    ST_LOAD(p.j_lo * KVBLK, 0);
    { const bf16* qrow = p.Q + (size_t)(wid * QBLK + r32) * p.ldq + hi * 8;
#pragma unroll
      for (int d0 = 0; d0 < ND0; ++d0) qr[d0] = *(const bf16x8*)(qrow + d0 * 16); }
    float pq = 0.f;
    if (KIND == 0) {
        const float* rt = p.rope + (size_t)(wid * QBLK + r32) * 64;
#pragma unroll
        for (int dd = 0; dd < 2; ++dd) {
            const int i0 = dd * 16 + hi * 8;
            const f32x4 c0 = *(const f32x4*)(rt + i0), c1 = *(const f32x4*)(rt + i0 + 4), s0 = *(const f32x4*)(rt + 32 + i0), s1 = *(const f32x4*)(rt + 32 + i0 + 4);
            bf16x8 a = qr[8 + dd], b = qr[10 + dd]; u32x4 ra, rb; float x1[8], x2[8], cs[8], sn[8];
#pragma unroll
            for (int j = 0; j < 4; ++j) { cs[j] = c0[j]; cs[4 + j] = c1[j]; sn[j] = s0[j]; sn[4 + j] = s1[j]; }
#pragma unroll
            for (int j = 0; j < 8; ++j) { x1[j] = bf2f((unsigned short)a[j]); x2[j] = bf2f((unsigned short)b[j]); }
#pragma unroll
            for (int j = 0; j < 4; ++j) { ra[j] = cvt_pk_bf16(x1[2 * j] * cs[2 * j] - x2[2 * j] * sn[2 * j], x1[2 * j + 1] * cs[2 * j + 1] - x2[2 * j + 1] * sn[2 * j + 1]);
                                          rb[j] = cvt_pk_bf16(x2[2 * j] * cs[2 * j] + x1[2 * j] * sn[2 * j], x2[2 * j + 1] * cs[2 * j + 1] + x1[2 * j + 1] * sn[2 * j + 1]); }
            qr[8 + dd] = *reinterpret_cast<bf16x8*>(&ra); qr[10 + dd] = *reinterpret_cast<bf16x8*>(&rb);
        }
    } else { pq = (float)p.pos[qlo + r32]; }
    int ka[4];
#pragma unroll
    for (int j = 0; j < 4; ++j) ka[j] = r32 * 128 + (((2 * j + hi) ^ ((r32 >> 1) & 7)) << 4);
    const int vb0 = (int)(uintptr_t)V_lds + v_rd_base(lane);
    float m_reg = -1e30f, l_reg = 0.f; f32x16 o[NCB];
#pragma unroll
    for (int d = 0; d < NCB; ++d) o[d] = f32x16{};
    asm volatile("s_waitcnt vmcnt(0)" ::: "memory");
    ST_WRITE(0);
    __syncthreads();
#define TRRD(dst, off) asm volatile("ds_read_b64_tr_b16 %0, %1 offset:%2" : "=&v"(dst) : "v"(vb0), "i"(off) : "memory")
#define TILE(t, BF) do { \
        const int kb_ = (p.j_lo + (t)) * KVBLK; \
        if ((t) + 1 < NT) { const int kn_ = kb_ + KVBLK; ST_LOAD(kn_, (BF) ^ 1); } \
        const bool act_ = (kb_ <= qlo + QBLK - 1) && (kb_ + KVBLK - 1 >= qlo - W + 1); \
        if (act_) { \
            f32x16 p0 = f32x16{}, p1 = f32x16{}; \
            _Pragma("unroll") for (int d0 = 0; d0 < ND0; ++d0) { const char* a_ = K_lds + (BF) * KT + (d0 >> 2) * 8192 + ka[d0 & 3]; \
                const bf16x8 b0 = *(const bf16x8*)a_, b1 = *(const bf16x8*)(a_ + 4096); \
                p0 = __builtin_amdgcn_mfma_f32_32x32x16_bf16(b0, qr[d0], p0, 0, 0, 0); p1 = __builtin_amdgcn_mfma_f32_32x32x16_bf16(b1, qr[d0], p1, 0, 0, 0); } \
            if (KIND == 1) { const float* kq = kp_lds + (BF) * 64 + 4 * hi; \
                _Pragma("unroll") for (int g_ = 0; g_ < 4; ++g_) { const f32x4 k0 = *(const f32x4*)(kq + 8 * g_), k1 = *(const f32x4*)(kq + 32 + 8 * g_); \
                    _Pragma("unroll") for (int c_ = 0; c_ < 4; ++c_) { p0[4 * g_ + c_] = fmaf(-p.slope_over_scale, fabsf(pq - k0[c_]), p0[4 * g_ + c_]); p1[4 * g_ + c_] = fmaf(-p.slope_over_scale, fabsf(pq - k1[c_]), p1[4 * g_ + c_]); } } } \
            if (kb_ + KVBLK - 1 > qlo || kb_ <= qlo + QBLK - 1 - W) { const int dq_ = qm - kb_; const float NEG = -__builtin_inff(); \
                _Pragma("unroll") for (int r = 0; r < 16; ++r) { const int c_ = (r & 3) + 8 * (r >> 2); \
                    if ((unsigned)(dq_ - c_) >= (unsigned)W) p0[r] = NEG; if ((unsigned)(dq_ - c_ - 32) >= (unsigned)W) p1[r] = NEG; } } \
            float pmax = p0[0]; \
            _Pragma("unroll") for (int r = 1; r < 16; ++r) pmax = fmaxf(pmax, p0[r]); \
            _Pragma("unroll") for (int r = 0; r < 16; ++r) pmax = fmaxf(pmax, p1[r]); \
            { auto rr = __builtin_amdgcn_permlane32_swap(__float_as_uint(pmax), __float_as_uint(pmax), false, false); pmax = fmaxf(__uint_as_float(rr[0]), __uint_as_float(rr[1])); } \
            float mn, alpha; \
            if (__all((pmax - m_reg) * SCALE <= THR)) { mn = m_reg; alpha = 1.f; } \
            else { mn = fmaxf(m_reg, pmax); alpha = __builtin_amdgcn_exp2f((m_reg - mn) * C2); m_reg = mn; } \
            const float mnL = -mn * C2; float ps = 0.f; \
            _Pragma("unroll") for (int r = 0; r < 16; ++r) { p0[r] = __builtin_amdgcn_exp2f(fmaf(p0[r], C2, mnL)); p1[r] = __builtin_amdgcn_exp2f(fmaf(p1[r], C2, mnL)); } \
            _Pragma("unroll") for (int r = 0; r < 16; ++r) ps += p0[r] + p1[r]; \
            { auto rr = __builtin_amdgcn_permlane32_swap(__float_as_uint(ps), __float_as_uint(ps), false, false); ps = __uint_as_float(rr[0]) + __uint_as_float(rr[1]); } \
            l_reg = l_reg * alpha + ps; \
            bf16x8 pa[4]; \
            _Pragma("unroll") for (int q_ = 0; q_ < 4; ++q_) { const f32x16& P = (q_ < 2) ? p0 : p1; const int B_ = (q_ & 1) * 8; \
                const unsigned a0 = cvt_pk_bf16(P[B_ + 0], P[B_ + 1]), a1 = cvt_pk_bf16(P[B_ + 2], P[B_ + 3]), b0 = cvt_pk_bf16(P[B_ + 4], P[B_ + 5]), b1 = cvt_pk_bf16(P[B_ + 6], P[B_ + 7]); \
                auto r0 = __builtin_amdgcn_permlane32_swap(a0, b0, false, false); auto r1 = __builtin_amdgcn_permlane32_swap(a1, b1, false, false); \
                u32x4 w_ = {r0[0], r1[0], r0[1], r1[1]}; pa[q_] = *reinterpret_cast<bf16x8*>(&w_); } \
            if (__any(alpha < 1.f)) { if (hi == 0) al_l[r32] = alpha; asm volatile("s_waitcnt lgkmcnt(0)" ::: "memory"); \
                _Pragma("unroll") for (int r = 0; r < 16; ++r) { const float a_ = al_l[crow(r, hi)]; _Pragma("unroll") for (int d_ = 0; d_ < NCB; ++d_) o[d_][r] *= a_; } } \
            _Pragma("unroll") for (int d0 = 0; d0 < NCB; ++d0) { s16x4 l_[4], h_[4]; constexpr int b_ = (BF) * VT; \
                _Pragma("unroll") for (int ks = 0; ks < 4; ++ks) { TRRD(l_[ks], b_ + d0 * 512 + ks * (1024 * NCB)); TRRD(h_[ks], b_ + d0 * 512 + ks * (1024 * NCB) + 512 * NCB); } \
                asm volatile("s_waitcnt lgkmcnt(0)" ::: "memory"); __builtin_amdgcn_sched_barrier(0); \
                _Pragma("unroll") for (int ks = 0; ks < 4; ++ks) o[d0] = __builtin_amdgcn_mfma_f32_32x32x16_bf16(pa[ks], (bf16x8){l_[ks][0], l_[ks][1], l_[ks][2], l_[ks][3], h_[ks][0], h_[ks][1], h_[ks][2], h_[ks][3]}, o[d0], 0, 0, 0); } \
        } \
        if ((t) + 1 < NT) { asm volatile("s_waitcnt vmcnt(0)" ::: "memory"); ST_WRITE((BF) ^ 1); } \
        __syncthreads(); } while (0)
    for (int t = 0; t < NT; t += 2) {
        TILE(t, 0);
        if (t + 1 < NT) TILE(t + 1, 1);
    }
    if (KIND == 1) l_reg += __builtin_amdgcn_exp2f(p.sink_l2 - m_reg * C2);
    if (hi == 0) li_l[r32] = l_reg;
    asm volatile("s_waitcnt lgkmcnt(0)" ::: "memory");
    bf16* Ow = p.O + (size_t)(wid * QBLK) * p.ldo;
#pragma unroll
    for (int r = 0; r < 16; ++r) { const int orow = crow(r, hi); const float rl = __builtin_amdgcn_rcpf(li_l[orow]);
#pragma unroll
        for (int d0 = 0; d0 < NCB; ++d0) { const float v = o[d0][r] * rl; const float vn = __shfl_xor(v, 1);
            if ((r32 & 1) == 0) *(unsigned*)(Ow + (size_t)orow * p.ldo + d0 * 32 + r32) = cvt_pk_bf16(v, vn); } }
    __syncthreads();
#undef TILE
#undef TRRD
#undef ST_LOAD
#undef ST_WRITE
}
constexpr int LDS_MLA = 2 * (64 * 128 * 2) + 2 * (3 * 8192) + 512 + 8 * 256;
constexpr int LDS_SWA = 2 * (64 * 64 * 2) + 2 * 8192 + 512 + 8 * 256;
}
constexpr int NWAVES = 8, NTHREADS = NWAVES * 64;
constexpr int D = 1024, NB = 8, SEQ = 8192, T = NB * SEQ;
constexpr int FF = 2816, NE = 8, FE = 3584;
constexpr int QL = 384, KVL = 256, MH = 8, DQKM = 192, DVM = 128;
constexpr int MDN = 704, MDNP = 768;
constexpr int SQKV = 1280;
constexpr int MAXPAN = 520, MAXSLOT = MAXPAN * 256;
constexpr float EPS = 1e-6f;
constexpr size_t MiB = 1u << 20;
constexpr size_t WS_CTL = 0, CTL_ZERO_BYTES = 256 * 1024;
constexpr size_t WS_RT = 1 * MiB;
constexpr size_t RT_E = WS_RT, RT_W0 = RT_E + (size_t)T * 4, RT_W1 = RT_W0 + (size_t)T * 4, RT_S0 = RT_W1 + (size_t)T * 4, RT_S1 = RT_S0 + (size_t)T * 4, RT_CNT = RT_S1 + (size_t)T * 4, RT_PB = RT_CNT + 256 * 8 * 4;
constexpr size_t WS_ROPE = 8 * MiB;
constexpr size_t WS_W = 24 * MiB;
constexpr size_t W_CINB = WS_W, W_CINCU = W_CINB + 2 * (size_t)1024 * 1024 * 2, W_COUT = W_CINCU + 2 * (size_t)2048 * 1024 * 2;
constexpr size_t W_MDN = W_COUT + 2 * (size_t)1024 * 1024 * 2, W_MUQ = W_MDN + (size_t)MDNP * 1024 * 2, W_MUKV = W_MUQ + (size_t)1536 * QL * 2, W_MO = W_MUKV + (size_t)2048 * KVL * 2;
constexpr size_t W_SQKV = W_MO + (size_t)1024 * 1024 * 2, W_SO = W_SQKV + (size_t)SQKV * 1024 * 2;
constexpr size_t W_FGU = W_SO + (size_t)1024 * 1024 * 2, W_FD = W_FGU + 2 * (size_t)(2 * FF) * 1024 * 2;
constexpr size_t W_MGU = W_FD + 2 * (size_t)1024 * FF * 2, W_MD = W_MGU + 16 * (size_t)(2 * FE) * 1024 * 2, W_RT = W_MD + 16 * (size_t)1024 * FE * 2;
constexpr size_t W_END = W_RT + 2 * (size_t)8 * 1024 * 4;
constexpr size_t WS_XN = 420 * MiB;
constexpr size_t WS_XG = 548 * MiB;
constexpr size_t WS_BIG = 808 * MiB;
constexpr size_t WS_END = WS_BIG + (size_t)MAXSLOT * FE * 2;
static_assert(W_END <= WS_XN && WS_XN + (size_t)T * D * 2 <= WS_XG && WS_XG + (size_t)MAXSLOT * D * 2 <= WS_BIG, "d_ws map");
constexpr size_t B_CONV_B = 0, B_CONV_V = 128 * MiB, B_CONV_Y = 256 * MiB;
constexpr size_t B_HMID = 0;
constexpr size_t B_MC = 0, B_MO = 0, B_MCQ = 192 * MiB, B_MCKV = 240 * MiB, B_MQ = 272 * MiB, B_MK = 464 * MiB, B_MV = 656 * MiB;
constexpr size_t B_SQKV = 0, B_SO = 160 * MiB;
constexpr int CW_DBG = 8;
constexpr int CW_BAR = 1024;
constexpr int RING_BYTES = 131072, MISC_OFF = RING_BYTES, LDS_BYTES = 147456;

#define RLX_AGENT __ATOMIC_RELAXED, __HIP_MEMORY_SCOPE_AGENT
#define XB_TMO      128
#define XB_XCNT(j)  (256  + 64 * (j))
#define XB_XSUB(j)  (1280 + 64 * (j))
#define XB_XGEN(j)  (2304 + 64 * (j))
#define XB_TOP      3328
#define XB_TOPGEN   3392
#define XCD_BAR_WORDS 3456
#define XB_SPIN_CAP (1u << 18)
__device__ __forceinline__ unsigned xb_ld(unsigned* p)              { return __hip_atomic_load(p, __ATOMIC_RELAXED, __HIP_MEMORY_SCOPE_AGENT); }
__device__ __forceinline__ unsigned xb_add(unsigned* p, unsigned v) { return __hip_atomic_fetch_add(p, v, __ATOMIC_RELAXED, __HIP_MEMORY_SCOPE_AGENT); }
__device__ __forceinline__ unsigned xb_xcc_id() { return (unsigned)__builtin_amdgcn_s_getreg((3 << 11) | 20) & 0xFu; }
#define XB_SPIN(cond, bar) do { unsigned _sp = 0; while (cond) { __builtin_amdgcn_s_sleep(1); \
    if ((++_sp & 255u) == 0u) { if (xb_ld(&(bar)[XB_TMO])) break; if (_sp > XB_SPIN_CAP) { atomicAdd(&(bar)[XB_TMO], 1u); break; } } } } while (0)
struct XcdBarrier { unsigned* bar; unsigned x; volatile LAS unsigned* st; };
__device__ __forceinline__ XcdBarrier xcd_barrier_post(unsigned* bar, volatile LAS unsigned* st) {
    XcdBarrier b; b.bar = bar; b.x = xb_xcc_id(); b.st = st;
    if (threadIdx.x == 0) (void)xb_add(&bar[XB_XCNT(b.x)], 1u);
    return b;
}
__device__ __forceinline__ void xcd_barrier_complete(unsigned* bar, unsigned x, unsigned& nloc, unsigned& nx) {
    const unsigned G = gridDim.x * gridDim.y * gridDim.z;
    unsigned sum, cnt, mine, sp = 0u;
    for (;;) {
        sum = 0u; cnt = 0u; mine = 0u;
#pragma unroll
        for (unsigned j = 0; j < 16; ++j) { const unsigned c = xb_ld(&bar[XB_XCNT(j)]); sum += c; cnt += (c > 0u) ? 1u : 0u; mine = (j == x) ? c : mine; }
        if (sum == G) break;
        __builtin_amdgcn_s_sleep(1);
        if ((++sp & 255u) == 0u) { if (xb_ld(&bar[XB_TMO])) break; if (sp > XB_SPIN_CAP) { atomicAdd(&bar[XB_TMO], 1u); break; } }
    }
    nloc = mine > 0u ? mine : 1u; nx = cnt > 0u ? cnt : 1u;
}
__device__ __forceinline__ void xcd_barrier(const XcdBarrier& b) {
    asm volatile("s_waitcnt vmcnt(0)" ::: "memory");
    __syncthreads();
    if (threadIdx.x == 0) {
        unsigned* bar = b.bar;
        __builtin_amdgcn_s_waitcnt(0);
        unsigned nloc = b.st[0], nx = b.st[1];
        if (nloc == 0u) { xcd_barrier_complete(bar, b.x, nloc, nx); b.st[0] = nloc; b.st[1] = nx; }
        const unsigned old = xb_add(&bar[XB_XSUB(b.x)], 1u);
        const unsigned gen = old / nloc;
        if (old + 1u == (gen + 1u) * nloc) {
            __builtin_amdgcn_fence(__ATOMIC_RELEASE, "agent");
            asm volatile("s_waitcnt vmcnt(0)" ::: "memory");
            const unsigned og = xb_add(&bar[XB_TOP], 1u);
            const unsigned tg = og / nx;
            if (og + 1u == (tg + 1u) * nx) xb_add(&bar[XB_TOPGEN], 1u);
            else XB_SPIN(xb_ld(&bar[XB_TOPGEN]) == tg, bar);
            __builtin_amdgcn_fence(__ATOMIC_ACQUIRE, "agent");
            xb_add(&bar[XB_XGEN(b.x)], 1u);
            asm volatile("s_waitcnt vmcnt(0)" ::: "memory");
        } else {
            XB_SPIN(xb_ld(&bar[XB_XGEN(b.x)]) == gen, bar);
            __builtin_amdgcn_fence(__ATOMIC_ACQUIRE, "agent");
            asm volatile("s_waitcnt vmcnt(0)" ::: "memory");
        }
    }
    __syncthreads();
}

struct TC { int tid, lane, wave; };
__device__ __forceinline__ TC tc_get() { TC t; int x = threadIdx.x; asm volatile("" : "+v"(x)); t.tid = x; t.lane = x & 63; t.wave = __builtin_amdgcn_readfirstlane(x >> 6); return t; }
struct Frame {
    char* lds; int vcu, G;
    unsigned char* ws; float* out;
    const float* const* in;
};
#define LDS_WAIT() asm volatile("s_waitcnt lgkmcnt(0)" ::: "memory")
#define VM_WAIT() asm volatile("s_waitcnt vmcnt(0)" ::: "memory")

template <int MAP>
__device__ __forceinline__ void tr_item(const float* W, int K, int N, int ldw, bf16* WT, float* scr, int item, int lane) {
    const int nblk = N / 32, kb = item / nblk, nb = item % nblk, k0 = 64 * kb, n0 = 32 * nb;
    int r0 = n0;
    if (MAP == 1) { const int F = N / 2; r0 = (n0 < F) ? 256 * (n0 / 128) + (n0 % 128) : 256 * ((n0 - F) / 128) + 128 + ((n0 - F) % 128); }
    const float* src = W + (size_t)(k0 + (lane >> 5)) * ldw + n0 + (lane & 31);
#pragma unroll 16
    for (int i = 0; i < 32; ++i) scr[(2 * i + (lane >> 5)) * 33 + (lane & 31)] = src[(size_t)(2 * i) * ldw];
    LDS_WAIT(); asm volatile("" ::: "memory");
    const int c = lane & 7;
#pragma unroll
    for (int j = 0; j < 4; ++j) { const int n = (lane >> 3) + 8 * j; const float* s = scr + (8 * c) * 33 + n;
        u32x4 o; o.x = cvt_pk_bf16(s[0 * 33], s[1 * 33]); o.y = cvt_pk_bf16(s[2 * 33], s[3 * 33]); o.z = cvt_pk_bf16(s[4 * 33], s[5 * 33]); o.w = cvt_pk_bf16(s[6 * 33], s[7 * 33]);
        *(u32x4*)(WT + (size_t)(r0 + n) * K + k0 + 8 * c) = o; }
    LDS_WAIT(); asm volatile("" ::: "memory");
}
template <int MAP>
__device__ __forceinline__ void tr_matrix(Frame& F, const float* W, int K, int N, int ldw, bf16* WT, int rot) {
    const TC tc = tc_get();
    float* scr = (float*)(F.lds + tc.wave * 8448);
    const int NGW = F.G * NWAVES, gw = (F.vcu * NWAVES + tc.wave + rot) % NGW, nitems = (K / 64) * (N / 32);
    for (int it = gw; it < nitems; it += NGW) tr_item<MAP>(W, K, N, ldw, WT, scr, it, tc.lane);
}

struct RowArgs { const float* Xsrc; float* Xdst; const float* g; bf16* XN; float* outF; const bf16* Y; const int* s0; const int* s1; const float* w0; const float* w1;
                 const float* routerT; unsigned* rt_e; float* rt_w0; float* rt_w1; unsigned* cnt; };
template <int MODE, bool COMBINE>
__device__ __forceinline__ void row_pass(Frame& F, const RowArgs& a) {
    const TC tc = tc_get();
    const int lane = tc.lane;
    float* rtab = (float*)F.lds;
    unsigned* wcnt = (unsigned*)(F.lds + 32768);
    if (MODE == 1) { for (int i = tc.tid; i < 8 * 1024; i += NTHREADS) rtab[i] = a.routerT[i]; }
    f32x4 gv[4];
#pragma unroll
    for (int j = 0; j < 4; ++j) gv[j] = *(const f32x4*)(a.g + 4 * lane + 256 * j);
    for (int tb = blockIdx.x; tb < T / 256; tb += F.G) {
        if (MODE == 1) { if (tc.tid < 64) wcnt[tc.tid] = 0u; __syncthreads(); }
        unsigned myc[8] = {0u, 0u, 0u, 0u, 0u, 0u, 0u, 0u};
        for (int rr = 0; rr < 32; ++rr) {
            const int row = tb * 256 + tc.wave * 32 + rr;
            const f32x4* xr = (const f32x4*)(a.Xsrc + (size_t)row * D) + lane;
            f32x4 v[4];
#pragma unroll
            for (int j = 0; j < 4; ++j) v[j] = xr[64 * j];
            if (COMBINE) {
                const int sa = a.s0[row], sb = a.s1[row]; const float wa = a.w0[row], wb = a.w1[row];
                const u32x2* ya = (const u32x2*)(a.Y + (size_t)sa * D) + lane; const u32x2* yb = (const u32x2*)(a.Y + (size_t)sb * D) + lane;
#pragma unroll
                for (int j = 0; j < 4; ++j) { const u32x2 pa = ya[64 * j], pb = yb[64 * j];
                    v[j].x += wa * bflo(pa.x) + wb * bflo(pb.x); v[j].y += wa * bfhi(pa.x) + wb * bfhi(pb.x);
                    v[j].z += wa * bflo(pa.y) + wb * bflo(pb.y); v[j].w += wa * bfhi(pa.y) + wb * bfhi(pb.y); }
                if (MODE != 2) { f32x4* xd = (f32x4*)(a.Xdst + (size_t)row * D) + lane;
#pragma unroll
                    for (int j = 0; j < 4; ++j) xd[64 * j] = v[j]; }
            }
            float ss = 0.f;
#pragma unroll
            for (int j = 0; j < 4; ++j) ss += (v[j].x * v[j].x + v[j].y * v[j].y) + (v[j].z * v[j].z + v[j].w * v[j].w);
            const float rstd = 1.0f / sqrtf(wave_sum(ss) * (1.f / D) + EPS);
#pragma unroll
            for (int j = 0; j < 4; ++j) v[j] = v[j] * rstd * gv[j];
            if (MODE == 2) { f32x4* od = (f32x4*)(a.outF + (size_t)row * D) + lane;
#pragma unroll
                for (int j = 0; j < 4; ++j) od[64 * j] = v[j];
            } else { u32x2* o8 = (u32x2*)(a.XN + (size_t)row * D) + lane;
#pragma unroll
                for (int j = 0; j < 4; ++j) { u32x2 w; w.x = cvt_pk_bf16(v[j].x, v[j].y); w.y = cvt_pk_bf16(v[j].z, v[j].w); o8[64 * j] = w; } }
            if (MODE == 1) {
                float lg[8];
#pragma unroll
                for (int e = 0; e < 8; ++e) { float s = 0.f;
#pragma unroll
                    for (int j = 0; j < 4; ++j) { const f32x4 r = *(const f32x4*)(rtab + e * 1024 + 256 * j + 4 * lane); s += (v[j].x * r.x + v[j].y * r.y) + (v[j].z * r.z + v[j].w * r.w); }
                    lg[e] = wave_sum(s); }
                int e0 = 0; float v0 = lg[0];
#pragma unroll
                for (int e = 1; e < 8; ++e) if (lg[e] > v0) { v0 = lg[e]; e0 = e; }
                int e1 = -1; float v1 = -3.0e38f;
#pragma unroll
                for (int e = 0; e < 8; ++e) if (e != e0 && lg[e] > v1) { v1 = lg[e]; e1 = e; }
                const float w0 = 1.0f / (1.0f + __expf(v1 - v0)), w1 = 1.0f - w0;
                if (lane == 0) { a.rt_e[row] = (unsigned)e0 | ((unsigned)e1 << 8); a.rt_w0[row] = w0; a.rt_w1[row] = w1; }
#pragma unroll
                for (int e = 0; e < 8; ++e) myc[e] += (e == e0 || e == e1) ? 1u : 0u;
            }
        }
        if (MODE == 1) {
            if (lane < 8) { unsigned c = 0;
#pragma unroll
                for (int e = 0; e < 8; ++e) c = (lane == e) ? myc[e] : c;
                wcnt[tc.wave * 8 + lane] = c; }
            __syncthreads();
            if (tc.tid < 8) { unsigned c = 0; for (int w = 0; w < 8; ++w) c += wcnt[w * 8 + tc.tid]; a.cnt[tb * 8 + tc.tid] = c; }
            __syncthreads();
        }
    }
}

__device__ __forceinline__ void moe_assign(Frame& F, const unsigned* cnt, const unsigned* rt_e, int* s0, int* s1, unsigned* pbase_out, const bf16* XN, bf16* XG) {
    const TC tc = tc_get();
    unsigned* tot = (unsigned*)F.lds;
    unsigned* pre = tot + 64;
    unsigned long long* msk = (unsigned long long*)(F.lds + 1024);
    int* slt = (int*)(F.lds + 2048);
    if (tc.tid < 8) tot[tc.tid] = 0u;
    __syncthreads();
    { unsigned part[8] = {0, 0, 0, 0, 0, 0, 0, 0};
      if (tc.tid < 256) {
#pragma unroll
          for (int e = 0; e < 8; ++e) part[e] = __hip_atomic_load(cnt + tc.tid * 8 + e, RLX_AGENT); }
#pragma unroll
      for (int e = 0; e < 8; ++e) { unsigned s = part[e];
#pragma unroll
          for (int o = 1; o < 64; o <<= 1) s += __shfl_xor(s, o);
          if (tc.lane == 0 && tc.wave < 4) atomicAdd(&tot[e], s); } }
    __syncthreads();
    if (tc.tid == 0) { unsigned p = 0; for (int e = 0; e < 8; ++e) { tot[8 + e] = p; p += (tot[e] + 255u) / 256u; } tot[16] = p;
        if (blockIdx.x == 0) for (int e = 0; e < 9; ++e) __hip_atomic_store(pbase_out + e, tot[8 + e], RLX_AGENT); }
    __syncthreads();
    for (int tb = blockIdx.x; tb < T / 256; tb += F.G) {
        if (tc.tid < 8) { unsigned s = 0; for (int b = 0; b < tb; ++b) s += __hip_atomic_load(cnt + b * 8 + tc.tid, RLX_AGENT); pre[tc.tid] = s; }
        int e0 = 0, e1 = 0;
        if (tc.tid < 256) { const unsigned pe = rt_e[tb * 256 + tc.tid]; e0 = pe & 0xff; e1 = (pe >> 8) & 0xff;
#pragma unroll
            for (int e = 0; e < 8; ++e) { const unsigned long long m = __ballot(e0 == e || e1 == e); if (tc.lane == 0) msk[e * 4 + tc.wave] = m; } }
        __syncthreads();
        if (tc.tid < 256) {
            int sl[2];
#pragma unroll
            for (int k = 0; k < 2; ++k) { const int e = k ? e1 : e0; unsigned rank = 0;
                for (int w = 0; w < tc.wave; ++w) rank += __popcll(msk[e * 4 + w]);
                rank += __popcll(msk[e * 4 + tc.wave] & ((1ull << tc.lane) - 1ull));
                sl[k] = (int)(tot[8 + e] * 256u + pre[e] + rank); }
            s0[tb * 256 + tc.tid] = sl[0]; s1[tb * 256 + tc.tid] = sl[1]; slt[2 * tc.tid] = sl[0]; slt[2 * tc.tid + 1] = sl[1];
        }
        __syncthreads();
        for (int rr = 0; rr < 32; ++rr) { const int i = tc.wave * 32 + rr; const int row = tb * 256 + i; const int sa = slt[2 * i], sb = slt[2 * i + 1];
            const u32x4* src = (const u32x4*)(XN + (size_t)row * D) + tc.lane; const u32x4 a = src[0], b = src[64];
            u32x4* d0 = (u32x4*)(XG + (size_t)sa * D) + tc.lane; u32x4* d1 = (u32x4*)(XG + (size_t)sb * D) + tc.lane;
            d0[0] = a; d0[64] = b; d1[0] = a; d1[64] = b; }
        __syncthreads();
    }
}

__device__ __forceinline__ void conv_pass(Frame& F, const bf16* Bc, const bf16* Vc, const float* wconv, bf16* Yc) {
    const TC tc = tc_get();
    const int sub = tc.tid >> 7, ch = (tc.tid & 127) * 8;
    float w[3][8];
#pragma unroll
    for (int j = 0; j < 3; ++j) { const f32x4 a = *(const f32x4*)(wconv + j * D + ch), b = *(const f32x4*)(wconv + j * D + ch + 4);
#pragma unroll
        for (int c = 0; c < 4; ++c) { w[j][c] = a[c]; w[j][4 + c] = b[c]; } }
    for (int run = blockIdx.x * 4 + sub; run < T / 32; run += F.G * 4) {
        const int t0 = run * 32, s0 = t0 & (SEQ - 1);
        float p2[8], p1[8];
        { u32x4 a = {0, 0, 0, 0}, b = {0, 0, 0, 0};
          if (s0 >= 2) { a = *(const u32x4*)(Vc + (size_t)(t0 - 2) * D + ch); b = *(const u32x4*)(Vc + (size_t)(t0 - 1) * D + ch); }
#pragma unroll
          for (int c = 0; c < 4; ++c) { p2[2 * c] = bflo(a[c]); p2[2 * c + 1] = bfhi(a[c]); p1[2 * c] = bflo(b[c]); p1[2 * c + 1] = bfhi(b[c]); } }
#pragma unroll 4
        for (int i = 0; i < 32; ++i) { const size_t o = (size_t)(t0 + i) * D + ch;
            const u32x4 vv = *(const u32x4*)(Vc + o), bb = *(const u32x4*)(Bc + o); float cur[8], y[8];
#pragma unroll
            for (int c = 0; c < 4; ++c) { cur[2 * c] = bflo(vv[c]); cur[2 * c + 1] = bfhi(vv[c]); }
#pragma unroll
            for (int c = 0; c < 8; ++c) { const float bq = (c & 1) ? bfhi(bb[c >> 1]) : bflo(bb[c >> 1]); y[c] = bq * (w[0][c] * p2[c] + w[1][c] * p1[c] + w[2][c] * cur[c]); p2[c] = p1[c]; p1[c] = cur[c]; }
            u32x4 r; r.x = cvt_pk_bf16(y[0], y[1]); r.y = cvt_pk_bf16(y[2], y[3]); r.z = cvt_pk_bf16(y[4], y[5]); r.w = cvt_pk_bf16(y[6], y[7]);
            *(u32x4*)(Yc + o) = r; }
    }
}

__device__ __forceinline__ void rope_table(Frame& F, const int* pos, float* tab) {
    const TC tc = tc_get();
    const int i = tc.lane & 31; const float inv = __builtin_amdgcn_exp2f(-(float)i * (13.287712379549449f / 32.0f));
    const int NGW = F.G * NWAVES, gw = F.vcu * NWAVES + tc.wave;
    for (int t = gw * 2 + (tc.lane >> 5); t < T; t += NGW * 2) {
        const float ang = (float)pos[t] * inv;
        const float k = rintf(ang * 0.15915494309189535f);
        float r = fmaf(-k, 6.28125f, ang); r = fmaf(-k, 1.9353071795864769e-3f, r);
        tab[(size_t)t * 64 + i] = __cosf(r); tab[(size_t)t * 64 + 32 + i] = __sinf(r);
    }
}

__device__ __forceinline__ void mla_mid(Frame& F, const float* C, const float* gq, const float* gkv, const float* tab, bf16* cqn, bf16* ckvn, bf16* Kf) {
    const TC tc = tc_get();
    const int lane = tc.lane, NGW = F.G * NWAVES, gw = F.vcu * NWAVES + tc.wave;
    f32x2 gqv[3];
#pragma unroll
    for (int j = 0; j < 3; ++j) gqv[j] = *(const f32x2*)(gq + 2 * lane + 128 * j);
    const f32x4 gk = *(const f32x4*)(gkv + 4 * lane);
    for (int t = gw; t < T; t += NGW) {
        const float* c = C + (size_t)t * MDNP;
        f32x2 q[3]; float ss = 0.f;
#pragma unroll
        for (int j = 0; j < 3; ++j) { q[j] = *(const f32x2*)(c + 2 * lane + 128 * j); ss += q[j].x * q[j].x + q[j].y * q[j].y; }
        const f32x4 kv = *(const f32x4*)(c + QL + 4 * lane);
        const float x = c[QL + KVL + lane];
        const float rq = 1.0f / sqrtf(wave_sum(ss) * (1.f / QL) + EPS);
        const float rk = 1.0f / sqrtf(wave_sum((kv.x * kv.x + kv.y * kv.y) + (kv.z * kv.z + kv.w * kv.w)) * (1.f / KVL) + EPS);
#pragma unroll
        for (int j = 0; j < 3; ++j) *(unsigned*)(cqn + (size_t)t * QL + 2 * lane + 128 * j) = cvt_pk_bf16(q[j].x * rq * gqv[j].x, q[j].y * rq * gqv[j].y);
        { u32x2 w; w.x = cvt_pk_bf16(kv.x * rk * gk.x, kv.y * rk * gk.y); w.y = cvt_pk_bf16(kv.z * rk * gk.z, kv.w * rk * gk.w); *(u32x2*)(ckvn + (size_t)t * KVL + 4 * lane) = w; }
        const float other = __shfl_xor(x, 32); const int i = lane & 31;
        const float cs = tab[(size_t)t * 64 + i], sn = tab[(size_t)t * 64 + 32 + i];
        const float r = (lane < 32) ? (x * cs - other * sn) : (x * cs + other * sn);
        const float rn = __shfl_xor(r, 1);
        if ((lane & 1) == 0) { const unsigned pk = cvt_pk_bf16(r, rn); const int b = t >> 13, s = t & (SEQ - 1);
#pragma unroll
            for (int h = 0; h < MH; ++h) *(unsigned*)(Kf + ((size_t)(b * MH + h) * SEQ + s) * DQKM + 128 + lane) = pk; }
    }
}
template <class Epi>
__device__ __forceinline__ void gemm_static(Frame& F, const bf16* A, int lda, int K, const bf16* Bt, int N, const Epi& E) {
    pg8::Gemm g{A, Bt, lda, K, 0}; pg8::StaticOrder S; S.init(T, N, F.G, (int)blockIdx.x);
    pg8::gemm_phase<Epi, pg8::StaticOrder>((LAS unsigned char*)F.lds, g, S, E);
}
template <class Epi>
__device__ __forceinline__ void gemm_grouped(Frame& F, const bf16* A, int lda, int K, const bf16* Bt, size_t estride, int N, const unsigned* pbase, const Epi& E) {
    pg8::Gemm g{A, Bt, lda, K, estride}; pg8::GroupedOrder S; S.init(pbase, N, F.G, (int)blockIdx.x, (LAS unsigned*)((LAS unsigned char*)F.lds + MISC_OFF + 512), 128);
    pg8::gemm_phase<Epi, pg8::GroupedOrder>((LAS unsigned char*)F.lds, g, S, E);
}
__device__ __forceinline__ void prologue(Frame& F) {
    const float* const* in = F.in; unsigned char* ws = F.ws;
    int rot = 0;
#define TRM(MAP, W, K, N, ldw, dst) do { tr_matrix<MAP>(F, (W), (K), (N), (ldw), (bf16*)(ws + (dst)), rot); rot += 37; } while (0)
    for (int j = 0; j < 2; ++j) {
        TRM(0, in[5] + (size_t)j * 1024 * 3072, 1024, 1024, 3072, W_CINB + (size_t)j * 1024 * 1024 * 2);
        TRM(1, in[5] + (size_t)j * 1024 * 3072 + 1024, 1024, 2048, 3072, W_CINCU + (size_t)j * 2048 * 1024 * 2);
        TRM(0, in[7] + (size_t)j * 1024 * 1024, 1024, 1024, 1024, W_COUT + (size_t)j * 1024 * 1024 * 2);
        TRM(1, in[19] + (size_t)j * 1024 * 2 * FF, 1024, 2 * FF, 2 * FF, W_FGU + (size_t)j * 2 * FF * 1024 * 2);
        TRM(0, in[20] + (size_t)j * FF * 1024, FF, 1024, 1024, W_FD + (size_t)j * 1024 * FF * 2);
    }
    TRM(0, in[8], 1024, MDN, MDN, W_MDN);
    TRM(0, in[10], QL, 1536, 1536, W_MUQ);
    TRM(0, in[12], KVL, 2048, 2048, W_MUKV);
    TRM(0, in[13], 1024, 1024, 1024, W_MO);
    TRM(0, in[14], 1024, SQKV, SQKV, W_SQKV);
    TRM(0, in[17], 1024, 1024, 1024, W_SO);
    for (int le = 0; le < 16; ++le) {
        TRM(1, in[22] + (size_t)le * 1024 * 2 * FE, 1024, 2 * FE, 2 * FE, W_MGU + (size_t)le * 2 * FE * 1024 * 2);
        TRM(0, in[23] + (size_t)le * FE * 1024, FE, 1024, 1024, W_MD + (size_t)le * 1024 * FE * 2);
    }
#undef TRM
    const TC tc = tc_get();
    const int gt = F.vcu * NTHREADS + tc.tid, NGT = F.G * NTHREADS;
    for (int i = gt; i < (MDNP - MDN) * 1024 / 2; i += NGT) ((unsigned*)(ws + W_MDN + (size_t)MDN * 1024 * 2))[i] = 0u;
    for (int i = gt; i < 2 * 8 * 1024; i += NGT) { const int l = i >> 13, e = (i >> 10) & 7, k = i & 1023; ((float*)(ws + W_RT))[i] = in[21][(size_t)l * 1024 * 8 + k * 8 + e]; }
    rope_table(F, (const int*)in[1], (float*)(ws + WS_ROPE));
}

__device__ __forceinline__ void mla_attention(Frame& F) {
    unsigned char* big = F.ws + WS_BIG;
    const bf16* Q = (const bf16*)(big + B_MQ); const bf16* Kf = (const bf16*)(big + B_MK); const bf16* V = (const bf16*)(big + B_MV); bf16* O = (bf16*)(big + B_MO);
    const float* tab = (const float*)(F.ws + WS_ROPE);
    for (int L = blockIdx.x; L < NB * MH * 16; L += F.G) {
        const int xcd = L & 7, kk = L >> 3, bh = xcd * 8 + (kk >> 4), x = kk & 15, b = bh >> 3, h = bh & 7;
        for (int pass = 0; pass < 2; ++pass) {
            const int qb = pass ? 31 - x : x; const size_t row0 = (size_t)b * SEQ + qb * 256;
            att::Params p;
            p.Q = Q + row0 * 1536 + h * DQKM; p.ldq = 1536;
            p.K = Kf + (size_t)bh * SEQ * DQKM; p.ldk = DQKM; p.V = V + (size_t)bh * SEQ * DVM; p.ldv = DVM;
            p.O = O + row0 * 1024 + h * DVM; p.ldo = 1024; p.P0 = qb * 256; p.j_lo = 0; p.j_hi = 4 * (qb + 1);
            p.rope = tab + row0 * 64; p.pos = nullptr; p.slope_over_scale = 0.f; p.sink_l2 = 0.f;
            att::attn_block<192, 128, 0, (1 << 30)>(p, F.lds);
        }
    }
}
__device__ __forceinline__ void swa_attention(Frame& F) {
    unsigned char* big = F.ws + WS_BIG;
    const bf16* QKV = (const bf16*)(big + B_SQKV); bf16* O = (bf16*)(big + B_SO);
    const int* pos = (const int*)F.in[1]; const float* sinks = F.in[16];
    for (int L = blockIdx.x; L < NB * 16 * 32; L += F.G) {
        const int xcd = L & 7, kk = L >> 3, pair = xcd * 2 + (kk >> 8), u = kk & 255, qb = u >> 3, g = u & 7, b = pair >> 1, kvh = pair & 1, qh = kvh * 8 + g;
        const size_t row0 = (size_t)b * SEQ + qb * 256;
        att::Params p;
        p.Q = QKV + row0 * SQKV + qh * 64; p.ldq = SQKV;
        p.K = QKV + (size_t)b * SEQ * SQKV + 1024 + kvh * 64; p.ldk = SQKV; p.V = QKV + (size_t)b * SEQ * SQKV + 1152 + kvh * 64; p.ldv = SQKV;
        p.O = O + row0 * 1024 + qh * 64; p.ldo = 1024; p.P0 = qb * 256; p.j_lo = qb ? 4 * qb - 2 : 0; p.j_hi = 4 * qb + 4;
        p.rope = nullptr; p.pos = pos + (size_t)b * SEQ;
        p.slope_over_scale = __builtin_amdgcn_exp2f(-0.5f * (float)(qh + 1)) * 8.0f;
        p.sink_l2 = sinks[qh] * 1.4426950408889634f;
        att::attn_block<64, 64, 1, 128>(p, F.lds);
    }
}

struct Args { const float* in[24]; float* out; unsigned char* ws; int ph_lo, ph_hi; };
constexpr int N_PHASES = 33;
__global__ void __launch_bounds__(NTHREADS, 2) mega(Args args) {
    extern __shared__ __attribute__((aligned(16))) unsigned char lds_raw[];
    Frame F;
    F.lds = (char*)lds_raw;
    F.G = gridDim.x; { const int bx = blockIdx.x; F.vcu = (F.G % 8 == 0) ? (bx % 8) * (F.G / 8) + bx / 8 : bx; }
    F.ws = args.ws; F.out = args.out; F.in = args.in;
    unsigned char* ws = args.ws; unsigned char* big = ws + WS_BIG;
    unsigned* ctl = (unsigned*)(ws + WS_CTL);
    volatile LAS unsigned* misc = (volatile LAS unsigned*)((LAS unsigned char*)lds_raw + MISC_OFF);
    if (threadIdx.x < 32) misc[threadIdx.x] = 0u;
    __syncthreads();
    const int lo = args.ph_lo, hi = args.ph_hi;
    XcdBarrier bar; bar.bar = ctl + CW_BAR; bar.x = 0; bar.st = nullptr;
    if (hi - lo > 1) bar = xcd_barrier_post(ctl + CW_BAR, misc + 8);
#ifndef PH_SEL
#define PH_SEL -1
#endif
#define IN(k) ((PH_SEL < 0 || PH_SEL == (k)) && lo <= (k) && (k) < hi)
#define SEAM(k) do { if (IN(k) && IN((k) + 1)) xcd_barrier(bar); } while (0)
    const float* x_in = args.in[0]; float* X = args.out;
    bf16* XN = (bf16*)(ws + WS_XN); bf16* XG = (bf16*)(ws + WS_XG);
    unsigned* rt_e = (unsigned*)(ws + RT_E); float* rt_w0 = (float*)(ws + RT_W0); float* rt_w1 = (float*)(ws + RT_W1); int* rt_s0 = (int*)(ws + RT_S0); int* rt_s1 = (int*)(ws + RT_S1);
    unsigned* rt_cnt = (unsigned*)(ws + RT_CNT); unsigned* rt_pb = (unsigned*)(ws + RT_PB);
    const float* nmix = args.in[2]; const float* nffn = args.in[3];

    if (IN(0)) { prologue(F); __syncthreads();
        RowArgs a{}; a.Xsrc = x_in; a.g = nmix; a.XN = XN; row_pass<0, false>(F, a); }
    SEAM(0);
    if (IN(1)) { gemm_static(F, XN, D, D, (const bf16*)(ws + W_CINB), 1024, pg8::EpiBf16{(bf16*)(big + B_CONV_B), D, nullptr});
                 gemm_static(F, XN, D, D, (const bf16*)(ws + W_CINCU), 2048, pg8::EpiPair<0>{(bf16*)(big + B_CONV_V), D}); }
    SEAM(1);
    if (IN(2)) conv_pass(F, (const bf16*)(big + B_CONV_B), (const bf16*)(big + B_CONV_V), args.in[6], (bf16*)(big + B_CONV_Y));
    SEAM(2);
    if (IN(3)) gemm_static(F, (const bf16*)(big + B_CONV_Y), D, D, (const bf16*)(ws + W_COUT), 1024, pg8::EpiRes{x_in, X, D, nullptr});
    SEAM(3);
    if (IN(4)) { RowArgs a{}; a.Xsrc = X; a.g = nffn; a.XN = XN; row_pass<0, false>(F, a); }
    SEAM(4);
    if (IN(5)) gemm_static(F, XN, D, D, (const bf16*)(ws + W_FGU), 2 * FF, pg8::EpiPair<1>{(bf16*)(big + B_HMID), FF});
    SEAM(5);
    if (IN(6)) gemm_static(F, (const bf16*)(big + B_HMID), FF, FF, (const bf16*)(ws + W_FD), 1024, pg8::EpiRes{X, X, D, nullptr});
    SEAM(6);
    if (IN(7)) { RowArgs a{}; a.Xsrc = X; a.g = nmix + D; a.XN = XN; row_pass<0, false>(F, a); }
    SEAM(7);
    if (IN(8)) gemm_static(F, XN, D, D, (const bf16*)(ws + W_MDN), MDNP, pg8::EpiF32{(float*)(big + B_MC), MDNP});
    SEAM(8);
    if (IN(9)) mla_mid(F, (const float*)(big + B_MC), args.in[9], args.in[11], (const float*)(ws + WS_ROPE), (bf16*)(big + B_MCQ), (bf16*)(big + B_MCKV), (bf16*)(big + B_MK));
    SEAM(9);
    if (IN(10)) {
#ifndef NO_UQ
 gemm_static(F, (const bf16*)(big + B_MCQ), QL, QL, (const bf16*)(ws + W_MUQ), 1536, pg8::EpiBf16{(bf16*)(big + B_MQ), 1536, nullptr});
#endif
#ifndef NO_UKV
                  gemm_static(F, (const bf16*)(big + B_MCKV), KVL, KVL, (const bf16*)(ws + W_MUKV), 2048, pg8::EpiKV{(bf16*)(big + B_MK), (bf16*)(big + B_MV)});
#endif
 }
    SEAM(10);
    if (IN(11)) mla_attention(F);
    SEAM(11);
    if (IN(12)) gemm_static(F, (const bf16*)(big + B_MO), D, D, (const bf16*)(ws + W_MO), 1024, pg8::EpiRes{X, X, D, nullptr});
    SEAM(12);
    if (IN(13)) { RowArgs a{}; a.Xsrc = X; a.g = nffn + D; a.XN = XN; a.routerT = (const float*)(ws + W_RT); a.rt_e = rt_e; a.rt_w0 = rt_w0; a.rt_w1 = rt_w1; a.cnt = rt_cnt; row_pass<1, false>(F, a); }
    SEAM(13);
    if (IN(14)) moe_assign(F, rt_cnt, rt_e, rt_s0, rt_s1, rt_pb, XN, XG);
    SEAM(14);
    if (IN(15)) gemm_grouped(F, XG, D, D, (const bf16*)(ws + W_MGU), (size_t)2 * FE * 1024 * 2, 2 * FE, rt_pb, pg8::EpiPair<1>{(bf16*)big, FE});
    SEAM(15);
    if (IN(16)) gemm_grouped(F, (const bf16*)big, FE, FE, (const bf16*)(ws + W_MD), (size_t)1024 * FE * 2, 1024, rt_pb, pg8::EpiBf16{XG, D, nullptr});
    SEAM(16);
    if (IN(17)) { RowArgs a{}; a.Xsrc = X; a.Xdst = X; a.g = nmix + 2 * D; a.XN = XN; a.Y = XG; a.s0 = rt_s0; a.s1 = rt_s1; a.w0 = rt_w0; a.w1 = rt_w1; row_pass<0, true>(F, a); }
    SEAM(17);
    if (IN(18)) gemm_static(F, XN, D, D, (const bf16*)(ws + W_SQKV), SQKV, pg8::EpiBf16{(bf16*)(big + B_SQKV), SQKV, args.in[15]});
    SEAM(18);
    if (IN(19)) swa_attention(F);
    SEAM(19);
    if (IN(20)) gemm_static(F, (const bf16*)(big + B_SO), D, D, (const bf16*)(ws + W_SO), 1024, pg8::EpiRes{X, X, D, args.in[18]});
    SEAM(20);
    if (IN(21)) { RowArgs a{}; a.Xsrc = X; a.g = nffn + 2 * D; a.XN = XN; row_pass<0, false>(F, a); }
    SEAM(21);
    if (IN(22)) gemm_static(F, XN, D, D, (const bf16*)(ws + W_FGU + (size_t)2 * FF * 1024 * 2), 2 * FF, pg8::EpiPair<1>{(bf16*)(big + B_HMID), FF});
    SEAM(22);
    if (IN(23)) gemm_static(F, (const bf16*)(big + B_HMID), FF, FF, (const bf16*)(ws + W_FD + (size_t)1024 * FF * 2), 1024, pg8::EpiRes{X, X, D, nullptr});
    SEAM(23);
    if (IN(24)) { RowArgs a{}; a.Xsrc = X; a.g = nmix + 3 * D; a.XN = XN; row_pass<0, false>(F, a); }
    SEAM(24);
    if (IN(25)) { gemm_static(F, XN, D, D, (const bf16*)(ws + W_CINB + (size_t)1024 * 1024 * 2), 1024, pg8::EpiBf16{(bf16*)(big + B_CONV_B), D, nullptr});
                  gemm_static(F, XN, D, D, (const bf16*)(ws + W_CINCU + (size_t)2048 * 1024 * 2), 2048, pg8::EpiPair<0>{(bf16*)(big + B_CONV_V), D}); }
    SEAM(25);
    if (IN(26)) conv_pass(F, (const bf16*)(big + B_CONV_B), (const bf16*)(big + B_CONV_V), args.in[6] + 3 * D, (bf16*)(big + B_CONV_Y));
    SEAM(26);
    if (IN(27)) gemm_static(F, (const bf16*)(big + B_CONV_Y), D, D, (const bf16*)(ws + W_COUT + (size_t)1024 * 1024 * 2), 1024, pg8::EpiRes{X, X, D, nullptr});
    SEAM(27);
    if (IN(28)) { RowArgs a{}; a.Xsrc = X; a.g = nffn + 3 * D; a.XN = XN; a.routerT = (const float*)(ws + W_RT) + 8 * 1024; a.rt_e = rt_e; a.rt_w0 = rt_w0; a.rt_w1 = rt_w1; a.cnt = rt_cnt; row_pass<1, false>(F, a); }
    SEAM(28);
    if (IN(29)) moe_assign(F, rt_cnt, rt_e, rt_s0, rt_s1, rt_pb + 16, XN, XG);
    SEAM(29);
    if (IN(30)) gemm_grouped(F, XG, D, D, (const bf16*)(ws + W_MGU + (size_t)8 * 2 * FE * 1024 * 2), (size_t)2 * FE * 1024 * 2, 2 * FE, rt_pb + 16, pg8::EpiPair<1>{(bf16*)big, FE});
    SEAM(30);
    if (IN(31)) gemm_grouped(F, (const bf16*)big, FE, FE, (const bf16*)(ws + W_MD + (size_t)8 * 1024 * FE * 2), (size_t)1024 * FE * 2, 1024, rt_pb + 16, pg8::EpiBf16{XG, D, nullptr});
    SEAM(31);
    if (IN(32)) { RowArgs a{}; a.Xsrc = X; a.g = args.in[4]; a.outF = X; a.Y = XG; a.s0 = rt_s0; a.s1 = rt_s1; a.w0 = rt_w0; a.w1 = rt_w1; row_pass<2, true>(F, a); }
#undef IN
#undef SEAM
}

#ifndef MK_LAUNCH_PER_PHASE
#define MK_LAUNCH_PER_PHASE 0
#endif
extern "C" void kernel_launch(void* const* d_in, const int* in_sizes, int n_in, void* d_out, int out_size, void* d_ws, size_t ws_size, hipStream_t stream) {
    static int grid = 0;
    if (grid == 0) {
        if (n_in != 24 || in_sizes[0] != T * D || out_size != T * D || ws_size < WS_END) { fprintf(stderr, "kernel_launch: unexpected shapes (n_in %d, in0 %d, out %d, ws %zu < %zu); nothing launched\n", n_in, n_in > 0 ? in_sizes[0] : -1, out_size, ws_size, (size_t)WS_END); grid = -1; return; }
        int dev = 0, cus = 0, per_cu = 0;
        if (hipGetDevice(&dev) != hipSuccess || hipDeviceGetAttribute(&cus, hipDeviceAttributeMultiprocessorCount, dev) != hipSuccess) { grid = -1; return; }
        if (hipFuncSetAttribute((const void*)mega, hipFuncAttributeMaxDynamicSharedMemorySize, LDS_BYTES) != hipSuccess) { fprintf(stderr, "kernel_launch: hipFuncSetAttribute failed\n"); grid = -1; return; }
        if (hipOccupancyMaxActiveBlocksPerMultiprocessor(&per_cu, (const void*)mega, NTHREADS, LDS_BYTES) != hipSuccess || per_cu < 1) fprintf(stderr, "kernel_launch: occupancy query reports %d\n", per_cu);
        (void)hipGetLastError();
        grid = cus;
    }
    if (grid < 0) return;
    (void)hipMemsetAsync((char*)d_ws + WS_CTL, 0, CTL_ZERO_BYTES, stream);
    Args a{};
    for (int i = 0; i < 24; ++i) a.in[i] = (const float*)d_in[i];
    a.out = (float*)d_out; a.ws = (unsigned char*)d_ws;
#if MK_LAUNCH_PER_PHASE
    for (int p = 0; p < N_PHASES; ++p) { a.ph_lo = p; a.ph_hi = p + 1; hipLaunchKernelGGL(mega, dim3(grid), dim3(NTHREADS), LDS_BYTES, stream, a); }
#else
    a.ph_lo = 0; a.ph_hi = N_PHASES; hipLaunchKernelGGL(mega, dim3(grid), dim3(NTHREADS), LDS_BYTES, stream, a);
#endif
}
```

```cpp
#include <hip/hip_runtime.h>
#include <cstdio>
#include <cstdint>

#define LAS __attribute__((address_space(3)))
#define GAS __attribute__((address_space(1)))
typedef unsigned short bf16;
typedef short bf16x8 __attribute__((ext_vector_type(8)));
typedef short s16x4 __attribute__((ext_vector_type(4)));
typedef float f32x2 __attribute__((ext_vector_type(2)));
typedef float f32x4 __attribute__((ext_vector_type(4)));
typedef float f32x16 __attribute__((ext_vector_type(16)));
typedef unsigned u32x2 __attribute__((ext_vector_type(2)));
typedef unsigned u32x4 __attribute__((ext_vector_type(4)));

__device__ __forceinline__ unsigned cvt_pk_bf16(float lo, float hi) { unsigned r; asm volatile("v_cvt_pk_bf16_f32 %0, %1, %2" : "=v"(r) : "v"(lo), "v"(hi)); return r; }
__device__ __forceinline__ float bf2f(unsigned short b) { return __uint_as_float(((unsigned)b) << 16); }
__device__ __forceinline__ float bflo(unsigned w) { return __uint_as_float(w << 16); }
__device__ __forceinline__ float bfhi(unsigned w) { return __uint_as_float(w & 0xffff0000u); }
__device__ __forceinline__ float wave_sum(float v) {
#pragma unroll
    for (int o = 1; o < 64; o <<= 1) v += __shfl_xor(v, o);
    return v;
}
__device__ __forceinline__ float fast_silu(float g) { return g * __builtin_amdgcn_rcpf(1.0f + __builtin_amdgcn_exp2f(-1.4426950408889634f * g)); }

namespace pg8 {
constexpr int BM = 256, BK = 64, HALF = 128, HTB = HALF * BK * 2, STAGE_BYTES = 8 * HTB, NXCD = 8, WGM = 8;
__host__ __device__ __forceinline__ int lds_byte(int r, int c) { const int st = (r >> 4) * 2 + (c >> 5), rr = r & 15, cc = c & 31, ob = rr * 64 + cc * 2; return st * 1024 + (ob ^ (((ob >> 9) & 1) << 5)); }
__host__ __device__ __forceinline__ void stage_rc(int b, int& R, int& C) { const int st = b / 1024, sb = b % 1024, swz = sb ^ (((sb >> 9) & 1) << 5); R = (st >> 1) * 16 + swz / 64; C = (st & 1) * 32 + (swz % 64) / 2; }
__host__ __device__ __forceinline__ int perm32(int rho) { const int n = rho >> 4, i = rho & 15; return 8 * (i >> 2) + 4 * n + (i & 3); }

struct Unit { int pm, pn, e; };
struct Gemm { const bf16* A; const bf16* Bt; int lda, K; size_t estride; };

struct StaticOrder {
    int nM, nN, nwg, G, c;
    __device__ __forceinline__ void init(int M, int N, int G_, int c_) { nM = M / BM; nN = N / BM; nwg = nM * nN; G = G_; c = c_; }
    __device__ __forceinline__ bool next(int i, Unit& u) const {
        const long L = (long)i * G + c; if (L >= nwg) return false;
        int wgid = (int)L; { const int q = nwg / NXCD, r = nwg % NXCD, xcd = wgid % NXCD, off = wgid / NXCD; wgid = (xcd < r ? xcd * (q + 1) : r * (q + 1) + (xcd - r) * q) + off; }
        const int nig = WGM * nN, gid = wgid / nig, fm = gid * WGM, gsz = (nM - fm) < WGM ? (nM - fm) : WGM;
        u.pm = fm + ((wgid % nig) % gsz); u.pn = (wgid % nig) / gsz; u.e = 0; return true;
    }
};
struct GroupedOrder {
    const LAS unsigned* tab;
    __device__ __forceinline__ void init(const unsigned* pbase, int N, int G, int c, LAS unsigned* table, int cap) {
        const int tid = threadIdx.x;
        int pb[9];
#pragma unroll
        for (int i = 0; i < 9; ++i) pb[i] = (int)__hip_atomic_load(pbase + i, __ATOMIC_RELAXED, __HIP_MEMORY_SCOPE_AGENT);
        const int nM = pb[8], nN = N / BM, nwg = nM * nN;
        if (tid < cap) {
            unsigned w = 0u; const long L = (long)tid * G + c;
            if (L < nwg) {
                int wgid = (int)L; { const int q = nwg / NXCD, r = nwg % NXCD, xcd = wgid % NXCD, off = wgid / NXCD; wgid = (xcd < r ? xcd * (q + 1) : r * (q + 1) + (xcd - r) * q) + off; }
                const int nig = WGM * nN, gid = wgid / nig, fm = gid * WGM, gsz = (nM - fm) < WGM ? (nM - fm) : WGM;
                const int pm = fm + ((wgid % nig) % gsz), pn = (wgid % nig) / gsz;
                int e = 0;
#pragma unroll
                for (int j = 1; j < 8; ++j) e += (pm >= pb[j]) ? 1 : 0;
                w = (unsigned)pm | ((unsigned)pn << 12) | ((unsigned)e << 20) | 0x80000000u;
            }
            table[tid] = w;
        }
        tab = table;
        __syncthreads();
    }
    __device__ __forceinline__ bool next(int i, Unit& u) const {
        const unsigned w = (unsigned)__builtin_amdgcn_readfirstlane((int)tab[i]);
        u.pm = (int)(w & 0xfffu); u.pn = (int)((w >> 12) & 0xffu); u.e = (int)((w >> 20) & 0xfu); return (w >> 31) != 0u;
    }
};

struct EpiBf16 {
    static constexpr bool PERM = true;
    bf16* O; int ldc; const float* bias; float scale;
    __device__ __forceinline__ void operator()(const f32x4 (&acc)[2][2][4][2], const Unit& u, int wr, int wc, int fr, int fq) const {
        const int row0 = u.pm * BM + wr * 64 + fr, col0 = u.pn * BM + wc * 32 + 8 * fq;
        f32x4 bv[2][2];
#pragma unroll
        for (int bj = 0; bj < 2; ++bj)
#pragma unroll
            for (int n = 0; n < 2; ++n) bv[bj][n] = bias ? *(const f32x4*)(bias + col0 + bj * HALF + 4 * n) : (f32x4){0.f, 0.f, 0.f, 0.f};
#pragma unroll
        for (int ai = 0; ai < 2; ++ai)
#pragma unroll
            for (int m = 0; m < 4; ++m) { bf16* rowp = O + (size_t)(row0 + ai * HALF + m * 16) * ldc + col0;
#pragma unroll
                for (int bj = 0; bj < 2; ++bj) { const f32x4 v0 = acc[ai][bj][m][0] * scale + bv[bj][0], v1 = acc[ai][bj][m][1] * scale + bv[bj][1];
                    u32x4 w; w.x = cvt_pk_bf16(v0[0], v0[1]); w.y = cvt_pk_bf16(v0[2], v0[3]); w.z = cvt_pk_bf16(v1[0], v1[1]); w.w = cvt_pk_bf16(v1[2], v1[3]);
                    *(u32x4*)(rowp + bj * HALF) = w; } }
    }
};
template <int ACT  > struct EpiPair {
    static constexpr bool PERM = true;
    bf16* O; int ldc;
    __device__ __forceinline__ void operator()(const f32x4 (&acc)[2][2][4][2], const Unit& u, int wr, int wc, int fr, int fq) const {
        const int row0 = u.pm * BM + wr * 64 + fr, col0 = u.pn * HALF + wc * 32 + 8 * fq;
#pragma unroll
        for (int ai = 0; ai < 2; ++ai)
#pragma unroll
            for (int m = 0; m < 4; ++m) { bf16* rowp = O + (size_t)(row0 + ai * HALF + m * 16) * ldc + col0;
                f32x4 r[2];
#pragma unroll
                for (int n = 0; n < 2; ++n) { const f32x4 a = acc[ai][0][m][n], b = acc[ai][1][m][n];
                    if (ACT == 1) r[n] = (f32x4){fast_silu(a[0]) * b[0], fast_silu(a[1]) * b[1], fast_silu(a[2]) * b[2], fast_silu(a[3]) * b[3]};
                    else r[n] = a * b; }
                u32x4 w; w.x = cvt_pk_bf16(r[0][0], r[0][1]); w.y = cvt_pk_bf16(r[0][2], r[0][3]); w.z = cvt_pk_bf16(r[1][0], r[1][1]); w.w = cvt_pk_bf16(r[1][2], r[1][3]);
                *(u32x4*)rowp = w; }
    }
};
struct EpiPair8 {
    static constexpr bool PERM = true;
    unsigned char* O; int ldc; float sin, sout;
    __device__ __forceinline__ void operator()(const f32x4 (&acc)[2][2][4][2], const Unit& u, int wr, int wc, int fr, int fq) const {
        const int row0 = u.pm * BM + wr * 64 + fr, col0 = u.pn * HALF + wc * 32 + 8 * fq;
#pragma unroll
        for (int ai = 0; ai < 2; ++ai)
#pragma unroll
            for (int m = 0; m < 4; ++m) { unsigned char* rowp = O + (size_t)(row0 + ai * HALF + m * 16) * ldc + col0;
                float r[8];
#pragma unroll
                for (int n = 0; n < 2; ++n) { const f32x4 a = acc[ai][0][m][n] * sin, b = acc[ai][1][m][n] * (sin * sout);
#pragma unroll
                    for (int j = 0; j < 4; ++j) r[4 * n + j] = fminf(fmaxf(fast_silu(a[j]) * b[j], -448.f), 448.f); }
                u32x2 w; int t = __builtin_amdgcn_cvt_pk_fp8_f32(r[0], r[1], 0, false); t = __builtin_amdgcn_cvt_pk_fp8_f32(r[2], r[3], t, true); w.x = (unsigned)t;
                t = __builtin_amdgcn_cvt_pk_fp8_f32(r[4], r[5], 0, false); t = __builtin_amdgcn_cvt_pk_fp8_f32(r[6], r[7], t, true); w.y = (unsigned)t;
                *(u32x2*)rowp = w; }
    }
};
struct EpiRes {
    static constexpr bool PERM = false;
    const float* src; float* dst; int ldc; const float* bias;
    __device__ __forceinline__ void operator()(const f32x4 (&acc)[2][2][4][2], const Unit& u, int wr, int wc, int fr, int fq) const {
        const int row0 = u.pm * BM + wr * 64 + fr, col0 = u.pn * BM + wc * 32 + 4 * fq;
        f32x4 bv[2][2];
#pragma unroll
        for (int bj = 0; bj < 2; ++bj)
#pragma unroll
            for (int n = 0; n < 2; ++n) bv[bj][n] = bias ? *(const f32x4*)(bias + col0 + bj * HALF + n * 16) : (f32x4){0.f, 0.f, 0.f, 0.f};
#pragma unroll
        for (int ai = 0; ai < 2; ++ai)
#pragma unroll
            for (int m = 0; m < 4; ++m) { const size_t off = (size_t)(row0 + ai * HALF + m * 16) * ldc + col0;
                f32x4 s[2][2];
#pragma unroll
                for (int bj = 0; bj < 2; ++bj)
#pragma unroll
                    for (int n = 0; n < 2; ++n) s[bj][n] = *(const f32x4*)(src + off + bj * HALF + n * 16);
#pragma unroll
                for (int bj = 0; bj < 2; ++bj)
#pragma unroll
                    for (int n = 0; n < 2; ++n) *(f32x4*)(dst + off + bj * HALF + n * 16) = s[bj][n] + acc[ai][bj][m][n] + bv[bj][n];
                asm volatile("" ::: "memory"); }
    }
};
struct EpiF32 {
    static constexpr bool PERM = false;
    float* C; int ldc;
    __device__ __forceinline__ void operator()(const f32x4 (&acc)[2][2][4][2], const Unit& u, int wr, int wc, int fr, int fq) const {
        const int row0 = u.pm * BM + wr * 64 + fr, col0 = u.pn * BM + wc * 32 + 4 * fq;
#pragma unroll
        for (int ai = 0; ai < 2; ++ai)
#pragma unroll
            for (int m = 0; m < 4; ++m) { float* rowp = C + (size_t)(row0 + ai * HALF + m * 16) * ldc + col0;
#pragma unroll
                for (int bj = 0; bj < 2; ++bj)
#pragma unroll
                    for (int n = 0; n < 2; ++n) *(f32x4*)(rowp + bj * HALF + n * 16) = acc[ai][bj][m][n]; }
    }
};
struct EpiKV {
    static constexpr bool PERM = true;
    bf16* Kf; bf16* V;
    __device__ __forceinline__ void operator()(const f32x4 (&acc)[2][2][4][2], const Unit& u, int wr, int wc, int fr, int fq) const {
        const int row0 = u.pm * BM + wr * 64 + fr, col0 = wc * 32 + 8 * fq, h = u.pn;
#pragma unroll
        for (int ai = 0; ai < 2; ++ai)
#pragma unroll
            for (int m = 0; m < 4; ++m) { const int row = row0 + ai * HALF + m * 16, b = row >> 13, s = row & 8191; const size_t hr = (size_t)(b * 8 + h) * 8192 + s;
#pragma unroll
                for (int bj = 0; bj < 2; ++bj) { const f32x4 v0 = acc[ai][bj][m][0], v1 = acc[ai][bj][m][1];
                    u32x4 w; w.x = cvt_pk_bf16(v0[0], v0[1]); w.y = cvt_pk_bf16(v0[2], v0[3]); w.z = cvt_pk_bf16(v1[0], v1[1]); w.w = cvt_pk_bf16(v1[2], v1[3]);
                    if (bj == 0) *(u32x4*)(Kf + hr * 192 + col0) = w; else *(u32x4*)(V + hr * 128 + col0) = w; } }
    }
};

typedef int v8i32 __attribute__((ext_vector_type(8)));
__device__ __forceinline__ v8i32 cat8(bf16x8 a, bf16x8 b) { typedef int v4i32 __attribute__((ext_vector_type(4))); const v4i32 x = __builtin_bit_cast(v4i32, a), y = __builtin_bit_cast(v4i32, b); return __builtin_shufflevector(x, y, 0, 1, 2, 3, 4, 5, 6, 7); }
template <class Epi, class Sched, bool F8 = false>
__device__ __forceinline__ void gemm_phase(LAS unsigned char* lds, const Gemm g, const Sched& S, const Epi& E) {
    const int tid = threadIdx.x, wid = __builtin_amdgcn_readfirstlane(tid >> 6), lane = tid & 63, wr = wid >> 2, wc = wid & 3, fr = lane & 15, fq = lane >> 4;
    const int K = g.K, nt = K / BK, lda = g.lda;
    unsigned voffA[2], voffB[2];
#pragma unroll
    for (int i = 0; i < 2; ++i) { int R, C; stage_rc(tid * 16 + i * 8192, R, C); const int Rb = Epi::PERM ? ((R & ~31) + perm32(R & 31)) : R;
        voffA[i] = (unsigned)(R * lda + C) * 2u; voffB[i] = (unsigned)(Rb * K + C) * 2u; }
    const size_t kstep = (size_t)(BK * 2);
    const size_t hstepA = (size_t)HALF * lda * 2, hstepB = (size_t)HALF * K * 2;
    const size_t tstepA = 2 * hstepA, tstepB = 2 * hstepB;
    const unsigned ldsw = (unsigned)wid * 1024u;
    const int aoff = lds_byte(wr * 64 + fr, fq * 8), boff = lds_byte(wc * 32 + fr, fq * 8);
#define PG8_SA(b, h) (((b) * 2 + (h)) * HTB)
#define PG8_SB(b, h) ((4 + (b) * 2 + (h)) * HTB)
#define PG8_STAGE(bufoff, gbase, voff) do { _Pragma("unroll") for (int _i = 0; _i < 2; ++_i) \
        __builtin_amdgcn_global_load_lds((const unsigned*)((const char*)(gbase) + (voff)[_i]), (LAS unsigned*)(lds + (bufoff) + ldsw + _i * 8192), 16, 0, 0); } while (0)
#define PG8_LDA(dst, b, h) do { _Pragma("unroll") for (int m = 0; m < 4; ++m) _Pragma("unroll") for (int k = 0; k < 2; ++k) dst[m][k] = *(const LAS bf16x8*)(lds + PG8_SA(b, h) + aoff + m * 2048 + k * 1024); } while (0)
#define PG8_LDB(dst, b, h) do { _Pragma("unroll") for (int n = 0; n < 2; ++n) _Pragma("unroll") for (int k = 0; k < 2; ++k) dst[n][k] = *(const LAS bf16x8*)(lds + PG8_SB(b, h) + boff + n * 2048 + k * 1024); } while (0)
#define PG8_MMA(ai, bj, At, Bt) do { __builtin_amdgcn_s_setprio(1); if constexpr (F8) asm volatile("s_nop 1"); _Pragma("unroll") for (int m = 0; m < 4; ++m) _Pragma("unroll") for (int n = 0; n < 2; ++n) { \
        if constexpr (F8) { const v8i32 b8_ = cat8(Bt[n][0], Bt[n][1]), a8_ = cat8(At[m][0], At[m][1]); asm("v_mfma_f32_16x16x128_f8f6f4 %0, %1, %2, %0" : "+v"(acc[ai][bj][m][n]) : "v"(b8_), "v"(a8_)); } \
        else { _Pragma("unroll") for (int k = 0; k < 2; ++k) acc[ai][bj][m][n] = __builtin_amdgcn_mfma_f32_16x16x32_bf16(Bt[n][k], At[m][k], acc[ai][bj][m][n], 0, 0, 0); } } __builtin_amdgcn_s_setprio(0); } while (0)
#define PG8_WAIT_V(n) asm volatile("s_waitcnt vmcnt(" #n ")" ::: "memory")
#define PG8_WAIT_L(n) asm volatile("s_waitcnt lgkmcnt(" #n ")" ::: "memory")
#define PG8_BAR __builtin_amdgcn_s_barrier()
#define PG8_SCHED __builtin_amdgcn_sched_barrier(0)
    Unit cur, nxt; int ui = 0;
    if (!S.next(0, cur)) return;
    f32x4 acc[2][2][4][2];
#pragma unroll
    for (int a = 0; a < 2; ++a)
#pragma unroll
        for (int b = 0; b < 2; ++b)
#pragma unroll
            for (int m = 0; m < 4; ++m)
#pragma unroll
                for (int n = 0; n < 2; ++n) acc[a][b][m][n] = (f32x4){0.f, 0.f, 0.f, 0.f};
    bf16x8 At[4][2], B0[2][2], B1[2][2];
    const char* cA = (const char*)g.A + (size_t)cur.pm * tstepA; const char* cB = (const char*)g.Bt + (size_t)cur.e * g.estride + (size_t)cur.pn * tstepB;
    PG8_STAGE(PG8_SB(0, 0), cB, voffB); PG8_STAGE(PG8_SB(0, 1), cB + hstepB, voffB); PG8_STAGE(PG8_SA(0, 0), cA, voffA); PG8_STAGE(PG8_SA(0, 1), cA + hstepA, voffA);
    if (wr == 1) PG8_BAR;
    PG8_WAIT_V(2); PG8_BAR;
    PG8_STAGE(PG8_SB(1, 0), cB + kstep, voffB); PG8_STAGE(PG8_SA(1, 0), cA + kstep, voffA); PG8_STAGE(PG8_SB(1, 1), cB + hstepB + kstep, voffB);
    PG8_WAIT_V(6); PG8_BAR;
    for (;;) {
        const bool has_next = S.next(ui + 1, nxt);
        const char* nA = has_next ? (const char*)g.A + (size_t)nxt.pm * tstepA : cA; const char* nB = has_next ? (const char*)g.Bt + (size_t)nxt.e * g.estride + (size_t)nxt.pn * tstepB : cB;
#pragma nounroll
        for (int t = 0; t < nt; t += 2) {
            const bool last = (t == nt - 2);
            const char* a1 = cA + (size_t)(t + 1) * kstep;
            const char* a2 = last ? nA : cA + (size_t)(t + 2) * kstep; const char* b2 = last ? nB : cB + (size_t)(t + 2) * kstep;
            const char* a3 = a2 + kstep; const char* b3 = b2 + kstep;
            PG8_LDB(B0, 0, 0); PG8_LDB(B1, 0, 1); PG8_SCHED; PG8_LDA(At, 0, 0); PG8_STAGE(PG8_SA(1, 1), a1 + hstepA, voffA);
            PG8_WAIT_V(8); PG8_WAIT_L(0); PG8_BAR; PG8_MMA(0, 0, At, B0); PG8_MMA(0, 1, At, B1); PG8_BAR; PG8_SCHED;
            PG8_LDA(At, 0, 1); PG8_STAGE(PG8_SB(0, 0), b2, voffB); PG8_STAGE(PG8_SB(0, 1), b2 + hstepB, voffB); PG8_STAGE(PG8_SA(0, 0), a2, voffA);
            PG8_WAIT_V(8); PG8_WAIT_L(0); PG8_BAR; PG8_MMA(1, 0, At, B0); PG8_MMA(1, 1, At, B1); PG8_BAR; PG8_SCHED;
            PG8_LDB(B0, 1, 0); PG8_LDB(B1, 1, 1); PG8_SCHED; PG8_LDA(At, 1, 0); PG8_STAGE(PG8_SA(0, 1), a2 + hstepA, voffA);
            PG8_WAIT_V(8); PG8_WAIT_L(0); PG8_BAR; PG8_MMA(0, 0, At, B0); PG8_MMA(0, 1, At, B1); PG8_BAR; PG8_SCHED;
            PG8_LDA(At, 1, 1); PG8_STAGE(PG8_SB(1, 0), b3, voffB); PG8_STAGE(PG8_SB(1, 1), b3 + hstepB, voffB); PG8_STAGE(PG8_SA(1, 0), a3, voffA);
            PG8_WAIT_V(8); PG8_WAIT_L(0); PG8_BAR; PG8_MMA(1, 0, At, B0); PG8_MMA(1, 1, At, B1); PG8_BAR; PG8_SCHED;
        }
        if constexpr (F8) asm volatile("s_nop 15\n\ts_nop 15" ::: "memory");
        if (wr == 0) PG8_BAR;
        E(acc, cur, wr, wc, fr, fq);
        if (!has_next) break;
#pragma unroll
        for (int a = 0; a < 2; ++a)
#pragma unroll
            for (int b = 0; b < 2; ++b)
#pragma unroll
                for (int m = 0; m < 4; ++m)
#pragma unroll
                    for (int n = 0; n < 2; ++n) acc[a][b][m][n] = (f32x4){0.f, 0.f, 0.f, 0.f};
        cur = nxt; cA = nA; cB = nB; ++ui;
        if (wr == 1) PG8_BAR;
    }
    PG8_WAIT_V(0);
    PG8_BAR;
#undef PG8_SA
#undef PG8_SB
#undef PG8_STAGE
#undef PG8_LDA
#undef PG8_LDB
#undef PG8_MMA
#undef PG8_WAIT_V
#undef PG8_WAIT_L
#undef PG8_BAR
#undef PG8_SCHED
}
}
namespace att {
constexpr int NW = 8, QBLK = 32, KVBLK = 64, QB = NW * QBLK;
__device__ __forceinline__ int crow(int r, int hi) { return (r & 3) + 8 * (r >> 2) + 4 * hi; }
template <int NCB> __device__ __forceinline__ int v_st(int k, int c) { const int kk = (k & ~0xC) | ((k & 4) << 1) | ((k & 8) >> 1); return ((kk >> 3) * NCB + (c >> 5)) * 512 + ((kk & 7) * 32 + (c & 31)) * 2; }
__device__ __forceinline__ int v_rd_base(int lane) { return ((lane & 3) << 3) | (((lane >> 2) & 3) << 6) | (((lane >> 4) & 1) << 5) | (((lane >> 5) & 1) << 8); }

struct Params {
    const bf16* Q; int ldq;
    const bf16* K; int ldk;
    const bf16* V; int ldv;
    bf16* O; int ldo;
    int P0;
    int j_lo, j_hi;
    const float* rope;
    const int* pos;
    float slope_over_scale, sink_l2;
};

template <int DQK, int DV, int KIND, int W>
__device__ __forceinline__ void attn_block(const Params& p, char* lds) {
    constexpr int NKS = DQK / 64, ND0 = DQK / 16, NCB = DV / 32, NVP = DV / 64;
    constexpr int KT = NKS * 8192, VT = KVBLK * DV * 2;
    constexpr int OFF_K = 2 * VT, OFF_KP = OFF_K + 2 * KT, OFF_WS = OFF_KP + 2 * 256;
    const float SCALE = (DQK == 192) ? 0.07216878364870322f : 0.125f;
    const float C2 = 1.4426950408889634f * SCALE;
    constexpr float THR = 8.f;
    const int tid = threadIdx.x, wid = __builtin_amdgcn_readfirstlane(tid >> 6), lane = tid & 63, r32 = lane & 31, hi = lane >> 5;
    LAS unsigned char* lds3 = (LAS unsigned char*)lds; char* V_lds = lds; char* K_lds = lds + OFF_K; float* kp_lds = (float*)(lds + OFF_KP);
    float* ws = (float*)(lds + OFF_WS) + wid * 64; float* li_l = ws, * al_l = ws + 32;
    const int NT = p.j_hi - p.j_lo;
    const int qlo = p.P0 + wid * QBLK, qm = qlo + r32 - 4 * hi;
    unsigned kofs, vofs[NVP];
    { const int q = wid * 64 + lane, key = q >> 3, c = (q & 7) ^ ((key >> 1) & 7); kofs = (unsigned)(key * p.ldk + c * 8) * 2u; }
#pragma unroll
    for (int i = 0; i < NVP; ++i) { const int bo = (wid + 8 * i) * 1024 + lane * 16, sub = bo >> 9, within = bo & 511, kk = (sub / NCB) * 8 + (within >> 6), c = (sub % NCB) * 32 + ((within & 63) >> 1);
        const int k = (kk & ~0xC) | ((kk & 4) << 1) | ((kk & 8) >> 1); vofs[i] = (unsigned)(k * p.ldv + c) * 2u; }
    float st_p = 0.f;
#define ST_LOAD(kb, bf) do { \
        const char* kb_ = (const char*)p.K + (size_t)(kb) * (size_t)(p.ldk * 2); const char* vb_ = (const char*)p.V + (size_t)(kb) * (size_t)(p.ldv * 2); \
        _Pragma("unroll") for (int s_ = 0; s_ < NKS; ++s_) __builtin_amdgcn_global_load_lds((const unsigned*)(kb_ + kofs + s_ * 128), (LAS unsigned*)(lds3 + OFF_K + (bf) * KT + s_ * 8192 + wid * 1024), 16, 0, 0); \
        _Pragma("unroll") for (int i_ = 0; i_ < NVP; ++i_) __builtin_amdgcn_global_load_lds((const unsigned*)(vb_ + vofs[i_]), (LAS unsigned*)(lds3 + (bf) * VT + (wid + 8 * i_) * 1024), 16, 0, 0); \
        if (KIND == 1 && tid < 64) st_p = (float)p.pos[(kb) + tid]; } while (0)
#define ST_WRITE(bf) do { if (KIND == 1 && tid < 64) kp_lds[(bf) * 64 + tid] = st_p; } while (0)
    bf16x8 qr[ND0];
    ST_LOAD(p.j_lo * KVBLK, 0);
    { const bf16* qrow = p.Q + (size_t)(wid * QBLK + r32) * p.ldq + hi * 8;
#pragma unroll
      for (int d0 = 0; d0 < ND0; ++d0) qr[d0] = *(const bf16x8*)(qrow + d0 * 16); }
    float pq = 0.f;
    if (KIND == 0) {
        const float* rt = p.rope + (size_t)(wid * QBLK + r32) * 64;
#pragma unroll
        for (int dd = 0; dd < 2; ++dd) {
            const int i0 = dd * 16 + hi * 8;
            const f32x4 c0 = *(const f32x4*)(rt + i0), c1 = *(const f32x4*)(rt + i0 + 4), s0 = *(const f32x4*)(rt + 32 + i0), s1 = *(const f32x4*)(rt + 32 + i0 + 4);
            bf16x8 a = qr[8 + dd], b = qr[10 + dd]; u32x4 ra, rb; float x1[8], x2[8], cs[8], sn[8];
#pragma unroll
            for (int j = 0; j < 4; ++j) { cs[j] = c0[j]; cs[4 + j] = c1[j]; sn[j] = s0[j]; sn[4 + j] = s1[j]; }
#pragma unroll
            for (int j = 0; j < 8; ++j) { x1[j] = bf2f((unsigned short)a[j]); x2[j] = bf2f((unsigned short)b[j]); }
#pragma unroll
            for (int j = 0; j < 4; ++j) { ra[j] = cvt_pk_bf16(x1[2 * j] * cs[2 * j] - x2[2 * j] * sn[2 * j], x1[2 * j + 1] * cs[2 * j + 1] - x2[2 * j + 1] * sn[2 * j + 1]);
                                          rb[j] = cvt_pk_bf16(x2[2 * j] * cs[2 * j] + x1[2 * j] * sn[2 * j], x2[2 * j + 1] * cs[2 * j + 1] + x1[2 * j + 1] * sn[2 * j + 1]); }
            qr[8 + dd] = *reinterpret_cast<bf16x8*>(&ra); qr[10 + dd] = *reinterpret_cast<bf16x8*>(&rb);
        }
    } else { pq = (float)p.pos[qlo + r32]; }
    int ka[4];
#pragma unroll
    for (int j = 0; j < 4; ++j) ka[j] = r32 * 128 + (((2 * j + hi) ^ ((r32 >> 1) & 7)) << 4);
    const int vb0 = (int)(uintptr_t)V_lds + v_rd_base(lane);
    float m_reg = -1e30f, l_reg = 0.f; f32x16 o[NCB];
#pragma unroll
    for (int d = 0; d < NCB; ++d) o[d] = f32x16{};
    asm volatile("s_waitcnt vmcnt(0)" ::: "memory");
    ST_WRITE(0);
    __syncthreads();
#define TRRD(dst, off) asm volatile("ds_read_b64_tr_b16 %0, %1 offset:%2" : "=&v"(dst) : "v"(vb0), "i"(off) : "memory")
#define TILE(t, BF) do { \
        const int kb_ = (p.j_lo + (t)) * KVBLK; \
        if ((t) + 1 < NT) { const int kn_ = kb_ + KVBLK; ST_LOAD(kn_, (BF) ^ 1); } \
        const bool act_ = (kb_ <= qlo + QBLK - 1) && (kb_ + KVBLK - 1 >= qlo - W + 1); \
        if (act_) { \
            f32x16 p0 = f32x16{}, p1 = f32x16{}; \
            _Pragma("unroll") for (int d0 = 0; d0 < ND0; ++d0) { const char* a_ = K_lds + (BF) * KT + (d0 >> 2) * 8192 + ka[d0 & 3]; \
                const bf16x8 b0 = *(const bf16x8*)a_, b1 = *(const bf16x8*)(a_ + 4096); \
                p0 = __builtin_amdgcn_mfma_f32_32x32x16_bf16(b0, qr[d0], p0, 0, 0, 0); p1 = __builtin_amdgcn_mfma_f32_32x32x16_bf16(b1, qr[d0], p1, 0, 0, 0); } \
            if (KIND == 1) { const float* kq = kp_lds + (BF) * 64 + 4 * hi; \
                _Pragma("unroll") for (int g_ = 0; g_ < 4; ++g_) { const f32x4 k0 = *(const f32x4*)(kq + 8 * g_), k1 = *(const f32x4*)(kq + 32 + 8 * g_); \
                    _Pragma("unroll") for (int c_ = 0; c_ < 4; ++c_) { p0[4 * g_ + c_] = fmaf(-p.slope_over_scale, fabsf(pq - k0[c_]), p0[4 * g_ + c_]); p1[4 * g_ + c_] = fmaf(-p.slope_over_scale, fabsf(pq - k1[c_]), p1[4 * g_ + c_]); } } } \
            if (kb_ + KVBLK - 1 > qlo || kb_ <= qlo + QBLK - 1 - W) { const int dq_ = qm - kb_; const float NEG = -__builtin_inff(); \
                _Pragma("unroll") for (int r = 0; r < 16; ++r) { const int c_ = (r & 3) + 8 * (r >> 2); \
                    if ((unsigned)(dq_ - c_) >= (unsigned)W) p0[r] = NEG; if ((unsigned)(dq_ - c_ - 32) >= (unsigned)W) p1[r] = NEG; } } \
            float pmax = p0[0]; \
            _Pragma("unroll") for (int r = 1; r < 16; ++r) pmax = fmaxf(pmax, p0[r]); \
            _Pragma("unroll") for (int r = 0; r < 16; ++r) pmax = fmaxf(pmax, p1[r]); \
            { auto rr = __builtin_amdgcn_permlane32_swap(__float_as_uint(pmax), __float_as_uint(pmax), false, false); pmax = fmaxf(__uint_as_float(rr[0]), __uint_as_float(rr[1])); } \
            float mn, alpha; \
            if (__all((pmax - m_reg) * SCALE <= THR)) { mn = m_reg; alpha = 1.f; } \
            else { mn = fmaxf(m_reg, pmax); alpha = __builtin_amdgcn_exp2f((m_reg - mn) * C2); m_reg = mn; } \
            const float mnL = -mn * C2; float ps = 0.f; \
            _Pragma("unroll") for (int r = 0; r < 16; ++r) { p0[r] = __builtin_amdgcn_exp2f(fmaf(p0[r], C2, mnL)); p1[r] = __builtin_amdgcn_exp2f(fmaf(p1[r], C2, mnL)); } \
            _Pragma("unroll") for (int r = 0; r < 16; ++r) ps += p0[r] + p1[r]; \
            { auto rr = __builtin_amdgcn_permlane32_swap(__float_as_uint(ps), __float_as_uint(ps), false, false); ps = __uint_as_float(rr[0]) + __uint_as_float(rr[1]); } \
            l_reg = l_reg * alpha + ps; \
            bf16x8 pa[4]; \
            _Pragma("unroll") for (int q_ = 0; q_ < 4; ++q_) { const f32x16& P = (q_ < 2) ? p0 : p1; const int B_ = (q_ & 1) * 8; \
                const unsigned a0 = cvt_pk_bf16(P[B_ + 0], P[B_ + 1]), a1 = cvt_pk_bf16(P[B_ + 2], P[B_ + 3]), b0 = cvt_pk_bf16(P[B_ + 4], P[B_ + 5]), b1 = cvt_pk_bf16(P[B_ + 6], P[B_ + 7]); \
                auto r0 = __builtin_amdgcn_permlane32_swap(a0, b0, false, false); auto r1 = __builtin_amdgcn_permlane32_swap(a1, b1, false, false); \
                u32x4 w_ = {r0[0], r1[0], r0[1], r1[1]}; pa[q_] = *reinterpret_cast<bf16x8*>(&w_); } \
            if (__any(alpha < 1.f)) { if (hi == 0) al_l[r32] = alpha; asm volatile("s_waitcnt lgkmcnt(0)" ::: "memory"); \
                _Pragma("unroll") for (int r = 0; r < 16; ++r) { const float a_ = al_l[crow(r, hi)]; _Pragma("unroll") for (int d_ = 0; d_ < NCB; ++d_) o[d_][r] *= a_; } } \
            _Pragma("unroll") for (int d0 = 0; d0 < NCB; ++d0) { s16x4 l_[4], h_[4]; constexpr int b_ = (BF) * VT; \
                _Pragma("unroll") for (int ks = 0; ks < 4; ++ks) { TRRD(l_[ks], b_ + d0 * 512 + ks * (1024 * NCB)); TRRD(h_[ks], b_ + d0 * 512 + ks * (1024 * NCB) + 512 * NCB); } \
                asm volatile("s_waitcnt lgkmcnt(0)" ::: "memory"); __builtin_amdgcn_sched_barrier(0); \
                _Pragma("unroll") for (int ks = 0; ks < 4; ++ks) o[d0] = __builtin_amdgcn_mfma_f32_32x32x16_bf16(pa[ks], (bf16x8){l_[ks][0], l_[ks][1], l_[ks][2], l_[ks][3], h_[ks][0], h_[ks][1], h_[ks][2], h_[ks][3]}, o[d0], 0, 0, 0); } \
        } \
        if ((t) + 1 < NT) { asm volatile("s_waitcnt vmcnt(0)" ::: "memory"); ST_WRITE((BF) ^ 1); } \
        __syncthreads(); } while (0)
    for (int t = 0; t < NT; t += 2) {
        TILE(t, 0);
        if (t + 1 < NT) TILE(t + 1, 1);
    }
    if (KIND == 1) l_reg += __builtin_amdgcn_exp2f(p.sink_l2 - m_reg * C2);
    if (hi == 0) li_l[r32] = l_reg;
    asm volatile("s_waitcnt lgkmcnt(0)" ::: "memory");
    bf16* Ow = p.O + (size_t)(wid * QBLK) * p.ldo;
#pragma unroll
    for (int r = 0; r < 16; ++r) { const int orow = crow(r, hi); const float rl = __builtin_amdgcn_rcpf(li_l[orow]);
#pragma unroll
        for (int d0 = 0; d0 < NCB; ++d0) { const float v = o[d0][r] * rl; const float vn = __shfl_xor(v, 1);
            if ((r32 & 1) == 0) *(unsigned*)(Ow + (size_t)orow * p.ldo + d0 * 32 + r32) = cvt_pk_bf16(v, vn); } }
    __syncthreads();
#undef TILE
#undef TRRD
#undef ST_LOAD
#undef ST_WRITE
}
constexpr int LDS_MLA = 2 * (64 * 128 * 2) + 2 * (3 * 8192) + 512 + 8 * 256;
constexpr int LDS_SWA = 2 * (64 * 64 * 2) + 2 * 8192 + 512 + 8 * 256;
}
constexpr int NWAVES = 8, NTHREADS = NWAVES * 64;
constexpr int D = 1024, NB = 8, SEQ = 8192, T = NB * SEQ;
constexpr int FF = 2816, NE = 8, FE = 3584;
constexpr int QL = 384, KVL = 256, MH = 8, DQKM = 192, DVM = 128;
constexpr int MDN = 704, MDNP = 768;
constexpr int SQKV = 1280;
constexpr int MAXPAN = 520, MAXSLOT = MAXPAN * 256;
constexpr float EPS = 1e-6f;
constexpr float ACT_SCALE8 = 8.f, HID_SCALE8 = 8.f, W_SCALE8 = 256.f;
constexpr size_t MiB = 1u << 20;
constexpr size_t WS_CTL = 0, CTL_ZERO_BYTES = 256 * 1024;
constexpr size_t WS_RT = 1 * MiB;
constexpr size_t RT_E = WS_RT, RT_W0 = RT_E + (size_t)T * 4, RT_W1 = RT_W0 + (size_t)T * 4, RT_S0 = RT_W1 + (size_t)T * 4, RT_S1 = RT_S0 + (size_t)T * 4, RT_CNT = RT_S1 + (size_t)T * 4, RT_PB = RT_CNT + 256 * 8 * 4;
constexpr size_t WS_ROPE = 8 * MiB;
constexpr size_t WS_W = 24 * MiB;
constexpr size_t W_CINB = WS_W, W_CINCU = W_CINB + 2 * (size_t)1024 * 1024 * 2, W_COUT = W_CINCU + 2 * (size_t)2048 * 1024 * 2;
constexpr size_t W_MDN = W_COUT + 2 * (size_t)1024 * 1024 * 2, W_MUQ = W_MDN + (size_t)MDNP * 1024 * 2, W_MUKV = W_MUQ + (size_t)1536 * QL * 2, W_MO = W_MUKV + (size_t)2048 * KVL * 2;
constexpr size_t W_SQKV = W_MO + (size_t)1024 * 1024 * 2, W_SO = W_SQKV + (size_t)SQKV * 1024 * 2;
constexpr size_t W_FGU = W_SO + (size_t)1024 * 1024 * 2, W_FD = W_FGU + 2 * (size_t)(2 * FF) * 1024 * 2;
constexpr size_t W_MGU = W_FD + 2 * (size_t)1024 * FF * 2, W_MD = W_MGU + 16 * (size_t)(2 * FE) * 1024 * 2, W_RT = W_MD + 16 * (size_t)1024 * FE * 2;
constexpr size_t W_END = W_RT + 2 * (size_t)8 * 1024 * 4;
constexpr size_t WS_XN = 420 * MiB;
constexpr size_t WS_XG = 548 * MiB;
constexpr size_t WS_BIG = 808 * MiB;
constexpr size_t WS_END = WS_BIG + (size_t)MAXSLOT * FE * 2;
static_assert(W_END <= WS_XN && WS_XN + (size_t)T * D * 2 <= WS_XG && WS_XG + (size_t)MAXSLOT * D * 2 <= WS_BIG, "d_ws map");
constexpr size_t B_CONV_B = 0, B_CONV_V = 128 * MiB, B_CONV_Y = 256 * MiB;
constexpr size_t B_HMID = 0;
constexpr size_t B_MC = 0, B_MO = 0, B_MCQ = 192 * MiB, B_MCKV = 240 * MiB, B_MQ = 272 * MiB, B_MK = 464 * MiB, B_MV = 656 * MiB;
constexpr size_t B_SQKV = 0, B_SO = 160 * MiB;
constexpr int CW_DBG = 8;
constexpr int CW_BAR = 1024;
constexpr int RING_BYTES = 131072, MISC_OFF = RING_BYTES, LDS_BYTES = 147456;

#define RLX_AGENT __ATOMIC_RELAXED, __HIP_MEMORY_SCOPE_AGENT
#define XB_TMO      128
#define XB_XCNT(j)  (256  + 64 * (j))
#define XB_XSUB(j)  (1280 + 64 * (j))
#define XB_XGEN(j)  (2304 + 64 * (j))
#define XB_TOP      3328
#define XB_TOPGEN   3392
#define XCD_BAR_WORDS 3456
#define XB_SPIN_CAP (1u << 18)
__device__ __forceinline__ unsigned xb_ld(unsigned* p)              { return __hip_atomic_load(p, __ATOMIC_RELAXED, __HIP_MEMORY_SCOPE_AGENT); }
__device__ __forceinline__ unsigned xb_add(unsigned* p, unsigned v) { return __hip_atomic_fetch_add(p, v, __ATOMIC_RELAXED, __HIP_MEMORY_SCOPE_AGENT); }
__device__ __forceinline__ unsigned xb_xcc_id() { return (unsigned)__builtin_amdgcn_s_getreg((3 << 11) | 20) & 0xFu; }
#define XB_SPIN(cond, bar) do { unsigned _sp = 0; while (cond) { __builtin_amdgcn_s_sleep(1); \
    if ((++_sp & 255u) == 0u) { if (xb_ld(&(bar)[XB_TMO])) break; if (_sp > XB_SPIN_CAP) { atomicAdd(&(bar)[XB_TMO], 1u); break; } } } } while (0)
struct XcdBarrier { unsigned* bar; unsigned x; volatile LAS unsigned* st; };
__device__ __forceinline__ XcdBarrier xcd_barrier_post(unsigned* bar, volatile LAS unsigned* st) {
    XcdBarrier b; b.bar = bar; b.x = xb_xcc_id(); b.st = st;
    if (threadIdx.x == 0) (void)xb_add(&bar[XB_XCNT(b.x)], 1u);
    return b;
}
__device__ __forceinline__ void xcd_barrier_complete(unsigned* bar, unsigned x, unsigned& nloc, unsigned& nx) {
    const unsigned G = gridDim.x * gridDim.y * gridDim.z;
    unsigned sum, cnt, mine, sp = 0u;
    for (;;) {
        sum = 0u; cnt = 0u; mine = 0u;
#pragma unroll
        for (unsigned j = 0; j < 16; ++j) { const unsigned c = xb_ld(&bar[XB_XCNT(j)]); sum += c; cnt += (c > 0u) ? 1u : 0u; mine = (j == x) ? c : mine; }
        if (sum == G) break;
        __builtin_amdgcn_s_sleep(1);
        if ((++sp & 255u) == 0u) { if (xb_ld(&bar[XB_TMO])) break; if (sp > XB_SPIN_CAP) { atomicAdd(&bar[XB_TMO], 1u); break; } }
    }
    nloc = mine > 0u ? mine : 1u; nx = cnt > 0u ? cnt : 1u;
}
__device__ __forceinline__ void xcd_barrier(const XcdBarrier& b) {
    asm volatile("s_waitcnt vmcnt(0)" ::: "memory");
    __syncthreads();
    if (threadIdx.x == 0) {
        unsigned* bar = b.bar;
        __builtin_amdgcn_s_waitcnt(0);
        unsigned nloc = b.st[0], nx = b.st[1];
        if (nloc == 0u) { xcd_barrier_complete(bar, b.x, nloc, nx); b.st[0] = nloc; b.st[1] = nx; }
        const unsigned old = xb_add(&bar[XB_XSUB(b.x)], 1u);
        const unsigned gen = old / nloc;
        if (old + 1u == (gen + 1u) * nloc) {
            __builtin_amdgcn_fence(__ATOMIC_RELEASE, "agent");
            asm volatile("s_waitcnt vmcnt(0)" ::: "memory");
            const unsigned og = xb_add(&bar[XB_TOP], 1u);
            const unsigned tg = og / nx;
            if (og + 1u == (tg + 1u) * nx) xb_add(&bar[XB_TOPGEN], 1u);
            else XB_SPIN(xb_ld(&bar[XB_TOPGEN]) == tg, bar);
            __builtin_amdgcn_fence(__ATOMIC_ACQUIRE, "agent");
            xb_add(&bar[XB_XGEN(b.x)], 1u);
            asm volatile("s_waitcnt vmcnt(0)" ::: "memory");
        } else {
            XB_SPIN(xb_ld(&bar[XB_XGEN(b.x)]) == gen, bar);
            __builtin_amdgcn_fence(__ATOMIC_ACQUIRE, "agent");
            asm volatile("s_waitcnt vmcnt(0)" ::: "memory");
        }
    }
    __syncthreads();
}

struct TC { int tid, lane, wave; };
__device__ __forceinline__ TC tc_get() { TC t; int x = threadIdx.x; asm volatile("" : "+v"(x)); t.tid = x; t.lane = x & 63; t.wave = __builtin_amdgcn_readfirstlane(x >> 6); return t; }
struct Frame {
    char* lds; int vcu, G;
    unsigned char* ws; float* out;
    const float* const* in;
};
#define LDS_WAIT() asm volatile("s_waitcnt lgkmcnt(0)" ::: "memory")
#define VM_WAIT() asm volatile("s_waitcnt vmcnt(0)" ::: "memory")

template <int MAP>
__device__ __forceinline__ void tr_item(const float* W, int K, int N, int ldw, bf16* WT, float* scr, int item, int lane) {
    const int nblk = N / 32, kb = item / nblk, nb = item % nblk, k0 = 64 * kb, n0 = 32 * nb;
    int r0 = n0;
    if (MAP == 1) { const int F = N / 2; r0 = (n0 < F) ? 256 * (n0 / 128) + (n0 % 128) : 256 * ((n0 - F) / 128) + 128 + ((n0 - F) % 128); }
    const float* src = W + (size_t)(k0 + (lane >> 5)) * ldw + n0 + (lane & 31);
#pragma unroll 16
    for (int i = 0; i < 32; ++i) scr[(2 * i + (lane >> 5)) * 33 + (lane & 31)] = src[(size_t)(2 * i) * ldw];
    LDS_WAIT(); asm volatile("" ::: "memory");
    const int c = lane & 7;
#pragma unroll
    for (int j = 0; j < 4; ++j) { const int n = (lane >> 3) + 8 * j; const float* s = scr + (8 * c) * 33 + n;
        u32x4 o; o.x = cvt_pk_bf16(s[0 * 33], s[1 * 33]); o.y = cvt_pk_bf16(s[2 * 33], s[3 * 33]); o.z = cvt_pk_bf16(s[4 * 33], s[5 * 33]); o.w = cvt_pk_bf16(s[6 * 33], s[7 * 33]);
        *(u32x4*)(WT + (size_t)(r0 + n) * K + k0 + 8 * c) = o; }
    LDS_WAIT(); asm volatile("" ::: "memory");
}
template <int MAP>
__device__ __forceinline__ void tr_item8(const float* W, int K, int N, int ldw, unsigned char* WT, float* scr, int item, int lane, float sw) {
    const int nblk = N / 32, kb = item / nblk, nb = item % nblk, k0 = 64 * kb, n0 = 32 * nb;
    int r0 = n0;
    if (MAP == 1) { const int F = N / 2; r0 = (n0 < F) ? 256 * (n0 / 128) + (n0 % 128) : 256 * ((n0 - F) / 128) + 128 + ((n0 - F) % 128); }
    const float* src = W + (size_t)(k0 + (lane >> 5)) * ldw + n0 + (lane & 31);
#pragma unroll 16
    for (int i = 0; i < 32; ++i) scr[(2 * i + (lane >> 5)) * 33 + (lane & 31)] = src[(size_t)(2 * i) * ldw];
    LDS_WAIT(); asm volatile("" ::: "memory");
    const int c = lane & 7;
#pragma unroll
    for (int j = 0; j < 4; ++j) { const int n = (lane >> 3) + 8 * j; const float* s = scr + (8 * c) * 33 + n;
        u32x2 o; int t = __builtin_amdgcn_cvt_pk_fp8_f32(s[0 * 33] * sw, s[1 * 33] * sw, 0, false); t = __builtin_amdgcn_cvt_pk_fp8_f32(s[2 * 33] * sw, s[3 * 33] * sw, t, true); o.x = (unsigned)t;
        t = __builtin_amdgcn_cvt_pk_fp8_f32(s[4 * 33] * sw, s[5 * 33] * sw, 0, false); t = __builtin_amdgcn_cvt_pk_fp8_f32(s[6 * 33] * sw, s[7 * 33] * sw, t, true); o.y = (unsigned)t;
        *(u32x2*)(WT + (size_t)(r0 + n) * K + k0 + 8 * c) = o; }
    LDS_WAIT(); asm volatile("" ::: "memory");
}
template <int MAP>
__device__ __forceinline__ void tr_matrix8(Frame& F, const float* W, int K, int N, int ldw, unsigned char* WT, int rot, float sw) {
    const TC tc = tc_get();
    float* scr = (float*)(F.lds + tc.wave * 8448);
    const int NGW = F.G * NWAVES, gw = (F.vcu * NWAVES + tc.wave + rot) % NGW, nitems = (K / 64) * (N / 32);
    for (int it = gw; it < nitems; it += NGW) tr_item8<MAP>(W, K, N, ldw, WT, scr, it, tc.lane, sw);
}
template <int MAP>
__device__ __forceinline__ void tr_matrix(Frame& F, const float* W, int K, int N, int ldw, bf16* WT, int rot) {
    const TC tc = tc_get();
    float* scr = (float*)(F.lds + tc.wave * 8448);
    const int NGW = F.G * NWAVES, gw = (F.vcu * NWAVES + tc.wave + rot) % NGW, nitems = (K / 64) * (N / 32);
    for (int it = gw; it < nitems; it += NGW) tr_item<MAP>(W, K, N, ldw, WT, scr, it, tc.lane);
}

struct RowArgs { const float* Xsrc; float* Xdst; const float* g; bf16* XN; float* outF; const bf16* Y; const int* s0; const int* s1; const float* w0; const float* w1;
                 const float* routerT; unsigned* rt_e; float* rt_w0; float* rt_w1; unsigned* cnt; };
template <int MODE, bool COMBINE>
__device__ __forceinline__ void row_pass(Frame& F, const RowArgs& a) {
    const TC tc = tc_get();
    const int lane = tc.lane;
    float* rtab = (float*)F.lds;
    unsigned* wcnt = (unsigned*)(F.lds + 32768);
    if (MODE == 1) { for (int i = tc.tid; i < 8 * 1024; i += NTHREADS) rtab[i] = a.routerT[i]; }
    f32x4 gv[4];
#pragma unroll
    for (int j = 0; j < 4; ++j) gv[j] = *(const f32x4*)(a.g + 4 * lane + 256 * j);
    for (int tb = blockIdx.x; tb < T / 256; tb += F.G) {
        if (MODE == 1) { if (tc.tid < 64) wcnt[tc.tid] = 0u; __syncthreads(); }
        unsigned myc[8] = {0u, 0u, 0u, 0u, 0u, 0u, 0u, 0u};
        for (int rr = 0; rr < 32; ++rr) {
            const int row = tb * 256 + tc.wave * 32 + rr;
            const f32x4* xr = (const f32x4*)(a.Xsrc + (size_t)row * D) + lane;
            f32x4 v[4];
#pragma unroll
            for (int j = 0; j < 4; ++j) v[j] = xr[64 * j];
            if (COMBINE) {
                const int sa = a.s0[row], sb = a.s1[row]; const float wa = a.w0[row], wb = a.w1[row];
                const u32x2* ya = (const u32x2*)(a.Y + (size_t)sa * D) + lane; const u32x2* yb = (const u32x2*)(a.Y + (size_t)sb * D) + lane;
#pragma unroll
                for (int j = 0; j < 4; ++j) { const u32x2 pa = ya[64 * j], pb = yb[64 * j];
                    v[j].x += wa * bflo(pa.x) + wb * bflo(pb.x); v[j].y += wa * bfhi(pa.x) + wb * bfhi(pb.x);
                    v[j].z += wa * bflo(pa.y) + wb * bflo(pb.y); v[j].w += wa * bfhi(pa.y) + wb * bfhi(pb.y); }
                if (MODE != 2) { f32x4* xd = (f32x4*)(a.Xdst + (size_t)row * D) + lane;
#pragma unroll
                    for (int j = 0; j < 4; ++j) xd[64 * j] = v[j]; }
            }
            float ss = 0.f;
#pragma unroll
            for (int j = 0; j < 4; ++j) ss += (v[j].x * v[j].x + v[j].y * v[j].y) + (v[j].z * v[j].z + v[j].w * v[j].w);
            const float rstd = 1.0f / sqrtf(wave_sum(ss) * (1.f / D) + EPS);
#pragma unroll
            for (int j = 0; j < 4; ++j) v[j] = v[j] * rstd * gv[j];
            if (MODE == 2) { f32x4* od = (f32x4*)(a.outF + (size_t)row * D) + lane;
#pragma unroll
                for (int j = 0; j < 4; ++j) od[64 * j] = v[j];
            } else { u32x2* o8 = (u32x2*)(a.XN + (size_t)row * D) + lane;
#pragma unroll
                for (int j = 0; j < 4; ++j) { u32x2 w; w.x = cvt_pk_bf16(v[j].x, v[j].y); w.y = cvt_pk_bf16(v[j].z, v[j].w); o8[64 * j] = w; } }
            if (MODE == 1) {
                float lg[8];
#pragma unroll
                for (int e = 0; e < 8; ++e) { float s = 0.f;
#pragma unroll
                    for (int j = 0; j < 4; ++j) { const f32x4 r = *(const f32x4*)(rtab + e * 1024 + 256 * j + 4 * lane); s += (v[j].x * r.x + v[j].y * r.y) + (v[j].z * r.z + v[j].w * r.w); }
                    lg[e] = wave_sum(s); }
                int e0 = 0; float v0 = lg[0];
#pragma unroll
                for (int e = 1; e < 8; ++e) if (lg[e] > v0) { v0 = lg[e]; e0 = e; }
                int e1 = -1; float v1 = -3.0e38f;
#pragma unroll
                for (int e = 0; e < 8; ++e) if (e != e0 && lg[e] > v1) { v1 = lg[e]; e1 = e; }
                const float w0 = 1.0f / (1.0f + __expf(v1 - v0)), w1 = 1.0f - w0;
                if (lane == 0) { a.rt_e[row] = (unsigned)e0 | ((unsigned)e1 << 8); a.rt_w0[row] = w0; a.rt_w1[row] = w1; }
#pragma unroll
                for (int e = 0; e < 8; ++e) myc[e] += (e == e0 || e == e1) ? 1u : 0u;
            }
        }
        if (MODE == 1) {
            if (lane < 8) { unsigned c = 0;
#pragma unroll
                for (int e = 0; e < 8; ++e) c = (lane == e) ? myc[e] : c;
                wcnt[tc.wave * 8 + lane] = c; }
            __syncthreads();
            if (tc.tid < 8) { unsigned c = 0; for (int w = 0; w < 8; ++w) c += wcnt[w * 8 + tc.tid]; a.cnt[tb * 8 + tc.tid] = c; }
            __syncthreads();
        }
    }
}

__device__ __forceinline__ float clamp8(float v) { return fminf(fmaxf(v, -448.f), 448.f); }
template <bool F8>
__device__ __forceinline__ void moe_assign(Frame& F, const unsigned* cnt, const unsigned* rt_e, int* s0, int* s1, unsigned* pbase_out, const bf16* XN, bf16* XG) {
    const TC tc = tc_get();
    unsigned* tot = (unsigned*)F.lds;
    unsigned* pre = tot + 64;
    unsigned long long* msk = (unsigned long long*)(F.lds + 1024);
    int* slt = (int*)(F.lds + 2048);
    if (tc.tid < 8) tot[tc.tid] = 0u;
    __syncthreads();
    { unsigned part[8] = {0, 0, 0, 0, 0, 0, 0, 0};
      if (tc.tid < 256) {
#pragma unroll
          for (int e = 0; e < 8; ++e) part[e] = __hip_atomic_load(cnt + tc.tid * 8 + e, RLX_AGENT); }
#pragma unroll
      for (int e = 0; e < 8; ++e) { unsigned s = part[e];
#pragma unroll
          for (int o = 1; o < 64; o <<= 1) s += __shfl_xor(s, o);
          if (tc.lane == 0 && tc.wave < 4) atomicAdd(&tot[e], s); } }
    __syncthreads();
    if (tc.tid == 0) { unsigned p = 0; for (int e = 0; e < 8; ++e) { tot[8 + e] = p; p += (tot[e] + 255u) / 256u; } tot[16] = p;
        if (blockIdx.x == 0) for (int e = 0; e < 9; ++e) __hip_atomic_store(pbase_out + e, tot[8 + e], RLX_AGENT); }
    __syncthreads();
    for (int tb = blockIdx.x; tb < T / 256; tb += F.G) {
        if (tc.tid < 8) { unsigned s = 0; for (int b = 0; b < tb; ++b) s += __hip_atomic_load(cnt + b * 8 + tc.tid, RLX_AGENT); pre[tc.tid] = s; }
        int e0 = 0, e1 = 0;
        if (tc.tid < 256) { const unsigned pe = rt_e[tb * 256 + tc.tid]; e0 = pe & 0xff; e1 = (pe >> 8) & 0xff;
#pragma unroll
            for (int e = 0; e < 8; ++e) { const unsigned long long m = __ballot(e0 == e || e1 == e); if (tc.lane == 0) msk[e * 4 + tc.wave] = m; } }
        __syncthreads();
        if (tc.tid < 256) {
            int sl[2];
#pragma unroll
            for (int k = 0; k < 2; ++k) { const int e = k ? e1 : e0; unsigned rank = 0;
                for (int w = 0; w < tc.wave; ++w) rank += __popcll(msk[e * 4 + w]);
                rank += __popcll(msk[e * 4 + tc.wave] & ((1ull << tc.lane) - 1ull));
                sl[k] = (int)(tot[8 + e] * 256u + pre[e] + rank); }
            s0[tb * 256 + tc.tid] = sl[0]; s1[tb * 256 + tc.tid] = sl[1]; slt[2 * tc.tid] = sl[0]; slt[2 * tc.tid + 1] = sl[1];
        }
        __syncthreads();
        for (int rr = 0; rr < 32; ++rr) { const int i = tc.wave * 32 + rr; const int row = tb * 256 + i; const int sa = slt[2 * i], sb = slt[2 * i + 1];
            if (F8) {
                const u32x4* src = (const u32x4*)(XN + (size_t)row * D) + 2 * tc.lane; const u32x4 a = src[0], b = src[1]; u32x4 o;
#pragma unroll
                for (int q = 0; q < 2; ++q) { const u32x4 v = q ? b : a; int t = __builtin_amdgcn_cvt_pk_fp8_f32(clamp8(bflo(v.x) * ACT_SCALE8), clamp8(bfhi(v.x) * ACT_SCALE8), 0, false); t = __builtin_amdgcn_cvt_pk_fp8_f32(clamp8(bflo(v.y) * ACT_SCALE8), clamp8(bfhi(v.y) * ACT_SCALE8), t, true);
                    int t2 = __builtin_amdgcn_cvt_pk_fp8_f32(clamp8(bflo(v.z) * ACT_SCALE8), clamp8(bfhi(v.z) * ACT_SCALE8), 0, false); t2 = __builtin_amdgcn_cvt_pk_fp8_f32(clamp8(bflo(v.w) * ACT_SCALE8), clamp8(bfhi(v.w) * ACT_SCALE8), t2, true);
                    if (q) { o.z = (unsigned)t; o.w = (unsigned)t2; } else { o.x = (unsigned)t; o.y = (unsigned)t2; } }
                ((u32x4*)((unsigned char*)XG + (size_t)sa * D))[tc.lane] = o; ((u32x4*)((unsigned char*)XG + (size_t)sb * D))[tc.lane] = o;
            } else {
            const u32x4* src = (const u32x4*)(XN + (size_t)row * D) + tc.lane; const u32x4 a = src[0], b = src[64];
            u32x4* d0 = (u32x4*)(XG + (size_t)sa * D) + tc.lane; u32x4* d1 = (u32x4*)(XG + (size_t)sb * D) + tc.lane;
            d0[0] = a; d0[64] = b; d1[0] = a; d1[64] = b; } }
        __syncthreads();
    }
}

__device__ __forceinline__ void conv_pass(Frame& F, const bf16* Bc, const bf16* Vc, const float* wconv, bf16* Yc) {
    const TC tc = tc_get();
    const int sub = tc.tid >> 7, ch = (tc.tid & 127) * 8;
    float w[3][8];
#pragma unroll
    for (int j = 0; j < 3; ++j) { const f32x4 a = *(const f32x4*)(wconv + j * D + ch), b = *(const f32x4*)(wconv + j * D + ch + 4);
#pragma unroll
        for (int c = 0; c < 4; ++c) { w[j][c] = a[c]; w[j][4 + c] = b[c]; } }
    for (int run = blockIdx.x * 4 + sub; run < T / 32; run += F.G * 4) {
        const int t0 = run * 32, s0 = t0 & (SEQ - 1);
        float p2[8], p1[8];
        { u32x4 a = {0, 0, 0, 0}, b = {0, 0, 0, 0};
          if (s0 >= 2) { a = *(const u32x4*)(Vc + (size_t)(t0 - 2) * D + ch); b = *(const u32x4*)(Vc + (size_t)(t0 - 1) * D + ch); }
#pragma unroll
          for (int c = 0; c < 4; ++c) { p2[2 * c] = bflo(a[c]); p2[2 * c + 1] = bfhi(a[c]); p1[2 * c] = bflo(b[c]); p1[2 * c + 1] = bfhi(b[c]); } }
#pragma unroll 4
        for (int i = 0; i < 32; ++i) { const size_t o = (size_t)(t0 + i) * D + ch;
            const u32x4 vv = *(const u32x4*)(Vc + o), bb = *(const u32x4*)(Bc + o); float cur[8], y[8];
#pragma unroll
            for (int c = 0; c < 4; ++c) { cur[2 * c] = bflo(vv[c]); cur[2 * c + 1] = bfhi(vv[c]); }
#pragma unroll
            for (int c = 0; c < 8; ++c) { const float bq = (c & 1) ? bfhi(bb[c >> 1]) : bflo(bb[c >> 1]); y[c] = bq * (w[0][c] * p2[c] + w[1][c] * p1[c] + w[2][c] * cur[c]); p2[c] = p1[c]; p1[c] = cur[c]; }
            u32x4 r; r.x = cvt_pk_bf16(y[0], y[1]); r.y = cvt_pk_bf16(y[2], y[3]); r.z = cvt_pk_bf16(y[4], y[5]); r.w = cvt_pk_bf16(y[6], y[7]);
            *(u32x4*)(Yc + o) = r; }
    }
}

__device__ __forceinline__ void rope_table(Frame& F, const int* pos, float* tab) {
    const TC tc = tc_get();
    const int i = tc.lane & 31; const float inv = __builtin_amdgcn_exp2f(-(float)i * (13.287712379549449f / 32.0f));
    const int NGW = F.G * NWAVES, gw = F.vcu * NWAVES + tc.wave;
    for (int t = gw * 2 + (tc.lane >> 5); t < T; t += NGW * 2) {
        const float ang = (float)pos[t] * inv;
        const float k = rintf(ang * 0.15915494309189535f);
        float r = fmaf(-k, 6.28125f, ang); r = fmaf(-k, 1.9353071795864769e-3f, r);
        tab[(size_t)t * 64 + i] = __cosf(r); tab[(size_t)t * 64 + 32 + i] = __sinf(r);
    }
}

__device__ __forceinline__ void mla_mid(Frame& F, const float* C, const float* gq, const float* gkv, const float* tab, bf16* cqn, bf16* ckvn, bf16* Kf) {
    const TC tc = tc_get();
    const int lane = tc.lane, NGW = F.G * NWAVES, gw = F.vcu * NWAVES + tc.wave;
    f32x2 gqv[3];
#pragma unroll
    for (int j = 0; j < 3; ++j) gqv[j] = *(const f32x2*)(gq + 2 * lane + 128 * j);
    const f32x4 gk = *(const f32x4*)(gkv + 4 * lane);
    for (int t = gw; t < T; t += NGW) {
        const float* c = C + (size_t)t * MDNP;
        f32x2 q[3]; float ss = 0.f;
#pragma unroll
        for (int j = 0; j < 3; ++j) { q[j] = *(const f32x2*)(c + 2 * lane + 128 * j); ss += q[j].x * q[j].x + q[j].y * q[j].y; }
        const f32x4 kv = *(const f32x4*)(c + QL + 4 * lane);
        const float x = c[QL + KVL + lane];
        const float rq = 1.0f / sqrtf(wave_sum(ss) * (1.f / QL) + EPS);
        const float rk = 1.0f / sqrtf(wave_sum((kv.x * kv.x + kv.y * kv.y) + (kv.z * kv.z + kv.w * kv.w)) * (1.f / KVL) + EPS);
#pragma unroll
        for (int j = 0; j < 3; ++j) *(unsigned*)(cqn + (size_t)t * QL + 2 * lane + 128 * j) = cvt_pk_bf16(q[j].x * rq * gqv[j].x, q[j].y * rq * gqv[j].y);
        { u32x2 w; w.x = cvt_pk_bf16(kv.x * rk * gk.x, kv.y * rk * gk.y); w.y = cvt_pk_bf16(kv.z * rk * gk.z, kv.w * rk * gk.w); *(u32x2*)(ckvn + (size_t)t * KVL + 4 * lane) = w; }
        const float other = __shfl_xor(x, 32); const int i = lane & 31;
        const float cs = tab[(size_t)t * 64 + i], sn = tab[(size_t)t * 64 + 32 + i];
        const float r = (lane < 32) ? (x * cs - other * sn) : (x * cs + other * sn);
        const float rn = __shfl_xor(r, 1);
        if ((lane & 1) == 0) { const unsigned pk = cvt_pk_bf16(r, rn); const int b = t >> 13, s = t & (SEQ - 1);
#pragma unroll
            for (int h = 0; h < MH; ++h) *(unsigned*)(Kf + ((size_t)(b * MH + h) * SEQ + s) * DQKM + 128 + lane) = pk; }
    }
}
template <class Epi>
__device__ __forceinline__ void gemm_static(Frame& F, const bf16* A, int lda, int K, const bf16* Bt, int N, const Epi& E) {
    pg8::Gemm g{A, Bt, lda, K, 0}; pg8::StaticOrder S; S.init(T, N, F.G, (int)blockIdx.x);
    pg8::gemm_phase<Epi, pg8::StaticOrder>((LAS unsigned char*)F.lds, g, S, E);
}
template <bool F8, class Epi>
__device__ __forceinline__ void gemm_grouped(Frame& F, const void* A, int lda, int K, const void* Bt, size_t estride, int N, const unsigned* pbase, const Epi& E) {
    pg8::Gemm g{(const bf16*)A, (const bf16*)Bt, lda, K, estride}; pg8::GroupedOrder S; S.init(pbase, N, F.G, (int)blockIdx.x, (LAS unsigned*)((LAS unsigned char*)F.lds + MISC_OFF + 512), 128);
    pg8::gemm_phase<Epi, pg8::GroupedOrder, F8>((LAS unsigned char*)F.lds, g, S, E);
}
#ifndef MOE_F8_A
#define MOE_F8_A 1
#endif
#ifndef MOE_F8_B
#define MOE_F8_B 1
#endif
template <bool F8>
__device__ __forceinline__ void moe_gemm1(Frame& F, int l, const unsigned* pb) {
    unsigned char* ws = F.ws; unsigned char* big = ws + WS_BIG;
    if (F8) gemm_grouped<true>(F, ws + WS_XG, D / 2, D / 2, ws + W_MGU + (size_t)l * 8 * 2 * FE * 1024 * 2, (size_t)2 * FE * 1024, 2 * FE, pb, pg8::EpiPair8{big, FE, 1.0f / (ACT_SCALE8 * W_SCALE8), HID_SCALE8});
    else gemm_grouped<false>(F, ws + WS_XG, D, D, ws + W_MGU + (size_t)l * 8 * 2 * FE * 1024 * 2, (size_t)2 * FE * 1024 * 2, 2 * FE, pb, pg8::EpiPair<1>{(bf16*)big, FE});
}
template <bool F8>
__device__ __forceinline__ void moe_gemm2(Frame& F, int l, const unsigned* pb) {
    unsigned char* ws = F.ws; unsigned char* big = ws + WS_BIG;
    if (F8) gemm_grouped<true>(F, big, FE / 2, FE / 2, ws + W_MD + (size_t)l * 8 * 1024 * FE * 2, (size_t)1024 * FE, 1024, pb, pg8::EpiBf16{(bf16*)(ws + WS_XG), D, nullptr, 1.0f / (HID_SCALE8 * W_SCALE8)});
    else gemm_grouped<false>(F, big, FE, FE, ws + W_MD + (size_t)l * 8 * 1024 * FE * 2, (size_t)1024 * FE * 2, 1024, pb, pg8::EpiBf16{(bf16*)(ws + WS_XG), D, nullptr, 1.0f});
}
__device__ __forceinline__ void prologue(Frame& F) {
    const float* const* in = F.in; unsigned char* ws = F.ws;
    int rot = 0;
#define TRM(MAP, W, K, N, ldw, dst) do { tr_matrix<MAP>(F, (W), (K), (N), (ldw), (bf16*)(ws + (dst)), rot); rot += 37; } while (0)
    for (int j = 0; j < 2; ++j) {
        TRM(0, in[5] + (size_t)j * 1024 * 3072, 1024, 1024, 3072, W_CINB + (size_t)j * 1024 * 1024 * 2);
        TRM(1, in[5] + (size_t)j * 1024 * 3072 + 1024, 1024, 2048, 3072, W_CINCU + (size_t)j * 2048 * 1024 * 2);
        TRM(0, in[7] + (size_t)j * 1024 * 1024, 1024, 1024, 1024, W_COUT + (size_t)j * 1024 * 1024 * 2);
        TRM(1, in[19] + (size_t)j * 1024 * 2 * FF, 1024, 2 * FF, 2 * FF, W_FGU + (size_t)j * 2 * FF * 1024 * 2);
        TRM(0, in[20] + (size_t)j * FF * 1024, FF, 1024, 1024, W_FD + (size_t)j * 1024 * FF * 2);
    }
    TRM(0, in[8], 1024, MDN, MDN, W_MDN);
    TRM(0, in[10], QL, 1536, 1536, W_MUQ);
    TRM(0, in[12], KVL, 2048, 2048, W_MUKV);
    TRM(0, in[13], 1024, 1024, 1024, W_MO);
    TRM(0, in[14], 1024, SQKV, SQKV, W_SQKV);
    TRM(0, in[17], 1024, 1024, 1024, W_SO);
    for (int le = 0; le < 16; ++le) {
        const bool f8 = (le < 8) ? (MOE_F8_A != 0) : (MOE_F8_B != 0);
        const size_t l = le >> 3, e = le & 7;
        if (f8) { tr_matrix8<1>(F, in[22] + (size_t)le * 1024 * 2 * FE, 1024, 2 * FE, 2 * FE, ws + W_MGU + l * 8 * 2 * FE * 1024 * 2 + e * 2 * FE * 1024, rot, W_SCALE8); rot += 37;
                  tr_matrix8<0>(F, in[23] + (size_t)le * FE * 1024, FE, 1024, 1024, ws + W_MD + l * 8 * 1024 * FE * 2 + e * 1024 * FE, rot, W_SCALE8); rot += 37; }
        else { TRM(1, in[22] + (size_t)le * 1024 * 2 * FE, 1024, 2 * FE, 2 * FE, W_MGU + (size_t)le * 2 * FE * 1024 * 2);
               TRM(0, in[23] + (size_t)le * FE * 1024, FE, 1024, 1024, W_MD + (size_t)le * 1024 * FE * 2); }
    }
#undef TRM
    const TC tc = tc_get();
    const int gt = F.vcu * NTHREADS + tc.tid, NGT = F.G * NTHREADS;
    for (int i = gt; i < (MDNP - MDN) * 1024 / 2; i += NGT) ((unsigned*)(ws + W_MDN + (size_t)MDN * 1024 * 2))[i] = 0u;
    for (int i = gt; i < 2 * 8 * 1024; i += NGT) { const int l = i >> 13, e = (i >> 10) & 7, k = i & 1023; ((float*)(ws + W_RT))[i] = in[21][(size_t)l * 1024 * 8 + k * 8 + e]; }
    rope_table(F, (const int*)in[1], (float*)(ws + WS_ROPE));
}

__device__ __forceinline__ void mla_attention(Frame& F) {
    unsigned char* big = F.ws + WS_BIG;
    const bf16* Q = (const bf16*)(big + B_MQ); const bf16* Kf = (const bf16*)(big + B_MK); const bf16* V = (const bf16*)(big + B_MV); bf16* O = (bf16*)(big + B_MO);
    const float* tab = (const float*)(F.ws + WS_ROPE);
    for (int L = blockIdx.x; L < NB * MH * 16; L += F.G) {
        const int xcd = L & 7, kk = L >> 3, bh = xcd * 8 + (kk >> 4), x = kk & 15, b = bh >> 3, h = bh & 7;
        for (int pass = 0; pass < 2; ++pass) {
            const int qb = pass ? 31 - x : x; const size_t row0 = (size_t)b * SEQ + qb * 256;
            att::Params p;
            p.Q = Q + row0 * 1536 + h * DQKM; p.ldq = 1536;
            p.K = Kf + (size_t)bh * SEQ * DQKM; p.ldk = DQKM; p.V = V + (size_t)bh * SEQ * DVM; p.ldv = DVM;
            p.O = O + row0 * 1024 + h * DVM; p.ldo = 1024; p.P0 = qb * 256; p.j_lo = 0; p.j_hi = 4 * (qb + 1);
            p.rope = tab + row0 * 64; p.pos = nullptr; p.slope_over_scale = 0.f; p.sink_l2 = 0.f;
            att::attn_block<192, 128, 0, (1 << 30)>(p, F.lds);
        }
    }
}
__device__ __forceinline__ void swa_attention(Frame& F) {
    unsigned char* big = F.ws + WS_BIG;
    const bf16* QKV = (const bf16*)(big + B_SQKV); bf16* O = (bf16*)(big + B_SO);
    const int* pos = (const int*)F.in[1]; const float* sinks = F.in[16];
    for (int L = blockIdx.x; L < NB * 16 * 32; L += F.G) {
        const int xcd = L & 7, kk = L >> 3, pair = xcd * 2 + (kk >> 8), u = kk & 255, qb = u >> 3, g = u & 7, b = pair >> 1, kvh = pair & 1, qh = kvh * 8 + g;
        const size_t row0 = (size_t)b * SEQ + qb * 256;
        att::Params p;
        p.Q = QKV + row0 * SQKV + qh * 64; p.ldq = SQKV;
        p.K = QKV + (size_t)b * SEQ * SQKV + 1024 + kvh * 64; p.ldk = SQKV; p.V = QKV + (size_t)b * SEQ * SQKV + 1152 + kvh * 64; p.ldv = SQKV;
        p.O = O + row0 * 1024 + qh * 64; p.ldo = 1024; p.P0 = qb * 256; p.j_lo = qb ? 4 * qb - 2 : 0; p.j_hi = 4 * qb + 4;
        p.rope = nullptr; p.pos = pos + (size_t)b * SEQ;
        p.slope_over_scale = __builtin_amdgcn_exp2f(-0.5f * (float)(qh + 1)) * 8.0f;
        p.sink_l2 = sinks[qh] * 1.4426950408889634f;
        att::attn_block<64, 64, 1, 128>(p, F.lds);
    }
}

struct Args { const float* in[24]; float* out; unsigned char* ws; int ph_lo, ph_hi; };
constexpr int N_PHASES = 33;
__global__ void __launch_bounds__(NTHREADS, 2) mega(Args args) {
    extern __shared__ __attribute__((aligned(16))) unsigned char lds_raw[];
    Frame F;
    F.lds = (char*)lds_raw;
    F.G = gridDim.x; { const int bx = blockIdx.x; F.vcu = (F.G % 8 == 0) ? (bx % 8) * (F.G / 8) + bx / 8 : bx; }
    F.ws = args.ws; F.out = args.out; F.in = args.in;
    unsigned char* ws = args.ws; unsigned char* big = ws + WS_BIG;
    unsigned* ctl = (unsigned*)(ws + WS_CTL);
    volatile LAS unsigned* misc = (volatile LAS unsigned*)((LAS unsigned char*)lds_raw + MISC_OFF);
    if (threadIdx.x < 32) misc[threadIdx.x] = 0u;
    __syncthreads();
    const int lo = args.ph_lo, hi = args.ph_hi;
    XcdBarrier bar; bar.bar = ctl + CW_BAR; bar.x = 0; bar.st = nullptr;
    if (hi - lo > 1) bar = xcd_barrier_post(ctl + CW_BAR, misc + 8);
#ifndef PH_SEL
#define PH_SEL -1
#endif
#define IN(k) ((PH_SEL < 0 || PH_SEL == (k)) && lo <= (k) && (k) < hi)
#ifndef PROBE_MASK
#define PROBE_MASK 0ull
#endif
#define REP(k) for (int rep_ = 0; rep_ < (((PROBE_MASK >> (k)) & 1ull) ? 2 : 1); ++rep_)
#define SEAM(k) do { if (IN(k) && IN((k) + 1)) xcd_barrier(bar); } while (0)
    const float* x_in = args.in[0]; float* X = args.out;
    bf16* XN = (bf16*)(ws + WS_XN); bf16* XG = (bf16*)(ws + WS_XG);
    unsigned* rt_e = (unsigned*)(ws + RT_E); float* rt_w0 = (float*)(ws + RT_W0); float* rt_w1 = (float*)(ws + RT_W1); int* rt_s0 = (int*)(ws + RT_S0); int* rt_s1 = (int*)(ws + RT_S1);
    unsigned* rt_cnt = (unsigned*)(ws + RT_CNT); unsigned* rt_pb = (unsigned*)(ws + RT_PB);
    const float* nmix = args.in[2]; const float* nffn = args.in[3];

    if (IN(0)) REP(0) { prologue(F); __syncthreads();
        RowArgs a{}; a.Xsrc = x_in; a.g = nmix; a.XN = XN; row_pass<0, false>(F, a); }
    SEAM(0);
    if (IN(1)) REP(1) { gemm_static(F, XN, D, D, (const bf16*)(ws + W_CINB), 1024, pg8::EpiBf16{(bf16*)(big + B_CONV_B), D, nullptr, 1.0f});
                 gemm_static(F, XN, D, D, (const bf16*)(ws + W_CINCU), 2048, pg8::EpiPair<0>{(bf16*)(big + B_CONV_V), D}); }
    SEAM(1);
    if (IN(2)) REP(2) conv_pass(F, (const bf16*)(big + B_CONV_B), (const bf16*)(big + B_CONV_V), args.in[6], (bf16*)(big + B_CONV_Y));
    SEAM(2);
    if (IN(3)) REP(3) gemm_static(F, (const bf16*)(big + B_CONV_Y), D, D, (const bf16*)(ws + W_COUT), 1024, pg8::EpiRes{x_in, X, D, nullptr});
    SEAM(3);
    if (IN(4)) REP(4) { RowArgs a{}; a.Xsrc = X; a.g = nffn; a.XN = XN; row_pass<0, false>(F, a); }
    SEAM(4);
    if (IN(5)) REP(5) gemm_static(F, XN, D, D, (const bf16*)(ws + W_FGU), 2 * FF, pg8::EpiPair<1>{(bf16*)(big + B_HMID), FF});
    SEAM(5);
    if (IN(6)) REP(6) gemm_static(F, (const bf16*)(big + B_HMID), FF, FF, (const bf16*)(ws + W_FD), 1024, pg8::EpiRes{X, X, D, nullptr});
    SEAM(6);
    if (IN(7)) REP(7) { RowArgs a{}; a.Xsrc = X; a.g = nmix + D; a.XN = XN; row_pass<0, false>(F, a); }
    SEAM(7);
    if (IN(8)) REP(8) gemm_static(F, XN, D, D, (const bf16*)(ws + W_MDN), MDNP, pg8::EpiF32{(float*)(big + B_MC), MDNP});
    SEAM(8);
    if (IN(9)) REP(9) mla_mid(F, (const float*)(big + B_MC), args.in[9], args.in[11], (const float*)(ws + WS_ROPE), (bf16*)(big + B_MCQ), (bf16*)(big + B_MCKV), (bf16*)(big + B_MK));
    SEAM(9);
    if (IN(10)) REP(10) {
#ifndef NO_UQ
 gemm_static(F, (const bf16*)(big + B_MCQ), QL, QL, (const bf16*)(ws + W_MUQ), 1536, pg8::EpiBf16{(bf16*)(big + B_MQ), 1536, nullptr, 1.0f});
#endif
#ifndef NO_UKV
                  gemm_static(F, (const bf16*)(big + B_MCKV), KVL, KVL, (const bf16*)(ws + W_MUKV), 2048, pg8::EpiKV{(bf16*)(big + B_MK), (bf16*)(big + B_MV)});
#endif
 }
    SEAM(10);
    if (IN(11)) REP(11) mla_attention(F);
    SEAM(11);
    if (IN(12)) REP(12) gemm_static(F, (const bf16*)(big + B_MO), D, D, (const bf16*)(ws + W_MO), 1024, pg8::EpiRes{X, X, D, nullptr});
    SEAM(12);
    if (IN(13)) REP(13) { RowArgs a{}; a.Xsrc = X; a.g = nffn + D; a.XN = XN; a.routerT = (const float*)(ws + W_RT); a.rt_e = rt_e; a.rt_w0 = rt_w0; a.rt_w1 = rt_w1; a.cnt = rt_cnt; row_pass<1, false>(F, a); }
    SEAM(13);
    if (IN(14)) REP(14) moe_assign<MOE_F8_A != 0>(F, rt_cnt, rt_e, rt_s0, rt_s1, rt_pb, XN, XG);
    SEAM(14);
    if (IN(15)) REP(15) moe_gemm1<MOE_F8_A != 0>(F, 0, rt_pb);
    SEAM(15);
    if (IN(16)) REP(16) moe_gemm2<MOE_F8_A != 0>(F, 0, rt_pb);
    SEAM(16);
    if (IN(17)) REP(17) { RowArgs a{}; a.Xsrc = X; a.Xdst = X; a.g = nmix + 2 * D; a.XN = XN; a.Y = XG; a.s0 = rt_s0; a.s1 = rt_s1; a.w0 = rt_w0; a.w1 = rt_w1; row_pass<0, true>(F, a); }
    SEAM(17);
    if (IN(18)) REP(18) gemm_static(F, XN, D, D, (const bf16*)(ws + W_SQKV), SQKV, pg8::EpiBf16{(bf16*)(big + B_SQKV), SQKV, args.in[15], 1.0f});
    SEAM(18);
    if (IN(19)) REP(19) swa_attention(F);
    SEAM(19);
    if (IN(20)) REP(20) gemm_static(F, (const bf16*)(big + B_SO), D, D, (const bf16*)(ws + W_SO), 1024, pg8::EpiRes{X, X, D, args.in[18]});
    SEAM(20);
    if (IN(21)) REP(21) { RowArgs a{}; a.Xsrc = X; a.g = nffn + 2 * D; a.XN = XN; row_pass<0, false>(F, a); }
    SEAM(21);
    if (IN(22)) REP(22) gemm_static(F, XN, D, D, (const bf16*)(ws + W_FGU + (size_t)2 * FF * 1024 * 2), 2 * FF, pg8::EpiPair<1>{(bf16*)(big + B_HMID), FF});
    SEAM(22);
    if (IN(23)) REP(23) gemm_static(F, (const bf16*)(big + B_HMID), FF, FF, (const bf16*)(ws + W_FD + (size_t)1024 * FF * 2), 1024, pg8::EpiRes{X, X, D, nullptr});
    SEAM(23);
    if (IN(24)) REP(24) { RowArgs a{}; a.Xsrc = X; a.g = nmix + 3 * D; a.XN = XN; row_pass<0, false>(F, a); }
    SEAM(24);
    if (IN(25)) REP(25) { gemm_static(F, XN, D, D, (const bf16*)(ws + W_CINB + (size_t)1024 * 1024 * 2), 1024, pg8::EpiBf16{(bf16*)(big + B_CONV_B), D, nullptr, 1.0f});
                  gemm_static(F, XN, D, D, (const bf16*)(ws + W_CINCU + (size_t)2048 * 1024 * 2), 2048, pg8::EpiPair<0>{(bf16*)(big + B_CONV_V), D}); }
    SEAM(25);
    if (IN(26)) REP(26) conv_pass(F, (const bf16*)(big + B_CONV_B), (const bf16*)(big + B_CONV_V), args.in[6] + 3 * D, (bf16*)(big + B_CONV_Y));
    SEAM(26);
    if (IN(27)) REP(27) gemm_static(F, (const bf16*)(big + B_CONV_Y), D, D, (const bf16*)(ws + W_COUT + (size_t)1024 * 1024 * 2), 1024, pg8::EpiRes{X, X, D, nullptr});
    SEAM(27);
    if (IN(28)) REP(28) { RowArgs a{}; a.Xsrc = X; a.g = nffn + 3 * D; a.XN = XN; a.routerT = (const float*)(ws + W_RT) + 8 * 1024; a.rt_e = rt_e; a.rt_w0 = rt_w0; a.rt_w1 = rt_w1; a.cnt = rt_cnt; row_pass<1, false>(F, a); }
    SEAM(28);
    if (IN(29)) REP(29) moe_assign<MOE_F8_B != 0>(F, rt_cnt, rt_e, rt_s0, rt_s1, rt_pb + 16, XN, XG);
    SEAM(29);
    if (IN(30)) REP(30) moe_gemm1<MOE_F8_B != 0>(F, 1, rt_pb + 16);
    SEAM(30);
    if (IN(31)) REP(31) moe_gemm2<MOE_F8_B != 0>(F, 1, rt_pb + 16);
    SEAM(31);
    if (IN(32)) REP(32) { RowArgs a{}; a.Xsrc = X; a.g = args.in[4]; a.outF = X; a.Y = XG; a.s0 = rt_s0; a.s1 = rt_s1; a.w0 = rt_w0; a.w1 = rt_w1; row_pass<2, true>(F, a); }
#undef IN
#undef SEAM
}

#ifndef MK_LAUNCH_PER_PHASE
#define MK_LAUNCH_PER_PHASE 0
#endif
extern "C" void kernel_launch(void* const* d_in, const int* in_sizes, int n_in, void* d_out, int out_size, void* d_ws, size_t ws_size, hipStream_t stream) {
    static int grid = 0;
    if (grid == 0) {
        if (n_in != 24 || in_sizes[0] != T * D || out_size != T * D || ws_size < WS_END) { fprintf(stderr, "kernel_launch: unexpected shapes (n_in %d, in0 %d, out %d, ws %zu < %zu); nothing launched\n", n_in, n_in > 0 ? in_sizes[0] : -1, out_size, ws_size, (size_t)WS_END); grid = -1; return; }
        int dev = 0, cus = 0, per_cu = 0;
        if (hipGetDevice(&dev) != hipSuccess || hipDeviceGetAttribute(&cus, hipDeviceAttributeMultiprocessorCount, dev) != hipSuccess) { grid = -1; return; }
        if (hipFuncSetAttribute((const void*)mega, hipFuncAttributeMaxDynamicSharedMemorySize, LDS_BYTES) != hipSuccess) { fprintf(stderr, "kernel_launch: hipFuncSetAttribute failed\n"); grid = -1; return; }
        if (hipOccupancyMaxActiveBlocksPerMultiprocessor(&per_cu, (const void*)mega, NTHREADS, LDS_BYTES) != hipSuccess || per_cu < 1) fprintf(stderr, "kernel_launch: occupancy query reports %d\n", per_cu);
        (void)hipGetLastError();
        grid = cus;
    }
    if (grid < 0) return;
    (void)hipMemsetAsync((char*)d_ws + WS_CTL, 0, CTL_ZERO_BYTES, stream);
    Args a{};
    for (int i = 0; i < 24; ++i) a.in[i] = (const float*)d_in[i];
    a.out = (float*)d_out; a.ws = (unsigned char*)d_ws;
#if MK_LAUNCH_PER_PHASE
    for (int p = 0; p < N_PHASES; ++p) { a.ph_lo = p; a.ph_hi = p + 1; hipLaunchKernelGGL(mega, dim3(grid), dim3(NTHREADS), LDS_BYTES, stream, a); }
#else
    a.ph_lo = 0; a.ph_hi = N_PHASES; hipLaunchKernelGGL(mega, dim3(grid), dim3(NTHREADS), LDS_BYTES, stream, a);
#endif
}
```

```cpp
#include <hip/hip_runtime.h>
#include <cstdio>
#include <cstdint>

#define LAS __attribute__((address_space(3)))
#define GAS __attribute__((address_space(1)))
typedef unsigned short bf16;
typedef short bf16x8 __attribute__((ext_vector_type(8)));
typedef short s16x4 __attribute__((ext_vector_type(4)));
typedef float f32x2 __attribute__((ext_vector_type(2)));
typedef float f32x4 __attribute__((ext_vector_type(4)));
typedef float f32x16 __attribute__((ext_vector_type(16)));
typedef unsigned u32x2 __attribute__((ext_vector_type(2)));
typedef unsigned u32x4 __attribute__((ext_vector_type(4)));

__device__ __forceinline__ unsigned cvt_pk_bf16(float lo, float hi) { unsigned r; asm volatile("v_cvt_pk_bf16_f32 %0, %1, %2" : "=v"(r) : "v"(lo), "v"(hi)); return r; }
__device__ __forceinline__ float bf2f(unsigned short b) { return __uint_as_float(((unsigned)b) << 16); }
__device__ __forceinline__ float bflo(unsigned w) { return __uint_as_float(w << 16); }
__device__ __forceinline__ float bfhi(unsigned w) { return __uint_as_float(w & 0xffff0000u); }
__device__ __forceinline__ float wave_sum(float v) {
#pragma unroll
    for (int o = 1; o < 64; o <<= 1) v += __shfl_xor(v, o);
    return v;
}
__device__ __forceinline__ float fast_silu(float g) { return g * __builtin_amdgcn_rcpf(1.0f + __builtin_amdgcn_exp2f(-1.4426950408889634f * g)); }

namespace pg8 {
constexpr int BM = 256, BK = 64, HALF = 128, HTB = HALF * BK * 2, STAGE_BYTES = 8 * HTB, NXCD = 8, WGM = 8;
__host__ __device__ __forceinline__ int lds_byte(int r, int c) { const int st = (r >> 4) * 2 + (c >> 5), rr = r & 15, cc = c & 31, ob = rr * 64 + cc * 2; return st * 1024 + (ob ^ (((ob >> 9) & 1) << 5)); }
__host__ __device__ __forceinline__ void stage_rc(int b, int& R, int& C) { const int st = b / 1024, sb = b % 1024, swz = sb ^ (((sb >> 9) & 1) << 5); R = (st >> 1) * 16 + swz / 64; C = (st & 1) * 32 + (swz % 64) / 2; }
__host__ __device__ __forceinline__ int perm32(int rho) { const int n = rho >> 4, i = rho & 15; return 8 * (i >> 2) + 4 * n + (i & 3); }

struct Unit { int pm, pn, e; };
struct Gemm { const bf16* A; const bf16* Bt; int lda, K; size_t estride; };

struct StaticOrder {
    int nM, nN, nwg, G, c;
    __device__ __forceinline__ void init(int M, int N, int G_, int c_) { nM = M / BM; nN = N / BM; nwg = nM * nN; G = G_; c = c_; }
    __device__ __forceinline__ bool next(int i, Unit& u) const {
        const long L = (long)i * G + c; if (L >= nwg) return false;
        int wgid = (int)L; { const int q = nwg / NXCD, r = nwg % NXCD, xcd = wgid % NXCD, off = wgid / NXCD; wgid = (xcd < r ? xcd * (q + 1) : r * (q + 1) + (xcd - r) * q) + off; }
        const int nig = WGM * nN, gid = wgid / nig, fm = gid * WGM, gsz = (nM - fm) < WGM ? (nM - fm) : WGM;
        u.pm = fm + ((wgid % nig) % gsz); u.pn = (wgid % nig) / gsz; u.e = 0; return true;
    }
};
struct GroupedOrder {
    const LAS unsigned* tab;
    __device__ __forceinline__ void init(const unsigned* pbase, int N, int G, int c, LAS unsigned* table, int cap) {
        const int tid = threadIdx.x;
        int pb[9];
#pragma unroll
        for (int i = 0; i < 9; ++i) pb[i] = (int)__hip_atomic_load(pbase + i, __ATOMIC_RELAXED, __HIP_MEMORY_SCOPE_AGENT);
        const int nM = pb[8], nN = N / BM, nwg = nM * nN;
        if (tid < cap) {
            unsigned w = 0u; const long L = (long)tid * G + c;
            if (L < nwg) {
                int wgid = (int)L; { const int q = nwg / NXCD, r = nwg % NXCD, xcd = wgid % NXCD, off = wgid / NXCD; wgid = (xcd < r ? xcd * (q + 1) : r * (q + 1) + (xcd - r) * q) + off; }
                const int nig = WGM * nN, gid = wgid / nig, fm = gid * WGM, gsz = (nM - fm) < WGM ? (nM - fm) : WGM;
                const int pm = fm + ((wgid % nig) % gsz), pn = (wgid % nig) / gsz;
                int e = 0;
#pragma unroll
                for (int j = 1; j < 8; ++j) e += (pm >= pb[j]) ? 1 : 0;
                w = (unsigned)pm | ((unsigned)pn << 12) | ((unsigned)e << 20) | 0x80000000u;
            }
            table[tid] = w;
        }
        tab = table;
        __syncthreads();
    }
    __device__ __forceinline__ bool next(int i, Unit& u) const {
        const unsigned w = (unsigned)__builtin_amdgcn_readfirstlane((int)tab[i]);
        u.pm = (int)(w & 0xfffu); u.pn = (int)((w >> 12) & 0xffu); u.e = (int)((w >> 20) & 0xfu); return (w >> 31) != 0u;
    }
};

struct EpiBf16 {
    static constexpr bool PERM = true;
    bf16* O; int ldc; const float* bias; float scale;
    __device__ __forceinline__ void operator()(const f32x4 (&acc)[2][2][4][2], const Unit& u, int wr, int wc, int fr, int fq) const {
        const int row0 = u.pm * BM + wr * 64 + fr, col0 = u.pn * BM + wc * 32 + 8 * fq;
        f32x4 bv[2][2];
#pragma unroll
        for (int bj = 0; bj < 2; ++bj)
#pragma unroll
            for (int n = 0; n < 2; ++n) bv[bj][n] = bias ? *(const f32x4*)(bias + col0 + bj * HALF + 4 * n) : (f32x4){0.f, 0.f, 0.f, 0.f};
#pragma unroll
        for (int ai = 0; ai < 2; ++ai)
#pragma unroll
            for (int m = 0; m < 4; ++m) { bf16* rowp = O + (size_t)(row0 + ai * HALF + m * 16) * ldc + col0;
#pragma unroll
                for (int bj = 0; bj < 2; ++bj) { const f32x4 v0 = acc[ai][bj][m][0] * scale + bv[bj][0], v1 = acc[ai][bj][m][1] * scale + bv[bj][1];
                    u32x4 w; w.x = cvt_pk_bf16(v0[0], v0[1]); w.y = cvt_pk_bf16(v0[2], v0[3]); w.z = cvt_pk_bf16(v1[0], v1[1]); w.w = cvt_pk_bf16(v1[2], v1[3]);
                    *(u32x4*)(rowp + bj * HALF) = w; } }
    }
};
template <int ACT  > struct EpiPair {
    static constexpr bool PERM = true;
    bf16* O; int ldc; float sin;
    __device__ __forceinline__ void operator()(const f32x4 (&acc)[2][2][4][2], const Unit& u, int wr, int wc, int fr, int fq) const {
        const int row0 = u.pm * BM + wr * 64 + fr, col0 = u.pn * HALF + wc * 32 + 8 * fq;
#pragma unroll
        for (int ai = 0; ai < 2; ++ai)
#pragma unroll
            for (int m = 0; m < 4; ++m) { bf16* rowp = O + (size_t)(row0 + ai * HALF + m * 16) * ldc + col0;
                f32x4 r[2];
#pragma unroll
                for (int n = 0; n < 2; ++n) { const f32x4 a = acc[ai][0][m][n] * sin, b = acc[ai][1][m][n] * sin;
                    if (ACT == 1) r[n] = (f32x4){fast_silu(a[0]) * b[0], fast_silu(a[1]) * b[1], fast_silu(a[2]) * b[2], fast_silu(a[3]) * b[3]};
                    else r[n] = a * b; }
                u32x4 w; w.x = cvt_pk_bf16(r[0][0], r[0][1]); w.y = cvt_pk_bf16(r[0][2], r[0][3]); w.z = cvt_pk_bf16(r[1][0], r[1][1]); w.w = cvt_pk_bf16(r[1][2], r[1][3]);
                *(u32x4*)rowp = w; }
    }
};
struct EpiPair8 {
    static constexpr bool PERM = true;
    unsigned char* O; int ldc; float sin, sout;
    __device__ __forceinline__ void operator()(const f32x4 (&acc)[2][2][4][2], const Unit& u, int wr, int wc, int fr, int fq) const {
        const int row0 = u.pm * BM + wr * 64 + fr, col0 = u.pn * HALF + wc * 32 + 8 * fq;
#pragma unroll
        for (int ai = 0; ai < 2; ++ai)
#pragma unroll
            for (int m = 0; m < 4; ++m) { unsigned char* rowp = O + (size_t)(row0 + ai * HALF + m * 16) * ldc + col0;
                float r[8];
#pragma unroll
                for (int n = 0; n < 2; ++n) { const f32x4 a = acc[ai][0][m][n] * sin, b = acc[ai][1][m][n] * (sin * sout);
#pragma unroll
                    for (int j = 0; j < 4; ++j) r[4 * n + j] = fminf(fmaxf(fast_silu(a[j]) * b[j], -448.f), 448.f); }
                u32x2 w; int t = __builtin_amdgcn_cvt_pk_fp8_f32(r[0], r[1], 0, false); t = __builtin_amdgcn_cvt_pk_fp8_f32(r[2], r[3], t, true); w.x = (unsigned)t;
                t = __builtin_amdgcn_cvt_pk_fp8_f32(r[4], r[5], 0, false); t = __builtin_amdgcn_cvt_pk_fp8_f32(r[6], r[7], t, true); w.y = (unsigned)t;
                *(u32x2*)rowp = w; }
    }
};
struct EpiRes {
    static constexpr bool PERM = false;
    const float* src; float* dst; int ldc; const float* bias; float scale;
    __device__ __forceinline__ void operator()(const f32x4 (&acc)[2][2][4][2], const Unit& u, int wr, int wc, int fr, int fq) const {
        const int row0 = u.pm * BM + wr * 64 + fr, col0 = u.pn * BM + wc * 32 + 4 * fq;
        f32x4 bv[2][2];
#pragma unroll
        for (int bj = 0; bj < 2; ++bj)
#pragma unroll
            for (int n = 0; n < 2; ++n) bv[bj][n] = bias ? *(const f32x4*)(bias + col0 + bj * HALF + n * 16) : (f32x4){0.f, 0.f, 0.f, 0.f};
#pragma unroll
        for (int ai = 0; ai < 2; ++ai)
#pragma unroll
            for (int m = 0; m < 4; ++m) { const size_t off = (size_t)(row0 + ai * HALF + m * 16) * ldc + col0;
                f32x4 s[2][2];
#pragma unroll
                for (int bj = 0; bj < 2; ++bj)
#pragma unroll
                    for (int n = 0; n < 2; ++n) s[bj][n] = *(const f32x4*)(src + off + bj * HALF + n * 16);
#pragma unroll
                for (int bj = 0; bj < 2; ++bj)
#pragma unroll
                    for (int n = 0; n < 2; ++n) *(f32x4*)(dst + off + bj * HALF + n * 16) = s[bj][n] + acc[ai][bj][m][n] * scale + bv[bj][n];
                asm volatile("" ::: "memory"); }
    }
};
struct EpiF32 {
    static constexpr bool PERM = false;
    float* C; int ldc; float scale;
    __device__ __forceinline__ void operator()(const f32x4 (&acc)[2][2][4][2], const Unit& u, int wr, int wc, int fr, int fq) const {
        const int row0 = u.pm * BM + wr * 64 + fr, col0 = u.pn * BM + wc * 32 + 4 * fq;
#pragma unroll
        for (int ai = 0; ai < 2; ++ai)
#pragma unroll
            for (int m = 0; m < 4; ++m) { float* rowp = C + (size_t)(row0 + ai * HALF + m * 16) * ldc + col0;
#pragma unroll
                for (int bj = 0; bj < 2; ++bj)
#pragma unroll
                    for (int n = 0; n < 2; ++n) *(f32x4*)(rowp + bj * HALF + n * 16) = acc[ai][bj][m][n] * scale; }
    }
};
struct EpiKV {
    static constexpr bool PERM = true;
    bf16* Kf; bf16* V;
    __device__ __forceinline__ void operator()(const f32x4 (&acc)[2][2][4][2], const Unit& u, int wr, int wc, int fr, int fq) const {
        const int row0 = u.pm * BM + wr * 64 + fr, col0 = wc * 32 + 8 * fq, h = u.pn;
#pragma unroll
        for (int ai = 0; ai < 2; ++ai)
#pragma unroll
            for (int m = 0; m < 4; ++m) { const int row = row0 + ai * HALF + m * 16, b = row >> 13, s = row & 8191; const size_t hr = (size_t)(b * 8 + h) * 8192 + s;
#pragma unroll
                for (int bj = 0; bj < 2; ++bj) { const f32x4 v0 = acc[ai][bj][m][0], v1 = acc[ai][bj][m][1];
                    u32x4 w; w.x = cvt_pk_bf16(v0[0], v0[1]); w.y = cvt_pk_bf16(v0[2], v0[3]); w.z = cvt_pk_bf16(v1[0], v1[1]); w.w = cvt_pk_bf16(v1[2], v1[3]);
                    if (bj == 0) *(u32x4*)(Kf + hr * 192 + col0) = w; else *(u32x4*)(V + hr * 128 + col0) = w; } }
    }
};

typedef int v8i32 __attribute__((ext_vector_type(8)));
__device__ __forceinline__ v8i32 cat8(bf16x8 a, bf16x8 b) { typedef int v4i32 __attribute__((ext_vector_type(4))); const v4i32 x = __builtin_bit_cast(v4i32, a), y = __builtin_bit_cast(v4i32, b); return __builtin_shufflevector(x, y, 0, 1, 2, 3, 4, 5, 6, 7); }
template <class Epi, class Sched, bool F8 = false>
__device__ __forceinline__ void gemm_phase(LAS unsigned char* lds, const Gemm g, const Sched& S, const Epi& E) {
    const int tid = threadIdx.x, wid = __builtin_amdgcn_readfirstlane(tid >> 6), lane = tid & 63, wr = wid >> 2, wc = wid & 3, fr = lane & 15, fq = lane >> 4;
    const int K = g.K, nt = K / BK, lda = g.lda;
    unsigned voffA[2], voffB[2];
#pragma unroll
    for (int i = 0; i < 2; ++i) { int R, C; stage_rc(tid * 16 + i * 8192, R, C); const int Rb = Epi::PERM ? ((R & ~31) + perm32(R & 31)) : R;
        voffA[i] = (unsigned)(R * lda + C) * 2u; voffB[i] = (unsigned)(Rb * K + C) * 2u; }
    const size_t kstep = (size_t)(BK * 2);
    const size_t hstepA = (size_t)HALF * lda * 2, hstepB = (size_t)HALF * K * 2;
    const size_t tstepA = 2 * hstepA, tstepB = 2 * hstepB;
    const unsigned ldsw = (unsigned)wid * 1024u;
    const int aoff = lds_byte(wr * 64 + fr, fq * 8), boff = lds_byte(wc * 32 + fr, fq * 8);
#define PG8_SA(b, h) (((b) * 2 + (h)) * HTB)
#define PG8_SB(b, h) ((4 + (b) * 2 + (h)) * HTB)
#define PG8_STAGE(bufoff, gbase, voff) do { _Pragma("unroll") for (int _i = 0; _i < 2; ++_i) \
        __builtin_amdgcn_global_load_lds((const unsigned*)((const char*)(gbase) + (voff)[_i]), (LAS unsigned*)(lds + (bufoff) + ldsw + _i * 8192), 16, 0, 0); } while (0)
#define PG8_LDA(dst, b, h) do { _Pragma("unroll") for (int m = 0; m < 4; ++m) _Pragma("unroll") for (int k = 0; k < 2; ++k) dst[m][k] = *(const LAS bf16x8*)(lds + PG8_SA(b, h) + aoff + m * 2048 + k * 1024); } while (0)
#define PG8_LDB(dst, b, h) do { _Pragma("unroll") for (int n = 0; n < 2; ++n) _Pragma("unroll") for (int k = 0; k < 2; ++k) dst[n][k] = *(const LAS bf16x8*)(lds + PG8_SB(b, h) + boff + n * 2048 + k * 1024); } while (0)
#define PG8_MMA(ai, bj, At, Bt) do { __builtin_amdgcn_s_setprio(1); if constexpr (F8) asm volatile("s_nop 1"); _Pragma("unroll") for (int m = 0; m < 4; ++m) _Pragma("unroll") for (int n = 0; n < 2; ++n) { \
        if constexpr (F8) { const v8i32 b8_ = cat8(Bt[n][0], Bt[n][1]), a8_ = cat8(At[m][0], At[m][1]); asm("v_mfma_f32_16x16x128_f8f6f4 %0, %1, %2, %0" : "+v"(acc[ai][bj][m][n]) : "v"(b8_), "v"(a8_)); } \
        else { _Pragma("unroll") for (int k = 0; k < 2; ++k) acc[ai][bj][m][n] = __builtin_amdgcn_mfma_f32_16x16x32_bf16(Bt[n][k], At[m][k], acc[ai][bj][m][n], 0, 0, 0); } } __builtin_amdgcn_s_setprio(0); } while (0)
#define PG8_WAIT_V(n) asm volatile("s_waitcnt vmcnt(" #n ")" ::: "memory")
#define PG8_WAIT_L(n) asm volatile("s_waitcnt lgkmcnt(" #n ")" ::: "memory")
#define PG8_BAR __builtin_amdgcn_s_barrier()
#define PG8_SCHED __builtin_amdgcn_sched_barrier(0)
    Unit cur, nxt; int ui = 0;
    if (!S.next(0, cur)) return;
    f32x4 acc[2][2][4][2];
#pragma unroll
    for (int a = 0; a < 2; ++a)
#pragma unroll
        for (int b = 0; b < 2; ++b)
#pragma unroll
            for (int m = 0; m < 4; ++m)
#pragma unroll
                for (int n = 0; n < 2; ++n) acc[a][b][m][n] = (f32x4){0.f, 0.f, 0.f, 0.f};
    bf16x8 At[4][2], B0[2][2], B1[2][2];
    const char* cA = (const char*)g.A + (size_t)cur.pm * tstepA; const char* cB = (const char*)g.Bt + (size_t)cur.e * g.estride + (size_t)cur.pn * tstepB;
    PG8_STAGE(PG8_SB(0, 0), cB, voffB); PG8_STAGE(PG8_SB(0, 1), cB + hstepB, voffB); PG8_STAGE(PG8_SA(0, 0), cA, voffA); PG8_STAGE(PG8_SA(0, 1), cA + hstepA, voffA);
    if (wr == 1) PG8_BAR;
    PG8_WAIT_V(2); PG8_BAR;
    PG8_STAGE(PG8_SB(1, 0), cB + kstep, voffB); PG8_STAGE(PG8_SA(1, 0), cA + kstep, voffA); PG8_STAGE(PG8_SB(1, 1), cB + hstepB + kstep, voffB);
    PG8_WAIT_V(6); PG8_BAR;
    for (;;) {
        const bool has_next = S.next(ui + 1, nxt);
        const char* nA = has_next ? (const char*)g.A + (size_t)nxt.pm * tstepA : cA; const char* nB = has_next ? (const char*)g.Bt + (size_t)nxt.e * g.estride + (size_t)nxt.pn * tstepB : cB;
#pragma nounroll
        for (int t = 0; t < nt; t += 2) {
            const bool last = (t == nt - 2);
            const char* a1 = cA + (size_t)(t + 1) * kstep;
            const char* a2 = last ? nA : cA + (size_t)(t + 2) * kstep; const char* b2 = last ? nB : cB + (size_t)(t + 2) * kstep;
            const char* a3 = a2 + kstep; const char* b3 = b2 + kstep;
            PG8_LDB(B0, 0, 0); PG8_LDB(B1, 0, 1); PG8_SCHED; PG8_LDA(At, 0, 0); PG8_STAGE(PG8_SA(1, 1), a1 + hstepA, voffA);
            PG8_WAIT_V(8); PG8_WAIT_L(0); PG8_BAR; PG8_MMA(0, 0, At, B0); PG8_MMA(0, 1, At, B1); PG8_BAR; PG8_SCHED;
            PG8_LDA(At, 0, 1); PG8_STAGE(PG8_SB(0, 0), b2, voffB); PG8_STAGE(PG8_SB(0, 1), b2 + hstepB, voffB); PG8_STAGE(PG8_SA(0, 0), a2, voffA);
            PG8_WAIT_V(8); PG8_WAIT_L(0); PG8_BAR; PG8_MMA(1, 0, At, B0); PG8_MMA(1, 1, At, B1); PG8_BAR; PG8_SCHED;
            PG8_LDB(B0, 1, 0); PG8_LDB(B1, 1, 1); PG8_SCHED; PG8_LDA(At, 1, 0); PG8_STAGE(PG8_SA(0, 1), a2 + hstepA, voffA);
            PG8_WAIT_V(8); PG8_WAIT_L(0); PG8_BAR; PG8_MMA(0, 0, At, B0); PG8_MMA(0, 1, At, B1); PG8_BAR; PG8_SCHED;
            PG8_LDA(At, 1, 1); PG8_STAGE(PG8_SB(1, 0), b3, voffB); PG8_STAGE(PG8_SB(1, 1), b3 + hstepB, voffB); PG8_STAGE(PG8_SA(1, 0), a3, voffA);
            PG8_WAIT_V(8); PG8_WAIT_L(0); PG8_BAR; PG8_MMA(1, 0, At, B0); PG8_MMA(1, 1, At, B1); PG8_BAR; PG8_SCHED;
        }
        if constexpr (F8) asm volatile("s_nop 15\n\ts_nop 15" ::: "memory");
        if (wr == 0) PG8_BAR;
        E(acc, cur, wr, wc, fr, fq);
        if (!has_next) break;
#pragma unroll
        for (int a = 0; a < 2; ++a)
#pragma unroll
            for (int b = 0; b < 2; ++b)
#pragma unroll
                for (int m = 0; m < 4; ++m)
#pragma unroll
                    for (int n = 0; n < 2; ++n) acc[a][b][m][n] = (f32x4){0.f, 0.f, 0.f, 0.f};
        cur = nxt; cA = nA; cB = nB; ++ui;
        if (wr == 1) PG8_BAR;
    }
    PG8_WAIT_V(0);
    PG8_BAR;
#undef PG8_SA
#undef PG8_SB
#undef PG8_STAGE
#undef PG8_LDA
#undef PG8_LDB
#undef PG8_MMA
#undef PG8_WAIT_V
#undef PG8_WAIT_L
#undef PG8_BAR
#undef PG8_SCHED
}
}
namespace att {
constexpr int NW = 8, QBLK = 32, KVBLK = 64, QB = NW * QBLK;
__device__ __forceinline__ int crow(int r, int hi) { return (r & 3) + 8 * (r >> 2) + 4 * hi; }
template <int NCB> __device__ __forceinline__ int v_st(int k, int c) { const int kk = (k & ~0xC) | ((k & 4) << 1) | ((k & 8) >> 1); return ((kk >> 3) * NCB + (c >> 5)) * 512 + ((kk & 7) * 32 + (c & 31)) * 2; }
__device__ __forceinline__ int v_rd_base(int lane) { return ((lane & 3) << 3) | (((lane >> 2) & 3) << 6) | (((lane >> 4) & 1) << 5) | (((lane >> 5) & 1) << 8); }

struct Params {
    const bf16* Q; int ldq;
    const bf16* K; int ldk;
    const bf16* V; int ldv;
    bf16* O; int ldo;
    int P0;
    int j_lo, j_hi;
    const float* rope;
    const int* pos;
    float slope_over_scale, sink_l2;
};

template <int DQK, int DV, int KIND, int W>
__device__ __forceinline__ void attn_block(const Params& p, char* lds) {
    constexpr int NKS = DQK / 64, ND0 = DQK / 16, NCB = DV / 32, NVP = DV / 64;
    constexpr int KT = NKS * 8192, VT = KVBLK * DV * 2;
    constexpr int OFF_K = 2 * VT, OFF_KP = OFF_K + 2 * KT, OFF_WS = OFF_KP + 2 * 256;
    const float SCALE = (DQK == 192) ? 0.07216878364870322f : 0.125f;
    const float C2 = 1.4426950408889634f * SCALE;
    constexpr float THR = 8.f;
    const int tid = threadIdx.x, wid = __builtin_amdgcn_readfirstlane(tid >> 6), lane = tid & 63, r32 = lane & 31, hi = lane >> 5;
    LAS unsigned char* lds3 = (LAS unsigned char*)lds; char* V_lds = lds; char* K_lds = lds + OFF_K; float* kp_lds = (float*)(lds + OFF_KP);
    float* ws = (float*)(lds + OFF_WS) + wid * 64; float* li_l = ws, * al_l = ws + 32;
    const int NT = p.j_hi - p.j_lo;
    const int qlo = p.P0 + wid * QBLK, qm = qlo + r32 - 4 * hi;
    unsigned kofs, vofs[NVP];
    { const int q = wid * 64 + lane, key = q >> 3, c = (q & 7) ^ ((key >> 1) & 7); kofs = (unsigned)(key * p.ldk + c * 8) * 2u; }
#pragma unroll
    for (int i = 0; i < NVP; ++i) { const int bo = (wid + 8 * i) * 1024 + lane * 16, sub = bo >> 9, within = bo & 511, kk = (sub / NCB) * 8 + (within >> 6), c = (sub % NCB) * 32 + ((within & 63) >> 1);
        const int k = (kk & ~0xC) | ((kk & 4) << 1) | ((kk & 8) >> 1); vofs[i] = (unsigned)(k * p.ldv + c) * 2u; }
    float st_p = 0.f;
#define ST_LOAD(kb, bf) do { \
        const char* kb_ = (const char*)p.K + (size_t)(kb) * (size_t)(p.ldk * 2); const char* vb_ = (const char*)p.V + (size_t)(kb) * (size_t)(p.ldv * 2); \
        _Pragma("unroll") for (int s_ = 0; s_ < NKS; ++s_) __builtin_amdgcn_global_load_lds((const unsigned*)(kb_ + kofs + s_ * 128), (LAS unsigned*)(lds3 + OFF_K + (bf) * KT + s_ * 8192 + wid * 1024), 16, 0, 0); \
        _Pragma("unroll") for (int i_ = 0; i_ < NVP; ++i_) __builtin_amdgcn_global_load_lds((const unsigned*)(vb_ + vofs[i_]), (LAS unsigned*)(lds3 + (bf) * VT + (wid + 8 * i_) * 1024), 16, 0, 0); \
        if (KIND == 1 && tid < 64) st_p = (float)p.pos[(kb) + tid]; } while (0)
#define ST_WRITE(bf) do { if (KIND == 1 && tid < 64) kp_lds[(bf) * 64 + tid] = st_p; } while (0)
    bf16x8 qr[ND0];
    ST_LOAD(p.j_lo * KVBLK, 0);
    { const bf16* qrow = p.Q + (size_t)(wid * QBLK + r32) * p.ldq + hi * 8;
#pragma unroll
      for (int d0 = 0; d0 < ND0; ++d0) qr[d0] = *(const bf16x8*)(qrow + d0 * 16); }
    float pq = 0.f;
    if (KIND == 0) {
        const float* rt = p.rope + (size_t)(wid * QBLK + r32) * 64;
#pragma unroll
        for (int dd = 0; dd < 2; ++dd) {
            const int i0 = dd * 16 + hi * 8;
            const f32x4 c0 = *(const f32x4*)(rt + i0), c1 = *(const f32x4*)(rt + i0 + 4), s0 = *(const f32x4*)(rt + 32 + i0), s1 = *(const f32x4*)(rt + 32 + i0 + 4);
            bf16x8 a = qr[8 + dd], b = qr[10 + dd]; u32x4 ra, rb; float x1[8], x2[8], cs[8], sn[8];
#pragma unroll
            for (int j = 0; j < 4; ++j) { cs[j] = c0[j]; cs[4 + j] = c1[j]; sn[j] = s0[j]; sn[4 + j] = s1[j]; }
#pragma unroll
            for (int j = 0; j < 8; ++j) { x1[j] = bf2f((unsigned short)a[j]); x2[j] = bf2f((unsigned short)b[j]); }
#pragma unroll
            for (int j = 0; j < 4; ++j) { ra[j] = cvt_pk_bf16(x1[2 * j] * cs[2 * j] - x2[2 * j] * sn[2 * j], x1[2 * j + 1] * cs[2 * j + 1] - x2[2 * j + 1] * sn[2 * j + 1]);
                                          rb[j] = cvt_pk_bf16(x2[2 * j] * cs[2 * j] + x1[2 * j] * sn[2 * j], x2[2 * j + 1] * cs[2 * j + 1] + x1[2 * j + 1] * sn[2 * j + 1]); }
            qr[8 + dd] = *reinterpret_cast<bf16x8*>(&ra); qr[10 + dd] = *reinterpret_cast<bf16x8*>(&rb);
        }
    } else { pq = (float)p.pos[qlo + r32]; }
    int ka[4];
#pragma unroll
    for (int j = 0; j < 4; ++j) ka[j] = r32 * 128 + (((2 * j + hi) ^ ((r32 >> 1) & 7)) << 4);
    const int vb0 = (int)(uintptr_t)V_lds + v_rd_base(lane);
    float m_reg = -1e30f, l_reg = 0.f; f32x16 o[NCB];
#pragma unroll
    for (int d = 0; d < NCB; ++d) o[d] = f32x16{};
    asm volatile("s_waitcnt vmcnt(0)" ::: "memory");
    ST_WRITE(0);
    __syncthreads();
#define TRRD(dst, off) asm volatile("ds_read_b64_tr_b16 %0, %1 offset:%2" : "=&v"(dst) : "v"(vb0), "i"(off) : "memory")
#define TILE(t, BF) do { \
        const int kb_ = (p.j_lo + (t)) * KVBLK; \
        if ((t) + 1 < NT) { const int kn_ = kb_ + KVBLK; ST_LOAD(kn_, (BF) ^ 1); } \
        const bool act_ = (kb_ <= qlo + QBLK - 1) && (kb_ + KVBLK - 1 >= qlo - W + 1); \
        if (act_) { \
            f32x16 p0 = f32x16{}, p1 = f32x16{}; \
            { bf16x8 kf[2][4];                                                  \
              _Pragma("unroll") for (int s_ = 0; s_ < 2; ++s_) { const char* a_ = K_lds + (BF) * KT + ka[s_]; kf[0][2 * s_] = *(const bf16x8*)a_; kf[0][2 * s_ + 1] = *(const bf16x8*)(a_ + 4096); } \
              _Pragma("unroll") for (int g_ = 0; g_ < ND0 / 2; ++g_) { \
                if (g_ + 1 < ND0 / 2) { _Pragma("unroll") for (int s_ = 0; s_ < 2; ++s_) { const int d0 = 2 * (g_ + 1) + s_; const char* a_ = K_lds + (BF) * KT + (d0 >> 2) * 8192 + ka[d0 & 3]; \
                    kf[(g_ + 1) & 1][2 * s_] = *(const bf16x8*)a_; kf[(g_ + 1) & 1][2 * s_ + 1] = *(const bf16x8*)(a_ + 4096); } } \
                __builtin_amdgcn_sched_barrier(0); \
                _Pragma("unroll") for (int s_ = 0; s_ < 2; ++s_) { const int d0 = 2 * g_ + s_; \
                    p0 = __builtin_amdgcn_mfma_f32_32x32x16_bf16(kf[g_ & 1][2 * s_], qr[d0], p0, 0, 0, 0); p1 = __builtin_amdgcn_mfma_f32_32x32x16_bf16(kf[g_ & 1][2 * s_ + 1], qr[d0], p1, 0, 0, 0); } \
                __builtin_amdgcn_sched_barrier(0); } } \
            if (KIND == 1) { const float* kq = kp_lds + (BF) * 64 + 4 * hi; \
                _Pragma("unroll") for (int g_ = 0; g_ < 4; ++g_) { const f32x4 k0 = *(const f32x4*)(kq + 8 * g_), k1 = *(const f32x4*)(kq + 32 + 8 * g_); \
                    _Pragma("unroll") for (int c_ = 0; c_ < 4; ++c_) { p0[4 * g_ + c_] = fmaf(-p.slope_over_scale, fabsf(pq - k0[c_]), p0[4 * g_ + c_]); p1[4 * g_ + c_] = fmaf(-p.slope_over_scale, fabsf(pq - k1[c_]), p1[4 * g_ + c_]); } } } \
            if (kb_ + KVBLK - 1 > qlo || kb_ <= qlo + QBLK - 1 - W) { const int dq_ = qm - kb_; const float NEG = -__builtin_inff(); \
                _Pragma("unroll") for (int r = 0; r < 16; ++r) { const int c_ = (r & 3) + 8 * (r >> 2); \
                    if ((unsigned)(dq_ - c_) >= (unsigned)W) p0[r] = NEG; if ((unsigned)(dq_ - c_ - 32) >= (unsigned)W) p1[r] = NEG; } } \
            float pmax = p0[0]; \
            _Pragma("unroll") for (int r = 1; r < 16; ++r) pmax = fmaxf(pmax, p0[r]); \
            _Pragma("unroll") for (int r = 0; r < 16; ++r) pmax = fmaxf(pmax, p1[r]); \
            { auto rr = __builtin_amdgcn_permlane32_swap(__float_as_uint(pmax), __float_as_uint(pmax), false, false); pmax = fmaxf(__uint_as_float(rr[0]), __uint_as_float(rr[1])); } \
            float mn, alpha; \
            if (__all((pmax - m_reg) * SCALE <= THR)) { mn = m_reg; alpha = 1.f; } \
            else { mn = fmaxf(m_reg, pmax); alpha = __builtin_amdgcn_exp2f((m_reg - mn) * C2); m_reg = mn; } \
            const float mnL = -mn * C2; float ps = 0.f; \
            _Pragma("unroll") for (int r = 0; r < 16; ++r) { p0[r] = __builtin_amdgcn_exp2f(fmaf(p0[r], C2, mnL)); p1[r] = __builtin_amdgcn_exp2f(fmaf(p1[r], C2, mnL)); } \
            _Pragma("unroll") for (int r = 0; r < 16; ++r) ps += p0[r] + p1[r]; \
            { auto rr = __builtin_amdgcn_permlane32_swap(__float_as_uint(ps), __float_as_uint(ps), false, false); ps = __uint_as_float(rr[0]) + __uint_as_float(rr[1]); } \
            l_reg = l_reg * alpha + ps; \
            bf16x8 pa[4]; \
            _Pragma("unroll") for (int q_ = 0; q_ < 4; ++q_) { const f32x16& P = (q_ < 2) ? p0 : p1; const int B_ = (q_ & 1) * 8; \
                const unsigned a0 = cvt_pk_bf16(P[B_ + 0], P[B_ + 1]), a1 = cvt_pk_bf16(P[B_ + 2], P[B_ + 3]), b0 = cvt_pk_bf16(P[B_ + 4], P[B_ + 5]), b1 = cvt_pk_bf16(P[B_ + 6], P[B_ + 7]); \
                auto r0 = __builtin_amdgcn_permlane32_swap(a0, b0, false, false); auto r1 = __builtin_amdgcn_permlane32_swap(a1, b1, false, false); \
                u32x4 w_ = {r0[0], r1[0], r0[1], r1[1]}; pa[q_] = *reinterpret_cast<bf16x8*>(&w_); } \
            if (__any(alpha < 1.f)) { if (hi == 0) al_l[r32] = alpha; asm volatile("s_waitcnt lgkmcnt(0)" ::: "memory"); \
                _Pragma("unroll") for (int r = 0; r < 16; ++r) { const float a_ = al_l[crow(r, hi)]; _Pragma("unroll") for (int d_ = 0; d_ < NCB; ++d_) o[d_][r] *= a_; } } \
            { s16x4 l_[2][2], h_[2][2]; constexpr int b_ = (BF) * VT;            \
              _Pragma("unroll") for (int k2 = 0; k2 < 2; ++k2) { TRRD(l_[0][k2], b_ + k2 * (1024 * NCB)); TRRD(h_[0][k2], b_ + k2 * (1024 * NCB) + 512 * NCB); } \
              _Pragma("unroll") for (int i_ = 0; i_ < 2 * NCB; ++i_) { \
                if (i_ + 1 < 2 * NCB) { \
                    _Pragma("unroll") for (int k2 = 0; k2 < 2; ++k2) { TRRD(l_[(i_ + 1) & 1][k2], b_ + ((i_ + 1) >> 1) * 512 + (2 * ((i_ + 1) & 1) + k2) * (1024 * NCB)); TRRD(h_[(i_ + 1) & 1][k2], b_ + ((i_ + 1) >> 1) * 512 + (2 * ((i_ + 1) & 1) + k2) * (1024 * NCB) + 512 * NCB); } \
                    asm volatile("s_waitcnt lgkmcnt(4)" ::: "memory"); } \
                else asm volatile("s_waitcnt lgkmcnt(0)" ::: "memory"); \
                __builtin_amdgcn_sched_barrier(0); \
                _Pragma("unroll") for (int k2 = 0; k2 < 2; ++k2) \
                    o[i_ >> 1] = __builtin_amdgcn_mfma_f32_32x32x16_bf16(pa[2 * (i_ & 1) + k2], (bf16x8){l_[i_ & 1][k2][0], l_[i_ & 1][k2][1], l_[i_ & 1][k2][2], l_[i_ & 1][k2][3], h_[i_ & 1][k2][0], h_[i_ & 1][k2][1], h_[i_ & 1][k2][2], h_[i_ & 1][k2][3]}, o[i_ >> 1], 0, 0, 0); \
                __builtin_amdgcn_sched_barrier(0); } } \
        } \
        if ((t) + 1 < NT) { asm volatile("s_waitcnt vmcnt(0)" ::: "memory"); ST_WRITE((BF) ^ 1); } \
        __syncthreads(); } while (0)
    for (int t = 0; t < NT; t += 2) {
        TILE(t, 0);
        if (t + 1 < NT) TILE(t + 1, 1);
    }
    if (KIND == 1) l_reg += __builtin_amdgcn_exp2f(p.sink_l2 - m_reg * C2);
    if (hi == 0) li_l[r32] = l_reg;
    asm volatile("s_waitcnt lgkmcnt(0)" ::: "memory");
    bf16* Ow = p.O + (size_t)(wid * QBLK) * p.ldo;
#pragma unroll
    for (int r = 0; r < 16; ++r) { const int orow = crow(r, hi); const float rl = __builtin_amdgcn_rcpf(li_l[orow]);
#pragma unroll
        for (int d0 = 0; d0 < NCB; ++d0) { const float v = o[d0][r] * rl; const float vn = __shfl_xor(v, 1);
            if ((r32 & 1) == 0) *(unsigned*)(Ow + (size_t)orow * p.ldo + d0 * 32 + r32) = cvt_pk_bf16(v, vn); } }
    __syncthreads();
#undef TILE
#undef TRRD
#undef ST_LOAD
#undef ST_WRITE
}
constexpr int LDS_MLA = 2 * (64 * 128 * 2) + 2 * (3 * 8192) + 512 + 8 * 256;
constexpr int LDS_SWA = 2 * (64 * 64 * 2) + 2 * 8192 + 512 + 8 * 256;
}
constexpr int NWAVES = 8, NTHREADS = NWAVES * 64;
constexpr int D = 1024, NB = 8, SEQ = 8192, T = NB * SEQ;
constexpr int FF = 2816, NE = 8, FE = 3584;
constexpr int QL = 384, KVL = 256, MH = 8, DQKM = 192, DVM = 128;
constexpr int MDN = 704, MDNP = 768;
constexpr int SQKV = 1280;
constexpr int MAXPAN = 520, MAXSLOT = MAXPAN * 256;
constexpr float EPS = 1e-6f;
constexpr float ACT_SCALE8 = 8.f, HID_SCALE8 = 8.f, W_SCALE8 = 256.f, YC_SCALE8 = 4.f;
constexpr size_t MiB = 1u << 20;
constexpr size_t WS_CTL = 0, CTL_ZERO_BYTES = 256 * 1024;
constexpr size_t WS_RT = 1 * MiB;
constexpr size_t RT_E = WS_RT, RT_W0 = RT_E + (size_t)T * 4, RT_W1 = RT_W0 + (size_t)T * 4, RT_S0 = RT_W1 + (size_t)T * 4, RT_S1 = RT_S0 + (size_t)T * 4, RT_CNT = RT_S1 + (size_t)T * 4, RT_PB = RT_CNT + 256 * 8 * 4;
constexpr size_t WS_ROPE = 8 * MiB;
constexpr size_t WS_W = 24 * MiB;
constexpr size_t W_CINB = WS_W, W_CINCU = W_CINB + 2 * (size_t)1024 * 1024 * 2, W_COUT = W_CINCU + 2 * (size_t)2048 * 1024 * 2;
constexpr size_t W_MDN = W_COUT + 2 * (size_t)1024 * 1024 * 2, W_MUQ = W_MDN + (size_t)MDNP * 1024 * 2, W_MUKV = W_MUQ + (size_t)1536 * QL * 2, W_MO = W_MUKV + (size_t)2048 * KVL * 2;
constexpr size_t W_SQKV = W_MO + (size_t)1024 * 1024 * 2, W_SO = W_SQKV + (size_t)SQKV * 1024 * 2;
constexpr size_t W_FGU = W_SO + (size_t)1024 * 1024 * 2, W_FD = W_FGU + 2 * (size_t)(2 * FF) * 1024 * 2;
constexpr size_t W_MGU = W_FD + 2 * (size_t)1024 * FF * 2, W_MD = W_MGU + 16 * (size_t)(2 * FE) * 1024 * 2, W_RT = W_MD + 16 * (size_t)1024 * FE * 2;
constexpr size_t W_END = W_RT + 2 * (size_t)8 * 1024 * 4;
constexpr size_t WS_XN = 420 * MiB;
constexpr size_t WS_XG = 548 * MiB;
constexpr size_t WS_BIG = 808 * MiB;
constexpr size_t WS_END = WS_BIG + (size_t)MAXSLOT * FE * 2;
static_assert(W_END <= WS_XN && WS_XN + (size_t)T * D * 2 <= WS_XG && WS_XG + (size_t)MAXSLOT * D * 2 <= WS_BIG, "d_ws map");
constexpr size_t B_CONV_B = 0, B_CONV_V = 128 * MiB, B_CONV_Y = 256 * MiB;
constexpr size_t B_HMID = 0;
constexpr size_t B_MC = 0, B_MO = 0, B_MCQ = 192 * MiB, B_MCKV = 240 * MiB, B_MQ = 272 * MiB, B_MK = 464 * MiB, B_MV = 656 * MiB;
constexpr size_t B_SQKV = 0, B_SO = 160 * MiB;
constexpr int CW_DBG = 8;
constexpr int CW_BAR = 1024;
constexpr int RING_BYTES = 131072, MISC_OFF = RING_BYTES, LDS_BYTES = 147456;

#define RLX_AGENT __ATOMIC_RELAXED, __HIP_MEMORY_SCOPE_AGENT
#define XB_TMO      128
#define XB_XCNT(j)  (256  + 64 * (j))
#define XB_XSUB(j)  (1280 + 64 * (j))
#define XB_XGEN(j)  (2304 + 64 * (j))
#define XB_TOP      3328
#define XB_TOPGEN   3392
#define XCD_BAR_WORDS 3456
#define XB_SPIN_CAP (1u << 18)
__device__ __forceinline__ unsigned xb_ld(unsigned* p)              { return __hip_atomic_load(p, __ATOMIC_RELAXED, __HIP_MEMORY_SCOPE_AGENT); }
__device__ __forceinline__ unsigned xb_add(unsigned* p, unsigned v) { return __hip_atomic_fetch_add(p, v, __ATOMIC_RELAXED, __HIP_MEMORY_SCOPE_AGENT); }
__device__ __forceinline__ unsigned xb_xcc_id() { return (unsigned)__builtin_amdgcn_s_getreg((3 << 11) | 20) & 0xFu; }
#define XB_SPIN(cond, bar) do { unsigned _sp = 0; while (cond) { __builtin_amdgcn_s_sleep(1); \
    if ((++_sp & 255u) == 0u) { if (xb_ld(&(bar)[XB_TMO])) break; if (_sp > XB_SPIN_CAP) { atomicAdd(&(bar)[XB_TMO], 1u); break; } } } } while (0)
struct XcdBarrier { unsigned* bar; unsigned x; volatile LAS unsigned* st; };
__device__ __forceinline__ XcdBarrier xcd_barrier_post(unsigned* bar, volatile LAS unsigned* st) {
    XcdBarrier b; b.bar = bar; b.x = xb_xcc_id(); b.st = st;
    if (threadIdx.x == 0) (void)xb_add(&bar[XB_XCNT(b.x)], 1u);
    return b;
}
__device__ __forceinline__ void xcd_barrier_complete(unsigned* bar, unsigned x, unsigned& nloc, unsigned& nx) {
    const unsigned G = gridDim.x * gridDim.y * gridDim.z;
    unsigned sum, cnt, mine, sp = 0u;
    for (;;) {
        sum = 0u; cnt = 0u; mine = 0u;
#pragma unroll
        for (unsigned j = 0; j < 16; ++j) { const unsigned c = xb_ld(&bar[XB_XCNT(j)]); sum += c; cnt += (c > 0u) ? 1u : 0u; mine = (j == x) ? c : mine; }
        if (sum == G) break;
        __builtin_amdgcn_s_sleep(1);
        if ((++sp & 255u) == 0u) { if (xb_ld(&bar[XB_TMO])) break; if (sp > XB_SPIN_CAP) { atomicAdd(&bar[XB_TMO], 1u); break; } }
    }
    nloc = mine > 0u ? mine : 1u; nx = cnt > 0u ? cnt : 1u;
}
__device__ __forceinline__ void xcd_barrier(const XcdBarrier& b) {
    asm volatile("s_waitcnt vmcnt(0)" ::: "memory");
    __syncthreads();
    if (threadIdx.x == 0) {
        unsigned* bar = b.bar;
        __builtin_amdgcn_s_waitcnt(0);
        unsigned nloc = b.st[0], nx = b.st[1];
        if (nloc == 0u) { xcd_barrier_complete(bar, b.x, nloc, nx); b.st[0] = nloc; b.st[1] = nx; }
        const unsigned old = xb_add(&bar[XB_XSUB(b.x)], 1u);
        const unsigned gen = old / nloc;
        if (old + 1u == (gen + 1u) * nloc) {
            __builtin_amdgcn_fence(__ATOMIC_RELEASE, "agent");
            asm volatile("s_waitcnt vmcnt(0)" ::: "memory");
            const unsigned og = xb_add(&bar[XB_TOP], 1u);
            const unsigned tg = og / nx;
            if (og + 1u == (tg + 1u) * nx) xb_add(&bar[XB_TOPGEN], 1u);
            else XB_SPIN(xb_ld(&bar[XB_TOPGEN]) == tg, bar);
            __builtin_amdgcn_fence(__ATOMIC_ACQUIRE, "agent");
            xb_add(&bar[XB_XGEN(b.x)], 1u);
            asm volatile("s_waitcnt vmcnt(0)" ::: "memory");
        } else {
            XB_SPIN(xb_ld(&bar[XB_XGEN(b.x)]) == gen, bar);
            __builtin_amdgcn_fence(__ATOMIC_ACQUIRE, "agent");
            asm volatile("s_waitcnt vmcnt(0)" ::: "memory");
        }
    }
    __syncthreads();
}

struct TC { int tid, lane, wave; };
__device__ __forceinline__ TC tc_get() { TC t; int x = threadIdx.x; asm volatile("" : "+v"(x)); t.tid = x; t.lane = x & 63; t.wave = __builtin_amdgcn_readfirstlane(x >> 6); return t; }
struct Frame {
    char* lds; int vcu, G;
    unsigned char* ws; float* out;
    const float* const* in;
};
__device__ __forceinline__ float clamp8(float v) { return fminf(fmaxf(v, -448.f), 448.f); }
__device__ __forceinline__ unsigned pk4_fp8(float a, float b, float c, float d, float sc) {
    int t = __builtin_amdgcn_cvt_pk_fp8_f32(clamp8(a * sc), clamp8(b * sc), 0, false); t = __builtin_amdgcn_cvt_pk_fp8_f32(clamp8(c * sc), clamp8(d * sc), t, true); return (unsigned)t; }
#define LDS_WAIT() asm volatile("s_waitcnt lgkmcnt(0)" ::: "memory")
#define VM_WAIT() asm volatile("s_waitcnt vmcnt(0)" ::: "memory")

template <int MAP>
__device__ __forceinline__ void tr_item(const float* W, int K, int N, int ldw, bf16* WT, float* scr, int item, int lane) {
    const int nblk = N / 32, kb = item / nblk, nb = item % nblk, k0 = 64 * kb, n0 = 32 * nb;
    int r0 = n0;
    if (MAP == 1) { const int F = N / 2; r0 = (n0 < F) ? 256 * (n0 / 128) + (n0 % 128) : 256 * ((n0 - F) / 128) + 128 + ((n0 - F) % 128); }
    const float* src = W + (size_t)(k0 + (lane >> 5)) * ldw + n0 + (lane & 31);
#pragma unroll 16
    for (int i = 0; i < 32; ++i) scr[(2 * i + (lane >> 5)) * 33 + (lane & 31)] = src[(size_t)(2 * i) * ldw];
    LDS_WAIT(); asm volatile("" ::: "memory");
    const int c = lane & 7;
#pragma unroll
    for (int j = 0; j < 4; ++j) { const int n = (lane >> 3) + 8 * j; const float* s = scr + (8 * c) * 33 + n;
        u32x4 o; o.x = cvt_pk_bf16(s[0 * 33], s[1 * 33]); o.y = cvt_pk_bf16(s[2 * 33], s[3 * 33]); o.z = cvt_pk_bf16(s[4 * 33], s[5 * 33]); o.w = cvt_pk_bf16(s[6 * 33], s[7 * 33]);
        *(u32x4*)(WT + (size_t)(r0 + n) * K + k0 + 8 * c) = o; }
    LDS_WAIT(); asm volatile("" ::: "memory");
}
template <int MAP>
__device__ __forceinline__ void tr_item8(const float* W, int K, int N, int ldw, unsigned char* WT, float* scr, int item, int lane, float sw) {
    const int nblk = N / 32, kb = item / nblk, nb = item % nblk, k0 = 64 * kb, n0 = 32 * nb;
    int r0 = n0;
    if (MAP == 1) { const int F = N / 2; r0 = (n0 < F) ? 256 * (n0 / 128) + (n0 % 128) : 256 * ((n0 - F) / 128) + 128 + ((n0 - F) % 128); }
    const float* src = W + (size_t)(k0 + (lane >> 5)) * ldw + n0 + (lane & 31);
#pragma unroll 16
    for (int i = 0; i < 32; ++i) scr[(2 * i + (lane >> 5)) * 33 + (lane & 31)] = src[(size_t)(2 * i) * ldw];
    LDS_WAIT(); asm volatile("" ::: "memory");
    const int c = lane & 7;
#pragma unroll
    for (int j = 0; j < 4; ++j) { const int n = (lane >> 3) + 8 * j; const float* s = scr + (8 * c) * 33 + n;
        u32x2 o; int t = __builtin_amdgcn_cvt_pk_fp8_f32(s[0 * 33] * sw, s[1 * 33] * sw, 0, false); t = __builtin_amdgcn_cvt_pk_fp8_f32(s[2 * 33] * sw, s[3 * 33] * sw, t, true); o.x = (unsigned)t;
        t = __builtin_amdgcn_cvt_pk_fp8_f32(s[4 * 33] * sw, s[5 * 33] * sw, 0, false); t = __builtin_amdgcn_cvt_pk_fp8_f32(s[6 * 33] * sw, s[7 * 33] * sw, t, true); o.y = (unsigned)t;
        *(u32x2*)(WT + (size_t)(r0 + n) * K + k0 + 8 * c) = o; }
    LDS_WAIT(); asm volatile("" ::: "memory");
}
template <int MAP>
__device__ __forceinline__ void tr_matrix8(Frame& F, const float* W, int K, int N, int ldw, unsigned char* WT, int rot, float sw) {
    const TC tc = tc_get();
    float* scr = (float*)(F.lds + tc.wave * 8448);
    const int NGW = F.G * NWAVES, gw = (F.vcu * NWAVES + tc.wave + rot) % NGW, nitems = (K / 64) * (N / 32);
    for (int it = gw; it < nitems; it += NGW) tr_item8<MAP>(W, K, N, ldw, WT, scr, it, tc.lane, sw);
}
template <int MAP>
__device__ __forceinline__ void tr_matrix(Frame& F, const float* W, int K, int N, int ldw, bf16* WT, int rot) {
    const TC tc = tc_get();
    float* scr = (float*)(F.lds + tc.wave * 8448);
    const int NGW = F.G * NWAVES, gw = (F.vcu * NWAVES + tc.wave + rot) % NGW, nitems = (K / 64) * (N / 32);
    for (int it = gw; it < nitems; it += NGW) tr_item<MAP>(W, K, N, ldw, WT, scr, it, tc.lane);
}

struct RowArgs { const float* Xsrc; float* Xdst; const float* g; bf16* XN; float* outF; const bf16* Y; const int* s0; const int* s1; const float* w0; const float* w1;
                 const float* routerT; unsigned* rt_e; float* rt_w0; float* rt_w1; unsigned* cnt; };
template <int MODE, bool COMBINE, bool OUT8 = false>
__device__ __forceinline__ void row_pass(Frame& F, const RowArgs& a) {
    const TC tc = tc_get();
    const int lane = tc.lane;
    float* rtab = (float*)F.lds;
    unsigned* wcnt = (unsigned*)(F.lds + 32768);
    if (MODE == 1) { for (int i = tc.tid; i < 8 * 1024; i += NTHREADS) rtab[i] = a.routerT[i]; }
    f32x4 gv[4];
#pragma unroll
    for (int j = 0; j < 4; ++j) gv[j] = *(const f32x4*)(a.g + 4 * lane + 256 * j);
    for (int tb = blockIdx.x; tb < T / 256; tb += F.G) {
        if (MODE == 1) { if (tc.tid < 64) wcnt[tc.tid] = 0u; __syncthreads(); }
        unsigned myc[8] = {0u, 0u, 0u, 0u, 0u, 0u, 0u, 0u};
        for (int rr = 0; rr < 32; ++rr) {
            const int row = tb * 256 + tc.wave * 32 + rr;
            const f32x4* xr = (const f32x4*)(a.Xsrc + (size_t)row * D) + lane;
            f32x4 v[4];
#pragma unroll
            for (int j = 0; j < 4; ++j) v[j] = xr[64 * j];
            if (COMBINE) {
                const int sa = a.s0[row], sb = a.s1[row]; const float wa = a.w0[row], wb = a.w1[row];
                const u32x2* ya = (const u32x2*)(a.Y + (size_t)sa * D) + lane; const u32x2* yb = (const u32x2*)(a.Y + (size_t)sb * D) + lane;
#pragma unroll
                for (int j = 0; j < 4; ++j) { const u32x2 pa = ya[64 * j], pb = yb[64 * j];
                    v[j].x += wa * bflo(pa.x) + wb * bflo(pb.x); v[j].y += wa * bfhi(pa.x) + wb * bfhi(pb.x);
                    v[j].z += wa * bflo(pa.y) + wb * bflo(pb.y); v[j].w += wa * bfhi(pa.y) + wb * bfhi(pb.y); }
                if (MODE != 2) { f32x4* xd = (f32x4*)(a.Xdst + (size_t)row * D) + lane;
#pragma unroll
                    for (int j = 0; j < 4; ++j) xd[64 * j] = v[j]; }
            }
            float ss = 0.f;
#pragma unroll
            for (int j = 0; j < 4; ++j) ss += (v[j].x * v[j].x + v[j].y * v[j].y) + (v[j].z * v[j].z + v[j].w * v[j].w);
            const float rstd = 1.0f / sqrtf(wave_sum(ss) * (1.f / D) + EPS);
#pragma unroll
            for (int j = 0; j < 4; ++j) v[j] = v[j] * rstd * gv[j];
            if (MODE == 2) { f32x4* od = (f32x4*)(a.outF + (size_t)row * D) + lane;
#pragma unroll
                for (int j = 0; j < 4; ++j) od[64 * j] = v[j];
            } else if (OUT8) { unsigned* o4 = (unsigned*)((unsigned char*)a.XN + (size_t)row * D) + lane;
#pragma unroll
                for (int j = 0; j < 4; ++j) o4[64 * j] = pk4_fp8(v[j].x, v[j].y, v[j].z, v[j].w, ACT_SCALE8);
            } else { u32x2* o8 = (u32x2*)(a.XN + (size_t)row * D) + lane;
#pragma unroll
                for (int j = 0; j < 4; ++j) { u32x2 w; w.x = cvt_pk_bf16(v[j].x, v[j].y); w.y = cvt_pk_bf16(v[j].z, v[j].w); o8[64 * j] = w; } }
            if (MODE == 1) {
                float lg[8];
#pragma unroll
                for (int e = 0; e < 8; ++e) { float s = 0.f;
#pragma unroll
                    for (int j = 0; j < 4; ++j) { const f32x4 r = *(const f32x4*)(rtab + e * 1024 + 256 * j + 4 * lane); s += (v[j].x * r.x + v[j].y * r.y) + (v[j].z * r.z + v[j].w * r.w); }
                    lg[e] = wave_sum(s); }
                int e0 = 0; float v0 = lg[0];
#pragma unroll
                for (int e = 1; e < 8; ++e) if (lg[e] > v0) { v0 = lg[e]; e0 = e; }
                int e1 = -1; float v1 = -3.0e38f;
#pragma unroll
                for (int e = 0; e < 8; ++e) if (e != e0 && lg[e] > v1) { v1 = lg[e]; e1 = e; }
                const float w0 = 1.0f / (1.0f + __expf(v1 - v0)), w1 = 1.0f - w0;
                if (lane == 0) { a.rt_e[row] = (unsigned)e0 | ((unsigned)e1 << 8); a.rt_w0[row] = w0; a.rt_w1[row] = w1; }
#pragma unroll
                for (int e = 0; e < 8; ++e) myc[e] += (e == e0 || e == e1) ? 1u : 0u;
            }
        }
        if (MODE == 1) {
            if (lane < 8) { unsigned c = 0;
#pragma unroll
                for (int e = 0; e < 8; ++e) c = (lane == e) ? myc[e] : c;
                wcnt[tc.wave * 8 + lane] = c; }
            __syncthreads();
            if (tc.tid < 8) { unsigned c = 0; for (int w = 0; w < 8; ++w) c += wcnt[w * 8 + tc.tid]; a.cnt[tb * 8 + tc.tid] = c; }
            __syncthreads();
        }
    }
}

template <bool F8>
__device__ __forceinline__ void moe_assign(Frame& F, const unsigned* cnt, const unsigned* rt_e, int* s0, int* s1, unsigned* pbase_out, const bf16* XN, bf16* XG) {
    const TC tc = tc_get();
    unsigned* tot = (unsigned*)F.lds;
    unsigned* pre = tot + 64;
    unsigned long long* msk = (unsigned long long*)(F.lds + 1024);
    int* slt = (int*)(F.lds + 2048);
    if (tc.tid < 8) tot[tc.tid] = 0u;
    __syncthreads();
    { unsigned part[8] = {0, 0, 0, 0, 0, 0, 0, 0};
      if (tc.tid < 256) {
#pragma unroll
          for (int e = 0; e < 8; ++e) part[e] = __hip_atomic_load(cnt + tc.tid * 8 + e, RLX_AGENT); }
#pragma unroll
      for (int e = 0; e < 8; ++e) { unsigned s = part[e];
#pragma unroll
          for (int o = 1; o < 64; o <<= 1) s += __shfl_xor(s, o);
          if (tc.lane == 0 && tc.wave < 4) atomicAdd(&tot[e], s); } }
    __syncthreads();
    if (tc.tid == 0) { unsigned p = 0; for (int e = 0; e < 8; ++e) { tot[8 + e] = p; p += (tot[e] + 255u) / 256u; } tot[16] = p;
        if (blockIdx.x == 0) for (int e = 0; e < 9; ++e) __hip_atomic_store(pbase_out + e, tot[8 + e], RLX_AGENT); }
    __syncthreads();
    for (int tb = blockIdx.x; tb < T / 256; tb += F.G) {
        if (tc.tid < 8) { unsigned s = 0; for (int b = 0; b < tb; ++b) s += __hip_atomic_load(cnt + b * 8 + tc.tid, RLX_AGENT); pre[tc.tid] = s; }
        int e0 = 0, e1 = 0;
        if (tc.tid < 256) { const unsigned pe = rt_e[tb * 256 + tc.tid]; e0 = pe & 0xff; e1 = (pe >> 8) & 0xff;
#pragma unroll
            for (int e = 0; e < 8; ++e) { const unsigned long long m = __ballot(e0 == e || e1 == e); if (tc.lane == 0) msk[e * 4 + tc.wave] = m; } }
        __syncthreads();
        if (tc.tid < 256) {
            int sl[2];
#pragma unroll
            for (int k = 0; k < 2; ++k) { const int e = k ? e1 : e0; unsigned rank = 0;
                for (int w = 0; w < tc.wave; ++w) rank += __popcll(msk[e * 4 + w]);
                rank += __popcll(msk[e * 4 + tc.wave] & ((1ull << tc.lane) - 1ull));
                sl[k] = (int)(tot[8 + e] * 256u + pre[e] + rank); }
            s0[tb * 256 + tc.tid] = sl[0]; s1[tb * 256 + tc.tid] = sl[1]; slt[2 * tc.tid] = sl[0]; slt[2 * tc.tid + 1] = sl[1];
        }
        __syncthreads();
        for (int rr = 0; rr < 32; ++rr) { const int i = tc.wave * 32 + rr; const int row = tb * 256 + i; const int sa = slt[2 * i], sb = slt[2 * i + 1];
            if (F8) {
                const u32x4 o = ((const u32x4*)((const unsigned char*)XN + (size_t)row * D))[tc.lane];
                ((u32x4*)((unsigned char*)XG + (size_t)sa * D))[tc.lane] = o; ((u32x4*)((unsigned char*)XG + (size_t)sb * D))[tc.lane] = o;
            } else {
            const u32x4* src = (const u32x4*)(XN + (size_t)row * D) + tc.lane; const u32x4 a = src[0], b = src[64];
            u32x4* d0 = (u32x4*)(XG + (size_t)sa * D) + tc.lane; u32x4* d1 = (u32x4*)(XG + (size_t)sb * D) + tc.lane;
            d0[0] = a; d0[64] = b; d1[0] = a; d1[64] = b; } }
        __syncthreads();
    }
}

template <bool OUT8>
__device__ __forceinline__ void conv_pass(Frame& F, const bf16* Bc, const bf16* Vc, const float* wconv, bf16* Yc) {
    const TC tc = tc_get();
    const int sub = tc.tid >> 7, ch = (tc.tid & 127) * 8;
    float w[3][8];
#pragma unroll
    for (int j = 0; j < 3; ++j) { const f32x4 a = *(const f32x4*)(wconv + j * D + ch), b = *(const f32x4*)(wconv + j * D + ch + 4);
#pragma unroll
        for (int c = 0; c < 4; ++c) { w[j][c] = a[c]; w[j][4 + c] = b[c]; } }
    for (int run = blockIdx.x * 4 + sub; run < T / 32; run += F.G * 4) {
        const int t0 = run * 32, s0 = t0 & (SEQ - 1);
        float p2[8], p1[8];
        { u32x4 a = {0, 0, 0, 0}, b = {0, 0, 0, 0};
          if (s0 >= 2) { a = *(const u32x4*)(Vc + (size_t)(t0 - 2) * D + ch); b = *(const u32x4*)(Vc + (size_t)(t0 - 1) * D + ch); }
#pragma unroll
          for (int c = 0; c < 4; ++c) { p2[2 * c] = bflo(a[c]); p2[2 * c + 1] = bfhi(a[c]); p1[2 * c] = bflo(b[c]); p1[2 * c + 1] = bfhi(b[c]); } }
#pragma unroll 4
        for (int i = 0; i < 32; ++i) { const size_t o = (size_t)(t0 + i) * D + ch;
            const u32x4 vv = *(const u32x4*)(Vc + o), bb = *(const u32x4*)(Bc + o); float cur[8], y[8];
#pragma unroll
            for (int c = 0; c < 4; ++c) { cur[2 * c] = bflo(vv[c]); cur[2 * c + 1] = bfhi(vv[c]); }
#pragma unroll
            for (int c = 0; c < 8; ++c) { const float bq = (c & 1) ? bfhi(bb[c >> 1]) : bflo(bb[c >> 1]); y[c] = bq * (w[0][c] * p2[c] + w[1][c] * p1[c] + w[2][c] * cur[c]); p2[c] = p1[c]; p1[c] = cur[c]; }
            if (OUT8) { u32x2 r; r.x = pk4_fp8(y[0], y[1], y[2], y[3], YC_SCALE8); r.y = pk4_fp8(y[4], y[5], y[6], y[7], YC_SCALE8); *(u32x2*)((unsigned char*)Yc + o) = r; }
            else { u32x4 r; r.x = cvt_pk_bf16(y[0], y[1]); r.y = cvt_pk_bf16(y[2], y[3]); r.z = cvt_pk_bf16(y[4], y[5]); r.w = cvt_pk_bf16(y[6], y[7]);
            *(u32x4*)(Yc + o) = r; } }
    }
}

__device__ __forceinline__ void rope_table(Frame& F, const int* pos, float* tab) {
    const TC tc = tc_get();
    const int i = tc.lane & 31; const float inv = __builtin_amdgcn_exp2f(-(float)i * (13.287712379549449f / 32.0f));
    const int NGW = F.G * NWAVES, gw = F.vcu * NWAVES + tc.wave;
    for (int t = gw * 2 + (tc.lane >> 5); t < T; t += NGW * 2) {
        const float ang = (float)pos[t] * inv;
        const float k = rintf(ang * 0.15915494309189535f);
        float r = fmaf(-k, 6.28125f, ang); r = fmaf(-k, 1.9353071795864769e-3f, r);
        tab[(size_t)t * 64 + i] = __cosf(r); tab[(size_t)t * 64 + 32 + i] = __sinf(r);
    }
}

__device__ __forceinline__ void mla_mid(Frame& F, const float* C, const float* gq, const float* gkv, const float* tab, bf16* cqn, bf16* ckvn, bf16* Kf) {
    const TC tc = tc_get();
    const int lane = tc.lane, NGW = F.G * NWAVES, gw = F.vcu * NWAVES + tc.wave;
    f32x2 gqv[3];
#pragma unroll
    for (int j = 0; j < 3; ++j) gqv[j] = *(const f32x2*)(gq + 2 * lane + 128 * j);
    const f32x4 gk = *(const f32x4*)(gkv + 4 * lane);
    for (int t = gw; t < T; t += NGW) {
        const float* c = C + (size_t)t * MDNP;
        f32x2 q[3]; float ss = 0.f;
#pragma unroll
        for (int j = 0; j < 3; ++j) { q[j] = *(const f32x2*)(c + 2 * lane + 128 * j); ss += q[j].x * q[j].x + q[j].y * q[j].y; }
        const f32x4 kv = *(const f32x4*)(c + QL + 4 * lane);
        const float x = c[QL + KVL + lane];
        const float rq = 1.0f / sqrtf(wave_sum(ss) * (1.f / QL) + EPS);
        const float rk = 1.0f / sqrtf(wave_sum((kv.x * kv.x + kv.y * kv.y) + (kv.z * kv.z + kv.w * kv.w)) * (1.f / KVL) + EPS);
#pragma unroll
        for (int j = 0; j < 3; ++j) *(unsigned*)(cqn + (size_t)t * QL + 2 * lane + 128 * j) = cvt_pk_bf16(q[j].x * rq * gqv[j].x, q[j].y * rq * gqv[j].y);
        { u32x2 w; w.x = cvt_pk_bf16(kv.x * rk * gk.x, kv.y * rk * gk.y); w.y = cvt_pk_bf16(kv.z * rk * gk.z, kv.w * rk * gk.w); *(u32x2*)(ckvn + (size_t)t * KVL + 4 * lane) = w; }
        const float other = __shfl_xor(x, 32); const int i = lane & 31;
        const float cs = tab[(size_t)t * 64 + i], sn = tab[(size_t)t * 64 + 32 + i];
        const float r = (lane < 32) ? (x * cs - other * sn) : (x * cs + other * sn);
        const float rn = __shfl_xor(r, 1);
        if ((lane & 1) == 0) { const unsigned pk = cvt_pk_bf16(r, rn); const int b = t >> 13, s = t & (SEQ - 1);
#pragma unroll
            for (int h = 0; h < MH; ++h) *(unsigned*)(Kf + ((size_t)(b * MH + h) * SEQ + s) * DQKM + 128 + lane) = pk; }
    }
}
#ifndef F8_FFN
#define F8_FFN 0
#endif
#ifndef F8_CONV
#define F8_CONV 0
#endif
#ifndef F8_PROJ
#define F8_PROJ 0
#endif
template <bool F8 = false, class Epi>
__device__ __forceinline__ void gemm_static(Frame& F, const void* A, int lda, int K, const void* Bt, int N, const Epi& E) {
    pg8::Gemm g{(const bf16*)A, (const bf16*)Bt, F8 ? lda / 2 : lda, F8 ? K / 2 : K, 0}; pg8::StaticOrder S; S.init(T, N, F.G, (int)blockIdx.x);
    pg8::gemm_phase<Epi, pg8::StaticOrder, F8>((LAS unsigned char*)F.lds, g, S, E);
}
template <bool F8, class Epi>
__device__ __forceinline__ void gemm_grouped(Frame& F, const void* A, int lda, int K, const void* Bt, size_t estride, int N, const unsigned* pbase, const Epi& E) {
    pg8::Gemm g{(const bf16*)A, (const bf16*)Bt, lda, K, estride}; pg8::GroupedOrder S; S.init(pbase, N, F.G, (int)blockIdx.x, (LAS unsigned*)((LAS unsigned char*)F.lds + MISC_OFF + 512), 128);
    pg8::gemm_phase<Epi, pg8::GroupedOrder, F8>((LAS unsigned char*)F.lds, g, S, E);
}
#ifndef MOE_F8_A
#define MOE_F8_A 1
#endif
#ifndef MOE_F8_B
#define MOE_F8_B 1
#endif
template <bool F8>
__device__ __forceinline__ void moe_gemm1(Frame& F, int l, const unsigned* pb) {
    unsigned char* ws = F.ws; unsigned char* big = ws + WS_BIG;
    if (F8) gemm_grouped<true>(F, ws + WS_XG, D / 2, D / 2, ws + W_MGU + (size_t)l * 8 * 2 * FE * 1024 * 2, (size_t)2 * FE * 1024, 2 * FE, pb, pg8::EpiPair8{big, FE, 1.0f / (ACT_SCALE8 * W_SCALE8), HID_SCALE8});
    else gemm_grouped<false>(F, ws + WS_XG, D, D, ws + W_MGU + (size_t)l * 8 * 2 * FE * 1024 * 2, (size_t)2 * FE * 1024 * 2, 2 * FE, pb, pg8::EpiPair<1>{(bf16*)big, FE, 1.0f});
}
template <bool F8>
__device__ __forceinline__ void moe_gemm2(Frame& F, int l, const unsigned* pb) {
    unsigned char* ws = F.ws; unsigned char* big = ws + WS_BIG;
    if (F8) gemm_grouped<true>(F, big, FE / 2, FE / 2, ws + W_MD + (size_t)l * 8 * 1024 * FE * 2, (size_t)1024 * FE, 1024, pb, pg8::EpiBf16{(bf16*)(ws + WS_XG), D, nullptr, 1.0f / (HID_SCALE8 * W_SCALE8)});
    else gemm_grouped<false>(F, big, FE, FE, ws + W_MD + (size_t)l * 8 * 1024 * FE * 2, (size_t)1024 * FE * 2, 1024, pb, pg8::EpiBf16{(bf16*)(ws + WS_XG), D, nullptr, 1.0f});
}
__device__ __forceinline__ void prologue(Frame& F) {
    const float* const* in = F.in; unsigned char* ws = F.ws;
    int rot = 0;
#define TRM(MAP, W, K, N, ldw, dst) do { tr_matrix<MAP>(F, (W), (K), (N), (ldw), (bf16*)(ws + (dst)), rot); rot += 37; } while (0)
#define TRM8(MAP, W, K, N, ldw, dst) do { tr_matrix8<MAP>(F, (W), (K), (N), (ldw), ws + (dst), rot, W_SCALE8); rot += 37; } while (0)
#define TRX(F8_, MAP, W, K, N, ldw, dst) do { if (F8_) TRM8(MAP, W, K, N, ldw, dst); else TRM(MAP, W, K, N, ldw, dst); } while (0)
    for (int j = 0; j < 2; ++j) {
        TRX(F8_CONV, 0, in[5] + (size_t)j * 1024 * 3072, 1024, 1024, 3072, W_CINB + (size_t)j * 1024 * 1024 * 2);
        TRX(F8_CONV, 1, in[5] + (size_t)j * 1024 * 3072 + 1024, 1024, 2048, 3072, W_CINCU + (size_t)j * 2048 * 1024 * 2);
        TRX(F8_CONV, 0, in[7] + (size_t)j * 1024 * 1024, 1024, 1024, 1024, W_COUT + (size_t)j * 1024 * 1024 * 2);
        TRX(F8_FFN, 1, in[19] + (size_t)j * 1024 * 2 * FF, 1024, 2 * FF, 2 * FF, W_FGU + (size_t)j * 2 * FF * 1024 * 2);
        TRX(F8_FFN, 0, in[20] + (size_t)j * FF * 1024, FF, 1024, 1024, W_FD + (size_t)j * 1024 * FF * 2);
    }
    TRX(F8_PROJ, 0, in[8], 1024, MDN, MDN, W_MDN);
    TRM(0, in[10], QL, 1536, 1536, W_MUQ);
    TRM(0, in[12], KVL, 2048, 2048, W_MUKV);
    TRM(0, in[13], 1024, 1024, 1024, W_MO);
    TRX(F8_PROJ, 0, in[14], 1024, SQKV, SQKV, W_SQKV);
    TRM(0, in[17], 1024, 1024, 1024, W_SO);
    for (int le = 0; le < 16; ++le) {
        const bool f8 = (le < 8) ? (MOE_F8_A != 0) : (MOE_F8_B != 0);
        const size_t l = le >> 3, e = le & 7;
        if (f8) { tr_matrix8<1>(F, in[22] + (size_t)le * 1024 * 2 * FE, 1024, 2 * FE, 2 * FE, ws + W_MGU + l * 8 * 2 * FE * 1024 * 2 + e * 2 * FE * 1024, rot, W_SCALE8); rot += 37;
                  tr_matrix8<0>(F, in[23] + (size_t)le * FE * 1024, FE, 1024, 1024, ws + W_MD + l * 8 * 1024 * FE * 2 + e * 1024 * FE, rot, W_SCALE8); rot += 37; }
        else { TRM(1, in[22] + (size_t)le * 1024 * 2 * FE, 1024, 2 * FE, 2 * FE, W_MGU + (size_t)le * 2 * FE * 1024 * 2);
               TRM(0, in[23] + (size_t)le * FE * 1024, FE, 1024, 1024, W_MD + (size_t)le * 1024 * FE * 2); }
    }
#undef TRM
#undef TRM8
#undef TRX
    const TC tc = tc_get();
    const int gt = F.vcu * NTHREADS + tc.tid, NGT = F.G * NTHREADS;
    if (F8_PROJ) { for (int i = gt; i < (MDNP - MDN) * 1024 / 4; i += NGT) ((unsigned*)(ws + W_MDN + (size_t)MDN * 1024))[i] = 0u; }
    else { for (int i = gt; i < (MDNP - MDN) * 1024 / 2; i += NGT) ((unsigned*)(ws + W_MDN + (size_t)MDN * 1024 * 2))[i] = 0u; }
    for (int i = gt; i < 2 * 8 * 1024; i += NGT) { const int l = i >> 13, e = (i >> 10) & 7, k = i & 1023; ((float*)(ws + W_RT))[i] = in[21][(size_t)l * 1024 * 8 + k * 8 + e]; }
    rope_table(F, (const int*)in[1], (float*)(ws + WS_ROPE));
}

__device__ __forceinline__ void mla_attention(Frame& F) {
    unsigned char* big = F.ws + WS_BIG;
    const bf16* Q = (const bf16*)(big + B_MQ); const bf16* Kf = (const bf16*)(big + B_MK); const bf16* V = (const bf16*)(big + B_MV); bf16* O = (bf16*)(big + B_MO);
    const float* tab = (const float*)(F.ws + WS_ROPE);
    for (int L = blockIdx.x; L < NB * MH * 16; L += F.G) {
        const int xcd = L & 7, kk = L >> 3, bh = xcd * 8 + (kk >> 4), x = kk & 15, b = bh >> 3, h = bh & 7;
        for (int pass = 0; pass < 2; ++pass) {
            const int qb = pass ? 31 - x : x; const size_t row0 = (size_t)b * SEQ + qb * 256;
            att::Params p;
            p.Q = Q + row0 * 1536 + h * DQKM; p.ldq = 1536;
            p.K = Kf + (size_t)bh * SEQ * DQKM; p.ldk = DQKM; p.V = V + (size_t)bh * SEQ * DVM; p.ldv = DVM;
            p.O = O + row0 * 1024 + h * DVM; p.ldo = 1024; p.P0 = qb * 256; p.j_lo = 0; p.j_hi = 4 * (qb + 1);
            p.rope = tab + row0 * 64; p.pos = nullptr; p.slope_over_scale = 0.f; p.sink_l2 = 0.f;
            att::attn_block<192, 128, 0, (1 << 30)>(p, F.lds);
        }
    }
}
__device__ __forceinline__ void swa_attention(Frame& F) {
    unsigned char* big = F.ws + WS_BIG;
    const bf16* QKV = (const bf16*)(big + B_SQKV); bf16* O = (bf16*)(big + B_SO);
    const int* pos = (const int*)F.in[1]; const float* sinks = F.in[16];
    for (int L = blockIdx.x; L < NB * 16 * 32; L += F.G) {
        const int xcd = L & 7, kk = L >> 3, pair = xcd * 2 + (kk >> 8), u = kk & 255, qb = u >> 3, g = u & 7, b = pair >> 1, kvh = pair & 1, qh = kvh * 8 + g;
        const size_t row0 = (size_t)b * SEQ + qb * 256;
        att::Params p;
        p.Q = QKV + row0 * SQKV + qh * 64; p.ldq = SQKV;
        p.K = QKV + (size_t)b * SEQ * SQKV + 1024 + kvh * 64; p.ldk = SQKV; p.V = QKV + (size_t)b * SEQ * SQKV + 1152 + kvh * 64; p.ldv = SQKV;
        p.O = O + row0 * 1024 + qh * 64; p.ldo = 1024; p.P0 = qb * 256; p.j_lo = qb ? 4 * qb - 2 : 0; p.j_hi = 4 * qb + 4;
        p.rope = nullptr; p.pos = pos + (size_t)b * SEQ;
        p.slope_over_scale = __builtin_amdgcn_exp2f(-0.5f * (float)(qh + 1)) * 8.0f;
        p.sink_l2 = sinks[qh] * 1.4426950408889634f;
        att::attn_block<64, 64, 1, 128>(p, F.lds);
    }
}

struct Args { const float* in[24]; float* out; unsigned char* ws; int ph_lo, ph_hi; };
constexpr int N_PHASES = 33;
__global__ void __launch_bounds__(NTHREADS, 2) mega(Args args) {
    extern __shared__ __attribute__((aligned(16))) unsigned char lds_raw[];
    Frame F;
    F.lds = (char*)lds_raw;
    F.G = gridDim.x; { const int bx = blockIdx.x; F.vcu = (F.G % 8 == 0) ? (bx % 8) * (F.G / 8) + bx / 8 : bx; }
    F.ws = args.ws; F.out = args.out; F.in = args.in;
    unsigned char* ws = args.ws; unsigned char* big = ws + WS_BIG;
    unsigned* ctl = (unsigned*)(ws + WS_CTL);
    volatile LAS unsigned* misc = (volatile LAS unsigned*)((LAS unsigned char*)lds_raw + MISC_OFF);
    if (threadIdx.x < 32) misc[threadIdx.x] = 0u;
    __syncthreads();
    const int lo = args.ph_lo, hi = args.ph_hi;
    XcdBarrier bar; bar.bar = ctl + CW_BAR; bar.x = 0; bar.st = nullptr;
    if (hi - lo > 1) bar = xcd_barrier_post(ctl + CW_BAR, misc + 8);
#ifndef PH_SEL
#define PH_SEL -1
#endif
#define IN(k) ((PH_SEL < 0 || PH_SEL == (k)) && lo <= (k) && (k) < hi)
#ifndef PROBE_MASK
#define PROBE_MASK 0ull
#endif
#define REP(k) for (int rep_ = 0; rep_ < (((PROBE_MASK >> (k)) & 1ull) ? 2 : 1); ++rep_)
#define SEAM(k) do { if (IN(k) && IN((k) + 1)) xcd_barrier(bar); } while (0)
    const float* x_in = args.in[0]; float* X = args.out;
    bf16* XN = (bf16*)(ws + WS_XN); bf16* XG = (bf16*)(ws + WS_XG);
    unsigned* rt_e = (unsigned*)(ws + RT_E); float* rt_w0 = (float*)(ws + RT_W0); float* rt_w1 = (float*)(ws + RT_W1); int* rt_s0 = (int*)(ws + RT_S0); int* rt_s1 = (int*)(ws + RT_S1);
    unsigned* rt_cnt = (unsigned*)(ws + RT_CNT); unsigned* rt_pb = (unsigned*)(ws + RT_PB);
    const float* nmix = args.in[2]; const float* nffn = args.in[3];

    constexpr float S_AW = 1.0f / (ACT_SCALE8 * W_SCALE8), S_HW = 1.0f / (HID_SCALE8 * W_SCALE8), S_YW = 1.0f / (YC_SCALE8 * W_SCALE8);
    constexpr bool C8 = F8_CONV != 0, FF8 = F8_FFN != 0, P8 = F8_PROJ != 0, MA8 = MOE_F8_A != 0, MB8 = MOE_F8_B != 0;
    bf16* Bc = (bf16*)(big + B_CONV_B); bf16* Vc = (bf16*)(big + B_CONV_V); bf16* Yc = (bf16*)(big + B_CONV_Y);
#define ROWPASS(MODE, COMB, O8, ...) do { RowArgs a{}; a.Xsrc = X; a.XN = XN; __VA_ARGS__; row_pass<MODE, COMB, O8>(F, a); } while (0)
#define CONV_IN(j) do { gemm_static<C8>(F, XN, D, D, ws + W_CINB + (size_t)(j) * 1024 * 1024 * 2, 1024, pg8::EpiBf16{Bc, D, nullptr, C8 ? S_AW : 1.0f}); \
                        gemm_static<C8>(F, XN, D, D, ws + W_CINCU + (size_t)(j) * 2048 * 1024 * 2, 2048, pg8::EpiPair<0>{Vc, D, C8 ? S_AW : 1.0f}); } while (0)
#define CONV_OUT(j, src) gemm_static<C8>(F, Yc, D, D, ws + W_COUT + (size_t)(j) * 1024 * 1024 * 2, 1024, pg8::EpiRes{(src), X, D, nullptr, C8 ? S_YW : 1.0f})
#define FFN_GU(f) do { if constexpr (FF8) gemm_static<true>(F, XN, D, D, ws + W_FGU + (size_t)(f) * 2 * FF * 1024 * 2, 2 * FF, pg8::EpiPair8{big + B_HMID, FF, S_AW, HID_SCALE8}); \
                       else gemm_static<false>(F, XN, D, D, ws + W_FGU + (size_t)(f) * 2 * FF * 1024 * 2, 2 * FF, pg8::EpiPair<1>{(bf16*)(big + B_HMID), FF, 1.0f}); } while (0)
#define FFN_DN(f) gemm_static<FF8>(F, big + B_HMID, FF, FF, ws + W_FD + (size_t)(f) * 1024 * FF * 2, 1024, pg8::EpiRes{X, X, D, nullptr, FF8 ? S_HW : 1.0f})

    if (IN(0)) REP(0) { prologue(F); __syncthreads(); ROWPASS(0, false, C8, a.Xsrc = x_in; a.g = nmix); }
    SEAM(0);
    if (IN(1)) REP(1) CONV_IN(0);
    SEAM(1);
    if (IN(2)) REP(2) conv_pass<C8>(F, Bc, Vc, args.in[6], Yc);
    SEAM(2);
    if (IN(3)) REP(3) CONV_OUT(0, x_in);
    SEAM(3);
    if (IN(4)) REP(4) ROWPASS(0, false, FF8, a.g = nffn);
    SEAM(4);
    if (IN(5)) REP(5) FFN_GU(0);
    SEAM(5);
    if (IN(6)) REP(6) FFN_DN(0);
    SEAM(6);
    if (IN(7)) REP(7) ROWPASS(0, false, P8, a.g = nmix + D);
    SEAM(7);
    if (IN(8)) REP(8) gemm_static<P8>(F, XN, D, D, ws + W_MDN, MDNP, pg8::EpiF32{(float*)(big + B_MC), MDNP, P8 ? S_AW : 1.0f});
    SEAM(8);
    if (IN(9)) REP(9) mla_mid(F, (const float*)(big + B_MC), args.in[9], args.in[11], (const float*)(ws + WS_ROPE), (bf16*)(big + B_MCQ), (bf16*)(big + B_MCKV), (bf16*)(big + B_MK));
    SEAM(9);
    if (IN(10)) REP(10) { gemm_static(F, big + B_MCQ, QL, QL, ws + W_MUQ, 1536, pg8::EpiBf16{(bf16*)(big + B_MQ), 1536, nullptr, 1.0f});
                          gemm_static(F, big + B_MCKV, KVL, KVL, ws + W_MUKV, 2048, pg8::EpiKV{(bf16*)(big + B_MK), (bf16*)(big + B_MV)}); }
    SEAM(10);
    if (IN(11)) REP(11) mla_attention(F);
    SEAM(11);
    if (IN(12)) REP(12) gemm_static(F, big + B_MO, D, D, ws + W_MO, 1024, pg8::EpiRes{X, X, D, nullptr, 1.0f});
    SEAM(12);
    if (IN(13)) REP(13) ROWPASS(1, false, MA8, a.g = nffn + D; a.routerT = (const float*)(ws + W_RT); a.rt_e = rt_e; a.rt_w0 = rt_w0; a.rt_w1 = rt_w1; a.cnt = rt_cnt);
    SEAM(13);
    if (IN(14)) REP(14) moe_assign<MA8>(F, rt_cnt, rt_e, rt_s0, rt_s1, rt_pb, XN, XG);
    SEAM(14);
    if (IN(15)) REP(15) moe_gemm1<MA8>(F, 0, rt_pb);
    SEAM(15);
    if (IN(16)) REP(16) moe_gemm2<MA8>(F, 0, rt_pb);
    SEAM(16);
    if (IN(17)) REP(17) ROWPASS(0, true, P8, a.Xdst = X; a.g = nmix + 2 * D; a.Y = XG; a.s0 = rt_s0; a.s1 = rt_s1; a.w0 = rt_w0; a.w1 = rt_w1);
    SEAM(17);
    if (IN(18)) REP(18) gemm_static<P8>(F, XN, D, D, ws + W_SQKV, SQKV, pg8::EpiBf16{(bf16*)(big + B_SQKV), SQKV, args.in[15], P8 ? S_AW : 1.0f});
    SEAM(18);
    if (IN(19)) REP(19) swa_attention(F);
    SEAM(19);
    if (IN(20)) REP(20) gemm_static(F, big + B_SO, D, D, ws + W_SO, 1024, pg8::EpiRes{X, X, D, args.in[18], 1.0f});
    SEAM(20);
    if (IN(21)) REP(21) ROWPASS(0, false, FF8, a.g = nffn + 2 * D);
    SEAM(21);
    if (IN(22)) REP(22) FFN_GU(1);
    SEAM(22);
    if (IN(23)) REP(23) FFN_DN(1);
    SEAM(23);
    if (IN(24)) REP(24) ROWPASS(0, false, C8, a.g = nmix + 3 * D);
    SEAM(24);
    if (IN(25)) REP(25) CONV_IN(1);
    SEAM(25);
    if (IN(26)) REP(26) conv_pass<C8>(F, Bc, Vc, args.in[6] + 3 * D, Yc);
    SEAM(26);
    if (IN(27)) REP(27) CONV_OUT(1, X);
    SEAM(27);
    if (IN(28)) REP(28) ROWPASS(1, false, MB8, a.g = nffn + 3 * D; a.routerT = (const float*)(ws + W_RT) + 8 * 1024; a.rt_e = rt_e; a.rt_w0 = rt_w0; a.rt_w1 = rt_w1; a.cnt = rt_cnt);
    SEAM(28);
    if (IN(29)) REP(29) moe_assign<MB8>(F, rt_cnt, rt_e, rt_s0, rt_s1, rt_pb + 16, XN, XG);
    SEAM(29);
    if (IN(30)) REP(30) moe_gemm1<MB8>(F, 1, rt_pb + 16);
    SEAM(30);
    if (IN(31)) REP(31) moe_gemm2<MB8>(F, 1, rt_pb + 16);
    SEAM(31);
    if (IN(32)) REP(32) ROWPASS(2, true, false, a.g = args.in[4]; a.outF = X; a.Y = XG; a.s0 = rt_s0; a.s1 = rt_s1; a.w0 = rt_w0; a.w1 = rt_w1);
#undef IN
#undef SEAM
}

#ifndef MK_LAUNCH_PER_PHASE
#define MK_LAUNCH_PER_PHASE 0
#endif
extern "C" void kernel_launch(void* const* d_in, const int* in_sizes, int n_in, void* d_out, int out_size, void* d_ws, size_t ws_size, hipStream_t stream) {
    static int grid = 0;
    if (grid == 0) {
        if (n_in != 24 || in_sizes[0] != T * D || out_size != T * D || ws_size < WS_END) { fprintf(stderr, "kernel_launch: unexpected shapes (n_in %d, in0 %d, out %d, ws %zu < %zu); nothing launched\n", n_in, n_in > 0 ? in_sizes[0] : -1, out_size, ws_size, (size_t)WS_END); grid = -1; return; }
        int dev = 0, cus = 0, per_cu = 0;
        if (hipGetDevice(&dev) != hipSuccess || hipDeviceGetAttribute(&cus, hipDeviceAttributeMultiprocessorCount, dev) != hipSuccess) { grid = -1; return; }
        if (hipFuncSetAttribute((const void*)mega, hipFuncAttributeMaxDynamicSharedMemorySize, LDS_BYTES) != hipSuccess) { fprintf(stderr, "kernel_launch: hipFuncSetAttribute failed\n"); grid = -1; return; }
        if (hipOccupancyMaxActiveBlocksPerMultiprocessor(&per_cu, (const void*)mega, NTHREADS, LDS_BYTES) != hipSuccess || per_cu < 1) fprintf(stderr, "kernel_launch: occupancy query reports %d\n", per_cu);
        (void)hipGetLastError();
        grid = cus;
    }
    if (grid < 0) return;
    (void)hipMemsetAsync((char*)d_ws + WS_CTL, 0, CTL_ZERO_BYTES, stream);
    Args a{};
    for (int i = 0; i < 24; ++i) a.in[i] = (const float*)d_in[i];
    a.out = (float*)d_out; a.ws = (unsigned char*)d_ws;
#if MK_LAUNCH_PER_PHASE
    for (int p = 0; p < N_PHASES; ++p) { a.ph_lo = p; a.ph_hi = p + 1; hipLaunchKernelGGL(mega, dim3(grid), dim3(NTHREADS), LDS_BYTES, stream, a); }
#else
    a.ph_lo = 0; a.ph_hi = N_PHASES; hipLaunchKernelGGL(mega, dim3(grid), dim3(NTHREADS), LDS_BYTES, stream, a);
#endif
}
```

```cpp
#include <hip/hip_runtime.h>
#include <cstdio>
#include <cstdint>

#define LAS __attribute__((address_space(3)))
#define GAS __attribute__((address_space(1)))
typedef unsigned short bf16;
typedef short bf16x8 __attribute__((ext_vector_type(8)));
typedef short s16x4 __attribute__((ext_vector_type(4)));
typedef float f32x2 __attribute__((ext_vector_type(2)));
typedef float f32x4 __attribute__((ext_vector_type(4)));
typedef float f32x16 __attribute__((ext_vector_type(16)));
typedef unsigned u32x2 __attribute__((ext_vector_type(2)));
typedef unsigned u32x4 __attribute__((ext_vector_type(4)));

__device__ __forceinline__ unsigned cvt_pk_bf16(float lo, float hi) { unsigned r; asm volatile("v_cvt_pk_bf16_f32 %0, %1, %2" : "=v"(r) : "v"(lo), "v"(hi)); return r; }
__device__ __forceinline__ float bf2f(unsigned short b) { return __uint_as_float(((unsigned)b) << 16); }
__device__ __forceinline__ float bflo(unsigned w) { return __uint_as_float(w << 16); }
__device__ __forceinline__ float bfhi(unsigned w) { return __uint_as_float(w & 0xffff0000u); }
__device__ __forceinline__ float wave_sum(float v) {
#pragma unroll
    for (int o = 1; o < 64; o <<= 1) v += __shfl_xor(v, o);
    return v;
}
__device__ __forceinline__ float fast_silu(float g) { return g * __builtin_amdgcn_rcpf(1.0f + __builtin_amdgcn_exp2f(-1.4426950408889634f * g)); }

namespace pg8 {
constexpr int BM = 256, BK = 64, HALF = 128, HTB = HALF * BK * 2, STAGE_BYTES = 8 * HTB, NXCD = 8, WGM = 8;
__host__ __device__ __forceinline__ int lds_byte(int r, int c) { const int st = (r >> 4) * 2 + (c >> 5), rr = r & 15, cc = c & 31, ob = rr * 64 + cc * 2; return st * 1024 + (ob ^ (((ob >> 9) & 1) << 5)); }
__host__ __device__ __forceinline__ void stage_rc(int b, int& R, int& C) { const int st = b / 1024, sb = b % 1024, swz = sb ^ (((sb >> 9) & 1) << 5); R = (st >> 1) * 16 + swz / 64; C = (st & 1) * 32 + (swz % 64) / 2; }
__host__ __device__ __forceinline__ int perm32(int rho) { const int n = rho >> 4, i = rho & 15; return 8 * (i >> 2) + 4 * n + (i & 3); }

struct Unit { int pm, pn, e; };
struct Gemm { const bf16* A; const bf16* Bt; int lda, K; size_t estride; const float* rs; const float* cs; int cs_estride; };

struct StaticOrder {
    int nM, nN, nwg, G, c;
    __device__ __forceinline__ void init(int M, int N, int G_, int c_) { nM = M / BM; nN = N / BM; nwg = nM * nN; G = G_; c = c_; }
    __device__ __forceinline__ bool next(int i, Unit& u) const {
        const long L = (long)i * G + c; if (L >= nwg) return false;
        int wgid = (int)L; { const int q = nwg / NXCD, r = nwg % NXCD, xcd = wgid % NXCD, off = wgid / NXCD; wgid = (xcd < r ? xcd * (q + 1) : r * (q + 1) + (xcd - r) * q) + off; }
        const int nig = WGM * nN, gid = wgid / nig, fm = gid * WGM, gsz = (nM - fm) < WGM ? (nM - fm) : WGM;
        u.pm = fm + ((wgid % nig) % gsz); u.pn = (wgid % nig) / gsz; u.e = 0; return true;
    }
};
struct GroupedOrder {
    const LAS unsigned* tab;
    __device__ __forceinline__ void init(const unsigned* pbase, int N, int G, int c, LAS unsigned* table, int cap) {
        const int tid = threadIdx.x;
        int pb[9];
#pragma unroll
        for (int i = 0; i < 9; ++i) pb[i] = (int)__hip_atomic_load(pbase + i, __ATOMIC_RELAXED, __HIP_MEMORY_SCOPE_AGENT);
        const int nM = pb[8], nN = N / BM, nwg = nM * nN;
        if (tid < cap) {
            unsigned w = 0u; const long L = (long)tid * G + c;
            if (L < nwg) {
                int wgid = (int)L; { const int q = nwg / NXCD, r = nwg % NXCD, xcd = wgid % NXCD, off = wgid / NXCD; wgid = (xcd < r ? xcd * (q + 1) : r * (q + 1) + (xcd - r) * q) + off; }
                const int nig = WGM * nN, gid = wgid / nig, fm = gid * WGM, gsz = (nM - fm) < WGM ? (nM - fm) : WGM;
                const int pm = fm + ((wgid % nig) % gsz), pn = (wgid % nig) / gsz;
                int e = 0;
#pragma unroll
                for (int j = 1; j < 8; ++j) e += (pm >= pb[j]) ? 1 : 0;
                w = (unsigned)pm | ((unsigned)pn << 12) | ((unsigned)e << 20) | 0x80000000u;
            }
            table[tid] = w;
        }
        tab = table;
        __syncthreads();
    }
    __device__ __forceinline__ bool next(int i, Unit& u) const {
        const unsigned w = (unsigned)__builtin_amdgcn_readfirstlane((int)tab[i]);
        u.pm = (int)(w & 0xfffu); u.pn = (int)((w >> 12) & 0xffu); u.e = (int)((w >> 20) & 0xfu); return (w >> 31) != 0u;
    }
};

struct EpiBf16 {
    static constexpr bool PERM = true;
    bf16* O; int ldc; const float* bias; float scale;
    __device__ __forceinline__ void operator()(const f32x4 (&acc)[2][2][4][2], const Unit& u, int wr, int wc, int fr, int fq) const {
        const int row0 = u.pm * BM + wr * 64 + fr, col0 = u.pn * BM + wc * 32 + 8 * fq;
        f32x4 bv[2][2];
#pragma unroll
        for (int bj = 0; bj < 2; ++bj)
#pragma unroll
            for (int n = 0; n < 2; ++n) bv[bj][n] = bias ? *(const f32x4*)(bias + col0 + bj * HALF + 4 * n) : (f32x4){0.f, 0.f, 0.f, 0.f};
#pragma unroll
        for (int ai = 0; ai < 2; ++ai)
#pragma unroll
            for (int m = 0; m < 4; ++m) { bf16* rowp = O + (size_t)(row0 + ai * HALF + m * 16) * ldc + col0;
#pragma unroll
                for (int bj = 0; bj < 2; ++bj) { const f32x4 v0 = acc[ai][bj][m][0] * scale + bv[bj][0], v1 = acc[ai][bj][m][1] * scale + bv[bj][1];
                    u32x4 w; w.x = cvt_pk_bf16(v0[0], v0[1]); w.y = cvt_pk_bf16(v0[2], v0[3]); w.z = cvt_pk_bf16(v1[0], v1[1]); w.w = cvt_pk_bf16(v1[2], v1[3]);
                    *(u32x4*)(rowp + bj * HALF) = w; } }
    }
};
template <int ACT  > struct EpiPair {
    static constexpr bool PERM = true;
    bf16* O; int ldc; float sin;
    __device__ __forceinline__ void operator()(const f32x4 (&acc)[2][2][4][2], const Unit& u, int wr, int wc, int fr, int fq) const {
        const int row0 = u.pm * BM + wr * 64 + fr, col0 = u.pn * HALF + wc * 32 + 8 * fq;
#pragma unroll
        for (int ai = 0; ai < 2; ++ai)
#pragma unroll
            for (int m = 0; m < 4; ++m) { bf16* rowp = O + (size_t)(row0 + ai * HALF + m * 16) * ldc + col0;
                f32x4 r[2];
#pragma unroll
                for (int n = 0; n < 2; ++n) { const f32x4 a = acc[ai][0][m][n] * sin, b = acc[ai][1][m][n] * sin;
                    if (ACT == 1) r[n] = (f32x4){fast_silu(a[0]) * b[0], fast_silu(a[1]) * b[1], fast_silu(a[2]) * b[2], fast_silu(a[3]) * b[3]};
                    else r[n] = a * b; }
                u32x4 w; w.x = cvt_pk_bf16(r[0][0], r[0][1]); w.y = cvt_pk_bf16(r[0][2], r[0][3]); w.z = cvt_pk_bf16(r[1][0], r[1][1]); w.w = cvt_pk_bf16(r[1][2], r[1][3]);
                *(u32x4*)rowp = w; }
    }
};
struct EpiPair8 {
    static constexpr bool PERM = true;
    unsigned char* O; int ldc; float sin, sout;
    __device__ __forceinline__ void operator()(const f32x4 (&acc)[2][2][4][2], const Unit& u, int wr, int wc, int fr, int fq) const {
        const int row0 = u.pm * BM + wr * 64 + fr, col0 = u.pn * HALF + wc * 32 + 8 * fq;
#pragma unroll
        for (int ai = 0; ai < 2; ++ai)
#pragma unroll
            for (int m = 0; m < 4; ++m) { unsigned char* rowp = O + (size_t)(row0 + ai * HALF + m * 16) * ldc + col0;
                float r[8];
#pragma unroll
                for (int n = 0; n < 2; ++n) { const f32x4 a = acc[ai][0][m][n] * sin, b = acc[ai][1][m][n] * (sin * sout);
#pragma unroll
                    for (int j = 0; j < 4; ++j) r[4 * n + j] = fminf(fmaxf(fast_silu(a[j]) * b[j], -448.f), 448.f); }
                u32x2 w; int t = __builtin_amdgcn_cvt_pk_fp8_f32(r[0], r[1], 0, false); t = __builtin_amdgcn_cvt_pk_fp8_f32(r[2], r[3], t, true); w.x = (unsigned)t;
                t = __builtin_amdgcn_cvt_pk_fp8_f32(r[4], r[5], 0, false); t = __builtin_amdgcn_cvt_pk_fp8_f32(r[6], r[7], t, true); w.y = (unsigned)t;
                *(u32x2*)rowp = w; }
    }
};
struct EpiRes {
    static constexpr bool PERM = false;
    const float* src; float* dst; int ldc; const float* bias; float scale;
    __device__ __forceinline__ void operator()(const f32x4 (&acc)[2][2][4][2], const Unit& u, int wr, int wc, int fr, int fq) const {
        const int row0 = u.pm * BM + wr * 64 + fr, col0 = u.pn * BM + wc * 32 + 4 * fq;
        f32x4 bv[2][2];
#pragma unroll
        for (int bj = 0; bj < 2; ++bj)
#pragma unroll
            for (int n = 0; n < 2; ++n) bv[bj][n] = bias ? *(const f32x4*)(bias + col0 + bj * HALF + n * 16) : (f32x4){0.f, 0.f, 0.f, 0.f};
#pragma unroll
        for (int ai = 0; ai < 2; ++ai)
#pragma unroll
            for (int m = 0; m < 4; ++m) { const size_t off = (size_t)(row0 + ai * HALF + m * 16) * ldc + col0;
                f32x4 s[2][2];
#pragma unroll
                for (int bj = 0; bj < 2; ++bj)
#pragma unroll
                    for (int n = 0; n < 2; ++n) s[bj][n] = *(const f32x4*)(src + off + bj * HALF + n * 16);
#pragma unroll
                for (int bj = 0; bj < 2; ++bj)
#pragma unroll
                    for (int n = 0; n < 2; ++n) *(f32x4*)(dst + off + bj * HALF + n * 16) = s[bj][n] + acc[ai][bj][m][n] * scale + bv[bj][n];
                asm volatile("" ::: "memory"); }
    }
};
struct EpiF32 {
    static constexpr bool PERM = false;
    float* C; int ldc; float scale;
    __device__ __forceinline__ void operator()(const f32x4 (&acc)[2][2][4][2], const Unit& u, int wr, int wc, int fr, int fq) const {
        const int row0 = u.pm * BM + wr * 64 + fr, col0 = u.pn * BM + wc * 32 + 4 * fq;
#pragma unroll
        for (int ai = 0; ai < 2; ++ai)
#pragma unroll
            for (int m = 0; m < 4; ++m) { float* rowp = C + (size_t)(row0 + ai * HALF + m * 16) * ldc + col0;
#pragma unroll
                for (int bj = 0; bj < 2; ++bj)
#pragma unroll
                    for (int n = 0; n < 2; ++n) *(f32x4*)(rowp + bj * HALF + n * 16) = acc[ai][bj][m][n] * scale; }
    }
};
struct EpiKV {
    static constexpr bool PERM = true;
    bf16* Kf; bf16* V;
    __device__ __forceinline__ void operator()(const f32x4 (&acc)[2][2][4][2], const Unit& u, int wr, int wc, int fr, int fq) const {
        const int row0 = u.pm * BM + wr * 64 + fr, col0 = wc * 32 + 8 * fq, h = u.pn;
#pragma unroll
        for (int ai = 0; ai < 2; ++ai)
#pragma unroll
            for (int m = 0; m < 4; ++m) { const int row = row0 + ai * HALF + m * 16, b = row >> 13, s = row & 8191; const size_t hr = (size_t)(b * 8 + h) * 8192 + s;
#pragma unroll
                for (int bj = 0; bj < 2; ++bj) { const f32x4 v0 = acc[ai][bj][m][0], v1 = acc[ai][bj][m][1];
                    u32x4 w; w.x = cvt_pk_bf16(v0[0], v0[1]); w.y = cvt_pk_bf16(v0[2], v0[3]); w.z = cvt_pk_bf16(v1[0], v1[1]); w.w = cvt_pk_bf16(v1[2], v1[3]);
                    if (bj == 0) *(u32x4*)(Kf + hr * 192 + col0) = w; else *(u32x4*)(V + hr * 128 + col0) = w; } }
    }
};

typedef int v8i32 __attribute__((ext_vector_type(8)));
__device__ __forceinline__ v8i32 cat8(bf16x8 a, bf16x8 b) { typedef int v4i32 __attribute__((ext_vector_type(4))); const v4i32 x = __builtin_bit_cast(v4i32, a), y = __builtin_bit_cast(v4i32, b); return __builtin_shufflevector(x, y, 0, 1, 2, 3, 4, 5, 6, 7); }
typedef int v4i32 __attribute__((ext_vector_type(4)));
template <class Epi, class Sched, int PREC = 0>
__device__ __forceinline__ void gemm_phase(LAS unsigned char* lds, const Gemm g, const Sched& S, const Epi& E) {
    constexpr bool F8 = (PREC == 1), I8 = (PREC == 2);
    const int tid = threadIdx.x, wid = __builtin_amdgcn_readfirstlane(tid >> 6), lane = tid & 63, wr = wid >> 2, wc = wid & 3, fr = lane & 15, fq = lane >> 4;
    const int K = g.K, nt = K / BK, lda = g.lda;
    unsigned voffA[2], voffB[2];
#pragma unroll
    for (int i = 0; i < 2; ++i) { int R, C; stage_rc(tid * 16 + i * 8192, R, C); const int Rb = Epi::PERM ? ((R & ~31) + perm32(R & 31)) : R;
        voffA[i] = (unsigned)(R * lda + C) * 2u; voffB[i] = (unsigned)(Rb * K + C) * 2u; }
    const size_t kstep = (size_t)(BK * 2);
    const size_t hstepA = (size_t)HALF * lda * 2, hstepB = (size_t)HALF * K * 2;
    const size_t tstepA = 2 * hstepA, tstepB = 2 * hstepB;
    const unsigned ldsw = (unsigned)wid * 1024u;
    const int aoff = lds_byte(wr * 64 + fr, fq * 8), boff = lds_byte(wc * 32 + fr, fq * 8);
#define PG8_SA(b, h) (((b) * 2 + (h)) * HTB)
#define PG8_SB(b, h) ((4 + (b) * 2 + (h)) * HTB)
#define PG8_STAGE(bufoff, gbase, voff) do { _Pragma("unroll") for (int _i = 0; _i < 2; ++_i) \
        __builtin_amdgcn_global_load_lds((const unsigned*)((const char*)(gbase) + (voff)[_i]), (LAS unsigned*)(lds + (bufoff) + ldsw + _i * 8192), 16, 0, 0); } while (0)
#define PG8_LDA(dst, b, h) do { _Pragma("unroll") for (int m = 0; m < 4; ++m) _Pragma("unroll") for (int k = 0; k < 2; ++k) dst[m][k] = *(const LAS bf16x8*)(lds + PG8_SA(b, h) + aoff + m * 2048 + k * 1024); } while (0)
#define PG8_LDB(dst, b, h) do { _Pragma("unroll") for (int n = 0; n < 2; ++n) _Pragma("unroll") for (int k = 0; k < 2; ++k) dst[n][k] = *(const LAS bf16x8*)(lds + PG8_SB(b, h) + boff + n * 2048 + k * 1024); } while (0)
#define PG8_MMA(ai, bj, At, Bt) do { __builtin_amdgcn_s_setprio(1); if constexpr (F8) asm volatile("s_nop 1"); _Pragma("unroll") for (int m = 0; m < 4; ++m) _Pragma("unroll") for (int n = 0; n < 2; ++n) { \
        if constexpr (F8) { const v8i32 b8_ = cat8(Bt[n][0], Bt[n][1]), a8_ = cat8(At[m][0], At[m][1]); asm("v_mfma_f32_16x16x128_f8f6f4 %0, %1, %2, %0" : "+v"(acc[ai][bj][m][n]) : "v"(b8_), "v"(a8_)); } \
        else if constexpr (I8) { _Pragma("unroll") for (int k = 0; k < 2; ++k) acc[ai][bj][m][n] = __builtin_bit_cast(f32x4, __builtin_amdgcn_mfma_i32_16x16x64_i8(__builtin_bit_cast(v4i32, Bt[n][k]), __builtin_bit_cast(v4i32, At[m][k]), __builtin_bit_cast(v4i32, acc[ai][bj][m][n]), 0, 0, 0)); } \
        else { _Pragma("unroll") for (int k = 0; k < 2; ++k) acc[ai][bj][m][n] = __builtin_amdgcn_mfma_f32_16x16x32_bf16(Bt[n][k], At[m][k], acc[ai][bj][m][n], 0, 0, 0); } } __builtin_amdgcn_s_setprio(0); } while (0)
#define PG8_WAIT_V(n) asm volatile("s_waitcnt vmcnt(" #n ")" ::: "memory")
#define PG8_WAIT_L(n) asm volatile("s_waitcnt lgkmcnt(" #n ")" ::: "memory")
#define PG8_BAR __builtin_amdgcn_s_barrier()
#define PG8_SCHED __builtin_amdgcn_sched_barrier(0)
    Unit cur, nxt; int ui = 0;
    if (!S.next(0, cur)) return;
    f32x4 acc[2][2][4][2];
#pragma unroll
    for (int a = 0; a < 2; ++a)
#pragma unroll
        for (int b = 0; b < 2; ++b)
#pragma unroll
            for (int m = 0; m < 4; ++m)
#pragma unroll
                for (int n = 0; n < 2; ++n) acc[a][b][m][n] = (f32x4){0.f, 0.f, 0.f, 0.f};
    bf16x8 At[4][2], B0[2][2], B1[2][2];
    const char* cA = (const char*)g.A + (size_t)cur.pm * tstepA; const char* cB = (const char*)g.Bt + (size_t)cur.e * g.estride + (size_t)cur.pn * tstepB;
    PG8_STAGE(PG8_SB(0, 0), cB, voffB); PG8_STAGE(PG8_SB(0, 1), cB + hstepB, voffB); PG8_STAGE(PG8_SA(0, 0), cA, voffA); PG8_STAGE(PG8_SA(0, 1), cA + hstepA, voffA);
    if (wr == 1) PG8_BAR;
    PG8_WAIT_V(2); PG8_BAR;
    PG8_STAGE(PG8_SB(1, 0), cB + kstep, voffB); PG8_STAGE(PG8_SA(1, 0), cA + kstep, voffA); PG8_STAGE(PG8_SB(1, 1), cB + hstepB + kstep, voffB);
    PG8_WAIT_V(6); PG8_BAR;
    for (;;) {
        const bool has_next = S.next(ui + 1, nxt);
        const char* nA = has_next ? (const char*)g.A + (size_t)nxt.pm * tstepA : cA; const char* nB = has_next ? (const char*)g.Bt + (size_t)nxt.e * g.estride + (size_t)nxt.pn * tstepB : cB;
#pragma nounroll
        for (int t = 0; t < nt; t += 2) {
            const bool last = (t == nt - 2);
            const char* a1 = cA + (size_t)(t + 1) * kstep;
            const char* a2 = last ? nA : cA + (size_t)(t + 2) * kstep; const char* b2 = last ? nB : cB + (size_t)(t + 2) * kstep;
            const char* a3 = a2 + kstep; const char* b3 = b2 + kstep;
            PG8_LDB(B0, 0, 0); PG8_LDB(B1, 0, 1); PG8_SCHED; PG8_LDA(At, 0, 0); PG8_STAGE(PG8_SA(1, 1), a1 + hstepA, voffA);
            PG8_WAIT_V(8); PG8_WAIT_L(0); PG8_BAR; PG8_MMA(0, 0, At, B0); PG8_MMA(0, 1, At, B1); PG8_BAR; PG8_SCHED;
            PG8_LDA(At, 0, 1); PG8_STAGE(PG8_SB(0, 0), b2, voffB); PG8_STAGE(PG8_SB(0, 1), b2 + hstepB, voffB); PG8_STAGE(PG8_SA(0, 0), a2, voffA);
            PG8_WAIT_V(8); PG8_WAIT_L(0); PG8_BAR; PG8_MMA(1, 0, At, B0); PG8_MMA(1, 1, At, B1); PG8_BAR; PG8_SCHED;
            PG8_LDB(B0, 1, 0); PG8_LDB(B1, 1, 1); PG8_SCHED; PG8_LDA(At, 1, 0); PG8_STAGE(PG8_SA(0, 1), a2 + hstepA, voffA);
            PG8_WAIT_V(8); PG8_WAIT_L(0); PG8_BAR; PG8_MMA(0, 0, At, B0); PG8_MMA(0, 1, At, B1); PG8_BAR; PG8_SCHED;
            PG8_LDA(At, 1, 1); PG8_STAGE(PG8_SB(1, 0), b3, voffB); PG8_STAGE(PG8_SB(1, 1), b3 + hstepB, voffB); PG8_STAGE(PG8_SA(1, 0), a3, voffA);
            PG8_WAIT_V(8); PG8_WAIT_L(0); PG8_BAR; PG8_MMA(1, 0, At, B0); PG8_MMA(1, 1, At, B1); PG8_BAR; PG8_SCHED;
        }
        if constexpr (F8) asm volatile("s_nop 15\n\ts_nop 15" ::: "memory");
        if (wr == 0) PG8_BAR;
        if constexpr (I8) {
            const float* csb = g.cs + (size_t)cur.e * g.cs_estride + cur.pn * BM + wc * 32;
            f32x4 cv[2][2];
#pragma unroll
            for (int bj = 0; bj < 2; ++bj)
#pragma unroll
                for (int n = 0; n < 2; ++n) cv[bj][n] = *(const f32x4*)(csb + bj * HALF + (Epi::PERM ? 8 * fq + 4 * n : 16 * n + 4 * fq));
#pragma unroll
            for (int ai = 0; ai < 2; ++ai)
#pragma unroll
                for (int m = 0; m < 4; ++m) { const float rv = g.rs[cur.pm * BM + ai * HALF + wr * 64 + m * 16 + fr];
#pragma unroll
                    for (int bj = 0; bj < 2; ++bj)
#pragma unroll
                        for (int n = 0; n < 2; ++n) { const v4i32 iv = __builtin_bit_cast(v4i32, acc[ai][bj][m][n]);
                            acc[ai][bj][m][n] = (f32x4){(float)iv[0], (float)iv[1], (float)iv[2], (float)iv[3]} * cv[bj][n] * rv; } }
        }
        E(acc, cur, wr, wc, fr, fq);
        if (!has_next) break;
#pragma unroll
        for (int a = 0; a < 2; ++a)
#pragma unroll
            for (int b = 0; b < 2; ++b)
#pragma unroll
                for (int m = 0; m < 4; ++m)
#pragma unroll
                    for (int n = 0; n < 2; ++n) acc[a][b][m][n] = (f32x4){0.f, 0.f, 0.f, 0.f};
        cur = nxt; cA = nA; cB = nB; ++ui;
        if (wr == 1) PG8_BAR;
    }
    PG8_WAIT_V(0);
    PG8_BAR;
#undef PG8_SA
#undef PG8_SB
#undef PG8_STAGE
#undef PG8_LDA
#undef PG8_LDB
#undef PG8_MMA
#undef PG8_WAIT_V
#undef PG8_WAIT_L
#undef PG8_BAR
#undef PG8_SCHED
}
}
namespace att {
constexpr int NW = 8, QBLK = 32, KVBLK = 64, QB = NW * QBLK;
__device__ __forceinline__ int crow(int r, int hi) { return (r & 3) + 8 * (r >> 2) + 4 * hi; }
template <int NCB> __device__ __forceinline__ int v_st(int k, int c) { const int kk = (k & ~0xC) | ((k & 4) << 1) | ((k & 8) >> 1); return ((kk >> 3) * NCB + (c >> 5)) * 512 + ((kk & 7) * 32 + (c & 31)) * 2; }
__device__ __forceinline__ int v_rd_base(int lane) { return ((lane & 3) << 3) | (((lane >> 2) & 3) << 6) | (((lane >> 4) & 1) << 5) | (((lane >> 5) & 1) << 8); }

struct Params {
    const bf16* Q; int ldq;
    const bf16* K; int ldk;
    const bf16* V; int ldv;
    bf16* O; int ldo;
    int P0;
    int j_lo, j_hi;
    const float* rope;
    const int* pos;
    float slope_over_scale, sink_l2;
};

template <int DQK, int DV, int KIND, int W>
__device__ __forceinline__ void attn_block(const Params& p, char* lds) {
    constexpr int NKS = DQK / 64, ND0 = DQK / 16, NCB = DV / 32, NVP = DV / 64;
    constexpr int KT = NKS * 8192, VT = KVBLK * DV * 2;
    constexpr int OFF_K = 2 * VT, OFF_KP = OFF_K + 2 * KT, OFF_WS = OFF_KP + 2 * 256;
    const float SCALE = (DQK == 192) ? 0.07216878364870322f : 0.125f;
    const float C2 = 1.4426950408889634f * SCALE;
    constexpr float THR = 8.f;
    const int tid = threadIdx.x, wid = __builtin_amdgcn_readfirstlane(tid >> 6), lane = tid & 63, r32 = lane & 31, hi = lane >> 5;
    LAS unsigned char* lds3 = (LAS unsigned char*)lds; char* V_lds = lds; char* K_lds = lds + OFF_K; float* kp_lds = (float*)(lds + OFF_KP);
    float* ws = (float*)(lds + OFF_WS) + wid * 64; float* li_l = ws, * al_l = ws + 32;
    const int NT = p.j_hi - p.j_lo;
    const int qlo = p.P0 + wid * QBLK, qm = qlo + r32 - 4 * hi;
    unsigned kofs, vofs[NVP];
    { const int q = wid * 64 + lane, key = q >> 3, c = (q & 7) ^ ((key >> 1) & 7); kofs = (unsigned)(key * p.ldk + c * 8) * 2u; }
#pragma unroll
    for (int i = 0; i < NVP; ++i) { const int bo = (wid + 8 * i) * 1024 + lane * 16, sub = bo >> 9, within = bo & 511, kk = (sub / NCB) * 8 + (within >> 6), c = (sub % NCB) * 32 + ((within & 63) >> 1);
        const int k = (kk & ~0xC) | ((kk & 4) << 1) | ((kk & 8) >> 1); vofs[i] = (unsigned)(k * p.ldv + c) * 2u; }
    float st_p = 0.f;
#define ST_LOAD(kb, bf) do { \
        const char* kb_ = (const char*)p.K + (size_t)(kb) * (size_t)(p.ldk * 2); const char* vb_ = (const char*)p.V + (size_t)(kb) * (size_t)(p.ldv * 2); \
        _Pragma("unroll") for (int s_ = 0; s_ < NKS; ++s_) __builtin_amdgcn_global_load_lds((const unsigned*)(kb_ + kofs + s_ * 128), (LAS unsigned*)(lds3 + OFF_K + (bf) * KT + s_ * 8192 + wid * 1024), 16, 0, 0); \
        _Pragma("unroll") for (int i_ = 0; i_ < NVP; ++i_) __builtin_amdgcn_global_load_lds((const unsigned*)(vb_ + vofs[i_]), (LAS unsigned*)(lds3 + (bf) * VT + (wid + 8 * i_) * 1024), 16, 0, 0); \
        if (KIND == 1 && tid < 64) st_p = (float)p.pos[(kb) + tid]; } while (0)
#define ST_WRITE(bf) do { if (KIND == 1 && tid < 64) kp_lds[(bf) * 64 + tid] = st_p; } while (0)
    bf16x8 qr[ND0];
    ST_LOAD(p.j_lo * KVBLK, 0);
    { const bf16* qrow = p.Q + (size_t)(wid * QBLK + r32) * p.ldq + hi * 8;
#pragma unroll
      for (int d0 = 0; d0 < ND0; ++d0) qr[d0] = *(const bf16x8*)(qrow + d0 * 16); }
    float pq = 0.f;
    if (KIND == 0) {
        const float* rt = p.rope + (size_t)(wid * QBLK + r32) * 64;
#pragma unroll
        for (int dd = 0; dd < 2; ++dd) {
            const int i0 = dd * 16 + hi * 8;
            const f32x4 c0 = *(const f32x4*)(rt + i0), c1 = *(const f32x4*)(rt + i0 + 4), s0 = *(const f32x4*)(rt + 32 + i0), s1 = *(const f32x4*)(rt + 32 + i0 + 4);
            bf16x8 a = qr[8 + dd], b = qr[10 + dd]; u32x4 ra, rb; float x1[8], x2[8], cs[8], sn[8];
#pragma unroll
            for (int j = 0; j < 4; ++j) { cs[j] = c0[j]; cs[4 + j] = c1[j]; sn[j] = s0[j]; sn[4 + j] = s1[j]; }
#pragma unroll
            for (int j = 0; j < 8; ++j) { x1[j] = bf2f((unsigned short)a[j]); x2[j] = bf2f((unsigned short)b[j]); }
#pragma unroll
            for (int j = 0; j < 4; ++j) { ra[j] = cvt_pk_bf16(x1[2 * j] * cs[2 * j] - x2[2 * j] * sn[2 * j], x1[2 * j + 1] * cs[2 * j + 1] - x2[2 * j + 1] * sn[2 * j + 1]);
                                          rb[j] = cvt_pk_bf16(x2[2 * j] * cs[2 * j] + x1[2 * j] * sn[2 * j], x2[2 * j + 1] * cs[2 * j + 1] + x1[2 * j + 1] * sn[2 * j + 1]); }
            qr[8 + dd] = *reinterpret_cast<bf16x8*>(&ra); qr[10 + dd] = *reinterpret_cast<bf16x8*>(&rb);
        }
    } else { pq = (float)p.pos[qlo + r32]; }
    int ka[4];
#pragma unroll
    for (int j = 0; j < 4; ++j) ka[j] = r32 * 128 + (((2 * j + hi) ^ ((r32 >> 1) & 7)) << 4);
    const int vb0 = (int)(uintptr_t)V_lds + v_rd_base(lane);
    float m_reg = -1e30f, l_reg = 0.f; f32x16 o[NCB];
#pragma unroll
    for (int d = 0; d < NCB; ++d) o[d] = f32x16{};
    asm volatile("s_waitcnt vmcnt(0)" ::: "memory");
    ST_WRITE(0);
    __syncthreads();
#define TRRD(dst, off) asm volatile("ds_read_b64_tr_b16 %0, %1 offset:%2" : "=&v"(dst) : "v"(vb0), "i"(off) : "memory")
#define TILE(t, BF) do { \
        const int kb_ = (p.j_lo + (t)) * KVBLK; \
        if ((t) + 1 < NT) { const int kn_ = kb_ + KVBLK; ST_LOAD(kn_, (BF) ^ 1); } \
        const bool act_ = (kb_ <= qlo + QBLK - 1) && (kb_ + KVBLK - 1 >= qlo - W + 1); \
        if (act_) { \
            f32x16 p0 = f32x16{}, p1 = f32x16{}; \
            { bf16x8 kf[2][4];                                                  \
              _Pragma("unroll") for (int s_ = 0; s_ < 2; ++s_) { const char* a_ = K_lds + (BF) * KT + ka[s_]; kf[0][2 * s_] = *(const bf16x8*)a_; kf[0][2 * s_ + 1] = *(const bf16x8*)(a_ + 4096); } \
              _Pragma("unroll") for (int g_ = 0; g_ < ND0 / 2; ++g_) { \
                if (g_ + 1 < ND0 / 2) { _Pragma("unroll") for (int s_ = 0; s_ < 2; ++s_) { const int d0 = 2 * (g_ + 1) + s_; const char* a_ = K_lds + (BF) * KT + (d0 >> 2) * 8192 + ka[d0 & 3]; \
                    kf[(g_ + 1) & 1][2 * s_] = *(const bf16x8*)a_; kf[(g_ + 1) & 1][2 * s_ + 1] = *(const bf16x8*)(a_ + 4096); } } \
                __builtin_amdgcn_sched_barrier(0); \
                _Pragma("unroll") for (int s_ = 0; s_ < 2; ++s_) { const int d0 = 2 * g_ + s_; \
                    p0 = __builtin_amdgcn_mfma_f32_32x32x16_bf16(kf[g_ & 1][2 * s_], qr[d0], p0, 0, 0, 0); p1 = __builtin_amdgcn_mfma_f32_32x32x16_bf16(kf[g_ & 1][2 * s_ + 1], qr[d0], p1, 0, 0, 0); } \
                __builtin_amdgcn_sched_barrier(0); } } \
            if (KIND == 1) { const float* kq = kp_lds + (BF) * 64 + 4 * hi; \
                _Pragma("unroll") for (int g_ = 0; g_ < 4; ++g_) { const f32x4 k0 = *(const f32x4*)(kq + 8 * g_), k1 = *(const f32x4*)(kq + 32 + 8 * g_); \
                    _Pragma("unroll") for (int c_ = 0; c_ < 4; ++c_) { p0[4 * g_ + c_] = fmaf(-p.slope_over_scale, fabsf(pq - k0[c_]), p0[4 * g_ + c_]); p1[4 * g_ + c_] = fmaf(-p.slope_over_scale, fabsf(pq - k1[c_]), p1[4 * g_ + c_]); } } } \
            if (kb_ + KVBLK - 1 > qlo || kb_ <= qlo + QBLK - 1 - W) { const int dq_ = qm - kb_; const float NEG = -__builtin_inff(); \
                _Pragma("unroll") for (int r = 0; r < 16; ++r) { const int c_ = (r & 3) + 8 * (r >> 2); \
                    if ((unsigned)(dq_ - c_) >= (unsigned)W) p0[r] = NEG; if ((unsigned)(dq_ - c_ - 32) >= (unsigned)W) p1[r] = NEG; } } \
            float pmax = p0[0]; \
            _Pragma("unroll") for (int r = 1; r < 16; ++r) pmax = fmaxf(pmax, p0[r]); \
            _Pragma("unroll") for (int r = 0; r < 16; ++r) pmax = fmaxf(pmax, p1[r]); \
            { auto rr = __builtin_amdgcn_permlane32_swap(__float_as_uint(pmax), __float_as_uint(pmax), false, false); pmax = fmaxf(__uint_as_float(rr[0]), __uint_as_float(rr[1])); } \
            float mn, alpha; \
            if (__all((pmax - m_reg) * SCALE <= THR)) { mn = m_reg; alpha = 1.f; } \
            else { mn = fmaxf(m_reg, pmax); alpha = __builtin_amdgcn_exp2f((m_reg - mn) * C2); m_reg = mn; } \
            const float mnL = -mn * C2; float ps = 0.f; \
            _Pragma("unroll") for (int r = 0; r < 16; ++r) { p0[r] = __builtin_amdgcn_exp2f(fmaf(p0[r], C2, mnL)); p1[r] = __builtin_amdgcn_exp2f(fmaf(p1[r], C2, mnL)); } \
            _Pragma("unroll") for (int r = 0; r < 16; ++r) ps += p0[r] + p1[r]; \
            { auto rr = __builtin_amdgcn_permlane32_swap(__float_as_uint(ps), __float_as_uint(ps), false, false); ps = __uint_as_float(rr[0]) + __uint_as_float(rr[1]); } \
            l_reg = l_reg * alpha + ps; \
            bf16x8 pa[4]; \
            _Pragma("unroll") for (int q_ = 0; q_ < 4; ++q_) { const f32x16& P = (q_ < 2) ? p0 : p1; const int B_ = (q_ & 1) * 8; \
                const unsigned a0 = cvt_pk_bf16(P[B_ + 0], P[B_ + 1]), a1 = cvt_pk_bf16(P[B_ + 2], P[B_ + 3]), b0 = cvt_pk_bf16(P[B_ + 4], P[B_ + 5]), b1 = cvt_pk_bf16(P[B_ + 6], P[B_ + 7]); \
                auto r0 = __builtin_amdgcn_permlane32_swap(a0, b0, false, false); auto r1 = __builtin_amdgcn_permlane32_swap(a1, b1, false, false); \
                u32x4 w_ = {r0[0], r1[0], r0[1], r1[1]}; pa[q_] = *reinterpret_cast<bf16x8*>(&w_); } \
            if (__any(alpha < 1.f)) { if (hi == 0) al_l[r32] = alpha; asm volatile("s_waitcnt lgkmcnt(0)" ::: "memory"); \
                _Pragma("unroll") for (int r = 0; r < 16; ++r) { const float a_ = al_l[crow(r, hi)]; _Pragma("unroll") for (int d_ = 0; d_ < NCB; ++d_) o[d_][r] *= a_; } } \
            { s16x4 l_[2][2], h_[2][2]; constexpr int b_ = (BF) * VT;            \
              _Pragma("unroll") for (int k2 = 0; k2 < 2; ++k2) { TRRD(l_[0][k2], b_ + k2 * (1024 * NCB)); TRRD(h_[0][k2], b_ + k2 * (1024 * NCB) + 512 * NCB); } \
              _Pragma("unroll") for (int i_ = 0; i_ < 2 * NCB; ++i_) { \
                if (i_ + 1 < 2 * NCB) { \
                    _Pragma("unroll") for (int k2 = 0; k2 < 2; ++k2) { TRRD(l_[(i_ + 1) & 1][k2], b_ + ((i_ + 1) >> 1) * 512 + (2 * ((i_ + 1) & 1) + k2) * (1024 * NCB)); TRRD(h_[(i_ + 1) & 1][k2], b_ + ((i_ + 1) >> 1) * 512 + (2 * ((i_ + 1) & 1) + k2) * (1024 * NCB) + 512 * NCB); } \
                    asm volatile("s_waitcnt lgkmcnt(4)" ::: "memory"); } \
                else asm volatile("s_waitcnt lgkmcnt(0)" ::: "memory"); \
                __builtin_amdgcn_sched_barrier(0); \
                _Pragma("unroll") for (int k2 = 0; k2 < 2; ++k2) \
                    o[i_ >> 1] = __builtin_amdgcn_mfma_f32_32x32x16_bf16(pa[2 * (i_ & 1) + k2], (bf16x8){l_[i_ & 1][k2][0], l_[i_ & 1][k2][1], l_[i_ & 1][k2][2], l_[i_ & 1][k2][3], h_[i_ & 1][k2][0], h_[i_ & 1][k2][1], h_[i_ & 1][k2][2], h_[i_ & 1][k2][3]}, o[i_ >> 1], 0, 0, 0); \
                __builtin_amdgcn_sched_barrier(0); } } \
        } \
        if ((t) + 1 < NT) { asm volatile("s_waitcnt vmcnt(0)" ::: "memory"); ST_WRITE((BF) ^ 1); } \
        __syncthreads(); } while (0)
    for (int t = 0; t < NT; t += 2) {
        TILE(t, 0);
        if (t + 1 < NT) TILE(t + 1, 1);
    }
    if (KIND == 1) l_reg += __builtin_amdgcn_exp2f(p.sink_l2 - m_reg * C2);
    if (hi == 0) li_l[r32] = l_reg;
    asm volatile("s_waitcnt lgkmcnt(0)" ::: "memory");
    bf16* Ow = p.O + (size_t)(wid * QBLK) * p.ldo;
#pragma unroll
    for (int r = 0; r < 16; ++r) { const int orow = crow(r, hi); const float rl = __builtin_amdgcn_rcpf(li_l[orow]);
#pragma unroll
        for (int d0 = 0; d0 < NCB; ++d0) { const float v = o[d0][r] * rl; const float vn = __shfl_xor(v, 1);
            if ((r32 & 1) == 0) *(unsigned*)(Ow + (size_t)orow * p.ldo + d0 * 32 + r32) = cvt_pk_bf16(v, vn); } }
    __syncthreads();
#undef TILE
#undef TRRD
#undef ST_LOAD
#undef ST_WRITE
}
constexpr int LDS_MLA = 2 * (64 * 128 * 2) + 2 * (3 * 8192) + 512 + 8 * 256;
constexpr int LDS_SWA = 2 * (64 * 64 * 2) + 2 * 8192 + 512 + 8 * 256;
}
constexpr int NWAVES = 8, NTHREADS = NWAVES * 64;
constexpr int D = 1024, NB = 8, SEQ = 8192, T = NB * SEQ;
constexpr int FF = 2816, NE = 8, FE = 3584;
constexpr int QL = 384, KVL = 256, MH = 8, DQKM = 192, DVM = 128;
constexpr int MDN = 704, MDNP = 768;
constexpr int SQKV = 1280;
constexpr int MAXPAN = 520, MAXSLOT = MAXPAN * 256;
constexpr float EPS = 1e-6f;
constexpr float ACT_SCALE8 = 8.f, HID_SCALE8 = 8.f, W_SCALE8 = 256.f, YC_SCALE8 = 4.f;
constexpr size_t MiB = 1u << 20;
constexpr size_t WS_CTL = 0, CTL_ZERO_BYTES = 1024 * 1024;
constexpr size_t WS_RT = 1 * MiB;
constexpr size_t RT_E = WS_RT, RT_W0 = RT_E + (size_t)T * 4, RT_W1 = RT_W0 + (size_t)T * 4, RT_S0 = RT_W1 + (size_t)T * 4, RT_S1 = RT_S0 + (size_t)T * 4, RT_CNT = RT_S1 + (size_t)T * 4, RT_PB = RT_CNT + 256 * 8 * 4;
constexpr size_t WS_RS = 3 * MiB;
constexpr size_t WS_CS = 4 * MiB;
constexpr size_t WS_ROPE = 8 * MiB;
constexpr size_t WS_W = 24 * MiB;
constexpr size_t W_CINB = WS_W, W_CINCU = W_CINB + 2 * (size_t)1024 * 1024 * 2, W_COUT = W_CINCU + 2 * (size_t)2048 * 1024 * 2;
constexpr size_t W_MDN = W_COUT + 2 * (size_t)1024 * 1024 * 2, W_MUQ = W_MDN + (size_t)MDNP * 1024 * 2, W_MUKV = W_MUQ + (size_t)1536 * QL * 2, W_MO = W_MUKV + (size_t)2048 * KVL * 2;
constexpr size_t W_SQKV = W_MO + (size_t)1024 * 1024 * 2, W_SO = W_SQKV + (size_t)SQKV * 1024 * 2;
constexpr size_t W_FGU = W_SO + (size_t)1024 * 1024 * 2, W_FD = W_FGU + 2 * (size_t)(2 * FF) * 1024 * 2;
constexpr size_t W_MGU = W_FD + 2 * (size_t)1024 * FF * 2, W_MD = W_MGU + 16 * (size_t)(2 * FE) * 1024 * 2, W_RT = W_MD + 16 * (size_t)1024 * FE * 2;
constexpr size_t W_END = W_RT + 2 * (size_t)8 * 1024 * 4;
constexpr size_t WS_XN = 420 * MiB;
constexpr size_t WS_XG = 548 * MiB;
constexpr size_t WS_BIG = 808 * MiB;
constexpr size_t WS_END = WS_BIG + (size_t)MAXSLOT * FE * 2;
static_assert(W_END <= WS_XN && WS_XN + (size_t)T * D * 2 <= WS_XG && WS_XG + (size_t)MAXSLOT * D * 2 <= WS_BIG, "d_ws map");
constexpr size_t B_CONV_B = 0, B_CONV_V = 128 * MiB, B_CONV_Y = 256 * MiB;
constexpr size_t B_HMID = 0;
constexpr size_t B_MC = 0, B_MO = 0, B_MCQ = 192 * MiB, B_MCKV = 240 * MiB, B_MQ = 272 * MiB, B_MK = 464 * MiB, B_MV = 656 * MiB;
constexpr size_t B_SQKV = 0, B_SO = 160 * MiB;
constexpr int CW_DBG = 8;
constexpr int CW_BAR = 1024;
constexpr int CW_CMAX = 8192, CM_CIN = 0, CM_FGU = CM_CIN + 2 * 3072, CM_MDN = CM_FGU + 2 * 5632, CM_SQKV = CM_MDN + 768, CM_MGU = 24576, CM_END = CM_MGU + 16 * 7168;
static_assert(CM_SQKV + 1280 <= CM_MGU && (CW_CMAX + CM_END) * 4 <= (int)CTL_ZERO_BYTES, "column-max words inside the memset region");
constexpr int RING_BYTES = 131072, MISC_OFF = RING_BYTES, LDS_BYTES = 147456;

#define RLX_AGENT __ATOMIC_RELAXED, __HIP_MEMORY_SCOPE_AGENT
#define XB_TMO      128
#define XB_XCNT(j)  (256  + 64 * (j))
#define XB_XSUB(j)  (1280 + 64 * (j))
#define XB_XGEN(j)  (2304 + 64 * (j))
#define XB_TOP      3328
#define XB_TOPGEN   3392
#define XCD_BAR_WORDS 3456
#define XB_SPIN_CAP (1u << 18)
__device__ __forceinline__ unsigned xb_ld(unsigned* p)              { return __hip_atomic_load(p, __ATOMIC_RELAXED, __HIP_MEMORY_SCOPE_AGENT); }
__device__ __forceinline__ unsigned xb_add(unsigned* p, unsigned v) { return __hip_atomic_fetch_add(p, v, __ATOMIC_RELAXED, __HIP_MEMORY_SCOPE_AGENT); }
__device__ __forceinline__ unsigned xb_xcc_id() { return (unsigned)__builtin_amdgcn_s_getreg((3 << 11) | 20) & 0xFu; }
#define XB_SPIN(cond, bar) do { unsigned _sp = 0; while (cond) { __builtin_amdgcn_s_sleep(1); \
    if ((++_sp & 255u) == 0u) { if (xb_ld(&(bar)[XB_TMO])) break; if (_sp > XB_SPIN_CAP) { atomicAdd(&(bar)[XB_TMO], 1u); break; } } } } while (0)
struct XcdBarrier { unsigned* bar; unsigned x; volatile LAS unsigned* st; };
__device__ __forceinline__ XcdBarrier xcd_barrier_post(unsigned* bar, volatile LAS unsigned* st) {
    XcdBarrier b; b.bar = bar; b.x = xb_xcc_id(); b.st = st;
    if (threadIdx.x == 0) (void)xb_add(&bar[XB_XCNT(b.x)], 1u);
    return b;
}
__device__ __forceinline__ void xcd_barrier_complete(unsigned* bar, unsigned x, unsigned& nloc, unsigned& nx) {
    const unsigned G = gridDim.x * gridDim.y * gridDim.z;
    unsigned sum, cnt, mine, sp = 0u;
    for (;;) {
        sum = 0u; cnt = 0u; mine = 0u;
#pragma unroll
        for (unsigned j = 0; j < 16; ++j) { const unsigned c = xb_ld(&bar[XB_XCNT(j)]); sum += c; cnt += (c > 0u) ? 1u : 0u; mine = (j == x) ? c : mine; }
        if (sum == G) break;
        __builtin_amdgcn_s_sleep(1);
        if ((++sp & 255u) == 0u) { if (xb_ld(&bar[XB_TMO])) break; if (sp > XB_SPIN_CAP) { atomicAdd(&bar[XB_TMO], 1u); break; } }
    }
    nloc = mine > 0u ? mine : 1u; nx = cnt > 0u ? cnt : 1u;
}
__device__ __forceinline__ void xcd_barrier(const XcdBarrier& b) {
    asm volatile("s_waitcnt vmcnt(0)" ::: "memory");
    __syncthreads();
    if (threadIdx.x == 0) {
        unsigned* bar = b.bar;
        __builtin_amdgcn_s_waitcnt(0);
        unsigned nloc = b.st[0], nx = b.st[1];
        if (nloc == 0u) { xcd_barrier_complete(bar, b.x, nloc, nx); b.st[0] = nloc; b.st[1] = nx; }
        const unsigned old = xb_add(&bar[XB_XSUB(b.x)], 1u);
        const unsigned gen = old / nloc;
        if (old + 1u == (gen + 1u) * nloc) {
            __builtin_amdgcn_fence(__ATOMIC_RELEASE, "agent");
            asm volatile("s_waitcnt vmcnt(0)" ::: "memory");
            const unsigned og = xb_add(&bar[XB_TOP], 1u);
            const unsigned tg = og / nx;
            if (og + 1u == (tg + 1u) * nx) xb_add(&bar[XB_TOPGEN], 1u);
            else XB_SPIN(xb_ld(&bar[XB_TOPGEN]) == tg, bar);
            __builtin_amdgcn_fence(__ATOMIC_ACQUIRE, "agent");
            xb_add(&bar[XB_XGEN(b.x)], 1u);
            asm volatile("s_waitcnt vmcnt(0)" ::: "memory");
        } else {
            XB_SPIN(xb_ld(&bar[XB_XGEN(b.x)]) == gen, bar);
            __builtin_amdgcn_fence(__ATOMIC_ACQUIRE, "agent");
            asm volatile("s_waitcnt vmcnt(0)" ::: "memory");
        }
    }
    __syncthreads();
}

struct TC { int tid, lane, wave; };
__device__ __forceinline__ TC tc_get() { TC t; int x = threadIdx.x; asm volatile("" : "+v"(x)); t.tid = x; t.lane = x & 63; t.wave = __builtin_amdgcn_readfirstlane(x >> 6); return t; }
struct Frame {
    char* lds; int vcu, G;
    unsigned char* ws; float* out;
    const float* const* in;
};
__device__ __forceinline__ float clamp8(float v) { return fminf(fmaxf(v, -448.f), 448.f); }
__device__ __forceinline__ unsigned pk4_fp8(float a, float b, float c, float d, float sc) {
    int t = __builtin_amdgcn_cvt_pk_fp8_f32(clamp8(a * sc), clamp8(b * sc), 0, false); t = __builtin_amdgcn_cvt_pk_fp8_f32(clamp8(c * sc), clamp8(d * sc), t, true); return (unsigned)t; }
#define LDS_WAIT() asm volatile("s_waitcnt lgkmcnt(0)" ::: "memory")
#define VM_WAIT() asm volatile("s_waitcnt vmcnt(0)" ::: "memory")

template <int MAP>
__device__ __forceinline__ void tr_item(const float* W, int K, int N, int ldw, bf16* WT, float* scr, int item, int lane) {
    const int nblk = N / 32, kb = item / nblk, nb = item % nblk, k0 = 64 * kb, n0 = 32 * nb;
    int r0 = n0;
    if (MAP == 1) { const int F = N / 2; r0 = (n0 < F) ? 256 * (n0 / 128) + (n0 % 128) : 256 * ((n0 - F) / 128) + 128 + ((n0 - F) % 128); }
    const float* src = W + (size_t)(k0 + (lane >> 5)) * ldw + n0 + (lane & 31);
#pragma unroll 16
    for (int i = 0; i < 32; ++i) scr[(2 * i + (lane >> 5)) * 33 + (lane & 31)] = src[(size_t)(2 * i) * ldw];
    LDS_WAIT(); asm volatile("" ::: "memory");
    const int c = lane & 7;
#pragma unroll
    for (int j = 0; j < 4; ++j) { const int n = (lane >> 3) + 8 * j; const float* s = scr + (8 * c) * 33 + n;
        u32x4 o; o.x = cvt_pk_bf16(s[0 * 33], s[1 * 33]); o.y = cvt_pk_bf16(s[2 * 33], s[3 * 33]); o.z = cvt_pk_bf16(s[4 * 33], s[5 * 33]); o.w = cvt_pk_bf16(s[6 * 33], s[7 * 33]);
        *(u32x4*)(WT + (size_t)(r0 + n) * K + k0 + 8 * c) = o; }
    LDS_WAIT(); asm volatile("" ::: "memory");
}
template <int MAP>
__device__ __forceinline__ void tr_item8(const float* W, int K, int N, int ldw, unsigned char* WT, float* scr, int item, int lane, float sw) {
    const int nblk = N / 32, kb = item / nblk, nb = item % nblk, k0 = 64 * kb, n0 = 32 * nb;
    int r0 = n0;
    if (MAP == 1) { const int F = N / 2; r0 = (n0 < F) ? 256 * (n0 / 128) + (n0 % 128) : 256 * ((n0 - F) / 128) + 128 + ((n0 - F) % 128); }
    const float* src = W + (size_t)(k0 + (lane >> 5)) * ldw + n0 + (lane & 31);
#pragma unroll 16
    for (int i = 0; i < 32; ++i) scr[(2 * i + (lane >> 5)) * 33 + (lane & 31)] = src[(size_t)(2 * i) * ldw];
    LDS_WAIT(); asm volatile("" ::: "memory");
    const int c = lane & 7;
#pragma unroll
    for (int j = 0; j < 4; ++j) { const int n = (lane >> 3) + 8 * j; const float* s = scr + (8 * c) * 33 + n;
        u32x2 o; int t = __builtin_amdgcn_cvt_pk_fp8_f32(s[0 * 33] * sw, s[1 * 33] * sw, 0, false); t = __builtin_amdgcn_cvt_pk_fp8_f32(s[2 * 33] * sw, s[3 * 33] * sw, t, true); o.x = (unsigned)t;
        t = __builtin_amdgcn_cvt_pk_fp8_f32(s[4 * 33] * sw, s[5 * 33] * sw, 0, false); t = __builtin_amdgcn_cvt_pk_fp8_f32(s[6 * 33] * sw, s[7 * 33] * sw, t, true); o.y = (unsigned)t;
        *(u32x2*)(WT + (size_t)(r0 + n) * K + k0 + 8 * c) = o; }
    LDS_WAIT(); asm volatile("" ::: "memory");
}
template <int MAP>
__device__ __forceinline__ void tr_matrix8(Frame& F, const float* W, int K, int N, int ldw, unsigned char* WT, int rot, float sw) {
    const TC tc = tc_get();
    float* scr = (float*)(F.lds + tc.wave * 8448);
    const int NGW = F.G * NWAVES, gw = (F.vcu * NWAVES + tc.wave + rot) % NGW, nitems = (K / 64) * (N / 32);
    for (int it = gw; it < nitems; it += NGW) tr_item8<MAP>(W, K, N, ldw, WT, scr, it, tc.lane, sw);
}
__device__ __forceinline__ void cmax_matrix(Frame& F, const float* W, int K, int N, int ldw, unsigned* cmax, int rot) {
    const TC tc = tc_get();
    const int NGW = F.G * NWAVES, gw = (F.vcu * NWAVES + tc.wave + rot) % NGW, ncb = (N + 255) / 256, nitems = (K / 64) * ncb;
    for (int it = gw; it < nitems; it += NGW) { const int kb = it / ncb, cb = it % ncb, col = cb * 256 + 4 * tc.lane;
        if (col < N) { const float* src = W + (size_t)(kb * 64) * ldw + col; f32x4 m = {0.f, 0.f, 0.f, 0.f};
#pragma unroll 16
            for (int r = 0; r < 64; ++r) { const f32x4 v = *(const f32x4*)(src + (size_t)r * ldw); m.x = fmaxf(m.x, fabsf(v.x)); m.y = fmaxf(m.y, fabsf(v.y)); m.z = fmaxf(m.z, fabsf(v.z)); m.w = fmaxf(m.w, fabsf(v.w)); }
            atomicMax(cmax + col, __float_as_uint(m.x)); atomicMax(cmax + col + 1, __float_as_uint(m.y)); atomicMax(cmax + col + 2, __float_as_uint(m.z)); atomicMax(cmax + col + 3, __float_as_uint(m.w)); } }
}
template <int MAP>
__device__ __forceinline__ void tr_item_i8(const float* W, int K, int N, int ldw, unsigned char* WT, float* scr, int item, int lane, const unsigned* cmax, float* cs) {
    const int nblk = N / 32, kb = item / nblk, nb = item % nblk, k0 = 64 * kb, n0 = 32 * nb;
    int r0 = n0;
    if (MAP == 1) { const int F = N / 2; r0 = (n0 < F) ? 256 * (n0 / 128) + (n0 % 128) : 256 * ((n0 - F) / 128) + 128 + ((n0 - F) % 128); }
    const float* src = W + (size_t)(k0 + (lane >> 5)) * ldw + n0 + (lane & 31);
#pragma unroll 16
    for (int i = 0; i < 32; ++i) scr[(2 * i + (lane >> 5)) * 33 + (lane & 31)] = src[(size_t)(2 * i) * ldw];
    LDS_WAIT(); asm volatile("" ::: "memory");
    const int c = lane & 7;
#pragma unroll
    for (int j = 0; j < 4; ++j) { const int n = (lane >> 3) + 8 * j; const float* s = scr + (8 * c) * 33 + n;
        const float cm = __uint_as_float(cmax[n0 + n]), inv = cm > 0.f ? 127.0f / cm : 0.f;
        if (kb == 0 && c == 0) cs[r0 + n] = cm * (1.0f / 127.0f);
        unsigned w[2];
#pragma unroll
        for (int h = 0; h < 2; ++h) { const int q0 = __float2int_rn(s[(4 * h + 0) * 33] * inv), q1 = __float2int_rn(s[(4 * h + 1) * 33] * inv), q2 = __float2int_rn(s[(4 * h + 2) * 33] * inv), q3 = __float2int_rn(s[(4 * h + 3) * 33] * inv);
            w[h] = (unsigned)(q0 & 0xff) | ((unsigned)(q1 & 0xff) << 8) | ((unsigned)(q2 & 0xff) << 16) | ((unsigned)q3 << 24); }
        u32x2 o; o.x = w[0]; o.y = w[1];
        *(u32x2*)(WT + (size_t)(r0 + n) * K + k0 + 8 * c) = o; }
    LDS_WAIT(); asm volatile("" ::: "memory");
}
template <int MAP>
__device__ __forceinline__ void tr_matrix_i8(Frame& F, const float* W, int K, int N, int ldw, unsigned char* WT, int rot, const unsigned* cmax, float* cs) {
    const TC tc = tc_get();
    float* scr = (float*)(F.lds + tc.wave * 8448);
    const int NGW = F.G * NWAVES, gw = (F.vcu * NWAVES + tc.wave + rot) % NGW, nitems = (K / 64) * (N / 32);
    for (int it = gw; it < nitems; it += NGW) tr_item_i8<MAP>(W, K, N, ldw, WT, scr, it, tc.lane, cmax, cs);
}
template <int MAP>
__device__ __forceinline__ void tr_matrix(Frame& F, const float* W, int K, int N, int ldw, bf16* WT, int rot) {
    const TC tc = tc_get();
    float* scr = (float*)(F.lds + tc.wave * 8448);
    const int NGW = F.G * NWAVES, gw = (F.vcu * NWAVES + tc.wave + rot) % NGW, nitems = (K / 64) * (N / 32);
    for (int it = gw; it < nitems; it += NGW) tr_item<MAP>(W, K, N, ldw, WT, scr, it, tc.lane);
}

struct RowArgs { const float* Xsrc; float* Xdst; const float* g; bf16* XN; float* outF; const bf16* Y; const int* s0; const int* s1; const float* w0; const float* w1;
                 const float* routerT; unsigned* rt_e; float* rt_w0; float* rt_w1; unsigned* cnt; float* rs; };
template <int MODE, bool COMBINE, int OUTM = 0  >
__device__ __forceinline__ void row_pass(Frame& F, const RowArgs& a) {
    const TC tc = tc_get();
    const int lane = tc.lane;
    float* rtab = (float*)F.lds;
    unsigned* wcnt = (unsigned*)(F.lds + 32768);
    if (MODE == 1) { for (int i = tc.tid; i < 8 * 1024; i += NTHREADS) rtab[i] = a.routerT[i]; }
    f32x4 gv[4];
#pragma unroll
    for (int j = 0; j < 4; ++j) gv[j] = *(const f32x4*)(a.g + 4 * lane + 256 * j);
    for (int tb = blockIdx.x; tb < T / 256; tb += F.G) {
        if (MODE == 1) { if (tc.tid < 64) wcnt[tc.tid] = 0u; __syncthreads(); }
        unsigned myc[8] = {0u, 0u, 0u, 0u, 0u, 0u, 0u, 0u};
        for (int rr = 0; rr < 32; ++rr) {
            const int row = tb * 256 + tc.wave * 32 + rr;
            const f32x4* xr = (const f32x4*)(a.Xsrc + (size_t)row * D) + lane;
            f32x4 v[4];
#pragma unroll
            for (int j = 0; j < 4; ++j) v[j] = xr[64 * j];
            if (COMBINE) {
                const int sa = a.s0[row], sb = a.s1[row]; const float wa = a.w0[row], wb = a.w1[row];
                const u32x2* ya = (const u32x2*)(a.Y + (size_t)sa * D) + lane; const u32x2* yb = (const u32x2*)(a.Y + (size_t)sb * D) + lane;
#pragma unroll
                for (int j = 0; j < 4; ++j) { const u32x2 pa = ya[64 * j], pb = yb[64 * j];
                    v[j].x += wa * bflo(pa.x) + wb * bflo(pb.x); v[j].y += wa * bfhi(pa.x) + wb * bfhi(pb.x);
                    v[j].z += wa * bflo(pa.y) + wb * bflo(pb.y); v[j].w += wa * bfhi(pa.y) + wb * bfhi(pb.y); }
                if (MODE != 2) { f32x4* xd = (f32x4*)(a.Xdst + (size_t)row * D) + lane;
#pragma unroll
                    for (int j = 0; j < 4; ++j) xd[64 * j] = v[j]; }
            }
            float ss = 0.f;
#pragma unroll
            for (int j = 0; j < 4; ++j) ss += (v[j].x * v[j].x + v[j].y * v[j].y) + (v[j].z * v[j].z + v[j].w * v[j].w);
            const float rstd = 1.0f / sqrtf(wave_sum(ss) * (1.f / D) + EPS);
#pragma unroll
            for (int j = 0; j < 4; ++j) v[j] = v[j] * rstd * gv[j];
            if (MODE == 2) { f32x4* od = (f32x4*)(a.outF + (size_t)row * D) + lane;
#pragma unroll
                for (int j = 0; j < 4; ++j) od[64 * j] = v[j];
            } else if (OUTM == 2) { float am = 0.f;
#pragma unroll
                for (int j = 0; j < 4; ++j) am = fmaxf(fmaxf(am, fmaxf(fabsf(v[j].x), fabsf(v[j].y))), fmaxf(fabsf(v[j].z), fabsf(v[j].w)));
#pragma unroll
                for (int o = 1; o < 64; o <<= 1) am = fmaxf(am, __shfl_xor(am, o));
                const float inv = am > 0.f ? 127.0f / am : 0.f;
                unsigned* o4 = (unsigned*)((unsigned char*)a.XN + (size_t)row * D) + lane;
#pragma unroll
                for (int j = 0; j < 4; ++j) { const int q0 = __float2int_rn(v[j].x * inv), q1 = __float2int_rn(v[j].y * inv), q2 = __float2int_rn(v[j].z * inv), q3 = __float2int_rn(v[j].w * inv);
                    o4[64 * j] = (unsigned)(q0 & 0xff) | ((unsigned)(q1 & 0xff) << 8) | ((unsigned)(q2 & 0xff) << 16) | ((unsigned)q3 << 24); }
                if (lane == 0) a.rs[row] = am * (1.0f / 127.0f);
            } else if (OUTM == 1) { unsigned* o4 = (unsigned*)((unsigned char*)a.XN + (size_t)row * D) + lane;
#pragma unroll
                for (int j = 0; j < 4; ++j) o4[64 * j] = pk4_fp8(v[j].x, v[j].y, v[j].z, v[j].w, ACT_SCALE8);
            } else { u32x2* o8 = (u32x2*)(a.XN + (size_t)row * D) + lane;
#pragma unroll
                for (int j = 0; j < 4; ++j) { u32x2 w; w.x = cvt_pk_bf16(v[j].x, v[j].y); w.y = cvt_pk_bf16(v[j].z, v[j].w); o8[64 * j] = w; } }
            if (MODE == 1) {
                float lg[8];
#pragma unroll
                for (int e = 0; e < 8; ++e) { float s = 0.f;
#pragma unroll
                    for (int j = 0; j < 4; ++j) { const f32x4 r = *(const f32x4*)(rtab + e * 1024 + 256 * j + 4 * lane); s += (v[j].x * r.x + v[j].y * r.y) + (v[j].z * r.z + v[j].w * r.w); }
                    lg[e] = wave_sum(s); }
                int e0 = 0; float v0 = lg[0];
#pragma unroll
                for (int e = 1; e < 8; ++e) if (lg[e] > v0) { v0 = lg[e]; e0 = e; }
                int e1 = -1; float v1 = -3.0e38f;
#pragma unroll
                for (int e = 0; e < 8; ++e) if (e != e0 && lg[e] > v1) { v1 = lg[e]; e1 = e; }
                const float w0 = 1.0f / (1.0f + __expf(v1 - v0)), w1 = 1.0f - w0;
                if (lane == 0) { a.rt_e[row] = (unsigned)e0 | ((unsigned)e1 << 8); a.rt_w0[row] = w0; a.rt_w1[row] = w1; }
#pragma unroll
                for (int e = 0; e < 8; ++e) myc[e] += (e == e0 || e == e1) ? 1u : 0u;
            }
        }
        if (MODE == 1) {
            if (lane < 8) { unsigned c = 0;
#pragma unroll
                for (int e = 0; e < 8; ++e) c = (lane == e) ? myc[e] : c;
                wcnt[tc.wave * 8 + lane] = c; }
            __syncthreads();
            if (tc.tid < 8) { unsigned c = 0; for (int w = 0; w < 8; ++w) c += wcnt[w * 8 + tc.tid]; a.cnt[tb * 8 + tc.tid] = c; }
            __syncthreads();
        }
    }
}

template <bool F8>
__device__ __forceinline__ void moe_assign(Frame& F, const unsigned* cnt, const unsigned* rt_e, int* s0, int* s1, unsigned* pbase_out, const bf16* XN, bf16* XG) {
    const TC tc = tc_get();
    unsigned* tot = (unsigned*)F.lds;
    unsigned* pre = tot + 64;
    unsigned long long* msk = (unsigned long long*)(F.lds + 1024);
    int* slt = (int*)(F.lds + 2048);
    if (tc.tid < 8) tot[tc.tid] = 0u;
    __syncthreads();
    { unsigned part[8] = {0, 0, 0, 0, 0, 0, 0, 0};
      if (tc.tid < 256) {
#pragma unroll
          for (int e = 0; e < 8; ++e) part[e] = __hip_atomic_load(cnt + tc.tid * 8 + e, RLX_AGENT); }
#pragma unroll
      for (int e = 0; e < 8; ++e) { unsigned s = part[e];
#pragma unroll
          for (int o = 1; o < 64; o <<= 1) s += __shfl_xor(s, o);
          if (tc.lane == 0 && tc.wave < 4) atomicAdd(&tot[e], s); } }
    __syncthreads();
    if (tc.tid == 0) { unsigned p = 0; for (int e = 0; e < 8; ++e) { tot[8 + e] = p; p += (tot[e] + 255u) / 256u; } tot[16] = p;
        if (blockIdx.x == 0) for (int e = 0; e < 9; ++e) __hip_atomic_store(pbase_out + e, tot[8 + e], RLX_AGENT); }
    __syncthreads();
    for (int tb = blockIdx.x; tb < T / 256; tb += F.G) {
        if (tc.tid < 8) { unsigned s = 0; for (int b = 0; b < tb; ++b) s += __hip_atomic_load(cnt + b * 8 + tc.tid, RLX_AGENT); pre[tc.tid] = s; }
        int e0 = 0, e1 = 0;
        if (tc.tid < 256) { const unsigned pe = rt_e[tb * 256 + tc.tid]; e0 = pe & 0xff; e1 = (pe >> 8) & 0xff;
#pragma unroll
            for (int e = 0; e < 8; ++e) { const unsigned long long m = __ballot(e0 == e || e1 == e); if (tc.lane == 0) msk[e * 4 + tc.wave] = m; } }
        __syncthreads();
        if (tc.tid < 256) {
            int sl[2];
#pragma unroll
            for (int k = 0; k < 2; ++k) { const int e = k ? e1 : e0; unsigned rank = 0;
                for (int w = 0; w < tc.wave; ++w) rank += __popcll(msk[e * 4 + w]);
                rank += __popcll(msk[e * 4 + tc.wave] & ((1ull << tc.lane) - 1ull));
                sl[k] = (int)(tot[8 + e] * 256u + pre[e] + rank); }
            s0[tb * 256 + tc.tid] = sl[0]; s1[tb * 256 + tc.tid] = sl[1]; slt[2 * tc.tid] = sl[0]; slt[2 * tc.tid + 1] = sl[1];
        }
        __syncthreads();
        for (int rr = 0; rr < 32; ++rr) { const int i = tc.wave * 32 + rr; const int row = tb * 256 + i; const int sa = slt[2 * i], sb = slt[2 * i + 1];
            if (F8) {
                const u32x4 o = ((const u32x4*)((const unsigned char*)XN + (size_t)row * D))[tc.lane];
                ((u32x4*)((unsigned char*)XG + (size_t)sa * D))[tc.lane] = o; ((u32x4*)((unsigned char*)XG + (size_t)sb * D))[tc.lane] = o;
            } else {
            const u32x4* src = (const u32x4*)(XN + (size_t)row * D) + tc.lane; const u32x4 a = src[0], b = src[64];
            u32x4* d0 = (u32x4*)(XG + (size_t)sa * D) + tc.lane; u32x4* d1 = (u32x4*)(XG + (size_t)sb * D) + tc.lane;
            d0[0] = a; d0[64] = b; d1[0] = a; d1[64] = b; } }
        __syncthreads();
    }
}

template <bool OUT8>
__device__ __forceinline__ void conv_pass(Frame& F, const bf16* Bc, const bf16* Vc, const float* wconv, bf16* Yc) {
    const TC tc = tc_get();
    const int sub = tc.tid >> 7, ch = (tc.tid & 127) * 8;
    float w[3][8];
#pragma unroll
    for (int j = 0; j < 3; ++j) { const f32x4 a = *(const f32x4*)(wconv + j * D + ch), b = *(const f32x4*)(wconv + j * D + ch + 4);
#pragma unroll
        for (int c = 0; c < 4; ++c) { w[j][c] = a[c]; w[j][4 + c] = b[c]; } }
    for (int run = blockIdx.x * 4 + sub; run < T / 32; run += F.G * 4) {
        const int t0 = run * 32, s0 = t0 & (SEQ - 1);
        float p2[8], p1[8];
        { u32x4 a = {0, 0, 0, 0}, b = {0, 0, 0, 0};
          if (s0 >= 2) { a = *(const u32x4*)(Vc + (size_t)(t0 - 2) * D + ch); b = *(const u32x4*)(Vc + (size_t)(t0 - 1) * D + ch); }
#pragma unroll
          for (int c = 0; c < 4; ++c) { p2[2 * c] = bflo(a[c]); p2[2 * c + 1] = bfhi(a[c]); p1[2 * c] = bflo(b[c]); p1[2 * c + 1] = bfhi(b[c]); } }
#pragma unroll 4
        for (int i = 0; i < 32; ++i) { const size_t o = (size_t)(t0 + i) * D + ch;
            const u32x4 vv = *(const u32x4*)(Vc + o), bb = *(const u32x4*)(Bc + o); float cur[8], y[8];
#pragma unroll
            for (int c = 0; c < 4; ++c) { cur[2 * c] = bflo(vv[c]); cur[2 * c + 1] = bfhi(vv[c]); }
#pragma unroll
            for (int c = 0; c < 8; ++c) { const float bq = (c & 1) ? bfhi(bb[c >> 1]) : bflo(bb[c >> 1]); y[c] = bq * (w[0][c] * p2[c] + w[1][c] * p1[c] + w[2][c] * cur[c]); p2[c] = p1[c]; p1[c] = cur[c]; }
            if (OUT8) { u32x2 r; r.x = pk4_fp8(y[0], y[1], y[2], y[3], YC_SCALE8); r.y = pk4_fp8(y[4], y[5], y[6], y[7], YC_SCALE8); *(u32x2*)((unsigned char*)Yc + o) = r; }
            else { u32x4 r; r.x = cvt_pk_bf16(y[0], y[1]); r.y = cvt_pk_bf16(y[2], y[3]); r.z = cvt_pk_bf16(y[4], y[5]); r.w = cvt_pk_bf16(y[6], y[7]);
            *(u32x4*)(Yc + o) = r; } }
    }
}

__device__ __forceinline__ void rope_table(Frame& F, const int* pos, float* tab) {
    const TC tc = tc_get();
    const int i = tc.lane & 31; const float inv = __builtin_amdgcn_exp2f(-(float)i * (13.287712379549449f / 32.0f));
    const int NGW = F.G * NWAVES, gw = F.vcu * NWAVES + tc.wave;
    for (int t = gw * 2 + (tc.lane >> 5); t < T; t += NGW * 2) {
        const float ang = (float)pos[t] * inv;
        const float k = rintf(ang * 0.15915494309189535f);
        float r = fmaf(-k, 6.28125f, ang); r = fmaf(-k, 1.9353071795864769e-3f, r);
        tab[(size_t)t * 64 + i] = __cosf(r); tab[(size_t)t * 64 + 32 + i] = __sinf(r);
    }
}

__device__ __forceinline__ void mla_mid(Frame& F, const float* C, const float* gq, const float* gkv, const float* tab, bf16* cqn, bf16* ckvn, bf16* Kf) {
    const TC tc = tc_get();
    const int lane = tc.lane, NGW = F.G * NWAVES, gw = F.vcu * NWAVES + tc.wave;
    f32x2 gqv[3];
#pragma unroll
    for (int j = 0; j < 3; ++j) gqv[j] = *(const f32x2*)(gq + 2 * lane + 128 * j);
    const f32x4 gk = *(const f32x4*)(gkv + 4 * lane);
    for (int t = gw; t < T; t += NGW) {
        const float* c = C + (size_t)t * MDNP;
        f32x2 q[3]; float ss = 0.f;
#pragma unroll
        for (int j = 0; j < 3; ++j) { q[j] = *(const f32x2*)(c + 2 * lane + 128 * j); ss += q[j].x * q[j].x + q[j].y * q[j].y; }
        const f32x4 kv = *(const f32x4*)(c + QL + 4 * lane);
        const float x = c[QL + KVL + lane];
        const float rq = 1.0f / sqrtf(wave_sum(ss) * (1.f / QL) + EPS);
        const float rk = 1.0f / sqrtf(wave_sum((kv.x * kv.x + kv.y * kv.y) + (kv.z * kv.z + kv.w * kv.w)) * (1.f / KVL) + EPS);
#pragma unroll
        for (int j = 0; j < 3; ++j) *(unsigned*)(cqn + (size_t)t * QL + 2 * lane + 128 * j) = cvt_pk_bf16(q[j].x * rq * gqv[j].x, q[j].y * rq * gqv[j].y);
        { u32x2 w; w.x = cvt_pk_bf16(kv.x * rk * gk.x, kv.y * rk * gk.y); w.y = cvt_pk_bf16(kv.z * rk * gk.z, kv.w * rk * gk.w); *(u32x2*)(ckvn + (size_t)t * KVL + 4 * lane) = w; }
        const float other = __shfl_xor(x, 32); const int i = lane & 31;
        const float cs = tab[(size_t)t * 64 + i], sn = tab[(size_t)t * 64 + 32 + i];
        const float r = (lane < 32) ? (x * cs - other * sn) : (x * cs + other * sn);
        const float rn = __shfl_xor(r, 1);
        if ((lane & 1) == 0) { const unsigned pk = cvt_pk_bf16(r, rn); const int b = t >> 13, s = t & (SEQ - 1);
#pragma unroll
            for (int h = 0; h < MH; ++h) *(unsigned*)(Kf + ((size_t)(b * MH + h) * SEQ + s) * DQKM + 128 + lane) = pk; }
    }
}
#ifndef PC_CONV_IN
#define PC_CONV_IN 2
#endif
#ifndef PC_FFN_GU
#define PC_FFN_GU 2
#endif
#ifndef PC_MDN
#define PC_MDN 2
#endif
#ifndef PC_SQKV
#define PC_SQKV 2
#endif
#ifndef PC_FFN_DN
#define PC_FFN_DN 0
#endif
template <int PREC = 0, class Epi>
__device__ __forceinline__ void gemm_static(Frame& F, const void* A, int lda, int K, const void* Bt, int N, const Epi& E, const float* rs = nullptr, const float* cs = nullptr) {
    pg8::Gemm g{(const bf16*)A, (const bf16*)Bt, PREC ? lda / 2 : lda, PREC ? K / 2 : K, 0, rs, cs, 0}; pg8::StaticOrder S; S.init(T, N, F.G, (int)blockIdx.x);
    pg8::gemm_phase<Epi, pg8::StaticOrder, PREC>((LAS unsigned char*)F.lds, g, S, E);
}
template <bool F8, class Epi>
__device__ __forceinline__ void gemm_grouped(Frame& F, const void* A, int lda, int K, const void* Bt, size_t estride, int N, const unsigned* pbase, const Epi& E) {
    pg8::Gemm g{(const bf16*)A, (const bf16*)Bt, lda, K, estride, nullptr, nullptr, 0}; pg8::GroupedOrder S; S.init(pbase, N, F.G, (int)blockIdx.x, (LAS unsigned*)((LAS unsigned char*)F.lds + MISC_OFF + 512), 128);
    pg8::gemm_phase<Epi, pg8::GroupedOrder, F8 ? 1 : 0>((LAS unsigned char*)F.lds, g, S, E);
}
#ifndef MOE_F8_A
#define MOE_F8_A 1
#endif
#ifndef MOE_F8_B
#define MOE_F8_B 1
#endif
template <bool F8>
__device__ __forceinline__ void moe_gemm1(Frame& F, int l, const unsigned* pb) {
    unsigned char* ws = F.ws; unsigned char* big = ws + WS_BIG;
    if (F8) gemm_grouped<true>(F, ws + WS_XG, D / 2, D / 2, ws + W_MGU + (size_t)l * 8 * 2 * FE * 1024 * 2, (size_t)2 * FE * 1024, 2 * FE, pb, pg8::EpiPair8{big, FE, 1.0f / (ACT_SCALE8 * W_SCALE8), HID_SCALE8});
    else gemm_grouped<false>(F, ws + WS_XG, D, D, ws + W_MGU + (size_t)l * 8 * 2 * FE * 1024 * 2, (size_t)2 * FE * 1024 * 2, 2 * FE, pb, pg8::EpiPair<1>{(bf16*)big, FE, 1.0f});
}
template <bool F8>
__device__ __forceinline__ void moe_gemm2(Frame& F, int l, const unsigned* pb) {
    unsigned char* ws = F.ws; unsigned char* big = ws + WS_BIG;
    if (F8) gemm_grouped<true>(F, big, FE / 2, FE / 2, ws + W_MD + (size_t)l * 8 * 1024 * FE * 2, (size_t)1024 * FE, 1024, pb, pg8::EpiBf16{(bf16*)(ws + WS_XG), D, nullptr, 1.0f / (HID_SCALE8 * W_SCALE8)});
    else gemm_grouped<false>(F, big, FE, FE, ws + W_MD + (size_t)l * 8 * 1024 * FE * 2, (size_t)1024 * FE * 2, 1024, pb, pg8::EpiBf16{(bf16*)(ws + WS_XG), D, nullptr, 1.0f});
}
#define W_DENSE_LIST(X) \
    for (int j = 0; j < 2; ++j) { \
        X(PC_CONV_IN, 0, in[5] + (size_t)j * 1024 * 3072, 1024, 1024, 3072, W_CINB + (size_t)j * 1024 * 1024 * 2, CM_CIN + j * 3072) \
        X(PC_CONV_IN, 1, in[5] + (size_t)j * 1024 * 3072 + 1024, 1024, 2048, 3072, W_CINCU + (size_t)j * 2048 * 1024 * 2, CM_CIN + j * 3072 + 1024) \
        X(0, 0, in[7] + (size_t)j * 1024 * 1024, 1024, 1024, 1024, W_COUT + (size_t)j * 1024 * 1024 * 2, 0) \
        X(PC_FFN_GU, 1, in[19] + (size_t)j * 1024 * 2 * FF, 1024, 2 * FF, 2 * FF, W_FGU + (size_t)j * 2 * FF * 1024 * 2, CM_FGU + j * 5632) \
        X(PC_FFN_DN, 0, in[20] + (size_t)j * FF * 1024, FF, 1024, 1024, W_FD + (size_t)j * 1024 * FF * 2, 0) \
    } \
    X(PC_MDN, 0, in[8], 1024, MDN, MDN, W_MDN, CM_MDN) \
    X(0, 0, in[10], QL, 1536, 1536, W_MUQ, 0) \
    X(0, 0, in[12], KVL, 2048, 2048, W_MUKV, 0) \
    X(0, 0, in[13], 1024, 1024, 1024, W_MO, 0) \
    X(PC_SQKV, 0, in[14], 1024, SQKV, SQKV, W_SQKV, CM_SQKV) \
    X(0, 0, in[17], 1024, 1024, 1024, W_SO, 0)
__device__ __forceinline__ void prologue_a(Frame& F) {
    const float* const* in = F.in; unsigned char* ws = F.ws; unsigned* cmw = (unsigned*)(ws + WS_CTL) + CW_CMAX;
    int rot = 0;
#define XA(PC, MAP, W, K, N, ldw, dst, cm) { if ((PC) == 2) cmax_matrix(F, (W), (K), (N), (ldw), cmw + (cm), rot); else if ((PC) == 1) tr_matrix8<MAP>(F, (W), (K), (N), (ldw), ws + (dst), rot, W_SCALE8); else tr_matrix<MAP>(F, (W), (K), (N), (ldw), (bf16*)(ws + (dst)), rot); rot += 37; }
    W_DENSE_LIST(XA)
#undef XA
    for (int le = 0; le < 16; ++le) {
        const bool f8 = (le < 8) ? (MOE_F8_A != 0) : (MOE_F8_B != 0);
        const size_t l = le >> 3, e = le & 7;
        if (f8) { tr_matrix8<1>(F, in[22] + (size_t)le * 1024 * 2 * FE, 1024, 2 * FE, 2 * FE, ws + W_MGU + l * 8 * 2 * FE * 1024 * 2 + e * 2 * FE * 1024, rot, W_SCALE8); rot += 37;
                  tr_matrix8<0>(F, in[23] + (size_t)le * FE * 1024, FE, 1024, 1024, ws + W_MD + l * 8 * 1024 * FE * 2 + e * 1024 * FE, rot, W_SCALE8); rot += 37; }
        else { tr_matrix<1>(F, in[22] + (size_t)le * 1024 * 2 * FE, 1024, 2 * FE, 2 * FE, (bf16*)(ws + W_MGU + (size_t)le * 2 * FE * 1024 * 2), rot); rot += 37;
               tr_matrix<0>(F, in[23] + (size_t)le * FE * 1024, FE, 1024, 1024, (bf16*)(ws + W_MD + (size_t)le * 1024 * FE * 2), rot); rot += 37; }
    }
    const TC tc = tc_get();
    const int gt = F.vcu * NTHREADS + tc.tid, NGT = F.G * NTHREADS;
    { const int esz = PC_MDN ? 1 : 2; for (int i = gt; i < (MDNP - MDN) * 1024 * esz / 4; i += NGT) ((unsigned*)(ws + W_MDN + (size_t)MDN * 1024 * esz))[i] = 0u;
      if (PC_MDN == 2) for (int i = gt; i < MDNP - MDN; i += NGT) ((float*)(ws + WS_CS))[CM_MDN + MDN + i] = 0.f; }
    for (int i = gt; i < 2 * 8 * 1024; i += NGT) { const int l = i >> 13, e = (i >> 10) & 7, k = i & 1023; ((float*)(ws + W_RT))[i] = in[21][(size_t)l * 1024 * 8 + k * 8 + e]; }
    rope_table(F, (const int*)in[1], (float*)(ws + WS_ROPE));
}
__device__ __forceinline__ void prologue_b(Frame& F) {
    const float* const* in = F.in; unsigned char* ws = F.ws; const unsigned* cmw = (const unsigned*)(ws + WS_CTL) + CW_CMAX; float* csw = (float*)(ws + WS_CS);
    int rot = 0;
#define XB(PC, MAP, W, K, N, ldw, dst, cm) { if ((PC) == 2) tr_matrix_i8<MAP>(F, (W), (K), (N), (ldw), ws + (dst), rot, cmw + (cm), csw + (cm)); rot += 37; }
    W_DENSE_LIST(XB)
#undef XB
}

__device__ __forceinline__ void mla_attention(Frame& F) {
    unsigned char* big = F.ws + WS_BIG;
    const bf16* Q = (const bf16*)(big + B_MQ); const bf16* Kf = (const bf16*)(big + B_MK); const bf16* V = (const bf16*)(big + B_MV); bf16* O = (bf16*)(big + B_MO);
    const float* tab = (const float*)(F.ws + WS_ROPE);
    for (int L = blockIdx.x; L < NB * MH * 16; L += F.G) {
        const int xcd = L & 7, kk = L >> 3, bh = xcd * 8 + (kk >> 4), x = kk & 15, b = bh >> 3, h = bh & 7;
        for (int pass = 0; pass < 2; ++pass) {
            const int qb = pass ? 31 - x : x; const size_t row0 = (size_t)b * SEQ + qb * 256;
            att::Params p;
            p.Q = Q + row0 * 1536 + h * DQKM; p.ldq = 1536;
            p.K = Kf + (size_t)bh * SEQ * DQKM; p.ldk = DQKM; p.V = V + (size_t)bh * SEQ * DVM; p.ldv = DVM;
            p.O = O + row0 * 1024 + h * DVM; p.ldo = 1024; p.P0 = qb * 256; p.j_lo = 0; p.j_hi = 4 * (qb + 1);
            p.rope = tab + row0 * 64; p.pos = nullptr; p.slope_over_scale = 0.f; p.sink_l2 = 0.f;
            att::attn_block<192, 128, 0, (1 << 30)>(p, F.lds);
        }
    }
}
__device__ __forceinline__ void swa_attention(Frame& F) {
    unsigned char* big = F.ws + WS_BIG;
    const bf16* QKV = (const bf16*)(big + B_SQKV); bf16* O = (bf16*)(big + B_SO);
    const int* pos = (const int*)F.in[1]; const float* sinks = F.in[16];
    for (int L = blockIdx.x; L < NB * 16 * 32; L += F.G) {
        const int xcd = L & 7, kk = L >> 3, pair = xcd * 2 + (kk >> 8), u = kk & 255, qb = u >> 3, g = u & 7, b = pair >> 1, kvh = pair & 1, qh = kvh * 8 + g;
        const size_t row0 = (size_t)b * SEQ + qb * 256;
        att::Params p;
        p.Q = QKV + row0 * SQKV + qh * 64; p.ldq = SQKV;
        p.K = QKV + (size_t)b * SEQ * SQKV + 1024 + kvh * 64; p.ldk = SQKV; p.V = QKV + (size_t)b * SEQ * SQKV + 1152 + kvh * 64; p.ldv = SQKV;
        p.O = O + row0 * 1024 + qh * 64; p.ldo = 1024; p.P0 = qb * 256; p.j_lo = qb ? 4 * qb - 2 : 0; p.j_hi = 4 * qb + 4;
        p.rope = nullptr; p.pos = pos + (size_t)b * SEQ;
        p.slope_over_scale = __builtin_amdgcn_exp2f(-0.5f * (float)(qh + 1)) * 8.0f;
        p.sink_l2 = sinks[qh] * 1.4426950408889634f;
        att::attn_block<64, 64, 1, 128>(p, F.lds);
    }
}

struct Args { const float* in[24]; float* out; unsigned char* ws; int ph_lo, ph_hi; };
constexpr int N_PHASES = 33;
__global__ void __launch_bounds__(NTHREADS, 2) mega(Args args) {
    extern __shared__ __attribute__((aligned(16))) unsigned char lds_raw[];
    Frame F;
    F.lds = (char*)lds_raw;
    F.G = gridDim.x; { const int bx = blockIdx.x; F.vcu = (F.G % 8 == 0) ? (bx % 8) * (F.G / 8) + bx / 8 : bx; }
    F.ws = args.ws; F.out = args.out; F.in = args.in;
    unsigned char* ws = args.ws; unsigned char* big = ws + WS_BIG;
    unsigned* ctl = (unsigned*)(ws + WS_CTL);
    volatile LAS unsigned* misc = (volatile LAS unsigned*)((LAS unsigned char*)lds_raw + MISC_OFF);
    if (threadIdx.x < 32) misc[threadIdx.x] = 0u;
    __syncthreads();
    const int lo = args.ph_lo, hi = args.ph_hi;
    XcdBarrier bar; bar.bar = ctl + CW_BAR; bar.x = 0; bar.st = nullptr;
    if (hi - lo > 1) bar = xcd_barrier_post(ctl + CW_BAR, misc + 8);
#ifndef PH_SEL
#define PH_SEL -1
#endif
#define IN(k) ((PH_SEL < 0 || PH_SEL == (k)) && lo <= (k) && (k) < hi)
#ifndef PROBE_MASK
#define PROBE_MASK 0ull
#endif
#define REP(k) for (int rep_ = 0; rep_ < (((PROBE_MASK >> (k)) & 1ull) ? 2 : 1); ++rep_)
#define SEAM(k) do { if (IN(k) && IN((k) + 1)) xcd_barrier(bar); } while (0)
    const float* x_in = args.in[0]; float* X = args.out;
    bf16* XN = (bf16*)(ws + WS_XN); bf16* XG = (bf16*)(ws + WS_XG);
    unsigned* rt_e = (unsigned*)(ws + RT_E); float* rt_w0 = (float*)(ws + RT_W0); float* rt_w1 = (float*)(ws + RT_W1); int* rt_s0 = (int*)(ws + RT_S0); int* rt_s1 = (int*)(ws + RT_S1);
    unsigned* rt_cnt = (unsigned*)(ws + RT_CNT); unsigned* rt_pb = (unsigned*)(ws + RT_PB);
    const float* nmix = args.in[2]; const float* nffn = args.in[3];

    constexpr float S_AW = 1.0f / (ACT_SCALE8 * W_SCALE8), S_HW = 1.0f / (HID_SCALE8 * W_SCALE8);
    constexpr bool MA8 = MOE_F8_A != 0, MB8 = MOE_F8_B != 0;
    bf16* Bc = (bf16*)(big + B_CONV_B); bf16* Vc = (bf16*)(big + B_CONV_V); bf16* Yc = (bf16*)(big + B_CONV_Y);
    float* rsA = (float*)(ws + WS_RS); const float* csw = (const float*)(ws + WS_CS);
#define ASC(PC) ((PC) == 1 ? S_AW : 1.0f)
#define ROWPASS(MODE, COMB, OM, ...) do { RowArgs a{}; a.Xsrc = X; a.XN = XN; a.rs = rsA; __VA_ARGS__; row_pass<MODE, COMB, OM>(F, a); } while (0)
#define CONV_IN(j) do { gemm_static<PC_CONV_IN>(F, XN, D, D, ws + W_CINB + (size_t)(j) * 1024 * 1024 * 2, 1024, pg8::EpiBf16{Bc, D, nullptr, ASC(PC_CONV_IN)}, rsA, csw + CM_CIN + (j) * 3072); \
                        gemm_static<PC_CONV_IN>(F, XN, D, D, ws + W_CINCU + (size_t)(j) * 2048 * 1024 * 2, 2048, pg8::EpiPair<0>{Vc, D, ASC(PC_CONV_IN)}, rsA, csw + CM_CIN + (j) * 3072 + 1024); } while (0)
#define CONV_OUT(j, src) gemm_static<0>(F, Yc, D, D, ws + W_COUT + (size_t)(j) * 1024 * 1024 * 2, 1024, pg8::EpiRes{(src), X, D, nullptr, 1.0f})
#define FFN_GU(f) do { if constexpr (PC_FFN_DN == 1) gemm_static<PC_FFN_GU>(F, XN, D, D, ws + W_FGU + (size_t)(f) * 2 * FF * 1024 * 2, 2 * FF, pg8::EpiPair8{big + B_HMID, FF, ASC(PC_FFN_GU), HID_SCALE8}, rsA, csw + CM_FGU + (f) * 5632); \
                       else gemm_static<PC_FFN_GU>(F, XN, D, D, ws + W_FGU + (size_t)(f) * 2 * FF * 1024 * 2, 2 * FF, pg8::EpiPair<1>{(bf16*)(big + B_HMID), FF, ASC(PC_FFN_GU)}, rsA, csw + CM_FGU + (f) * 5632); } while (0)
#define FFN_DN(f) gemm_static<PC_FFN_DN>(F, big + B_HMID, FF, FF, ws + W_FD + (size_t)(f) * 1024 * FF * 2, 1024, pg8::EpiRes{X, X, D, nullptr, PC_FFN_DN == 1 ? S_HW : 1.0f})

    if (IN(0)) REP(0) { prologue_a(F); xcd_barrier(bar); prologue_b(F); __syncthreads(); ROWPASS(0, false, PC_CONV_IN, a.Xsrc = x_in; a.g = nmix); }
    SEAM(0);
    if (IN(1)) REP(1) CONV_IN(0);
    SEAM(1);
    if (IN(2)) REP(2) conv_pass<false>(F, Bc, Vc, args.in[6], Yc);
    SEAM(2);
    if (IN(3)) REP(3) CONV_OUT(0, x_in);
    SEAM(3);
    if (IN(4)) REP(4) ROWPASS(0, false, PC_FFN_GU, a.g = nffn);
    SEAM(4);
    if (IN(5)) REP(5) FFN_GU(0);
    SEAM(5);
    if (IN(6)) REP(6) FFN_DN(0);
    SEAM(6);
    if (IN(7)) REP(7) ROWPASS(0, false, PC_MDN, a.g = nmix + D);
    SEAM(7);
    if (IN(8)) REP(8) gemm_static<PC_MDN>(F, XN, D, D, ws + W_MDN, MDNP, pg8::EpiF32{(float*)(big + B_MC), MDNP, ASC(PC_MDN)}, rsA, csw + CM_MDN);
    SEAM(8);
    if (IN(9)) REP(9) mla_mid(F, (const float*)(big + B_MC), args.in[9], args.in[11], (const float*)(ws + WS_ROPE), (bf16*)(big + B_MCQ), (bf16*)(big + B_MCKV), (bf16*)(big + B_MK));
    SEAM(9);
    if (IN(10)) REP(10) { gemm_static(F, big + B_MCQ, QL, QL, ws + W_MUQ, 1536, pg8::EpiBf16{(bf16*)(big + B_MQ), 1536, nullptr, 1.0f});
                          gemm_static(F, big + B_MCKV, KVL, KVL, ws + W_MUKV, 2048, pg8::EpiKV{(bf16*)(big + B_MK), (bf16*)(big + B_MV)}); }
    SEAM(10);
    if (IN(11)) REP(11) mla_attention(F);
    SEAM(11);
    if (IN(12)) REP(12) gemm_static(F, big + B_MO, D, D, ws + W_MO, 1024, pg8::EpiRes{X, X, D, nullptr, 1.0f});
    SEAM(12);
    if (IN(13)) REP(13) ROWPASS(1, false, MA8 ? 1 : 0, a.g = nffn + D; a.routerT = (const float*)(ws + W_RT); a.rt_e = rt_e; a.rt_w0 = rt_w0; a.rt_w1 = rt_w1; a.cnt = rt_cnt);
    SEAM(13);
    if (IN(14)) REP(14) moe_assign<MA8>(F, rt_cnt, rt_e, rt_s0, rt_s1, rt_pb, XN, XG);
    SEAM(14);
    if (IN(15)) REP(15) moe_gemm1<MA8>(F, 0, rt_pb);
    SEAM(15);
    if (IN(16)) REP(16) moe_gemm2<MA8>(F, 0, rt_pb);
    SEAM(16);
    if (IN(17)) REP(17) ROWPASS(0, true, PC_SQKV, a.Xdst = X; a.g = nmix + 2 * D; a.Y = XG; a.s0 = rt_s0; a.s1 = rt_s1; a.w0 = rt_w0; a.w1 = rt_w1);
    SEAM(17);
    if (IN(18)) REP(18) gemm_static<PC_SQKV>(F, XN, D, D, ws + W_SQKV, SQKV, pg8::EpiBf16{(bf16*)(big + B_SQKV), SQKV, args.in[15], ASC(PC_SQKV)}, rsA, csw + CM_SQKV);
    SEAM(18);
    if (IN(19)) REP(19) swa_attention(F);
    SEAM(19);
    if (IN(20)) REP(20) gemm_static(F, big + B_SO, D, D, ws + W_SO, 1024, pg8::EpiRes{X, X, D, args.in[18], 1.0f});
    SEAM(20);
    if (IN(21)) REP(21) ROWPASS(0, false, PC_FFN_GU, a.g = nffn + 2 * D);
    SEAM(21);
    if (IN(22)) REP(22) FFN_GU(1);
    SEAM(22);
    if (IN(23)) REP(23) FFN_DN(1);
    SEAM(23);
    if (IN(24)) REP(24) ROWPASS(0, false, PC_CONV_IN, a.g = nmix + 3 * D);
    SEAM(24);
    if (IN(25)) REP(25) CONV_IN(1);
    SEAM(25);
    if (IN(26)) REP(26) conv_pass<false>(F, Bc, Vc, args.in[6] + 3 * D, Yc);
    SEAM(26);
    if (IN(27)) REP(27) CONV_OUT(1, X);
    SEAM(27);
    if (IN(28)) REP(28) ROWPASS(1, false, MB8 ? 1 : 0, a.g = nffn + 3 * D; a.routerT = (const float*)(ws + W_RT) + 8 * 1024; a.rt_e = rt_e; a.rt_w0 = rt_w0; a.rt_w1 = rt_w1; a.cnt = rt_cnt);
    SEAM(28);
    if (IN(29)) REP(29) moe_assign<MB8>(F, rt_cnt, rt_e, rt_s0, rt_s1, rt_pb + 16, XN, XG);
    SEAM(29);
    if (IN(30)) REP(30) moe_gemm1<MB8>(F, 1, rt_pb + 16);
    SEAM(30);
    if (IN(31)) REP(31) moe_gemm2<MB8>(F, 1, rt_pb + 16);
    SEAM(31);
    if (IN(32)) REP(32) ROWPASS(2, true, 0, a.g = args.in[4]; a.outF = X; a.Y = XG; a.s0 = rt_s0; a.s1 = rt_s1; a.w0 = rt_w0; a.w1 = rt_w1);
#undef IN
#undef SEAM
}

#ifndef MK_LAUNCH_PER_PHASE
#define MK_LAUNCH_PER_PHASE 0
#endif
extern "C" void kernel_launch(void* const* d_in, const int* in_sizes, int n_in, void* d_out, int out_size, void* d_ws, size_t ws_size, hipStream_t stream) {
    static int grid = 0;
    if (grid == 0) {
        if (n_in != 24 || in_sizes[0] != T * D || out_size != T * D || ws_size < WS_END) { fprintf(stderr, "kernel_launch: unexpected shapes (n_in %d, in0 %d, out %d, ws %zu < %zu); nothing launched\n", n_in, n_in > 0 ? in_sizes[0] : -1, out_size, ws_size, (size_t)WS_END); grid = -1; return; }
        int dev = 0, cus = 0, per_cu = 0;
        if (hipGetDevice(&dev) != hipSuccess || hipDeviceGetAttribute(&cus, hipDeviceAttributeMultiprocessorCount, dev) != hipSuccess) { grid = -1; return; }
        if (hipFuncSetAttribute((const void*)mega, hipFuncAttributeMaxDynamicSharedMemorySize, LDS_BYTES) != hipSuccess) { fprintf(stderr, "kernel_launch: hipFuncSetAttribute failed\n"); grid = -1; return; }
        if (hipOccupancyMaxActiveBlocksPerMultiprocessor(&per_cu, (const void*)mega, NTHREADS, LDS_BYTES) != hipSuccess || per_cu < 1) fprintf(stderr, "kernel_launch: occupancy query reports %d\n", per_cu);
        (void)hipGetLastError();
        grid = cus;
    }
    if (grid < 0) return;
    (void)hipMemsetAsync((char*)d_ws + WS_CTL, 0, CTL_ZERO_BYTES, stream);
    Args a{};
    for (int i = 0; i < 24; ++i) a.in[i] = (const float*)d_in[i];
    a.out = (float*)d_out; a.ws = (unsigned char*)d_ws;
#if MK_LAUNCH_PER_PHASE
    for (int p = 0; p < N_PHASES; ++p) { a.ph_lo = p; a.ph_hi = p + 1; hipLaunchKernelGGL(mega, dim3(grid), dim3(NTHREADS), LDS_BYTES, stream, a); }
#else
    a.ph_lo = 0; a.ph_hi = N_PHASES; hipLaunchKernelGGL(mega, dim3(grid), dim3(NTHREADS), LDS_BYTES, stream, a);
#endif
}
```

```cpp
#include <hip/hip_runtime.h>
#include <cstdio>
#include <cstdint>

#define LAS __attribute__((address_space(3)))
#define GAS __attribute__((address_space(1)))
typedef unsigned short bf16;
typedef short bf16x8 __attribute__((ext_vector_type(8)));
typedef short s16x4 __attribute__((ext_vector_type(4)));
typedef float f32x2 __attribute__((ext_vector_type(2)));
typedef float f32x4 __attribute__((ext_vector_type(4)));
typedef float f32x16 __attribute__((ext_vector_type(16)));
typedef unsigned u32x2 __attribute__((ext_vector_type(2)));
typedef unsigned u32x4 __attribute__((ext_vector_type(4)));

__device__ __forceinline__ unsigned cvt_pk_bf16(float lo, float hi) { unsigned r; asm volatile("v_cvt_pk_bf16_f32 %0, %1, %2" : "=v"(r) : "v"(lo), "v"(hi)); return r; }
__device__ __forceinline__ float bf2f(unsigned short b) { return __uint_as_float(((unsigned)b) << 16); }
__device__ __forceinline__ float bflo(unsigned w) { return __uint_as_float(w << 16); }
__device__ __forceinline__ float bfhi(unsigned w) { return __uint_as_float(w & 0xffff0000u); }
__device__ __forceinline__ float wave_sum(float v) {
#pragma unroll
    for (int o = 1; o < 64; o <<= 1) v += __shfl_xor(v, o);
    return v;
}
__device__ __forceinline__ float fast_silu(float g) { return g * __builtin_amdgcn_rcpf(1.0f + __builtin_amdgcn_exp2f(-1.4426950408889634f * g)); }

namespace pg8 {
constexpr int BM = 256, BK = 64, HALF = 128, HTB = HALF * BK * 2, STAGE_BYTES = 8 * HTB, NXCD = 8, WGM = 8;
__host__ __device__ __forceinline__ int lds_byte(int r, int c) { const int st = (r >> 4) * 2 + (c >> 5), rr = r & 15, cc = c & 31, ob = rr * 64 + cc * 2; return st * 1024 + (ob ^ (((ob >> 9) & 1) << 5)); }
__host__ __device__ __forceinline__ void stage_rc(int b, int& R, int& C) { const int st = b / 1024, sb = b % 1024, swz = sb ^ (((sb >> 9) & 1) << 5); R = (st >> 1) * 16 + swz / 64; C = (st & 1) * 32 + (swz % 64) / 2; }
__host__ __device__ __forceinline__ int perm32(int rho) { const int n = rho >> 4, i = rho & 15; return 8 * (i >> 2) + 4 * n + (i & 3); }

struct Unit { int pm, pn, e, qm = 15; };
struct Gemm { const bf16* A; const bf16* Bt; int lda, K; size_t estride; const float* rs; const float* cs; int cs_estride; unsigned long long* diag; const int* gidx = nullptr; };

struct StaticOrder {
    const LAS unsigned* tab;
    __device__ __forceinline__ void init(int M, int N, int G, int c, LAS unsigned* table, int cap) {
        const int tid = threadIdx.x; const int nM = M / BM, nN = N / BM, nwg = nM * nN;
        if (tid < cap) {
            unsigned w = 0u; const long L = (long)tid * G + c;
            if (L < nwg) {
                int wgid = (int)L; { const int q = nwg / NXCD, r = nwg % NXCD, xcd = wgid % NXCD, off = wgid / NXCD; wgid = (xcd < r ? xcd * (q + 1) : r * (q + 1) + (xcd - r) * q) + off; }
                const int nig = WGM * nN, gid = wgid / nig, fm = gid * WGM, gsz = (nM - fm) < WGM ? (nM - fm) : WGM;
                w = (unsigned)(fm + ((wgid % nig) % gsz)) | ((unsigned)((wgid % nig) / gsz) << 12) | 0x80000000u;
            }
            table[tid] = w;
        }
        tab = table;
        __syncthreads();
    }
    __device__ __forceinline__ void init_panel(int M, int N, int G, int c, LAS unsigned* table, int cap) {
        const int tid = threadIdx.x; const int nM = M / BM, nN = N / BM;
        if (tid < cap) { const int pm = c + (tid / nN) * G, pn = tid % nN; table[tid] = (pm < nM) ? ((unsigned)pm | ((unsigned)pn << 12) | 0x80000000u) : 0u; }
        tab = table;
        __syncthreads();
    }
    __device__ __forceinline__ bool next(int i, Unit& u) const {
        const unsigned w = (unsigned)__builtin_amdgcn_readfirstlane((int)tab[i]);
        u.pm = (int)(w & 0xfffu); u.pn = (int)((w >> 12) & 0xfffu); u.e = 0; return (w >> 31) != 0u;
    }
};
template <bool QSPLIT = false>
struct GroupedOrderT {
    const LAS unsigned* tab;
    __device__ __forceinline__ void init(const unsigned* pbase, int N, int G, int c, LAS unsigned* table, int cap) {
        const int tid = threadIdx.x;
        int pb[9];
#pragma unroll
        for (int i = 0; i < 9; ++i) pb[i] = (int)__hip_atomic_load(pbase + i, __ATOMIC_RELAXED, __HIP_MEMORY_SCOPE_AGENT);
        const int nM = pb[8], nN = N / BM, nwg = nM * nN;
        const int per = nwg / G, left = nwg - per * G; const bool qs = QSPLIT && left > 0 && 4 * left <= G && per < cap;
        if (tid < cap) {
            unsigned w = 0u; long L = (long)tid * G + c; unsigned qm = 15u;
            if (qs && tid >= per) { L = (tid == per && c < 4 * left) ? (long)per * G + (c >> 2) : (long)nwg; qm = 1u << (c & 3); }
            if (L < nwg) {
                int wgid = (int)L; { const int q = nwg / NXCD, r = nwg % NXCD, xcd = wgid % NXCD, off = wgid / NXCD; wgid = (xcd < r ? xcd * (q + 1) : r * (q + 1) + (xcd - r) * q) + off; }
                const int nig = WGM * nN, gid = wgid / nig, fm = gid * WGM, gsz = (nM - fm) < WGM ? (nM - fm) : WGM;
                const int pm = fm + ((wgid % nig) % gsz), pn = (wgid % nig) / gsz;
                int e = 0;
#pragma unroll
                for (int j = 1; j < 8; ++j) e += (pm >= pb[j]) ? 1 : 0;
                w = (unsigned)pm | ((unsigned)pn << 12) | ((unsigned)e << 20) | (qm << 24) | 0x80000000u;
            }
            table[tid] = w;
        }
        tab = table;
        __syncthreads();
    }
    __device__ __forceinline__ bool next(int i, Unit& u) const {
        const unsigned w = (unsigned)__builtin_amdgcn_readfirstlane((int)tab[i]);
        u.pm = (int)(w & 0xfffu); u.pn = (int)((w >> 12) & 0xffu); u.e = (int)((w >> 20) & 0xfu); u.qm = (int)((w >> 24) & 0xfu); return (w >> 31) != 0u;
    }
};
typedef GroupedOrderT<false> GroupedOrder;

struct EpiBf16 {
    static constexpr bool PERM = true;
    bf16* O; int ldc; const float* bias; float scale;
    __device__ __forceinline__ void operator()(const f32x4 (&acc)[2][2][4][2], const Unit& u, int wr, int wc, int fr, int fq) const {
        const int row0 = u.pm * BM + wr * 64 + fr, col0 = u.pn * BM + wc * 32 + 8 * fq;
        f32x4 bv[2][2];
#pragma unroll
        for (int bj = 0; bj < 2; ++bj)
#pragma unroll
            for (int n = 0; n < 2; ++n) bv[bj][n] = bias ? *(const f32x4*)(bias + col0 + bj * HALF + 4 * n) : (f32x4){0.f, 0.f, 0.f, 0.f};
#pragma unroll
        for (int ai = 0; ai < 2; ++ai)
#pragma unroll
            for (int m = 0; m < 4; ++m) { bf16* rowp = O + (size_t)(row0 + ai * HALF + m * 16) * ldc + col0;
#pragma unroll
                for (int bj = 0; bj < 2; ++bj) { const f32x4 v0 = acc[ai][bj][m][0] * scale + bv[bj][0], v1 = acc[ai][bj][m][1] * scale + bv[bj][1];
                    u32x4 w; w.x = cvt_pk_bf16(v0[0], v0[1]); w.y = cvt_pk_bf16(v0[2], v0[3]); w.z = cvt_pk_bf16(v1[0], v1[1]); w.w = cvt_pk_bf16(v1[2], v1[3]);
                    *(u32x4*)(rowp + bj * HALF) = w; } }
    }
};
__device__ __forceinline__ f32x2 swiglu2(f32x2 a, f32x2 b, float c1  , float c2  ) {
    const float inv = __builtin_amdgcn_rcpf(c2), k = __builtin_amdgcn_logf(inv);
    const f32x2 t = a * c1 + k; f32x2 e; e.x = __builtin_amdgcn_exp2f(t.x); e.y = __builtin_amdgcn_exp2f(t.y);
    const f32x2 d = e + inv; f32x2 r; r.x = __builtin_amdgcn_rcpf(d.x); r.y = __builtin_amdgcn_rcpf(d.y);
    return (a * b) * r;
}
#ifndef HW_SAT8
#define HW_SAT8 1
#endif
#if HW_SAT8
#define SAT8(x) (x)
#else
#define SAT8(x) fminf(fmaxf((x), -448.f), 448.f)
#endif
struct EpiF8 {
    static constexpr bool PERM = true;
    unsigned char* O; int ldc; float scale;
    __device__ __forceinline__ void operator()(const f32x4 (&acc)[2][2][4][2], const Unit& u, int wr, int wc, int fr, int fq) const {
        const int row0 = u.pm * BM + wr * 64 + fr, col0 = u.pn * BM + wc * 32 + 8 * fq;
#pragma unroll
        for (int ai = 0; ai < 2; ++ai)
#pragma unroll
            for (int m = 0; m < 4; ++m) { unsigned char* rowp = O + (size_t)(row0 + ai * HALF + m * 16) * ldc + col0;
#pragma unroll
                for (int bj = 0; bj < 2; ++bj) { if (!((u.qm >> (2 * ai + bj)) & 1)) continue;
                    const f32x4 v0 = acc[ai][bj][m][0] * scale, v1 = acc[ai][bj][m][1] * scale; u32x2 w;
                    int t0 = __builtin_amdgcn_cvt_pk_fp8_f32(SAT8(v0[0]), SAT8(v0[1]), 0, false); t0 = __builtin_amdgcn_cvt_pk_fp8_f32(SAT8(v0[2]), SAT8(v0[3]), t0, true);
                    int t1 = __builtin_amdgcn_cvt_pk_fp8_f32(SAT8(v1[0]), SAT8(v1[1]), 0, false); t1 = __builtin_amdgcn_cvt_pk_fp8_f32(SAT8(v1[2]), SAT8(v1[3]), t1, true);
                    w.x = (unsigned)t0; w.y = (unsigned)t1; *(u32x2*)(rowp + bj * HALF) = w; } }
    }
};
template <int ACT  > struct EpiPair {
    static constexpr bool PERM = true;
    bf16* O; int ldc; float sin;
    __device__ __forceinline__ void operator()(const f32x4 (&acc)[2][2][4][2], const Unit& u, int wr, int wc, int fr, int fq) const {
        const int row0 = u.pm * BM + wr * 64 + fr, col0 = u.pn * HALF + wc * 32 + 8 * fq;
#pragma unroll
        for (int ai = 0; ai < 2; ++ai)
#pragma unroll
            for (int m = 0; m < 4; ++m) { bf16* rowp = O + (size_t)(row0 + ai * HALF + m * 16) * ldc + col0;
                f32x4 r[2];
#pragma unroll
                for (int n = 0; n < 2; ++n) { const f32x4 a = acc[ai][0][m][n], b = acc[ai][1][m][n];
                    if (ACT == 1) { const f32x2 lo = swiglu2((f32x2){a[0], a[1]}, (f32x2){b[0], b[1]}, -1.4426950408889634f * sin, sin * sin), hi = swiglu2((f32x2){a[2], a[3]}, (f32x2){b[2], b[3]}, -1.4426950408889634f * sin, sin * sin);
                        r[n] = (f32x4){lo.x, lo.y, hi.x, hi.y}; }
                    else r[n] = (a * b) * (sin * sin); }
                u32x4 w; w.x = cvt_pk_bf16(r[0][0], r[0][1]); w.y = cvt_pk_bf16(r[0][2], r[0][3]); w.z = cvt_pk_bf16(r[1][0], r[1][1]); w.w = cvt_pk_bf16(r[1][2], r[1][3]);
                *(u32x4*)rowp = w; }
    }
};
struct EpiPair8 {
    static constexpr bool PERM = true;
    unsigned char* O; int ldc; float sin, sout;
    __device__ __forceinline__ void operator()(const f32x4 (&acc)[2][2][4][2], const Unit& u, int wr, int wc, int fr, int fq) const {
        const int row0 = u.pm * BM + wr * 64 + fr, col0 = u.pn * HALF + wc * 32 + 8 * fq;
#pragma unroll
        for (int ai = 0; ai < 2; ++ai)
#pragma unroll
            for (int m = 0; m < 4; ++m) { unsigned char* rowp = O + (size_t)(row0 + ai * HALF + m * 16) * ldc + col0;
                float r[8];
#pragma unroll
                for (int n = 0; n < 2; ++n) { const f32x4 a = acc[ai][0][m][n], b = acc[ai][1][m][n];
                    const f32x2 lo = swiglu2((f32x2){a[0], a[1]}, (f32x2){b[0], b[1]}, -1.4426950408889634f * sin, sin * sin * sout), hi = swiglu2((f32x2){a[2], a[3]}, (f32x2){b[2], b[3]}, -1.4426950408889634f * sin, sin * sin * sout);
                    r[4 * n + 0] = SAT8(lo.x); r[4 * n + 1] = SAT8(lo.y); r[4 * n + 2] = SAT8(hi.x); r[4 * n + 3] = SAT8(hi.y); }
                u32x2 w; int t = __builtin_amdgcn_cvt_pk_fp8_f32(r[0], r[1], 0, false); t = __builtin_amdgcn_cvt_pk_fp8_f32(r[2], r[3], t, true); w.x = (unsigned)t;
                t = __builtin_amdgcn_cvt_pk_fp8_f32(r[4], r[5], 0, false); t = __builtin_amdgcn_cvt_pk_fp8_f32(r[6], r[7], t, true); w.y = (unsigned)t;
                *(u32x2*)rowp = w; }
    }
};
struct EpiRes {
    static constexpr bool PERM = false;
    const float* src; float* dst; int ldc; const float* bias; float scale;
    __device__ __forceinline__ void operator()(const f32x4 (&acc)[2][2][4][2], const Unit& u, int wr, int wc, int fr, int fq) const {
        const int row0 = u.pm * BM + wr * 64 + fr, col0 = u.pn * BM + wc * 32 + 4 * fq;
        f32x4 bv[2][2];
#pragma unroll
        for (int bj = 0; bj < 2; ++bj)
#pragma unroll
            for (int n = 0; n < 2; ++n) bv[bj][n] = bias ? *(const f32x4*)(bias + col0 + bj * HALF + n * 16) : (f32x4){0.f, 0.f, 0.f, 0.f};
#pragma unroll
        for (int ai = 0; ai < 2; ++ai)
#pragma unroll
            for (int m = 0; m < 4; ++m) { const size_t off = (size_t)(row0 + ai * HALF + m * 16) * ldc + col0;
                f32x4 s[2][2];
#pragma unroll
                for (int bj = 0; bj < 2; ++bj)
#pragma unroll
                    for (int n = 0; n < 2; ++n) s[bj][n] = *(const f32x4*)(src + off + bj * HALF + n * 16);
#pragma unroll
                for (int bj = 0; bj < 2; ++bj)
#pragma unroll
                    for (int n = 0; n < 2; ++n) *(f32x4*)(dst + off + bj * HALF + n * 16) = s[bj][n] + acc[ai][bj][m][n] * scale + bv[bj][n];
                if (m == 3) asm volatile("" ::: "memory"); }
    }
};
template <bool SRCF>
struct EpiResB {
    static constexpr bool PERM = false;
    const void* src; bf16* dst; int ldc; const float* bias; float scale;
    __device__ __forceinline__ void operator()(const f32x4 (&acc)[2][2][4][2], const Unit& u, int wr, int wc, int fr, int fq) const {
        const int row0 = u.pm * BM + wr * 64 + fr, col0 = u.pn * BM + wc * 32 + 4 * fq;
        f32x4 bv[2][2];
#pragma unroll
        for (int bj = 0; bj < 2; ++bj)
#pragma unroll
            for (int n = 0; n < 2; ++n) bv[bj][n] = bias ? *(const f32x4*)(bias + col0 + bj * HALF + n * 16) : (f32x4){0.f, 0.f, 0.f, 0.f};
#pragma unroll
        for (int ai = 0; ai < 2; ++ai)
#pragma unroll
            for (int m = 0; m < 4; ++m) { const size_t off = (size_t)(row0 + ai * HALF + m * 16) * ldc + col0;
                f32x4 s[2][2];
#pragma unroll
                for (int bj = 0; bj < 2; ++bj)
#pragma unroll
                    for (int n = 0; n < 2; ++n) {
                        if constexpr (SRCF) s[bj][n] = *(const f32x4*)((const float*)src + off + bj * HALF + n * 16);
                        else { const u32x2 w = *(const u32x2*)((const bf16*)src + off + bj * HALF + n * 16); s[bj][n] = (f32x4){bflo(w.x), bfhi(w.x), bflo(w.y), bfhi(w.y)}; } }
#pragma unroll
                for (int bj = 0; bj < 2; ++bj)
#pragma unroll
                    for (int n = 0; n < 2; ++n) { const f32x4 r = s[bj][n] + acc[ai][bj][m][n] * scale + bv[bj][n];
                        u32x2 w; w.x = cvt_pk_bf16(r[0], r[1]); w.y = cvt_pk_bf16(r[2], r[3]); *(u32x2*)(dst + off + bj * HALF + n * 16) = w; }
                if (m == 3) asm volatile("" ::: "memory"); }
    }
};
struct EpiF32 {
    static constexpr bool PERM = false;
    float* C; int ldc; float scale;
    __device__ __forceinline__ void operator()(const f32x4 (&acc)[2][2][4][2], const Unit& u, int wr, int wc, int fr, int fq) const {
        const int row0 = u.pm * BM + wr * 64 + fr, col0 = u.pn * BM + wc * 32 + 4 * fq;
#pragma unroll
        for (int ai = 0; ai < 2; ++ai)
#pragma unroll
            for (int m = 0; m < 4; ++m) { float* rowp = C + (size_t)(row0 + ai * HALF + m * 16) * ldc + col0;
#pragma unroll
                for (int bj = 0; bj < 2; ++bj)
#pragma unroll
                    for (int n = 0; n < 2; ++n) *(f32x4*)(rowp + bj * HALF + n * 16) = acc[ai][bj][m][n] * scale; }
    }
};
template <int K8> struct EpiKVT {
    static constexpr bool PERM = true;
    bf16* Kf; bf16* V; float kscale;
    __device__ __forceinline__ void operator()(const f32x4 (&acc)[2][2][4][2], const Unit& u, int wr, int wc, int fr, int fq) const {
        const int row0 = u.pm * BM + wr * 64 + fr, col0 = wc * 32 + 8 * fq, h = u.pn;
#pragma unroll
        for (int ai = 0; ai < 2; ++ai)
#pragma unroll
            for (int m = 0; m < 4; ++m) { const int row = row0 + ai * HALF + m * 16, b = row >> 13, s = row & 8191; const size_t hr = (size_t)(b * 8 + h) * 8192 + s;
#pragma unroll
                for (int bj = 0; bj < 2; ++bj) { const f32x4 v0 = acc[ai][bj][m][0], v1 = acc[ai][bj][m][1];
                    u32x4 w; w.x = cvt_pk_bf16(v0[0], v0[1]); w.y = cvt_pk_bf16(v0[2], v0[3]); w.z = cvt_pk_bf16(v1[0], v1[1]); w.w = cvt_pk_bf16(v1[2], v1[3]);
                    if (bj == 0) { if (K8) { const int c = col0 >> 6, dl = col0 & 63, a_ = dl >> 4, h_ = (dl >> 3) & 1; u32x2 w8;
                            int t0 = __builtin_amdgcn_cvt_pk_fp8_f32(fminf(fmaxf(v0[0] * kscale, -448.f), 448.f), fminf(fmaxf(v0[1] * kscale, -448.f), 448.f), 0, false); t0 = __builtin_amdgcn_cvt_pk_fp8_f32(fminf(fmaxf(v0[2] * kscale, -448.f), 448.f), fminf(fmaxf(v0[3] * kscale, -448.f), 448.f), t0, true);
                            int t1 = __builtin_amdgcn_cvt_pk_fp8_f32(fminf(fmaxf(v1[0] * kscale, -448.f), 448.f), fminf(fmaxf(v1[1] * kscale, -448.f), 448.f), 0, false); t1 = __builtin_amdgcn_cvt_pk_fp8_f32(fminf(fmaxf(v1[2] * kscale, -448.f), 448.f), fminf(fmaxf(v1[3] * kscale, -448.f), 448.f), t1, true);
                            w8.x = (unsigned)t0; w8.y = (unsigned)t1; *(u32x2*)((unsigned char*)Kf + hr * 192 + 64 * c + 32 * h_ + 8 * a_) = w8; }
                        else *(u32x4*)(Kf + hr * 192 + col0) = w; }
                    else *(u32x4*)(V + hr * 128 + col0) = w; } }
    }
};
typedef EpiKVT<0> EpiKV;

struct EpiK8 {
    static constexpr bool PERM = true;
    unsigned char* K8; float kscale;
    __device__ __forceinline__ void operator()(const f32x4 (&acc)[2][2][4][2], const Unit& u, int wr, int wc, int fr, int fq) const {
        const int row0 = u.pm * BM + wr * 64 + fr, col0 = wc * 32 + 8 * fq, c = col0 >> 6, dl = col0 & 63, a_ = dl >> 4, h_ = (dl >> 3) & 1;
#pragma unroll
        for (int ai = 0; ai < 2; ++ai)
#pragma unroll
            for (int m = 0; m < 4; ++m) { const int row = row0 + ai * HALF + m * 16, b = row >> 13, s = row & 8191;
#pragma unroll
                for (int bj = 0; bj < 2; ++bj) { const size_t hr = (size_t)(b * 8 + 2 * u.pn + bj) * 8192 + s; const f32x4 v0 = acc[ai][bj][m][0] * kscale, v1 = acc[ai][bj][m][1] * kscale; u32x2 w8;
                    int t0 = __builtin_amdgcn_cvt_pk_fp8_f32(SAT8(v0[0]), SAT8(v0[1]), 0, false); t0 = __builtin_amdgcn_cvt_pk_fp8_f32(SAT8(v0[2]), SAT8(v0[3]), t0, true);
                    int t1 = __builtin_amdgcn_cvt_pk_fp8_f32(SAT8(v1[0]), SAT8(v1[1]), 0, false); t1 = __builtin_amdgcn_cvt_pk_fp8_f32(SAT8(v1[2]), SAT8(v1[3]), t1, true);
                    w8.x = (unsigned)t0; w8.y = (unsigned)t1; *(u32x2*)(K8 + hr * 192 + 64 * c + 32 * h_ + 8 * a_) = w8; } }
    }
};
struct EpiVT8 {
    static constexpr bool PERM = true;
    unsigned char* VT; size_t ldt; float vscale;
    __device__ __forceinline__ void operator()(const f32x4 (&acc)[2][2][4][2], const Unit& u, int wr, int wc, int fr, int fq) const {
        const int row0 = u.pm * BM + wr * 64 + fr;
#pragma unroll
        for (int ai = 0; ai < 2; ++ai)
#pragma unroll
            for (int m = 0; m < 4; ++m) { unsigned char* rowp = VT + (size_t)(row0 + ai * HALF + m * 16) * ldt;
#pragma unroll
                for (int bj = 0; bj < 2; ++bj) { const int tok0 = u.pn * BM + bj * HALF + wc * 32 + 8 * fq, k0 = tok0 & 63, pos = (tok0 & ~63) + 16 * (k0 >> 5) + 4 * ((k0 >> 3) & 3);
                    const f32x4 v0 = acc[ai][bj][m][0] * vscale, v1 = acc[ai][bj][m][1] * vscale;
                    int t0 = __builtin_amdgcn_cvt_pk_fp8_f32(SAT8(v0[0]), SAT8(v0[1]), 0, false); t0 = __builtin_amdgcn_cvt_pk_fp8_f32(SAT8(v0[2]), SAT8(v0[3]), t0, true);
                    int t1 = __builtin_amdgcn_cvt_pk_fp8_f32(SAT8(v1[0]), SAT8(v1[1]), 0, false); t1 = __builtin_amdgcn_cvt_pk_fp8_f32(SAT8(v1[2]), SAT8(v1[3]), t1, true);
                    *(unsigned*)(rowp + pos) = (unsigned)t0; *(unsigned*)(rowp + pos + 32) = (unsigned)t1; } }
    }
};

typedef int v8i32 __attribute__((ext_vector_type(8)));
__device__ __forceinline__ v8i32 cat8(bf16x8 a, bf16x8 b) { typedef int v4i32 __attribute__((ext_vector_type(4))); const v4i32 x = __builtin_bit_cast(v4i32, a), y = __builtin_bit_cast(v4i32, b); return __builtin_shufflevector(x, y, 0, 1, 2, 3, 4, 5, 6, 7); }
typedef int v4i32 __attribute__((ext_vector_type(4)));
template <bool B_> struct BoolC { static constexpr bool value = B_; };
template <class Epi, class Sched, int PREC = 0, bool GATH = false, bool QS = false  >
__device__ __forceinline__ void gemm_phase(LAS unsigned char* lds, const Gemm g, const Sched& S, const Epi& E) {
    constexpr bool F8 = (PREC == 1), I8 = (PREC == 2);
    int tid = threadIdx.x; asm volatile("" : "+v"(tid));
    const int wid = __builtin_amdgcn_readfirstlane(tid >> 6), lane = tid & 63, wr = wid >> 2, wc = wid & 3, fr = lane & 15, fq = lane >> 4;
    const int K = g.K, nt = K / BK, lda = g.lda;
    unsigned voffA[2], voffB[2];
#pragma unroll
    for (int i = 0; i < 2; ++i) { int R, C; stage_rc(tid * 16 + i * 8192, R, C); const int Rb = Epi::PERM ? ((R & ~31) + perm32(R & 31)) : R;
        voffA[i] = (unsigned)(R * lda + C) * 2u; voffB[i] = (unsigned)(Rb * K + C) * 2u; }
    unsigned gvc[2][2], gvn[2][2];
#define PG8_GIDX(dst, pm_) do { _Pragma("unroll") for (int h_ = 0; h_ < 2; ++h_) _Pragma("unroll") for (int i_ = 0; i_ < 2; ++i_) { int R_, C_; stage_rc(tid * 16 + i_ * 8192, R_, C_); \
        const unsigned t_ = (unsigned)g.gidx[(pm_) * BM + h_ * HALF + R_]; dst[h_][i_] = ((t_ < 65536u ? t_ : 65535u) * (unsigned)lda + (unsigned)C_) * 2u; } } while (0)
    const size_t kstep = (size_t)(BK * 2);
    const size_t hstepA = (size_t)HALF * lda * 2, hstepB = (size_t)HALF * K * 2;
    const size_t tstepA = 2 * hstepA, tstepB = 2 * hstepB;
    const unsigned ldsw = (unsigned)wid * 1024u;
    const int aoff = lds_byte(wr * 64 + fr, fq * 8), boff = lds_byte(wc * 32 + fr, fq * 8);
#define PG8_SA(b, h) (((b) * 2 + (h)) * HTB)
#define PG8_SB(b, h) ((4 + (b) * 2 + (h)) * HTB)
#define PG8_STAGE(bufoff, gbase, voff) do { _Pragma("unroll") for (int _i = 0; _i < 2; ++_i) \
        __builtin_amdgcn_global_load_lds((const unsigned*)((const char*)(gbase) + (voff)[_i]), (LAS unsigned*)(lds + (bufoff) + ldsw + _i * 8192), 16, 0, 0); } while (0)
#define PG8_STAGE_A(bufoff, gbase, h, nx) do { if constexpr (GATH) { if (nx) PG8_STAGE(bufoff, gbase, gvn[h]); else PG8_STAGE(bufoff, gbase, gvc[h]); } else PG8_STAGE(bufoff, (gbase) + (h) * hstepA, voffA); } while (0)
#define PG8_LDA(dst, b, h) do { _Pragma("unroll") for (int m = 0; m < 4; ++m) _Pragma("unroll") for (int k = 0; k < 2; ++k) dst[m][k] = *(const LAS bf16x8*)(lds + PG8_SA(b, h) + aoff + m * 2048 + k * 1024); } while (0)
#define PG8_LDB(dst, b, h) do { _Pragma("unroll") for (int n = 0; n < 2; ++n) _Pragma("unroll") for (int k = 0; k < 2; ++k) dst[n][k] = *(const LAS bf16x8*)(lds + PG8_SB(b, h) + boff + n * 2048 + k * 1024); } while (0)
#define PG8_MMA(ai, bj, At, Bt) do { __builtin_amdgcn_s_setprio(1); asm volatile("s_nop 1"); _Pragma("unroll") for (int m = 0; m < 4; ++m) _Pragma("unroll") for (int n = 0; n < 2; ++n) { \
        if constexpr (F8) { const v8i32 b8_ = cat8(Bt[n][0], Bt[n][1]), a8_ = cat8(At[m][0], At[m][1]); asm("v_mfma_f32_16x16x128_f8f6f4 %0, %1, %2, %0" : "+v"(acc[ai][bj][m][n]) : "v"(b8_), "v"(a8_)); } \
        else if constexpr (I8) { _Pragma("unroll") for (int k = 0; k < 2; ++k) asm("v_mfma_i32_16x16x64_i8 %0, %1, %2, %0" : "+v"(acc[ai][bj][m][n]) : "v"(Bt[n][k]), "v"(At[m][k])); } \
        else { _Pragma("unroll") for (int k = 0; k < 2; ++k) asm("v_mfma_f32_16x16x32_bf16 %0, %1, %2, %0" : "+v"(acc[ai][bj][m][n]) : "v"(Bt[n][k]), "v"(At[m][k])); } } __builtin_amdgcn_s_setprio(0); } while (0)
#define PG8_MMAZ(ai, bj, At, Bt) do { __builtin_amdgcn_s_setprio(1); asm volatile("s_nop 1"); _Pragma("unroll") for (int m = 0; m < 4; ++m) _Pragma("unroll") for (int n = 0; n < 2; ++n) { \
        if constexpr (F8) { const v8i32 b8_ = cat8(Bt[n][0], Bt[n][1]), a8_ = cat8(At[m][0], At[m][1]); asm("v_mfma_f32_16x16x128_f8f6f4 %0, %1, %2, 0" : "=v"(acc[ai][bj][m][n]) : "v"(b8_), "v"(a8_)); } \
        else if constexpr (I8) { asm("v_mfma_i32_16x16x64_i8 %0, %1, %2, 0" : "=v"(acc[ai][bj][m][n]) : "v"(Bt[n][0]), "v"(At[m][0])); \
            asm("v_mfma_i32_16x16x64_i8 %0, %1, %2, %0" : "+v"(acc[ai][bj][m][n]) : "v"(Bt[n][1]), "v"(At[m][1])); } \
        else { asm("v_mfma_f32_16x16x32_bf16 %0, %1, %2, 0" : "=v"(acc[ai][bj][m][n]) : "v"(Bt[n][0]), "v"(At[m][0])); \
            asm("v_mfma_f32_16x16x32_bf16 %0, %1, %2, %0" : "+v"(acc[ai][bj][m][n]) : "v"(Bt[n][1]), "v"(At[m][1])); } } __builtin_amdgcn_s_setprio(0); } while (0)
#define PG8_WAIT_V(n) asm volatile("s_waitcnt vmcnt(" #n ")" ::: "memory")
#define PG8_WAIT_L(n) asm volatile("s_waitcnt lgkmcnt(" #n ")" ::: "memory")
#define PG8_BAR __builtin_amdgcn_s_barrier()
#define PG8_SCHED __builtin_amdgcn_sched_barrier(0)
    Unit cur, nxt; int ui = 0;
#ifdef DIAG_GEMM
    unsigned long long dg_k = 0, dg_b = 0, dg_e = 0, dg_t = __builtin_amdgcn_s_memrealtime(); const unsigned long long dg_w0 = dg_t, dg_c0 = __builtin_readcyclecounter();
#endif
    if (!S.next(0, cur)) return;
    f32x4 acc[2][2][4][2];
#pragma unroll
    for (int a = 0; a < 2; ++a)
#pragma unroll
        for (int b = 0; b < 2; ++b)
#pragma unroll
            for (int m = 0; m < 4; ++m)
#pragma unroll
                for (int n = 0; n < 2; ++n) acc[a][b][m][n] = (f32x4){0.f, 0.f, 0.f, 0.f};
    bf16x8 At[4][2], B0[2][2], B1[2][2];
    const char* cA = (const char*)g.A + (GATH ? (size_t)0 : (size_t)cur.pm * tstepA); const char* cB = (const char*)g.Bt + (size_t)cur.e * g.estride + (size_t)cur.pn * tstepB;
    if constexpr (GATH) PG8_GIDX(gvc, cur.pm);
    PG8_STAGE(PG8_SB(0, 0), cB, voffB); PG8_STAGE(PG8_SB(0, 1), cB + hstepB, voffB); PG8_STAGE_A(PG8_SA(0, 0), cA, 0, false); PG8_STAGE_A(PG8_SA(0, 1), cA, 1, false);
    if (wr == 1) PG8_BAR;
    PG8_WAIT_V(2); PG8_BAR;
    PG8_STAGE(PG8_SB(1, 0), cB + kstep, voffB); PG8_STAGE_A(PG8_SA(1, 0), cA + kstep, 0, false); PG8_STAGE(PG8_SB(1, 1), cB + hstepB + kstep, voffB);
    PG8_WAIT_V(6); PG8_BAR;
    for (;;) {
        const bool has_next = S.next(ui + 1, nxt);
        const char* nA = (has_next && !GATH) ? (const char*)g.A + (size_t)nxt.pm * tstepA : cA; const char* nB = has_next ? (const char*)g.Bt + (size_t)nxt.e * g.estride + (size_t)nxt.pn * tstepB : cB;
        if constexpr (I8) {
            const float* sp_ = (tid < 256) ? g.rs + (size_t)cur.pm * BM + tid : g.cs + (size_t)cur.e * g.cs_estride + (size_t)cur.pn * BM + (tid - 256);
            __builtin_amdgcn_global_load_lds((const unsigned*)sp_, (LAS unsigned*)(lds + 131072 + 4096 + (ui & 1) * 2048 + wid * 256), 4, 0, 0); }
        if constexpr (GATH) { if (has_next && nxt.pm != cur.pm) PG8_GIDX(gvn, nxt.pm); else {
#pragma unroll
            for (int h_ = 0; h_ < 2; ++h_) { gvn[h_][0] = gvc[h_][0]; gvn[h_][1] = gvc[h_][1]; } } }
        const int qm_ = QS ? cur.qm : 15;
        const bool Q00 = qm_ & 1, Q01 = qm_ & 2, Q10 = qm_ & 4, Q11 = qm_ & 8, QB0 = qm_ & 5, QB1 = qm_ & 10, QA0 = qm_ & 3, QA1 = qm_ & 12;
        auto kbody = [&](const int t, auto zc_) __attribute__((always_inline)) {
            constexpr bool ZC = decltype(zc_)::value;
            const bool last = (t == nt - 2);
            const char* a1 = cA + (size_t)(t + 1) * kstep;
            const char* a2 = last ? nA : cA + (size_t)(t + 2) * kstep; const char* b2 = last ? nB : cB + (size_t)(t + 2) * kstep;
            const char* a3 = a2 + kstep; const char* b3 = b2 + kstep;
            if (QB0) PG8_LDB(B0, 0, 0); if (QB1) PG8_LDB(B1, 0, 1); PG8_SCHED; if (QA0) PG8_LDA(At, 0, 0); PG8_STAGE_A(PG8_SA(1, 1), a1, 1, false);
            PG8_WAIT_V(8); PG8_WAIT_L(0); PG8_BAR; if constexpr (ZC) { if (Q00) PG8_MMAZ(0, 0, At, B0); if (Q01) PG8_MMAZ(0, 1, At, B1); } else { if (Q00) PG8_MMA(0, 0, At, B0); if (Q01) PG8_MMA(0, 1, At, B1); } PG8_BAR; PG8_SCHED;
            if (QA1) PG8_LDA(At, 0, 1); PG8_STAGE(PG8_SB(0, 0), b2, voffB); PG8_STAGE(PG8_SB(0, 1), b2 + hstepB, voffB); PG8_STAGE_A(PG8_SA(0, 0), a2, 0, last);
            PG8_WAIT_V(8); PG8_WAIT_L(0); PG8_BAR; if constexpr (ZC) { if (Q10) PG8_MMAZ(1, 0, At, B0); if (Q11) PG8_MMAZ(1, 1, At, B1); } else { if (Q10) PG8_MMA(1, 0, At, B0); if (Q11) PG8_MMA(1, 1, At, B1); } PG8_BAR; PG8_SCHED;
            if (QB0) PG8_LDB(B0, 1, 0); if (QB1) PG8_LDB(B1, 1, 1); PG8_SCHED; if (QA0) PG8_LDA(At, 1, 0); PG8_STAGE_A(PG8_SA(0, 1), a2, 1, last);
            PG8_WAIT_V(8); PG8_WAIT_L(0); PG8_BAR; if (Q00) PG8_MMA(0, 0, At, B0); if (Q01) PG8_MMA(0, 1, At, B1); PG8_BAR; PG8_SCHED;
            if (QA1) PG8_LDA(At, 1, 1); PG8_STAGE(PG8_SB(1, 0), b3, voffB); PG8_STAGE(PG8_SB(1, 1), b3 + hstepB, voffB); PG8_STAGE_A(PG8_SA(1, 0), a3, 0, last);
            PG8_WAIT_V(8); PG8_WAIT_L(0); PG8_BAR; if (Q10) PG8_MMA(1, 0, At, B0); if (Q11) PG8_MMA(1, 1, At, B1); PG8_BAR; PG8_SCHED;
        };
        kbody(0, BoolC<true>{});
#pragma nounroll
        for (int t = 2; t < nt; t += 2) kbody(t, BoolC<false>{});
        asm volatile("s_nop 15\n\ts_nop 15" ::: "memory");
#ifdef DIAG_GEMM
        { const unsigned long long c = __builtin_amdgcn_s_memrealtime(); dg_k += c - dg_t; dg_t = c; }
#endif
        if (wr == 0) PG8_BAR;
#ifdef DIAG_GEMM
        { const unsigned long long c = __builtin_amdgcn_s_memrealtime(); dg_b += c - dg_t; dg_t = c; }
#endif
        if constexpr (I8) {
            const LAS float* rsl = (const LAS float*)(lds + 131072 + 4096 + (ui & 1) * 2048); const LAS float* csb = rsl + 256 + wc * 32;
            f32x4 cv[2][2];
#pragma unroll
            for (int bj = 0; bj < 2; ++bj)
#pragma unroll
                for (int n = 0; n < 2; ++n) cv[bj][n] = *(const LAS f32x4*)(csb + bj * HALF + (Epi::PERM ? 8 * fq + 4 * n : 16 * n + 4 * fq));
#pragma unroll
            for (int ai = 0; ai < 2; ++ai)
#pragma unroll
                for (int m = 0; m < 4; ++m) { const float rv = rsl[ai * HALF + wr * 64 + m * 16 + fr];
#pragma unroll
                    for (int bj = 0; bj < 2; ++bj)
#pragma unroll
                        for (int n = 0; n < 2; ++n) { const v4i32 iv = __builtin_bit_cast(v4i32, acc[ai][bj][m][n]);
                            acc[ai][bj][m][n] = (f32x4){(float)iv[0], (float)iv[1], (float)iv[2], (float)iv[3]} * cv[bj][n] * rv; } }
        }
        E(acc, cur, wr, wc, fr, fq);
#ifdef DIAG_GEMM
        { const unsigned long long c = __builtin_amdgcn_s_memrealtime(); dg_e += c - dg_t; dg_t = c; }
#endif
        if (!has_next) break;
        cur = nxt; cA = nA; cB = nB; ++ui;
        if constexpr (GATH) {
#pragma unroll
            for (int h_ = 0; h_ < 2; ++h_) { gvc[h_][0] = gvn[h_][0]; gvc[h_][1] = gvn[h_][1]; } }
        if (wr == 1) PG8_BAR;
    }
    PG8_WAIT_V(0);
    PG8_BAR;
#ifdef DIAG_GEMM
    if (g.diag && blockIdx.x == DIAG_BLOCK && tid == 0) { g.diag[0] = dg_k; g.diag[1] = dg_b; g.diag[2] = dg_e; g.diag[3] = __builtin_readcyclecounter() - dg_c0; g.diag[4] = __builtin_amdgcn_s_memrealtime() - dg_w0; g.diag[5] = (unsigned long long)(ui + 1); }
#endif
#undef PG8_SA
#undef PG8_SB
#undef PG8_STAGE
#undef PG8_MMAZ
#undef PG8_STAGE_A
#undef PG8_GIDX
#undef PG8_LDA
#undef PG8_LDB
#undef PG8_MMA
#undef PG8_WAIT_V
#undef PG8_WAIT_L
#undef PG8_BAR
#undef PG8_SCHED
}
}
namespace att {
constexpr int NW = 8, QBLK = 32, KVBLK = 64, QB = NW * QBLK;
__device__ __forceinline__ int crow(int r, int hi) { return (r & 3) + 8 * (r >> 2) + 4 * hi; }
template <int NCB> __device__ __forceinline__ int v_st(int k, int c) { const int kk = (k & ~0xC) | ((k & 4) << 1) | ((k & 8) >> 1); return ((kk >> 3) * NCB + (c >> 5)) * 512 + ((kk & 7) * 32 + (c & 31)) * 2; }
__device__ __forceinline__ int v_rd_base(int lane) { return ((lane & 3) << 3) | (((lane >> 2) & 3) << 6) | (((lane >> 4) & 1) << 5) | (((lane >> 5) & 1) << 8); }

struct Params {
    const bf16* Q; int ldq;
    const bf16* K; int ldk;
    const bf16* V; int ldv;
    bf16* O; int ldo;
    int P0;
    int j_lo, j_hi;
    const float* rope;
    const int* pos;
    float slope_over_scale, sink_l2;
    const float* sinks; int qh0;
};

constexpr float QK8_SCALE = 8.f;
typedef int v8i32a __attribute__((ext_vector_type(8)));
typedef int v4i32a __attribute__((ext_vector_type(4)));
constexpr float O8_SCALE = 32.f;
template <int DQK, int DV, int KIND, int W, bool QK8 = false, bool O8 = false  , bool RES = false>
__device__ __forceinline__ void attn_block(const Params& p, char* lds) {
    constexpr bool PAIR = QK8 && !RES;
    constexpr int NBUF = RES ? 6 : (PAIR ? 4 : 2), NH = RES ? 8 : 1;
    constexpr int NKS = DQK / 64, ND0 = DQK / 16, NCB = DV / 32, NVP = DV / 64;
    constexpr int KT = QK8 ? NKS * 4096 : NKS * 8192, VT = QK8 ? KVBLK * DV : KVBLK * DV * 2;
    constexpr int OFF_K = NBUF * VT, OFF_KP = OFF_K + NBUF * KT, OFF_WS = OFF_KP + NBUF * 256;
    const float SCALE = ((DQK == 192) ? 0.07216878364870322f : 0.125f) * (QK8 ? 1.0f / (QK8_SCALE * QK8_SCALE) : 1.0f);
    const float C2 = 1.4426950408889634f * SCALE;
    constexpr float THR = QK8 ? 2.f : 8.f;
    int tid = threadIdx.x; asm volatile("" : "+v"(tid));
    const int wid = __builtin_amdgcn_readfirstlane(tid >> 6), lane = tid & 63, r32 = lane & 31, hi = lane >> 5;
    LAS unsigned char* lds3 = (LAS unsigned char*)lds; char* V_lds = lds; char* K_lds = lds + OFF_K; float* kp_lds = (float*)(lds + OFF_KP);
    float* ws = (float*)(lds + OFF_WS) + wid * 64; float* li_l = ws, * al_l = ws + 32;
    const int NT = p.j_hi - p.j_lo;
    const int qlo = p.P0 + wid * QBLK, qm = qlo + r32 - 4 * hi;
    unsigned kofs, vofs[NVP];
    if (QK8) { const int key = lane >> 2, lc = (lane & 3) ^ ((key >> 2) & 3); kofs = (unsigned)(key * p.ldk + 16 * lc); }
    else { const int q = wid * 64 + lane, key = q >> 3, c = (q & 7) ^ ((key >> 1) & 7); kofs = (unsigned)(key * p.ldk + c * 8) * 2u; }
    if (QK8) { const int lc = (lane & 3) ^ ((lane >> 4) & 3); vofs[0] = (unsigned)((lane >> 2) * p.ldv + 16 * lc); }
    else
#pragma unroll
    for (int i = 0; i < NVP; ++i) { const int bo = (wid + 8 * i) * 1024 + lane * 16, sub = bo >> 9, within = bo & 511, kk = (sub / NCB) * 8 + (within >> 6), c = (sub % NCB) * 32 + ((within & 63) >> 1);
        const int k = (kk & ~0xC) | ((kk & 4) << 1) | ((kk & 8) >> 1); vofs[i] = (unsigned)(k * p.ldv + c) * 2u; }
    float st_p = 0.f;
#define ST_LOAD(kb, bf) do { \
        const char* kb_ = (const char*)p.K + (size_t)(kb) * (size_t)(QK8 ? p.ldk : p.ldk * 2); const char* vb_ = (const char*)p.V + (size_t)(kb) * (size_t)(p.ldv * 2); \
        if constexpr (QK8) {   \
            { const int pc_ = wid; __builtin_amdgcn_global_load_lds((const unsigned*)(kb_ + kofs + (pc_ & 3) * 16 * p.ldk + (pc_ >> 2) * 64), (LAS unsigned*)(lds3 + OFF_K + (bf) * KT + pc_ * 1024), 16, 0, 0); } \
            if (wid < 4) { const int pc_ = 8 + wid; __builtin_amdgcn_global_load_lds((const unsigned*)(kb_ + kofs + (pc_ & 3) * 16 * p.ldk + (pc_ >> 2) * 64), (LAS unsigned*)(lds3 + OFF_K + (bf) * KT + pc_ * 1024), 16, 0, 0); } \
        } else { _Pragma("unroll") for (int s_ = 0; s_ < NKS; ++s_) __builtin_amdgcn_global_load_lds((const unsigned*)(kb_ + kofs + s_ * 128), (LAS unsigned*)(lds3 + OFF_K + (bf) * KT + s_ * 8192 + wid * 1024), 16, 0, 0); } \
        if constexpr (QK8) __builtin_amdgcn_global_load_lds((const unsigned*)((const char*)p.V + (size_t)(kb) + (size_t)(16 * wid) * (size_t)p.ldv + vofs[0]), (LAS unsigned*)(lds3 + (bf) * VT + wid * 1024), 16, 0, 0); \
        else { _Pragma("unroll") for (int i_ = 0; i_ < NVP; ++i_) __builtin_amdgcn_global_load_lds((const unsigned*)(vb_ + vofs[i_]), (LAS unsigned*)(lds3 + (bf) * VT + (wid + 8 * i_) * 1024), 16, 0, 0); } \
        if (KIND == 1 && !RES && tid < 64) st_p = (float)p.pos[(kb) + tid]; } while (0)
#define ST_WRITE(bf) do { if (KIND == 1 && tid < 64) kp_lds[(bf) * 64 + tid] = st_p; } while (0)
    bf16x8 qr[ND0];
    if constexpr (RES) {
#pragma unroll
        for (int t_ = 0; t_ < NBUF; ++t_) if (t_ < NT) ST_LOAD((p.j_lo + t_) * KVBLK, t_);
        if (tid < NT * KVBLK) kp_lds[tid] = (float)p.pos[p.j_lo * KVBLK + tid];
    } else { ST_LOAD(p.j_lo * KVBLK, 0); if constexpr (PAIR) ST_LOAD((p.j_lo + 1) * KVBLK, 1); }
    { const bf16* qrow = p.Q + (size_t)(wid * QBLK + r32) * p.ldq + hi * 8;
#pragma unroll
      for (int d0 = 0; d0 < ND0; ++d0) qr[d0] = *(const bf16x8*)(qrow + d0 * 16); }
    float pq = 0.f;
    if (KIND == 0) {
        const float* rt = p.rope + (size_t)(wid * QBLK + r32) * 64;
#pragma unroll
        for (int dd = 0; dd < 2; ++dd) {
            const int i0 = dd * 16 + hi * 8;
            const f32x4 c0 = *(const f32x4*)(rt + i0), c1 = *(const f32x4*)(rt + i0 + 4), s0 = *(const f32x4*)(rt + 32 + i0), s1 = *(const f32x4*)(rt + 32 + i0 + 4);
            bf16x8 a = qr[8 + dd], b = qr[10 + dd]; u32x4 ra, rb; float x1[8], x2[8], cs[8], sn[8];
#pragma unroll
            for (int j = 0; j < 4; ++j) { cs[j] = c0[j]; cs[4 + j] = c1[j]; sn[j] = s0[j]; sn[4 + j] = s1[j]; }
#pragma unroll
            for (int j = 0; j < 8; ++j) { x1[j] = bf2f((unsigned short)a[j]); x2[j] = bf2f((unsigned short)b[j]); }
#pragma unroll
            for (int j = 0; j < 4; ++j) { ra[j] = cvt_pk_bf16(x1[2 * j] * cs[2 * j] - x2[2 * j] * sn[2 * j], x1[2 * j + 1] * cs[2 * j + 1] - x2[2 * j + 1] * sn[2 * j + 1]);
                                          rb[j] = cvt_pk_bf16(x2[2 * j] * cs[2 * j] + x1[2 * j] * sn[2 * j], x2[2 * j + 1] * cs[2 * j + 1] + x1[2 * j + 1] * sn[2 * j + 1]); }
            qr[8 + dd] = *reinterpret_cast<bf16x8*>(&ra); qr[10 + dd] = *reinterpret_cast<bf16x8*>(&rb);
        }
    } else { pq = (float)p.pos[qlo + r32]; }
    int ka[4];
#pragma unroll
    for (int j = 0; j < 4; ++j) ka[j] = r32 * 128 + (((2 * j + hi) ^ ((r32 >> 1) & 7)) << 4);
    v8i32a q8[NKS];
    if (QK8) {
#pragma unroll
        for (int c = 0; c < NKS; ++c) {
#pragma unroll
            for (int a_ = 0; a_ < 4; ++a_) { const bf16x8 f = qr[4 * c + a_]; float x[8];
#pragma unroll
                for (int j = 0; j < 8; ++j) x[j] = fminf(fmaxf(bf2f((unsigned short)f[j]) * QK8_SCALE, -448.f), 448.f);
                int t0 = __builtin_amdgcn_cvt_pk_fp8_f32(x[0], x[1], 0, false); t0 = __builtin_amdgcn_cvt_pk_fp8_f32(x[2], x[3], t0, true);
                int t1 = __builtin_amdgcn_cvt_pk_fp8_f32(x[4], x[5], 0, false); t1 = __builtin_amdgcn_cvt_pk_fp8_f32(x[6], x[7], t1, true);
                q8[c][2 * a_] = t0; q8[c][2 * a_ + 1] = t1; } }
        ka[0] = r32 * 64 + (((2 * hi) ^ ((r32 >> 2) & 3)) << 4); ka[1] = r32 * 64 + (((2 * hi + 1) ^ ((r32 >> 2) & 3)) << 4);
    }
    const int vb0 = (int)(uintptr_t)V_lds + v_rd_base(lane);
    float m_reg = -1e30f, l_reg = 0.f; f32x16 o[NCB];
#pragma unroll
    for (int d = 0; d < NCB; ++d) o[d] = f32x16{};
    asm volatile("s_waitcnt vmcnt(0)" ::: "memory");
    if constexpr (!RES) ST_WRITE(0);
    __syncthreads();
    float slope_c = p.slope_over_scale, sink_c = p.sink_l2;
#pragma nounroll
    for (int g = 0; g < NH; ++g) {
    bf16x8 qn[ND0];
    if constexpr (RES) {
        if (g + 1 < NH) { const bf16* qrow = p.Q + (size_t)(wid * QBLK + r32) * p.ldq + hi * 8 + (g + 1) * DQK;
#pragma unroll
            for (int d0 = 0; d0 < ND0; ++d0) qn[d0] = *(const bf16x8*)(qrow + d0 * 16); }
        slope_c = __builtin_amdgcn_exp2f(-0.5f * (float)(p.qh0 + g + 1)) * 8.0f; sink_c = p.sinks[p.qh0 + g] * 1.4426950408889634f;
        m_reg = -1e30f; l_reg = 0.f;
#pragma unroll
        for (int d = 0; d < NCB; ++d) o[d] = f32x16{};
    }
#define TRRD(dst, off) asm volatile("ds_read_b64_tr_b16 %0, %1 offset:%2" : "=&v"(dst) : "v"(vb0), "i"(off) : "memory")
#define TILE(t, BF) do { \
        const int kb_ = (p.j_lo + (t)) * KVBLK; \
        if constexpr (!RES && !PAIR) { if ((t) + 1 < NT) { const int kn_ = kb_ + KVBLK; ST_LOAD(kn_, (BF) ^ 1); } } \
        const bool act_ = (kb_ <= qlo + QBLK - 1) && (kb_ + KVBLK - 1 >= qlo - W + 1); \
        if (act_) { \
            f32x16 p0 = f32x16{}, p1 = f32x16{}; \
            if constexpr (QK8) { \
              _Pragma("unroll") for (int c_ = 0; c_ < NKS; ++c_) { const char* a0_ = K_lds + (BF) * KT + c_ * 4096 + ka[0]; const char* a1_ = K_lds + (BF) * KT + c_ * 4096 + ka[1]; \
                const v8i32a k0 = __builtin_shufflevector(*(const v4i32a*)a0_, *(const v4i32a*)a1_, 0, 1, 2, 3, 4, 5, 6, 7), k1 = __builtin_shufflevector(*(const v4i32a*)(a0_ + 2048), *(const v4i32a*)(a1_ + 2048), 0, 1, 2, 3, 4, 5, 6, 7); \
                p0 = __builtin_amdgcn_mfma_scale_f32_32x32x64_f8f6f4(k0, q8[c_], p0, 0, 0, 0, 0, 0, 0); p1 = __builtin_amdgcn_mfma_scale_f32_32x32x64_f8f6f4(k1, q8[c_], p1, 0, 0, 0, 0, 0, 0); } \
            } else \
            { bf16x8 kf[2][4];                                                  \
              _Pragma("unroll") for (int s_ = 0; s_ < 2; ++s_) { const char* a_ = K_lds + (BF) * KT + ka[s_]; kf[0][2 * s_] = *(const bf16x8*)a_; kf[0][2 * s_ + 1] = *(const bf16x8*)(a_ + 4096); } \
              _Pragma("unroll") for (int g_ = 0; g_ < ND0 / 2; ++g_) { \
                if (g_ + 1 < ND0 / 2) { _Pragma("unroll") for (int s_ = 0; s_ < 2; ++s_) { const int d0 = 2 * (g_ + 1) + s_; const char* a_ = K_lds + (BF) * KT + (d0 >> 2) * 8192 + ka[d0 & 3]; \
                    kf[(g_ + 1) & 1][2 * s_] = *(const bf16x8*)a_; kf[(g_ + 1) & 1][2 * s_ + 1] = *(const bf16x8*)(a_ + 4096); } } \
                __builtin_amdgcn_sched_barrier(0); \
                _Pragma("unroll") for (int s_ = 0; s_ < 2; ++s_) { const int d0 = 2 * g_ + s_; \
                    p0 = __builtin_amdgcn_mfma_f32_32x32x16_bf16(kf[g_ & 1][2 * s_], qr[d0], p0, 0, 0, 0); p1 = __builtin_amdgcn_mfma_f32_32x32x16_bf16(kf[g_ & 1][2 * s_ + 1], qr[d0], p1, 0, 0, 0); } \
                __builtin_amdgcn_sched_barrier(0); } } \
            if (KIND == 1) { const float* kq = kp_lds + (BF) * 64 + 4 * hi; \
                _Pragma("unroll") for (int g_ = 0; g_ < 4; ++g_) { const f32x4 k0 = *(const f32x4*)(kq + 8 * g_), k1 = *(const f32x4*)(kq + 32 + 8 * g_); \
                    _Pragma("unroll") for (int c_ = 0; c_ < 4; ++c_) { p0[4 * g_ + c_] = fmaf(-slope_c, fabsf(pq - k0[c_]), p0[4 * g_ + c_]); p1[4 * g_ + c_] = fmaf(-slope_c, fabsf(pq - k1[c_]), p1[4 * g_ + c_]); } } } \
            if (kb_ + KVBLK - 1 > qlo || kb_ <= qlo + QBLK - 1 - W) { const int dq_ = qm - kb_; const float NEG = -__builtin_inff(); \
                _Pragma("unroll") for (int r = 0; r < 16; ++r) { const int c_ = (r & 3) + 8 * (r >> 2); \
                    if ((unsigned)(dq_ - c_) >= (unsigned)W) p0[r] = NEG; if ((unsigned)(dq_ - c_ - 32) >= (unsigned)W) p1[r] = NEG; } } \
            float pmax; { float m_[4];   \
              _Pragma("unroll") for (int q_ = 0; q_ < 4; ++q_) { m_[q_] = __builtin_fmaxf(__builtin_fmaxf(p0[4 * q_], p0[4 * q_ + 1]), p0[4 * q_ + 2]); m_[q_] = __builtin_fmaxf(__builtin_fmaxf(m_[q_], p0[4 * q_ + 3]), p1[4 * q_]); \
                  m_[q_] = __builtin_fmaxf(__builtin_fmaxf(m_[q_], p1[4 * q_ + 1]), p1[4 * q_ + 2]); m_[q_] = __builtin_fmaxf(m_[q_], p1[4 * q_ + 3]); } \
              pmax = __builtin_fmaxf(__builtin_fmaxf(m_[0], m_[1]), __builtin_fmaxf(m_[2], m_[3])); } \
            { auto rr = __builtin_amdgcn_permlane32_swap(__float_as_uint(pmax), __float_as_uint(pmax), false, false); pmax = fmaxf(__uint_as_float(rr[0]), __uint_as_float(rr[1])); } \
            float mn, alpha; \
            if (__all((pmax - m_reg) * SCALE <= THR)) { mn = m_reg; alpha = 1.f; } \
            else { mn = fmaxf(m_reg, pmax); alpha = __builtin_amdgcn_exp2f((m_reg - mn) * C2); m_reg = mn; } \
            const float mnL = -mn * C2 + (QK8 ? 5.0f : 0.0f); float ps = 0.f;     \
            _Pragma("unroll") for (int r = 0; r < 16; ++r) { p0[r] = __builtin_amdgcn_exp2f(fmaf(p0[r], C2, mnL)); p1[r] = __builtin_amdgcn_exp2f(fmaf(p1[r], C2, mnL)); } \
            { float s_[4] = {0.f, 0.f, 0.f, 0.f}; _Pragma("unroll") for (int r = 0; r < 16; ++r) s_[r & 3] += p0[r] + p1[r]; ps = (s_[0] + s_[1]) + (s_[2] + s_[3]); } \
            { auto rr = __builtin_amdgcn_permlane32_swap(__float_as_uint(ps), __float_as_uint(ps), false, false); ps = __uint_as_float(rr[0]) + __uint_as_float(rr[1]); } \
            l_reg = l_reg * alpha + ps; \
            if constexpr (QK8) { \
                if (__any(alpha < 1.f)) { _Pragma("unroll") for (int d_ = 0; d_ < NCB; ++d_) o[d_] = o[d_] * alpha; }            \
                v8i32a p8; \
                _Pragma("unroll") for (int g_ = 0; g_ < 4; ++g_) { int t0 = __builtin_amdgcn_cvt_pk_fp8_f32(p0[4 * g_], p0[4 * g_ + 1], 0, false); t0 = __builtin_amdgcn_cvt_pk_fp8_f32(p0[4 * g_ + 2], p0[4 * g_ + 3], t0, true); \
                    int t1 = __builtin_amdgcn_cvt_pk_fp8_f32(p1[4 * g_], p1[4 * g_ + 1], 0, false); t1 = __builtin_amdgcn_cvt_pk_fp8_f32(p1[4 * g_ + 2], p1[4 * g_ + 3], t1, true); p8[g_] = t0; p8[4 + g_] = t1; } \
                _Pragma("unroll") for (int d_ = 0; d_ < NCB; ++d_) { const char* a0_ = V_lds + (BF) * VT + d_ * 2048 + ka[0]; const char* a1_ = V_lds + (BF) * VT + d_ * 2048 + ka[1]; \
                    const v8i32a vf = __builtin_shufflevector(*(const v4i32a*)a0_, *(const v4i32a*)a1_, 0, 1, 2, 3, 4, 5, 6, 7); \
                    o[d_] = __builtin_amdgcn_mfma_scale_f32_32x32x64_f8f6f4(vf, p8, o[d_], 0, 0, 0, 0, 0, 0); } \
            } else { \
            bf16x8 pa[4]; \
            _Pragma("unroll") for (int q_ = 0; q_ < 4; ++q_) { const f32x16& P = (q_ < 2) ? p0 : p1; const int B_ = (q_ & 1) * 8; \
                const unsigned a0 = cvt_pk_bf16(P[B_ + 0], P[B_ + 1]), a1 = cvt_pk_bf16(P[B_ + 2], P[B_ + 3]), b0 = cvt_pk_bf16(P[B_ + 4], P[B_ + 5]), b1 = cvt_pk_bf16(P[B_ + 6], P[B_ + 7]); \
                auto r0 = __builtin_amdgcn_permlane32_swap(a0, b0, false, false); auto r1 = __builtin_amdgcn_permlane32_swap(a1, b1, false, false); \
                u32x4 w_ = {r0[0], r1[0], r0[1], r1[1]}; pa[q_] = *reinterpret_cast<bf16x8*>(&w_); } \
            if (__any(alpha < 1.f)) { if (hi == 0) al_l[r32] = alpha; asm volatile("s_waitcnt lgkmcnt(0)" ::: "memory"); \
                _Pragma("unroll") for (int r = 0; r < 16; ++r) { const float a_ = al_l[crow(r, hi)]; _Pragma("unroll") for (int d_ = 0; d_ < NCB; ++d_) o[d_][r] *= a_; } } \
            { s16x4 l_[2][2], h_[2][2]; constexpr int b_ = (BF) * VT;            \
              _Pragma("unroll") for (int k2 = 0; k2 < 2; ++k2) { TRRD(l_[0][k2], b_ + k2 * (1024 * NCB)); TRRD(h_[0][k2], b_ + k2 * (1024 * NCB) + 512 * NCB); } \
              _Pragma("unroll") for (int i_ = 0; i_ < 2 * NCB; ++i_) { \
                if (i_ + 1 < 2 * NCB) { \
                    _Pragma("unroll") for (int k2 = 0; k2 < 2; ++k2) { TRRD(l_[(i_ + 1) & 1][k2], b_ + ((i_ + 1) >> 1) * 512 + (2 * ((i_ + 1) & 1) + k2) * (1024 * NCB)); TRRD(h_[(i_ + 1) & 1][k2], b_ + ((i_ + 1) >> 1) * 512 + (2 * ((i_ + 1) & 1) + k2) * (1024 * NCB) + 512 * NCB); } \
                    asm volatile("s_waitcnt lgkmcnt(4)" ::: "memory"); } \
                else asm volatile("s_waitcnt lgkmcnt(0)" ::: "memory"); \
                __builtin_amdgcn_sched_barrier(0); \
                _Pragma("unroll") for (int k2 = 0; k2 < 2; ++k2) \
                    o[i_ >> 1] = __builtin_amdgcn_mfma_f32_32x32x16_bf16(pa[2 * (i_ & 1) + k2], (bf16x8){l_[i_ & 1][k2][0], l_[i_ & 1][k2][1], l_[i_ & 1][k2][2], l_[i_ & 1][k2][3], h_[i_ & 1][k2][0], h_[i_ & 1][k2][1], h_[i_ & 1][k2][2], h_[i_ & 1][k2][3]}, o[i_ >> 1], 0, 0, 0); \
                __builtin_amdgcn_sched_barrier(0); } } \
            } \
        } \
        if constexpr (!RES && !PAIR) { if ((t) + 1 < NT) { asm volatile("s_waitcnt vmcnt(0)" ::: "memory"); ST_WRITE((BF) ^ 1); } \
        __syncthreads(); } } while (0)
    if constexpr (RES) {
        TILE(0, 0); TILE(1, 1); TILE(2, 2); TILE(3, 3);
        if (NT > 4) { TILE(4, 4); TILE(5, 5); }
    } else if constexpr (PAIR) {
        for (int t = 0; t < NT; t += 4) {
            ST_LOAD((p.j_lo + t + 2) * KVBLK, 2); ST_LOAD((p.j_lo + t + 3) * KVBLK, 3);
            TILE(t, 0); TILE(t + 1, 1);
            asm volatile("s_waitcnt vmcnt(0)" ::: "memory"); __syncthreads();
            if (t + 4 < NT) { ST_LOAD((p.j_lo + t + 4) * KVBLK, 0); ST_LOAD((p.j_lo + t + 5) * KVBLK, 1); }
            TILE(t + 2, 2); TILE(t + 3, 3);
            if (t + 4 < NT) asm volatile("s_waitcnt vmcnt(0)" ::: "memory");
            __syncthreads();
        }
    } else
    for (int t = 0; t < NT; t += 2) {
        TILE(t, 0);
        if (t + 1 < NT) TILE(t + 1, 1);
    }
    if constexpr (QK8) {
        const float rl = __builtin_amdgcn_rcpf(l_reg * QK8_SCALE) * (O8 ? O8_SCALE : 1.0f);
        if (O8) { unsigned char* orow8 = (unsigned char*)p.O + (size_t)(wid * QBLK + r32) * p.ldo + 4 * hi;
#pragma unroll
            for (int d_ = 0; d_ < NCB; ++d_)
#pragma unroll
                for (int g_ = 0; g_ < 4; ++g_) { int t = __builtin_amdgcn_cvt_pk_fp8_f32(o[d_][4 * g_] * rl, o[d_][4 * g_ + 1] * rl, 0, false); t = __builtin_amdgcn_cvt_pk_fp8_f32(o[d_][4 * g_ + 2] * rl, o[d_][4 * g_ + 3] * rl, t, true);
                    *(unsigned*)(orow8 + 32 * d_ + 8 * g_) = (unsigned)t; }
        } else { bf16* orow = p.O + (size_t)(wid * QBLK + r32) * p.ldo + 4 * hi;
#pragma unroll
        for (int d_ = 0; d_ < NCB; ++d_)
#pragma unroll
            for (int g_ = 0; g_ < 4; ++g_) { u32x2 w; w.x = cvt_pk_bf16(o[d_][4 * g_] * rl, o[d_][4 * g_ + 1] * rl); w.y = cvt_pk_bf16(o[d_][4 * g_ + 2] * rl, o[d_][4 * g_ + 3] * rl);
                *(u32x2*)(orow + 32 * d_ + 8 * g_) = w; } }
        __syncthreads();
        return;
    }
    if (KIND == 1) l_reg += __builtin_amdgcn_exp2f(sink_c - m_reg * C2);
    if (hi == 0) li_l[r32] = l_reg;
    asm volatile("s_waitcnt lgkmcnt(0)" ::: "memory");
    bf16* Ow = p.O + (size_t)(wid * QBLK) * p.ldo + (RES && !O8 ? g * DV : 0);
    const int ocol = (RES && O8) ? g * DV : 0;
#pragma unroll
    for (int r = 0; r < 16; ++r) { const int orow = crow(r, hi); const float rl = __builtin_amdgcn_rcpf(li_l[orow]);
#pragma unroll
        for (int d0 = 0; d0 < NCB; ++d0) { const float v = o[d0][r] * rl;
            if (O8) { const float v8 = v * O8_SCALE, v1 = __shfl_down(v8, 1), v2 = __shfl_down(v8, 2), v3 = __shfl_down(v8, 3);
                if ((r32 & 3) == 0) { int t = __builtin_amdgcn_cvt_pk_fp8_f32(v8, v1, 0, false); t = __builtin_amdgcn_cvt_pk_fp8_f32(v2, v3, t, true); *(unsigned*)((unsigned char*)p.O + (size_t)(wid * QBLK + orow) * p.ldo + ocol + d0 * 32 + r32) = (unsigned)t; } }
            else { const float vn = __shfl_xor(v, 1);
            if ((r32 & 1) == 0) *(unsigned*)(Ow + (size_t)orow * p.ldo + d0 * 32 + r32) = cvt_pk_bf16(v, vn); } } }
    if constexpr (RES) { if (g + 1 < NH) {
#pragma unroll
        for (int d0 = 0; d0 < ND0; ++d0) qr[d0] = qn[d0]; } }
    }
    __syncthreads();
#undef TILE
#undef TRRD
#undef ST_LOAD
#undef ST_WRITE
}
constexpr int LDS_MLA = 2 * (64 * 128 * 2) + 2 * (3 * 8192) + 512 + 8 * 256;
constexpr int LDS_SWA = 2 * (64 * 64 * 2) + 2 * 8192 + 512 + 8 * 256;
}
constexpr int NWAVES = 8, NTHREADS = NWAVES * 64;
constexpr int D = 1024, NB = 8, SEQ = 8192, T = NB * SEQ;
constexpr int FF = 2816, NE = 8, FE = 3584;
constexpr int QL = 384, KVL = 256, MH = 8, DQKM = 192, DVM = 128;
constexpr int MDN = 704, MDNP = 768;
constexpr int SQKV = 1280;
constexpr int MAXPAN = 520, MAXSLOT = MAXPAN * 256;
constexpr float EPS = 1e-6f;
constexpr float ACT_SCALE8 = 8.f, HID_SCALE8 = 8.f, W_SCALE8 = 256.f, YC_SCALE8 = 4.f, Y_SCALE8 = 16.f;
constexpr size_t MiB = 1u << 20;
constexpr size_t WS_CTL = 0, CTL_ZERO_BYTES = 1024 * 1024;
constexpr size_t WS_RT = 1 * MiB;
constexpr size_t RT_E = WS_RT, RT_W0 = RT_E + (size_t)T * 4, RT_W1 = RT_W0 + (size_t)T * 4, RT_S0 = RT_W1 + (size_t)T * 4, RT_S1 = RT_S0 + (size_t)T * 4, RT_CNT = RT_S1 + (size_t)T * 4, RT_PB = RT_CNT + 256 * 8 * 4, RT_TOK = RT_PB + 4096;
constexpr size_t WS_RS = 3 * MiB;
constexpr size_t WS_CS = 4 * MiB;
constexpr size_t WS_ROPE = 8 * MiB;
constexpr size_t WS_W = 24 * MiB;
constexpr size_t W_CINB = WS_W, W_CINCU = W_CINB + 2 * (size_t)1024 * 1024 * 2, W_COUT = W_CINCU + 2 * (size_t)2048 * 1024 * 2;
constexpr size_t W_MDN = W_COUT + 2 * (size_t)1024 * 1024 * 2, W_MUQ = W_MDN + (size_t)MDNP * 1024 * 2, W_MUKV = W_MUQ + (size_t)1536 * QL * 2, W_MO = W_MUKV + (size_t)2048 * KVL * 2;
constexpr size_t W_SQKV = W_MO + (size_t)1024 * 1024 * 2, W_SO = W_SQKV + (size_t)SQKV * 1024 * 2;
constexpr size_t W_FGU = W_SO + (size_t)1024 * 1024 * 2, W_FD = W_FGU + 2 * (size_t)(2 * FF) * 1024 * 2;
constexpr size_t W_MGU = W_FD + 2 * (size_t)1024 * FF * 2, W_MD = W_MGU + 16 * (size_t)(2 * FE) * 1024 * 2, W_RT = W_MD + 16 * (size_t)1024 * FE * 2;
constexpr size_t W_END = W_RT + 2 * (size_t)8 * 1024 * 4;
constexpr size_t WS_XN = 420 * MiB;
constexpr size_t WS_XG = 548 * MiB;
constexpr size_t WS_BIG = 808 * MiB;
constexpr size_t WS_END = WS_BIG + (size_t)MAXSLOT * FE * 2;
static_assert(W_END <= WS_XN && WS_XN + (size_t)T * D * 2 <= WS_XG && WS_XG + (size_t)MAXSLOT * D * 2 <= WS_BIG, "d_ws map");
constexpr size_t B_CONV_B = 0, B_CONV_V = 128 * MiB, B_CONV_Y = 256 * MiB;
constexpr size_t B_HMID = 0;
constexpr size_t B_MC = 0, B_MO = 0, B_MCQ = 192 * MiB, B_MCKV = 240 * MiB, B_MQ = 272 * MiB, B_MK = 464 * MiB, B_MV = 656 * MiB;
constexpr size_t B_SQKV = 0, B_SO = 160 * MiB;
constexpr int CW_DBG = 8;
constexpr int CW_BAR = 1024;
constexpr int CW_CMAX = 8192, CM_CIN = 0, CM_FGU = CM_CIN + 2 * 3072, CM_MDN = CM_FGU + 2 * 5632, CM_SQKV = CM_MDN + 768, CM_MGU = 24576, CM_END = CM_MGU + 16 * 7168;
static_assert(CM_SQKV + 1280 <= CM_MGU && (CW_CMAX + CM_END) * 4 <= (int)CTL_ZERO_BYTES, "column-max words inside the memset region");
constexpr int RING_BYTES = 131072, MISC_OFF = RING_BYTES, LDS_BYTES = 147456;

#define RLX_AGENT __ATOMIC_RELAXED, __HIP_MEMORY_SCOPE_AGENT
#define XB_TMO      128
#define XB_XCNT(j)  (256  + 64 * (j))
#define XB_XSUB(j)  (1280 + 64 * (j))
#define XB_XGEN(j)  (2304 + 64 * (j))
#define XB_TOP      3328
#define XB_TOPGEN   3392
#define XCD_BAR_WORDS 3456
#define XB_SPIN_CAP (1u << 18)
__device__ __forceinline__ unsigned xb_ld(unsigned* p)              { return __hip_atomic_load(p, __ATOMIC_RELAXED, __HIP_MEMORY_SCOPE_AGENT); }
__device__ __forceinline__ unsigned xb_add(unsigned* p, unsigned v) { return __hip_atomic_fetch_add(p, v, __ATOMIC_RELAXED, __HIP_MEMORY_SCOPE_AGENT); }
__device__ __forceinline__ unsigned xb_xcc_id() { return (unsigned)__builtin_amdgcn_s_getreg((3 << 11) | 20) & 0xFu; }
#define XB_SPIN(cond, bar) do { unsigned _sp = 0; while (cond) { __builtin_amdgcn_s_sleep(1); \
    if ((++_sp & 255u) == 0u) { if (xb_ld(&(bar)[XB_TMO])) break; if (_sp > XB_SPIN_CAP) { atomicAdd(&(bar)[XB_TMO], 1u); break; } } } } while (0)
struct XcdBarrier { unsigned* bar; unsigned x; volatile LAS unsigned* st; };
__device__ __forceinline__ XcdBarrier xcd_barrier_post(unsigned* bar, volatile LAS unsigned* st) {
    XcdBarrier b; b.bar = bar; b.x = xb_xcc_id(); b.st = st;
    if (threadIdx.x == 0) (void)xb_add(&bar[XB_XCNT(b.x)], 1u);
    return b;
}
__device__ __forceinline__ void xcd_barrier_complete(unsigned* bar, unsigned x, unsigned& nloc, unsigned& nx) {
    const unsigned G = gridDim.x * gridDim.y * gridDim.z;
    unsigned sum, cnt, mine, sp = 0u;
    for (;;) {
        sum = 0u; cnt = 0u; mine = 0u;
#pragma unroll
        for (unsigned j = 0; j < 16; ++j) { const unsigned c = xb_ld(&bar[XB_XCNT(j)]); sum += c; cnt += (c > 0u) ? 1u : 0u; mine = (j == x) ? c : mine; }
        if (sum == G) break;
        __builtin_amdgcn_s_sleep(1);
        if ((++sp & 255u) == 0u) { if (xb_ld(&bar[XB_TMO])) break; if (sp > XB_SPIN_CAP) { atomicAdd(&bar[XB_TMO], 1u); break; } }
    }
    nloc = mine > 0u ? mine : 1u; nx = cnt > 0u ? cnt : 1u;
}
__device__ __forceinline__ void xcd_barrier(const XcdBarrier& b) {
    asm volatile("s_waitcnt vmcnt(0)" ::: "memory");
    __syncthreads();
    if (threadIdx.x == 0) {
        unsigned* bar = b.bar;
        __builtin_amdgcn_s_waitcnt(0);
        unsigned nloc = b.st[0], nx = b.st[1];
        if (nloc == 0u) { xcd_barrier_complete(bar, b.x, nloc, nx); b.st[0] = nloc; b.st[1] = nx; }
        const unsigned old = xb_add(&bar[XB_XSUB(b.x)], 1u);
        const unsigned gen = old / nloc;
        if (old + 1u == (gen + 1u) * nloc) {
            __builtin_amdgcn_fence(__ATOMIC_RELEASE, "agent");
            asm volatile("s_waitcnt vmcnt(0)" ::: "memory");
            const unsigned og = xb_add(&bar[XB_TOP], 1u);
            const unsigned tg = og / nx;
            if (og + 1u == (tg + 1u) * nx) xb_add(&bar[XB_TOPGEN], 1u);
            else XB_SPIN(xb_ld(&bar[XB_TOPGEN]) == tg, bar);
            __builtin_amdgcn_fence(__ATOMIC_ACQUIRE, "agent");
            xb_add(&bar[XB_XGEN(b.x)], 1u);
            asm volatile("s_waitcnt vmcnt(0)" ::: "memory");
        } else {
            XB_SPIN(xb_ld(&bar[XB_XGEN(b.x)]) == gen, bar);
            __builtin_amdgcn_fence(__ATOMIC_ACQUIRE, "agent");
            asm volatile("s_waitcnt vmcnt(0)" ::: "memory");
        }
    }
    __syncthreads();
}

struct TC { int tid, lane, wave; };
__device__ __forceinline__ TC tc_get() { TC t; int x = threadIdx.x; asm volatile("" : "+v"(x)); t.tid = x; t.lane = x & 63; t.wave = __builtin_amdgcn_readfirstlane(x >> 6); return t; }
struct Frame {
    char* lds; int vcu, G;
    unsigned char* ws; float* out;
    const float* const* in;
};
__device__ __forceinline__ float clamp8(float v) { return fminf(fmaxf(v, -448.f), 448.f); }
__device__ __forceinline__ unsigned pk4_fp8(float a, float b, float c, float d, float sc) {
    int t = __builtin_amdgcn_cvt_pk_fp8_f32(clamp8(a * sc), clamp8(b * sc), 0, false); t = __builtin_amdgcn_cvt_pk_fp8_f32(clamp8(c * sc), clamp8(d * sc), t, true); return (unsigned)t; }
#define LDS_WAIT() asm volatile("s_waitcnt lgkmcnt(0)" ::: "memory")
#define VM_WAIT() asm volatile("s_waitcnt vmcnt(0)" ::: "memory")

template <int MAP>
__device__ __forceinline__ void tr_item(const float* W, int K, int N, int ldw, bf16* WT, float* scr, int item, int lane) {
    const int nblk = N / 32, kb = item / nblk, nb = item % nblk, k0 = 64 * kb, n0 = 32 * nb;
    int r0 = n0;
    if (MAP == 1) { const int F = N / 2; r0 = (n0 < F) ? 256 * (n0 / 128) + (n0 % 128) : 256 * ((n0 - F) / 128) + 128 + ((n0 - F) % 128); }
    const float* src = W + (size_t)(k0 + (lane >> 5)) * ldw + n0 + (lane & 31);
#pragma unroll 16
    for (int i = 0; i < 32; ++i) scr[(2 * i + (lane >> 5)) * 33 + (lane & 31)] = src[(size_t)(2 * i) * ldw];
    LDS_WAIT(); asm volatile("" ::: "memory");
    const int c = lane & 7;
#pragma unroll
    for (int j = 0; j < 4; ++j) { const int n = (lane >> 3) + 8 * j; const float* s = scr + (8 * c) * 33 + n;
        u32x4 o; o.x = cvt_pk_bf16(s[0 * 33], s[1 * 33]); o.y = cvt_pk_bf16(s[2 * 33], s[3 * 33]); o.z = cvt_pk_bf16(s[4 * 33], s[5 * 33]); o.w = cvt_pk_bf16(s[6 * 33], s[7 * 33]);
        *(u32x4*)(WT + (size_t)(r0 + n) * K + k0 + 8 * c) = o; }
    LDS_WAIT(); asm volatile("" ::: "memory");
}
template <int MAP>
__device__ __forceinline__ void tr_item8(const float* W, int K, int N, int ldw, unsigned char* WT, float* scr, int item, int lane, float sw) {
    const int nblk = N / 32, kb = item / nblk, nb = item % nblk, k0 = 64 * kb, n0 = 32 * nb;
    int r0 = n0;
    if (MAP == 1) { const int F = N / 2; r0 = (n0 < F) ? 256 * (n0 / 128) + (n0 % 128) : 256 * ((n0 - F) / 128) + 128 + ((n0 - F) % 128); }
    const float* src = W + (size_t)(k0 + (lane >> 5)) * ldw + n0 + (lane & 31);
#pragma unroll 16
    for (int i = 0; i < 32; ++i) scr[(2 * i + (lane >> 5)) * 33 + (lane & 31)] = src[(size_t)(2 * i) * ldw];
    LDS_WAIT(); asm volatile("" ::: "memory");
    const int c = lane & 7;
#pragma unroll
    for (int j = 0; j < 4; ++j) { const int n = (lane >> 3) + 8 * j; const float* s = scr + (8 * c) * 33 + n;
        u32x2 o; int t = __builtin_amdgcn_cvt_pk_fp8_f32(s[0 * 33] * sw, s[1 * 33] * sw, 0, false); t = __builtin_amdgcn_cvt_pk_fp8_f32(s[2 * 33] * sw, s[3 * 33] * sw, t, true); o.x = (unsigned)t;
        t = __builtin_amdgcn_cvt_pk_fp8_f32(s[4 * 33] * sw, s[5 * 33] * sw, 0, false); t = __builtin_amdgcn_cvt_pk_fp8_f32(s[6 * 33] * sw, s[7 * 33] * sw, t, true); o.y = (unsigned)t;
        *(u32x2*)(WT + (size_t)(r0 + n) * K + k0 + 8 * c) = o; }
    LDS_WAIT(); asm volatile("" ::: "memory");
}
template <int MAP>
__device__ __forceinline__ void tr_matrix8(Frame& F, const float* W, int K, int N, int ldw, unsigned char* WT, int rot, float sw) {
    const TC tc = tc_get();
    float* scr = (float*)(F.lds + tc.wave * 8448);
    const int NGW = F.G * NWAVES, gw = (F.vcu * NWAVES + tc.wave + rot) % NGW, nitems = (K / 64) * (N / 32);
    for (int it = gw; it < nitems; it += NGW) tr_item8<MAP>(W, K, N, ldw, WT, scr, it, tc.lane, sw);
}
__device__ __forceinline__ void cmax_matrix(Frame& F, const float* W, int K, int N, int ldw, unsigned* cmax, int rot) {
    const TC tc = tc_get();
    const int NGW = F.G * NWAVES, gw = (F.vcu * NWAVES + tc.wave + rot) % NGW, ncb = (N + 255) / 256, nitems = (K / 64) * ncb;
    for (int it = gw; it < nitems; it += NGW) { const int kb = it / ncb, cb = it % ncb, col = cb * 256 + 4 * tc.lane;
        if (col < N) { const float* src = W + (size_t)(kb * 64) * ldw + col; f32x4 m = {0.f, 0.f, 0.f, 0.f};
#pragma unroll 16
            for (int r = 0; r < 64; ++r) { const f32x4 v = *(const f32x4*)(src + (size_t)r * ldw); m.x = fmaxf(m.x, fabsf(v.x)); m.y = fmaxf(m.y, fabsf(v.y)); m.z = fmaxf(m.z, fabsf(v.z)); m.w = fmaxf(m.w, fabsf(v.w)); }
            atomicMax(cmax + col, __float_as_uint(m.x)); atomicMax(cmax + col + 1, __float_as_uint(m.y)); atomicMax(cmax + col + 2, __float_as_uint(m.z)); atomicMax(cmax + col + 3, __float_as_uint(m.w)); } }
}
template <int MAP>
__device__ __forceinline__ void tr_item_i8(const float* W, int K, int N, int ldw, unsigned char* WT, float* scr, int item, int lane, const unsigned* cmax, float* cs) {
    const int nblk = N / 32, kb = item / nblk, nb = item % nblk, k0 = 64 * kb, n0 = 32 * nb;
    int r0 = n0;
    if (MAP == 1) { const int F = N / 2; r0 = (n0 < F) ? 256 * (n0 / 128) + (n0 % 128) : 256 * ((n0 - F) / 128) + 128 + ((n0 - F) % 128); }
    const float* src = W + (size_t)(k0 + (lane >> 5)) * ldw + n0 + (lane & 31);
#pragma unroll 16
    for (int i = 0; i < 32; ++i) scr[(2 * i + (lane >> 5)) * 33 + (lane & 31)] = src[(size_t)(2 * i) * ldw];
    LDS_WAIT(); asm volatile("" ::: "memory");
    const int c = lane & 7;
#pragma unroll
    for (int j = 0; j < 4; ++j) { const int n = (lane >> 3) + 8 * j; const float* s = scr + (8 * c) * 33 + n;
        const float cm = __uint_as_float(cmax[n0 + n]), inv = cm > 0.f ? 127.0f / cm : 0.f;
        if (kb == 0 && c == 0) cs[r0 + n] = cm * (1.0f / 127.0f);
        unsigned w[2];
#pragma unroll
        for (int h = 0; h < 2; ++h) { const int q0 = __float2int_rn(s[(4 * h + 0) * 33] * inv), q1 = __float2int_rn(s[(4 * h + 1) * 33] * inv), q2 = __float2int_rn(s[(4 * h + 2) * 33] * inv), q3 = __float2int_rn(s[(4 * h + 3) * 33] * inv);
            w[h] = (unsigned)(q0 & 0xff) | ((unsigned)(q1 & 0xff) << 8) | ((unsigned)(q2 & 0xff) << 16) | ((unsigned)q3 << 24); }
        u32x2 o; o.x = w[0]; o.y = w[1];
        *(u32x2*)(WT + (size_t)(r0 + n) * K + k0 + 8 * c) = o; }
    LDS_WAIT(); asm volatile("" ::: "memory");
}
template <int MAP>
__device__ __forceinline__ void tr_matrix_i8(Frame& F, const float* W, int K, int N, int ldw, unsigned char* WT, int rot, const unsigned* cmax, float* cs) {
    const TC tc = tc_get();
    float* scr = (float*)(F.lds + tc.wave * 8448);
    const int NGW = F.G * NWAVES, gw = (F.vcu * NWAVES + tc.wave + rot) % NGW, nitems = (K / 64) * (N / 32);
    for (int it = gw; it < nitems; it += NGW) tr_item_i8<MAP>(W, K, N, ldw, WT, scr, it, tc.lane, cmax, cs);
}
template <int MAP>
__device__ __forceinline__ void tr_matrix(Frame& F, const float* W, int K, int N, int ldw, bf16* WT, int rot) {
    const TC tc = tc_get();
    float* scr = (float*)(F.lds + tc.wave * 8448);
    const int NGW = F.G * NWAVES, gw = (F.vcu * NWAVES + tc.wave + rot) % NGW, nitems = (K / 64) * (N / 32);
    for (int it = gw; it < nitems; it += NGW) tr_item<MAP>(W, K, N, ldw, WT, scr, it, tc.lane);
}

struct RowArgs { const bf16* Xsb; bf16* Xdb; const float* Xsrc; float* Xdst; const float* g; bf16* XN; float* outF; const bf16* Y; const int* s0; const int* s1; const float* w0; const float* w1;
                 const float* routerT; unsigned* rt_e; float* rt_w0; float* rt_w1; unsigned* cnt; float* rs; };
template <int MODE, bool COMBINE, int OUTM = 0  , bool Y8 = false  , bool XBF = false  >
__device__ __forceinline__ void row_pass(Frame& F, const RowArgs& a) {
    const TC tc = tc_get();
    const int lane = tc.lane;
    float* rtab = (float*)F.lds;
    unsigned* wcnt = (unsigned*)(F.lds + 32768);
    if (MODE == 1) { for (int i = tc.tid; i < 8 * 1024; i += NTHREADS) rtab[i] = a.routerT[i]; }
    f32x4 gv[4];
#pragma unroll
    for (int j = 0; j < 4; ++j) gv[j] = *(const f32x4*)(a.g + 4 * lane + 256 * j);
    for (int tb = blockIdx.x; tb < T / 256; tb += F.G) {
        if (MODE == 1) { if (tc.tid < 64) wcnt[tc.tid] = 0u; __syncthreads(); }
        unsigned myc[8] = {0u, 0u, 0u, 0u, 0u, 0u, 0u, 0u};
        for (int rr = 0; rr < 32; ++rr) {
            const int row = tb * 256 + tc.wave * 32 + rr;
            f32x4 v[4];
            if constexpr (XBF) { const u32x2* xr = (const u32x2*)(a.Xsb + (size_t)row * D) + lane;
#pragma unroll
                for (int j = 0; j < 4; ++j) { const u32x2 w = xr[64 * j]; v[j] = (f32x4){bflo(w.x), bfhi(w.x), bflo(w.y), bfhi(w.y)}; }
            } else { const f32x4* xr = (const f32x4*)(a.Xsrc + (size_t)row * D) + lane;
#pragma unroll
                for (int j = 0; j < 4; ++j) v[j] = xr[64 * j]; }
            if (COMBINE) {
                const int sa = a.s0[row], sb = a.s1[row]; const float wa = a.w0[row], wb = a.w1[row];
                if (Y8) { const unsigned* ya = (const unsigned*)((const unsigned char*)a.Y + (size_t)sa * D) + lane; const unsigned* yb = (const unsigned*)((const unsigned char*)a.Y + (size_t)sb * D) + lane;
                    const float wa8 = wa * (1.0f / Y_SCALE8), wb8 = wb * (1.0f / Y_SCALE8);
#pragma unroll
                    for (int j = 0; j < 4; ++j) { const int pa = (int)ya[64 * j], pb = (int)yb[64 * j];
                        v[j].x += wa8 * __builtin_amdgcn_cvt_f32_fp8(pa, 0) + wb8 * __builtin_amdgcn_cvt_f32_fp8(pb, 0); v[j].y += wa8 * __builtin_amdgcn_cvt_f32_fp8(pa, 1) + wb8 * __builtin_amdgcn_cvt_f32_fp8(pb, 1);
                        v[j].z += wa8 * __builtin_amdgcn_cvt_f32_fp8(pa, 2) + wb8 * __builtin_amdgcn_cvt_f32_fp8(pb, 2); v[j].w += wa8 * __builtin_amdgcn_cvt_f32_fp8(pa, 3) + wb8 * __builtin_amdgcn_cvt_f32_fp8(pb, 3); }
                } else {
                const u32x2* ya = (const u32x2*)(a.Y + (size_t)sa * D) + lane; const u32x2* yb = (const u32x2*)(a.Y + (size_t)sb * D) + lane;
#pragma unroll
                for (int j = 0; j < 4; ++j) { const u32x2 pa = ya[64 * j], pb = yb[64 * j];
                    v[j].x += wa * bflo(pa.x) + wb * bflo(pb.x); v[j].y += wa * bfhi(pa.x) + wb * bfhi(pb.x);
                    v[j].z += wa * bflo(pa.y) + wb * bflo(pb.y); v[j].w += wa * bfhi(pa.y) + wb * bfhi(pb.y); } }
                if (MODE != 2) {
                    if constexpr (XBF) { u32x2* xd = (u32x2*)(a.Xdb + (size_t)row * D) + lane;
#pragma unroll
                        for (int j = 0; j < 4; ++j) { u32x2 w; w.x = cvt_pk_bf16(v[j].x, v[j].y); w.y = cvt_pk_bf16(v[j].z, v[j].w); xd[64 * j] = w; }
                    } else { f32x4* xd = (f32x4*)(a.Xdst + (size_t)row * D) + lane;
#pragma unroll
                        for (int j = 0; j < 4; ++j) xd[64 * j] = v[j]; } }
            }
            float ss = 0.f;
#pragma unroll
            for (int j = 0; j < 4; ++j) ss += (v[j].x * v[j].x + v[j].y * v[j].y) + (v[j].z * v[j].z + v[j].w * v[j].w);
            const float rstd = 1.0f / sqrtf(wave_sum(ss) * (1.f / D) + EPS);
#pragma unroll
            for (int j = 0; j < 4; ++j) v[j] = v[j] * rstd * gv[j];
            if (MODE == 2) { f32x4* od = (f32x4*)(a.outF + (size_t)row * D) + lane;
#pragma unroll
                for (int j = 0; j < 4; ++j) od[64 * j] = v[j];
            } else if (OUTM == 2) { float am = 0.f;
#pragma unroll
                for (int j = 0; j < 4; ++j) am = fmaxf(fmaxf(am, fmaxf(fabsf(v[j].x), fabsf(v[j].y))), fmaxf(fabsf(v[j].z), fabsf(v[j].w)));
#pragma unroll
                for (int o = 1; o < 64; o <<= 1) am = fmaxf(am, __shfl_xor(am, o));
                const float inv = am > 0.f ? 127.0f / am : 0.f;
                unsigned* o4 = (unsigned*)((unsigned char*)a.XN + (size_t)row * D) + lane;
#pragma unroll
                for (int j = 0; j < 4; ++j) { const int q0 = __float2int_rn(v[j].x * inv), q1 = __float2int_rn(v[j].y * inv), q2 = __float2int_rn(v[j].z * inv), q3 = __float2int_rn(v[j].w * inv);
                    o4[64 * j] = (unsigned)(q0 & 0xff) | ((unsigned)(q1 & 0xff) << 8) | ((unsigned)(q2 & 0xff) << 16) | ((unsigned)q3 << 24); }
                if (lane == 0) a.rs[row] = am * (1.0f / 127.0f);
            } else if (OUTM == 1) { unsigned* o4 = (unsigned*)((unsigned char*)a.XN + (size_t)row * D) + lane;
#pragma unroll
                for (int j = 0; j < 4; ++j) o4[64 * j] = pk4_fp8(v[j].x, v[j].y, v[j].z, v[j].w, ACT_SCALE8);
            } else { u32x2* o8 = (u32x2*)(a.XN + (size_t)row * D) + lane;
#pragma unroll
                for (int j = 0; j < 4; ++j) { u32x2 w; w.x = cvt_pk_bf16(v[j].x, v[j].y); w.y = cvt_pk_bf16(v[j].z, v[j].w); o8[64 * j] = w; } }
            if (MODE == 1) {
                float lg[8];
#pragma unroll
                for (int e = 0; e < 8; ++e) { float s = 0.f;
#pragma unroll
                    for (int j = 0; j < 4; ++j) { const f32x4 r = *(const f32x4*)(rtab + e * 1024 + 256 * j + 4 * lane); s += (v[j].x * r.x + v[j].y * r.y) + (v[j].z * r.z + v[j].w * r.w); }
                    lg[e] = wave_sum(s); }
                int e0 = 0; float v0 = lg[0];
#pragma unroll
                for (int e = 1; e < 8; ++e) if (lg[e] > v0) { v0 = lg[e]; e0 = e; }
                int e1 = -1; float v1 = -3.0e38f;
#pragma unroll
                for (int e = 0; e < 8; ++e) if (e != e0 && lg[e] > v1) { v1 = lg[e]; e1 = e; }
                const float w0 = 1.0f / (1.0f + __expf(v1 - v0)), w1 = 1.0f - w0;
                if (lane == 0) { a.rt_e[row] = (unsigned)e0 | ((unsigned)e1 << 8); a.rt_w0[row] = w0; a.rt_w1[row] = w1; }
#pragma unroll
                for (int e = 0; e < 8; ++e) myc[e] += (e == e0 || e == e1) ? 1u : 0u;
            }
        }
        if (MODE == 1) {
            if (lane < 8) { unsigned c = 0;
#pragma unroll
                for (int e = 0; e < 8; ++e) c = (lane == e) ? myc[e] : c;
                wcnt[tc.wave * 8 + lane] = c; }
            __syncthreads();
            if (tc.tid < 8) { unsigned c = 0; for (int w = 0; w < 8; ++w) c += wcnt[w * 8 + tc.tid]; a.cnt[tb * 8 + tc.tid] = c; }
            __syncthreads();
        }
    }
}

template <bool F8>
__device__ __forceinline__ void moe_assign(Frame& F, const unsigned* cnt, const unsigned* rt_e, int* s0, int* s1, unsigned* pbase_out, const bf16* XN, bf16* XG, int* tok = nullptr  ) {
    const TC tc = tc_get();
    unsigned* tot = (unsigned*)F.lds;
    unsigned* pre = tot + 64;
    unsigned long long* msk = (unsigned long long*)(F.lds + 1024);
    int* slt = (int*)(F.lds + 2048);
    if (tc.tid < 8) tot[tc.tid] = 0u;
    __syncthreads();
    { unsigned part[8] = {0, 0, 0, 0, 0, 0, 0, 0};
      if (tc.tid < 256) {
#pragma unroll
          for (int e = 0; e < 8; ++e) part[e] = __hip_atomic_load(cnt + tc.tid * 8 + e, RLX_AGENT); }
#pragma unroll
      for (int e = 0; e < 8; ++e) { unsigned s = part[e];
#pragma unroll
          for (int o = 1; o < 64; o <<= 1) s += __shfl_xor(s, o);
          if (tc.lane == 0 && tc.wave < 4) atomicAdd(&tot[e], s); } }
    __syncthreads();
    if (tc.tid == 0) { unsigned p = 0; for (int e = 0; e < 8; ++e) { tot[8 + e] = p; p += (tot[e] + 255u) / 256u; } tot[16] = p;
        if (blockIdx.x == 0) for (int e = 0; e < 9; ++e) __hip_atomic_store(pbase_out + e, tot[8 + e], RLX_AGENT); }
    __syncthreads();
    for (int tb = blockIdx.x; tb < T / 256; tb += F.G) {
        if (tc.tid < 8) { unsigned s = 0; for (int b = 0; b < tb; ++b) s += __hip_atomic_load(cnt + b * 8 + tc.tid, RLX_AGENT); pre[tc.tid] = s; }
        int e0 = 0, e1 = 0;
        if (tc.tid < 256) { const unsigned pe = rt_e[tb * 256 + tc.tid]; e0 = pe & 0xff; e1 = (pe >> 8) & 0xff;
#pragma unroll
            for (int e = 0; e < 8; ++e) { const unsigned long long m = __ballot(e0 == e || e1 == e); if (tc.lane == 0) msk[e * 4 + tc.wave] = m; } }
        __syncthreads();
        if (tc.tid < 256) {
            int sl[2];
#pragma unroll
            for (int k = 0; k < 2; ++k) { const int e = k ? e1 : e0; unsigned rank = 0;
                for (int w = 0; w < tc.wave; ++w) rank += __popcll(msk[e * 4 + w]);
                rank += __popcll(msk[e * 4 + tc.wave] & ((1ull << tc.lane) - 1ull));
                sl[k] = (int)(tot[8 + e] * 256u + pre[e] + rank); }
            s0[tb * 256 + tc.tid] = sl[0]; s1[tb * 256 + tc.tid] = sl[1]; slt[2 * tc.tid] = sl[0]; slt[2 * tc.tid + 1] = sl[1];
            if (F8 && tok) { tok[sl[0]] = tb * 256 + tc.tid; tok[sl[1]] = tb * 256 + tc.tid; }
        }
        __syncthreads();
        if (!(F8 && tok))
        for (int rr = 0; rr < 32; ++rr) { const int i = tc.wave * 32 + rr; const int row = tb * 256 + i; const int sa = slt[2 * i], sb = slt[2 * i + 1];
            if (F8) {
                const u32x4 o = ((const u32x4*)((const unsigned char*)XN + (size_t)row * D))[tc.lane];
                ((u32x4*)((unsigned char*)XG + (size_t)sa * D))[tc.lane] = o; ((u32x4*)((unsigned char*)XG + (size_t)sb * D))[tc.lane] = o;
            } else {
            const u32x4* src = (const u32x4*)(XN + (size_t)row * D) + tc.lane; const u32x4 a = src[0], b = src[64];
            u32x4* d0 = (u32x4*)(XG + (size_t)sa * D) + tc.lane; u32x4* d1 = (u32x4*)(XG + (size_t)sb * D) + tc.lane;
            d0[0] = a; d0[64] = b; d1[0] = a; d1[64] = b; } }
        __syncthreads();
    }
}

template <bool OUT8>
__device__ __forceinline__ void conv_pass(Frame& F, const bf16* Bc, const bf16* Vc, const float* wconv, bf16* Yc) {
    const TC tc = tc_get();
    const int sub = tc.tid >> 7, ch = (tc.tid & 127) * 8;
    float w[3][8];
#pragma unroll
    for (int j = 0; j < 3; ++j) { const f32x4 a = *(const f32x4*)(wconv + j * D + ch), b = *(const f32x4*)(wconv + j * D + ch + 4);
#pragma unroll
        for (int c = 0; c < 4; ++c) { w[j][c] = a[c]; w[j][4 + c] = b[c]; } }
    for (int run = blockIdx.x * 4 + sub; run < T / 32; run += F.G * 4) {
        const int t0 = run * 32, s0 = t0 & (SEQ - 1);
        float p2[8], p1[8];
        { u32x4 a = {0, 0, 0, 0}, b = {0, 0, 0, 0};
          if (s0 >= 2) { a = *(const u32x4*)(Vc + (size_t)(t0 - 2) * D + ch); b = *(const u32x4*)(Vc + (size_t)(t0 - 1) * D + ch); }
#pragma unroll
          for (int c = 0; c < 4; ++c) { p2[2 * c] = bflo(a[c]); p2[2 * c + 1] = bfhi(a[c]); p1[2 * c] = bflo(b[c]); p1[2 * c + 1] = bfhi(b[c]); } }
#pragma unroll 4
        for (int i = 0; i < 32; ++i) { const size_t o = (size_t)(t0 + i) * D + ch;
            const u32x4 vv = *(const u32x4*)(Vc + o), bb = *(const u32x4*)(Bc + o); float cur[8], y[8];
#pragma unroll
            for (int c = 0; c < 4; ++c) { cur[2 * c] = bflo(vv[c]); cur[2 * c + 1] = bfhi(vv[c]); }
#pragma unroll
            for (int c = 0; c < 8; ++c) { const float bq = (c & 1) ? bfhi(bb[c >> 1]) : bflo(bb[c >> 1]); y[c] = bq * (w[0][c] * p2[c] + w[1][c] * p1[c] + w[2][c] * cur[c]); p2[c] = p1[c]; p1[c] = cur[c]; }
            if (OUT8) { u32x2 r; r.x = pk4_fp8(y[0], y[1], y[2], y[3], YC_SCALE8); r.y = pk4_fp8(y[4], y[5], y[6], y[7], YC_SCALE8); *(u32x2*)((unsigned char*)Yc + o) = r; }
            else { u32x4 r; r.x = cvt_pk_bf16(y[0], y[1]); r.y = cvt_pk_bf16(y[2], y[3]); r.z = cvt_pk_bf16(y[4], y[5]); r.w = cvt_pk_bf16(y[6], y[7]);
            *(u32x4*)(Yc + o) = r; } }
    }
}

__device__ __forceinline__ void rope_table(Frame& F, const int* pos, float* tab) {
    const TC tc = tc_get();
    const int i = tc.lane & 31; const float inv = __builtin_amdgcn_exp2f(-(float)i * (13.287712379549449f / 32.0f));
    const int NGW = F.G * NWAVES, gw = F.vcu * NWAVES + tc.wave;
    for (int t = gw * 2 + (tc.lane >> 5); t < T; t += NGW * 2) {
        const float ang = (float)pos[t] * inv;
        const float k = rintf(ang * 0.15915494309189535f);
        float r = fmaf(-k, 6.28125f, ang); r = fmaf(-k, 1.9353071795864769e-3f, r);
        tab[(size_t)t * 64 + i] = __cosf(r); tab[(size_t)t * 64 + 32 + i] = __sinf(r);
    }
}

template <int K8  >
__device__ __forceinline__ void mla_mid(Frame& F, const float* C, const float* gq, const float* gkv, const float* tab, bf16* cqn, bf16* ckvn, bf16* Kf, float kscale) {
    const TC tc = tc_get();
    const int lane = tc.lane, NGW = F.G * NWAVES, gw = F.vcu * NWAVES + tc.wave;
    f32x2 gqv[3];
#pragma unroll
    for (int j = 0; j < 3; ++j) gqv[j] = *(const f32x2*)(gq + 2 * lane + 128 * j);
    const f32x4 gk = *(const f32x4*)(gkv + 4 * lane);
    for (int t = gw; t < T; t += NGW) {
        const bf16* c = (const bf16*)C + (size_t)t * MDNP;
        f32x2 q[3]; float ss = 0.f;
#pragma unroll
        for (int j = 0; j < 3; ++j) { const unsigned w = *(const unsigned*)(c + 2 * lane + 128 * j); q[j] = (f32x2){bflo(w), bfhi(w)}; ss += q[j].x * q[j].x + q[j].y * q[j].y; }
        f32x4 kv; { const u32x2 w = *(const u32x2*)(c + QL + 4 * lane); kv = (f32x4){bflo(w.x), bfhi(w.x), bflo(w.y), bfhi(w.y)}; }
        const float x = bf2f(c[QL + KVL + lane]);
        const float rq = 1.0f / sqrtf(wave_sum(ss) * (1.f / QL) + EPS);
        const float rk = 1.0f / sqrtf(wave_sum((kv.x * kv.x + kv.y * kv.y) + (kv.z * kv.z + kv.w * kv.w)) * (1.f / KVL) + EPS);
#pragma unroll
        for (int j = 0; j < 3; ++j) *(unsigned*)(cqn + (size_t)t * QL + 2 * lane + 128 * j) = cvt_pk_bf16(q[j].x * rq * gqv[j].x, q[j].y * rq * gqv[j].y);
        { u32x2 w; w.x = cvt_pk_bf16(kv.x * rk * gk.x, kv.y * rk * gk.y); w.y = cvt_pk_bf16(kv.z * rk * gk.z, kv.w * rk * gk.w); *(u32x2*)(ckvn + (size_t)t * KVL + 4 * lane) = w; }
        const float other = __shfl_xor(x, 32); const int i = lane & 31;
        const float cs = tab[(size_t)t * 64 + i], sn = tab[(size_t)t * 64 + 32 + i];
        const float r = (lane < 32) ? (x * cs - other * sn) : (x * cs + other * sn);
        if (K8) { const float rs_ = fminf(fmaxf(r * kscale, -448.f), 448.f); const float r1 = __shfl_down(rs_, 1), r2 = __shfl_down(rs_, 2), r3 = __shfl_down(rs_, 3);
            if ((lane & 3) == 0) { int tq = __builtin_amdgcn_cvt_pk_fp8_f32(rs_, r1, 0, false); tq = __builtin_amdgcn_cvt_pk_fp8_f32(r2, r3, tq, true);
                const int b = t >> 13, s = t & (SEQ - 1), a_ = lane >> 4, h_ = (lane >> 3) & 1, j_ = lane & 7;
#pragma unroll
                for (int h = 0; h < MH; ++h) *(unsigned*)((unsigned char*)Kf + ((size_t)(b * MH + h) * SEQ + s) * DQKM + 128 + 32 * h_ + 8 * a_ + j_) = (unsigned)tq; }
        } else {
        const float rn = __shfl_xor(r, 1);
        if ((lane & 1) == 0) { const unsigned pk = cvt_pk_bf16(r, rn); const int b = t >> 13, s = t & (SEQ - 1);
#pragma unroll
            for (int h = 0; h < MH; ++h) *(unsigned*)(Kf + ((size_t)(b * MH + h) * SEQ + s) * DQKM + 128 + lane) = pk; } }
    }
}
#ifndef PC_CONV_IN
#define PC_CONV_IN 2
#endif
#ifndef PC_FFN_GU
#define PC_FFN_GU 2
#endif
#ifndef PC_MDN
#define PC_MDN 2
#endif
#ifndef PC_SQKV
#define PC_SQKV 2
#endif
#ifndef PC_CONV_OUT
#define PC_CONV_OUT 0
#endif
#ifndef PC_ATT_O
#define PC_ATT_O 1
#endif
#ifndef PC_FFN_DN
#define PC_FFN_DN 1
#endif
#ifdef DIAG_GEMM
#define DIAG_PTR(N_, P_) (((N_) == DIAG_N && (P_) == DIAG_PREC) ? (unsigned long long*)(F.ws + WS_CTL + 24000) : nullptr)
#else
#define DIAG_PTR(N_, P_) nullptr
#endif
#ifndef STAGGER_TICKS
#define STAGGER_TICKS 0
#endif
template <int PREC = 0, bool PANEL = false, class Epi>
__device__ __forceinline__ void gemm_static(Frame& F, const void* A, int lda, int K, const void* Bt, int N, const Epi& E, const float* rs = nullptr, const float* cs = nullptr, int stagger = 0, int M = T) {
    if (stagger && ((blockIdx.x >> 3) & 1)) { const unsigned long long t0 = __builtin_amdgcn_s_memrealtime(); while (__builtin_amdgcn_s_memrealtime() - t0 < (unsigned long long)stagger) __builtin_amdgcn_s_sleep(8); }
    pg8::Gemm g{(const bf16*)A, (const bf16*)Bt, PREC ? lda / 2 : lda, PREC ? K / 2 : K, 0, rs, cs, 0, DIAG_PTR(N, PREC)}; pg8::StaticOrder S; if (PANEL) S.init_panel(M, N, F.G, (int)blockIdx.x, (LAS unsigned*)((LAS unsigned char*)F.lds + MISC_OFF + 512), 128); else S.init(M, N, F.G, (int)blockIdx.x, (LAS unsigned*)((LAS unsigned char*)F.lds + MISC_OFF + 512), 128);
    pg8::gemm_phase<Epi, pg8::StaticOrder, PREC>((LAS unsigned char*)F.lds, g, S, E);
}
template <bool F8, class Epi, bool GATH = false, bool QS = false>
__device__ __forceinline__ void gemm_grouped(Frame& F, const void* A, int lda, int K, const void* Bt, size_t estride, int N, const unsigned* pbase, const Epi& E, const int* gidx = nullptr) {
    pg8::Gemm g{(const bf16*)A, (const bf16*)Bt, lda, K, estride, nullptr, nullptr, 0, DIAG_PTR(N, F8 ? 1 : 0), gidx}; pg8::GroupedOrderT<QS> S; S.init(pbase, N, F.G, (int)blockIdx.x, (LAS unsigned*)((LAS unsigned char*)F.lds + MISC_OFF + 512), 128);
    pg8::gemm_phase<Epi, pg8::GroupedOrderT<QS>, F8 ? 1 : 0, GATH, QS>((LAS unsigned char*)F.lds, g, S, E);
}
#ifndef MOE_F8_A
#define MOE_F8_A 1
#endif
#ifndef MOE_F8_B
#define MOE_F8_B 1
#endif
template <bool F8>
__device__ __forceinline__ void moe_gemm1(Frame& F, int l, const unsigned* pb) {
    unsigned char* ws = F.ws; unsigned char* big = ws + WS_BIG;
    if (F8) gemm_grouped<true, pg8::EpiPair8, true>(F, ws + WS_XN, D / 2, D / 2, ws + W_MGU + (size_t)l * 8 * 2 * FE * 1024 * 2, (size_t)2 * FE * 1024, 2 * FE, pb, pg8::EpiPair8{big, FE, 1.0f / (ACT_SCALE8 * W_SCALE8), HID_SCALE8}, (const int*)(ws + RT_TOK));
    else gemm_grouped<false>(F, ws + WS_XG, D, D, ws + W_MGU + (size_t)l * 8 * 2 * FE * 1024 * 2, (size_t)2 * FE * 1024 * 2, 2 * FE, pb, pg8::EpiPair<1>{(bf16*)big, FE, 1.0f});
}
template <bool F8, bool Y8 = false>
__device__ __forceinline__ void moe_gemm2(Frame& F, int l, const unsigned* pb) {
    unsigned char* ws = F.ws; unsigned char* big = ws + WS_BIG;
    if (F8 && Y8) gemm_grouped<true, pg8::EpiF8, false, true>(F, big, FE / 2, FE / 2, ws + W_MD + (size_t)l * 8 * 1024 * FE * 2, (size_t)1024 * FE, 1024, pb, pg8::EpiF8{ws + WS_XG, D, Y_SCALE8 / (HID_SCALE8 * W_SCALE8)});
    else if (F8) gemm_grouped<true>(F, big, FE / 2, FE / 2, ws + W_MD + (size_t)l * 8 * 1024 * FE * 2, (size_t)1024 * FE, 1024, pb, pg8::EpiBf16{(bf16*)(ws + WS_XG), D, nullptr, 1.0f / (HID_SCALE8 * W_SCALE8)});
    else gemm_grouped<false>(F, big, FE, FE, ws + W_MD + (size_t)l * 8 * 1024 * FE * 2, (size_t)1024 * FE * 2, 1024, pb, pg8::EpiBf16{(bf16*)(ws + WS_XG), D, nullptr, 1.0f});
}
#define W_DENSE_LIST(X) \
    for (int j = 0; j < 2; ++j) { \
        X(PC_CONV_IN, 0, in[5] + (size_t)j * 1024 * 3072, 1024, 1024, 3072, W_CINB + (size_t)j * 1024 * 1024 * 2, CM_CIN + j * 3072) \
        X(PC_CONV_IN, 1, in[5] + (size_t)j * 1024 * 3072 + 1024, 1024, 2048, 3072, W_CINCU + (size_t)j * 2048 * 1024 * 2, CM_CIN + j * 3072 + 1024) \
        X(PC_CONV_OUT, 0, in[7] + (size_t)j * 1024 * 1024, 1024, 1024, 1024, W_COUT + (size_t)j * 1024 * 1024 * 2, 0) \
        X(PC_FFN_GU, 1, in[19] + (size_t)j * 1024 * 2 * FF, 1024, 2 * FF, 2 * FF, W_FGU + (size_t)j * 2 * FF * 1024 * 2, CM_FGU + j * 5632) \
        X(PC_FFN_DN, 0, in[20] + (size_t)j * FF * 1024, FF, 1024, 1024, W_FD + (size_t)j * 1024 * FF * 2, 0) \
    } \
    X(PC_MDN, 0, in[8], 1024, MDN, MDN, W_MDN, CM_MDN) \
    X(0, 0, in[10], QL, 1536, 1536, W_MUQ, 0) \
    for (int h = 0; h < MH; ++h) {   \
        X(0, 0, in[12] + h * 256, KVL, 128, 2048, W_MUKV + (size_t)h * 128 * KVL * 2, 0) \
        X(0, 0, in[12] + h * 256 + 128, KVL, 128, 2048, W_MUKV + (size_t)(1024 + h * 128) * KVL * 2, 0) \
    } \
    X(PC_ATT_O, 0, in[13], 1024, 1024, 1024, W_MO, 0) \
    X(PC_SQKV, 0, in[14], 1024, SQKV, SQKV, W_SQKV, CM_SQKV) \
    X(PC_ATT_O, 0, in[17], 1024, 1024, 1024, W_SO, 0)
__device__ __forceinline__ void prologue_a(Frame& F) {
    const float* const* in = F.in; unsigned char* ws = F.ws; unsigned* cmw = (unsigned*)(ws + WS_CTL) + CW_CMAX;
    int rot = 0;
#define XA(PC, MAP, W, K, N, ldw, dst, cm) { if ((PC) == 2) cmax_matrix(F, (W), (K), (N), (ldw), cmw + (cm), rot); else if ((PC) == 1) tr_matrix8<MAP>(F, (W), (K), (N), (ldw), ws + (dst), rot, W_SCALE8); else tr_matrix<MAP>(F, (W), (K), (N), (ldw), (bf16*)(ws + (dst)), rot); rot += 37; }
    W_DENSE_LIST(XA)
#undef XA
    for (int le = 0; le < 16; ++le) {
        const bool f8 = (le < 8) ? (MOE_F8_A != 0) : (MOE_F8_B != 0);
        const size_t l = le >> 3, e = le & 7;
        if (f8) { tr_matrix8<1>(F, in[22] + (size_t)le * 1024 * 2 * FE, 1024, 2 * FE, 2 * FE, ws + W_MGU + l * 8 * 2 * FE * 1024 * 2 + e * 2 * FE * 1024, rot, W_SCALE8); rot += 37;
                  tr_matrix8<0>(F, in[23] + (size_t)le * FE * 1024, FE, 1024, 1024, ws + W_MD + l * 8 * 1024 * FE * 2 + e * 1024 * FE, rot, W_SCALE8); rot += 37; }
        else { tr_matrix<1>(F, in[22] + (size_t)le * 1024 * 2 * FE, 1024, 2 * FE, 2 * FE, (bf16*)(ws + W_MGU + (size_t)le * 2 * FE * 1024 * 2), rot); rot += 37;
               tr_matrix<0>(F, in[23] + (size_t)le * FE * 1024, FE, 1024, 1024, (bf16*)(ws + W_MD + (size_t)le * 1024 * FE * 2), rot); rot += 37; }
    }
    const TC tc = tc_get();
    const int gt = F.vcu * NTHREADS + tc.tid, NGT = F.G * NTHREADS;
    { const int esz = PC_MDN ? 1 : 2; for (int i = gt; i < (MDNP - MDN) * 1024 * esz / 4; i += NGT) ((unsigned*)(ws + W_MDN + (size_t)MDN * 1024 * esz))[i] = 0u;
      if (PC_MDN == 2) for (int i = gt; i < MDNP - MDN; i += NGT) ((float*)(ws + WS_CS))[CM_MDN + MDN + i] = 0.f; }
    for (int i = gt; i < 2 * 8 * 1024; i += NGT) { const int l = i >> 13, e = (i >> 10) & 7, k = i & 1023; ((float*)(ws + W_RT))[i] = in[21][(size_t)l * 1024 * 8 + k * 8 + e]; }
    rope_table(F, (const int*)in[1], (float*)(ws + WS_ROPE));
}
__device__ __forceinline__ void prologue_b(Frame& F) {
    const float* const* in = F.in; unsigned char* ws = F.ws; const unsigned* cmw = (const unsigned*)(ws + WS_CTL) + CW_CMAX; float* csw = (float*)(ws + WS_CS);
    int rot = 0;
#define XB(PC, MAP, W, K, N, ldw, dst, cm) { if ((PC) == 2) tr_matrix_i8<MAP>(F, (W), (K), (N), (ldw), ws + (dst), rot, cmw + (cm), csw + (cm)); rot += 37; }
    W_DENSE_LIST(XB)
#undef XB
}

#ifndef MLA_QK8
#define MLA_QK8 1
#endif
__device__ __forceinline__ void mla_attention(Frame& F) {
    unsigned char* big = F.ws + WS_BIG;
    const bf16* Q = (const bf16*)(big + B_MQ); const bf16* Kf = (const bf16*)(big + B_MK); const bf16* V = (const bf16*)(big + B_MV); bf16* O = (bf16*)(big + B_MO);
    const float* tab = (const float*)(F.ws + WS_ROPE);
    for (int L = blockIdx.x; L < NB * MH * 16; L += F.G) {
        const int xcd = L & 7, kk = L >> 3, bh = xcd * 8 + (kk >> 4), x = kk & 15, b = bh >> 3, h = bh & 7;
        for (int pass = 0; pass < 2; ++pass) {
            const int qb = pass ? 31 - x : x; const size_t row0 = (size_t)b * SEQ + qb * 256;
            att::Params p;
            p.Q = Q + row0 * 1536 + h * DQKM; p.ldq = 1536;
            p.K = MLA_QK8 ? (const bf16*)((const unsigned char*)Kf + (size_t)bh * SEQ * DQKM) : Kf + (size_t)bh * SEQ * DQKM; p.ldk = DQKM;
            if (MLA_QK8) { p.V = (const bf16*)((const unsigned char*)V + (size_t)(h * DVM) * T + (size_t)b * SEQ); p.ldv = T; }
            else { p.V = V + (size_t)bh * SEQ * DVM; p.ldv = DVM; }
            p.O = PC_ATT_O ? (bf16*)((unsigned char*)O + row0 * 1024 + h * DVM) : O + row0 * 1024 + h * DVM; p.ldo = 1024; p.P0 = qb * 256; p.j_lo = 0; p.j_hi = 4 * (qb + 1);
            p.rope = tab + row0 * 64; p.pos = nullptr; p.slope_over_scale = 0.f; p.sink_l2 = 0.f;
            att::attn_block<192, 128, 0, (1 << 30), MLA_QK8 != 0, PC_ATT_O != 0>(p, F.lds);
        }
    }
}
#ifndef SWA_RES
#define SWA_RES 1
#endif
__device__ __forceinline__ void swa_attention(Frame& F) {
    unsigned char* big = F.ws + WS_BIG;
    const bf16* QKV = (const bf16*)(big + B_SQKV); bf16* O = (bf16*)(big + B_SO);
    const int* pos = (const int*)F.in[1]; const float* sinks = F.in[16];
#if SWA_RES
    for (int L = blockIdx.x; L < NB * 2 * 32; L += F.G) {
        const int qb = L & 31, pair = L >> 5, b = pair >> 1, kvh = pair & 1, qh = kvh * 8;
        const size_t row0 = (size_t)b * SEQ + qb * 256;
        att::Params p;
        p.Q = QKV + row0 * SQKV + qh * 64; p.ldq = SQKV;
        p.K = QKV + (size_t)b * SEQ * SQKV + 1024 + kvh * 64; p.ldk = SQKV; p.V = QKV + (size_t)b * SEQ * SQKV + 1152 + kvh * 64; p.ldv = SQKV;
        p.O = PC_ATT_O ? (bf16*)((unsigned char*)O + row0 * 1024 + qh * 64) : O + row0 * 1024 + qh * 64; p.ldo = 1024; p.P0 = qb * 256; p.j_lo = qb ? 4 * qb - 2 : 0; p.j_hi = 4 * qb + 4;
        p.rope = nullptr; p.pos = pos + (size_t)b * SEQ; p.slope_over_scale = 0.f; p.sink_l2 = 0.f; p.sinks = sinks; p.qh0 = qh;
        att::attn_block<64, 64, 1, 128, false, PC_ATT_O != 0, true>(p, F.lds);
    }
#else
    for (int L = blockIdx.x; L < NB * 16 * 32; L += F.G) {
        const int xcd = L & 7, kk = L >> 3, pair = xcd * 2 + (kk >> 8), u = kk & 255, qb = u >> 3, g = u & 7, b = pair >> 1, kvh = pair & 1, qh = kvh * 8 + g;
        const size_t row0 = (size_t)b * SEQ + qb * 256;
        att::Params p;
        p.Q = QKV + row0 * SQKV + qh * 64; p.ldq = SQKV;
        p.K = QKV + (size_t)b * SEQ * SQKV + 1024 + kvh * 64; p.ldk = SQKV; p.V = QKV + (size_t)b * SEQ * SQKV + 1152 + kvh * 64; p.ldv = SQKV;
        p.O = PC_ATT_O ? (bf16*)((unsigned char*)O + row0 * 1024 + qh * 64) : O + row0 * 1024 + qh * 64; p.ldo = 1024; p.P0 = qb * 256; p.j_lo = qb ? 4 * qb - 2 : 0; p.j_hi = 4 * qb + 4;
        p.rope = nullptr; p.pos = pos + (size_t)b * SEQ; p.sinks = sinks; p.qh0 = qh;
        p.slope_over_scale = __builtin_amdgcn_exp2f(-0.5f * (float)(qh + 1)) * 8.0f;
        p.sink_l2 = sinks[qh] * 1.4426950408889634f;
        att::attn_block<64, 64, 1, 128, false, PC_ATT_O != 0>(p, F.lds);
    }
#endif
}

struct Args { const float* in[24]; float* out; unsigned char* ws; int ph_lo, ph_hi; };
constexpr int N_PHASES = 33;
__global__ void __launch_bounds__(NTHREADS, 2) mega(Args args) {
    extern __shared__ __attribute__((aligned(16))) unsigned char lds_raw[];
#if HW_SAT8
    __builtin_amdgcn_s_setreg(1 | (23 << 6), 1);
#endif
    Frame F;
    F.lds = (char*)lds_raw;
    F.G = gridDim.x; { const int bx = blockIdx.x; F.vcu = (F.G % 8 == 0) ? (bx % 8) * (F.G / 8) + bx / 8 : bx; }
    F.ws = args.ws; F.out = args.out; F.in = args.in;
    unsigned char* ws = args.ws; unsigned char* big = ws + WS_BIG;
    unsigned* ctl = (unsigned*)(ws + WS_CTL);
    volatile LAS unsigned* misc = (volatile LAS unsigned*)((LAS unsigned char*)lds_raw + MISC_OFF);
    if (threadIdx.x < 32) misc[threadIdx.x] = 0u;
    __syncthreads();
    const int lo = args.ph_lo, hi = args.ph_hi;
    XcdBarrier bar; bar.bar = ctl + CW_BAR; bar.x = 0; bar.st = nullptr;
    if (hi - lo > 1) bar = xcd_barrier_post(ctl + CW_BAR, misc + 8);
#ifndef PH_SEL
#define PH_SEL -1
#endif
#define IN(k) ((PH_SEL < 0 || PH_SEL == (k)) && lo <= (k) && (k) < hi)
#ifndef PROBE_MASK
#define PROBE_MASK 0ull
#endif
#define REP(k) for (int rep_ = 0, nrep_ = (((PROBE_MASK >> (k)) & 1ull) ? 2 : 1); rep_ < nrep_; ++rep_)
#define XDST ((rep_ + 1 < nrep_) ? (float*)(ws + WS_XG) : X)
#define XBDST ((rep_ + 1 < nrep_) ? (bf16*)args.out : XB)
#ifndef XBF16
#define XBF16 1
#endif
#if XBF16
static_assert(MOE_F8_A && MOE_F8_B, "the bf16 residual stream lives in the half of the XG region that fp8 MoE rows leave free");
#define RES_EPI(srcf32, srcp, ...) pg8::EpiResB<srcf32>{(srcf32) ? (const void*)(srcp) : (const void*)XB, XBDST, __VA_ARGS__}
#else
#define RES_EPI(srcf32, srcp, ...) pg8::EpiRes{(srcf32) ? (const float*)(srcp) : (const float*)X, XDST, __VA_ARGS__}
#endif
#ifdef DIAG_GEMM
    unsigned long long dgw_wait = 0, dgw_sel = 0;
#define SEAM(k) do { if (IN(k) && IN((k) + 1)) { const unsigned long long t_ = __builtin_amdgcn_s_memrealtime(); xcd_barrier(bar); const unsigned long long d_ = __builtin_amdgcn_s_memrealtime() - t_; dgw_wait += d_; if ((k) == DIAG_SEAM) dgw_sel = d_; } } while (0)
#else
#define SEAM(k) do { if (IN(k) && IN((k) + 1)) { xcd_barrier(bar); if ((PROBE_MASK >> 40) & 1ull) xcd_barrier(bar); } } while (0)
#endif
    const float* x_in = args.in[0]; float* X = args.out; bf16* XB = (bf16*)(ws + WS_XG + (size_t)MAXSLOT * D);
    bf16* XN = (bf16*)(ws + WS_XN); bf16* XG = (bf16*)(ws + WS_XG);
    unsigned* rt_e = (unsigned*)(ws + RT_E); float* rt_w0 = (float*)(ws + RT_W0); float* rt_w1 = (float*)(ws + RT_W1); int* rt_s0 = (int*)(ws + RT_S0); int* rt_s1 = (int*)(ws + RT_S1);
    unsigned* rt_cnt = (unsigned*)(ws + RT_CNT); unsigned* rt_pb = (unsigned*)(ws + RT_PB);
    const float* nmix = args.in[2]; const float* nffn = args.in[3];

    constexpr float S_AW = 1.0f / (ACT_SCALE8 * W_SCALE8), S_HW = 1.0f / (HID_SCALE8 * W_SCALE8);
    constexpr bool MA8 = MOE_F8_A != 0, MB8 = MOE_F8_B != 0;
    bf16* Bc = (bf16*)(big + B_CONV_B); bf16* Vc = (bf16*)(big + B_CONV_V); bf16* Yc = (bf16*)(big + B_CONV_Y);
    float* rsA = (float*)(ws + WS_RS); const float* csw = (const float*)(ws + WS_CS);
#define ASC(PC) ((PC) == 1 ? S_AW : 1.0f)
#define ROWPASS(MODE, COMB, OM, ...) do { RowArgs a{}; a.Xsrc = X; a.Xsb = XB; a.Xdb = XB; a.XN = XN; a.rs = rsA; __VA_ARGS__; row_pass<MODE, COMB, OM, false, XBF16 != 0>(F, a); } while (0)
#define ROWPASS_Y8(MODE, COMB, OM, ...) do { RowArgs a{}; a.Xsrc = X; a.Xsb = XB; a.Xdb = XB; a.XN = XN; a.rs = rsA; __VA_ARGS__; row_pass<MODE, COMB, OM, true, XBF16 != 0>(F, a); } while (0)
#define CONV_IN(j) do { gemm_static<PC_CONV_IN>(F, XN, D, D, ws + W_CINB + (size_t)(j) * 1024 * 1024 * 2, 1024, pg8::EpiBf16{Bc, D, nullptr, ASC(PC_CONV_IN)}, rsA, csw + CM_CIN + (j) * 3072); \
                        gemm_static<PC_CONV_IN>(F, XN, D, D, ws + W_CINCU + (size_t)(j) * 2048 * 1024 * 2, 2048, pg8::EpiPair<0>{Vc, D, ASC(PC_CONV_IN)}, rsA, csw + CM_CIN + (j) * 3072 + 1024); } while (0)
#ifndef OWN_TOKENS
#define OWN_TOKENS 1
#endif
#define OWN_SEAM(k) do { if (OWN_TOKENS) __syncthreads(); else SEAM(k); } while (0)
#define CONV_OUT(j, srcin) gemm_static<PC_CONV_OUT, OWN_TOKENS != 0>(F, Yc, D, D, ws + W_COUT + (size_t)(j) * 1024 * 1024 * 2, 1024, RES_EPI(srcin, x_in, D, nullptr, PC_CONV_OUT == 1 ? 1.0f / (YC_SCALE8 * W_SCALE8) : 1.0f), nullptr, nullptr, STAGGER_TICKS)
#define FFN_GU(f) do { if constexpr (PC_FFN_DN == 1) gemm_static<PC_FFN_GU>(F, XN, D, D, ws + W_FGU + (size_t)(f) * 2 * FF * 1024 * 2, 2 * FF, pg8::EpiPair8{big + B_HMID, FF, ASC(PC_FFN_GU), HID_SCALE8}, rsA, csw + CM_FGU + (f) * 5632); \
                       else gemm_static<PC_FFN_GU>(F, XN, D, D, ws + W_FGU + (size_t)(f) * 2 * FF * 1024 * 2, 2 * FF, pg8::EpiPair<1>{(bf16*)(big + B_HMID), FF, ASC(PC_FFN_GU)}, rsA, csw + CM_FGU + (f) * 5632); } while (0)
#define FFN_DN(f) gemm_static<PC_FFN_DN, OWN_TOKENS != 0>(F, big + B_HMID, FF, FF, ws + W_FD + (size_t)(f) * 1024 * FF * 2, 1024, RES_EPI(false, x_in, D, nullptr, PC_FFN_DN == 1 ? S_HW : 1.0f), nullptr, nullptr, STAGGER_TICKS)

    if (IN(0)) REP(0) { prologue_a(F); xcd_barrier(bar); prologue_b(F); __syncthreads(); { RowArgs a{}; a.Xsrc = x_in; a.XN = XN; a.rs = rsA; a.g = nmix; row_pass<0, false, PC_CONV_IN, false, false>(F, a); } }
    SEAM(0);
    if (IN(1)) REP(1) CONV_IN(0);
    if (IN(1) && ((PROBE_MASK >> 41) & 1ull)) CONV_IN(0);
    SEAM(1);
    if (IN(2)) REP(2) conv_pass<PC_CONV_OUT == 1>(F, Bc, Vc, args.in[6], Yc);
    SEAM(2);
    if (IN(3)) REP(3) CONV_OUT(0, true);
    OWN_SEAM(3);
    if (IN(4)) REP(4) ROWPASS(0, false, PC_FFN_GU, a.g = nffn);
    SEAM(4);
    if (IN(5)) REP(5) FFN_GU(0);
    if (IN(5) && ((PROBE_MASK >> 42) & 1ull)) FFN_GU(0);
    SEAM(5);
    if (IN(6)) REP(6) FFN_DN(0);
    OWN_SEAM(6);
    if (IN(7)) REP(7) ROWPASS(0, false, PC_MDN, a.g = nmix + D);
    SEAM(7);
    if (IN(8)) REP(8) gemm_static<PC_MDN>(F, XN, D, D, ws + W_MDN, MDNP, pg8::EpiBf16{(bf16*)(big + B_MC), MDNP, nullptr, ASC(PC_MDN)}, rsA, csw + CM_MDN);
    SEAM(8);
    if (IN(9)) REP(9) mla_mid<MLA_QK8>(F, (const float*)(big + B_MC), args.in[9], args.in[11], (const float*)(ws + WS_ROPE), (bf16*)(big + B_MCQ), (bf16*)(big + B_MCKV), (bf16*)(big + B_MK), att::QK8_SCALE);
    SEAM(9);
    if (IN(10)) REP(10) {
        gemm_static(F, big + B_MCQ, QL, QL, ws + W_MUQ, 1536, pg8::EpiBf16{(bf16*)(big + B_MQ), 1536, nullptr, 1.0f});
#if MLA_QK8
        gemm_static(F, big + B_MCKV, KVL, KVL, ws + W_MUKV, 1024, pg8::EpiK8{big + B_MK, att::QK8_SCALE});
        gemm_static(F, ws + W_MUKV + (size_t)1024 * KVL * 2, KVL, KVL, big + B_MCKV, T, pg8::EpiVT8{big + B_MV, (size_t)T, att::QK8_SCALE}, nullptr, nullptr, 0, 1024);
#else
        gemm_static(F, big + B_MCKV, KVL, KVL, ws + W_MUKV, 2048, pg8::EpiKVT<0>{(bf16*)(big + B_MK), (bf16*)(big + B_MV), 1.0f});
#endif
    }
    SEAM(10);
#ifdef DIAG_GEMM
    unsigned long long dph_c = __builtin_readcyclecounter(), dph_w = __builtin_amdgcn_s_memrealtime();
#endif
    if (IN(11)) REP(11) mla_attention(F);
#ifdef DIAG_GEMM
    if (DIAG_N == -11 && blockIdx.x == DIAG_BLOCK && threadIdx.x == 0) { unsigned long long* dg = (unsigned long long*)(ws + WS_CTL + 24000); dg[3] = __builtin_readcyclecounter() - dph_c; dg[4] = __builtin_amdgcn_s_memrealtime() - dph_w; }
#endif
    SEAM(11);
    if (IN(12)) REP(12) gemm_static<PC_ATT_O, OWN_TOKENS != 0>(F, big + B_MO, D, D, ws + W_MO, 1024, RES_EPI(false, x_in, D, nullptr, PC_ATT_O ? 1.0f / (att::O8_SCALE * W_SCALE8) : 1.0f), nullptr, nullptr, STAGGER_TICKS);
    OWN_SEAM(12);
    if (IN(13)) REP(13) ROWPASS(1, false, MA8 ? 1 : 0, a.g = nffn + D; a.routerT = (const float*)(ws + W_RT); a.rt_e = rt_e; a.rt_w0 = rt_w0; a.rt_w1 = rt_w1; a.cnt = rt_cnt);
    SEAM(13);
    if (IN(14)) REP(14) moe_assign<MA8>(F, rt_cnt, rt_e, rt_s0, rt_s1, rt_pb, XN, XG, MA8 ? (int*)(ws + RT_TOK) : nullptr);
    SEAM(14);
    if (IN(15)) REP(15) moe_gemm1<MA8>(F, 0, rt_pb);
    SEAM(15);
    if (IN(16)) REP(16) moe_gemm2<MA8, MA8>(F, 0, rt_pb);
    SEAM(16);
    if (IN(17)) REP(17) ROWPASS_Y8(0, true, PC_SQKV, a.Xdst = X; a.g = nmix + 2 * D; a.Y = XG; a.s0 = rt_s0; a.s1 = rt_s1; a.w0 = rt_w0; a.w1 = rt_w1);
    SEAM(17);
    if (IN(18)) REP(18) gemm_static<PC_SQKV>(F, XN, D, D, ws + W_SQKV, SQKV, pg8::EpiBf16{(bf16*)(big + B_SQKV), SQKV, args.in[15], ASC(PC_SQKV)}, rsA, csw + CM_SQKV);
    SEAM(18);
    if (IN(19)) REP(19) swa_attention(F);
    SEAM(19);
    if (IN(20)) REP(20) gemm_static<PC_ATT_O, OWN_TOKENS != 0>(F, big + B_SO, D, D, ws + W_SO, 1024, RES_EPI(false, x_in, D, args.in[18], PC_ATT_O ? 1.0f / (att::O8_SCALE * W_SCALE8) : 1.0f), nullptr, nullptr, STAGGER_TICKS);
    OWN_SEAM(20);
    if (IN(21)) REP(21) ROWPASS(0, false, PC_FFN_GU, a.g = nffn + 2 * D);
    SEAM(21);
    if (IN(22)) REP(22) FFN_GU(1);
    SEAM(22);
    if (IN(23)) REP(23) FFN_DN(1);
    OWN_SEAM(23);
    if (IN(24)) REP(24) ROWPASS(0, false, PC_CONV_IN, a.g = nmix + 3 * D);
    SEAM(24);
    if (IN(25)) REP(25) CONV_IN(1);
    SEAM(25);
    if (IN(26)) REP(26) conv_pass<PC_CONV_OUT == 1>(F, Bc, Vc, args.in[6] + 3 * D, Yc);
    SEAM(26);
    if (IN(27)) REP(27) CONV_OUT(1, false);
    OWN_SEAM(27);
    if (IN(28)) REP(28) ROWPASS(1, false, MB8 ? 1 : 0, a.g = nffn + 3 * D; a.routerT = (const float*)(ws + W_RT) + 8 * 1024; a.rt_e = rt_e; a.rt_w0 = rt_w0; a.rt_w1 = rt_w1; a.cnt = rt_cnt);
    SEAM(28);
    if (IN(29)) REP(29) moe_assign<MB8>(F, rt_cnt, rt_e, rt_s0, rt_s1, rt_pb + 16, XN, XG, MB8 ? (int*)(ws + RT_TOK) : nullptr);
    SEAM(29);
    if (IN(30)) REP(30) moe_gemm1<MB8>(F, 1, rt_pb + 16);
    SEAM(30);
    if (IN(31)) REP(31) moe_gemm2<MB8, MB8>(F, 1, rt_pb + 16);
    SEAM(31);
    if (IN(32)) REP(32) ROWPASS_Y8(2, true, 0, a.g = args.in[4]; a.outF = X; a.Y = XG; a.s0 = rt_s0; a.s1 = rt_s1; a.w0 = rt_w0; a.w1 = rt_w1);
#ifdef DIAG_GEMM
    if (blockIdx.x == DIAG_BLOCK && threadIdx.x == 0) { const unsigned long long* dg = (const unsigned long long*)(ws + WS_CTL + 24000);
        unsigned long long q = dg[DIAG_SEL < 6 ? DIAG_SEL : 0]; if (DIAG_SEL == 3) q = q / 200ull;
        if (DIAG_SEL == 6) q = dgw_wait; if (DIAG_SEL == 7) q = dgw_sel;
        const unsigned long long t0 = __builtin_amdgcn_s_memrealtime(), tgt = q * DIAG_MUL;
        while (__builtin_amdgcn_s_memrealtime() - t0 < tgt) __builtin_amdgcn_s_sleep(20); }
#endif
#undef IN
#undef SEAM
}

#ifndef MK_LAUNCH_PER_PHASE
#define MK_LAUNCH_PER_PHASE 0
#endif
extern "C" void kernel_launch(void* const* d_in, const int* in_sizes, int n_in, void* d_out, int out_size, void* d_ws, size_t ws_size, hipStream_t stream) {
    static int grid = 0;
    if (grid == 0) {
        if (n_in != 24 || in_sizes[0] != T * D || out_size != T * D || ws_size < WS_END) { fprintf(stderr, "kernel_launch: unexpected shapes (n_in %d, in0 %d, out %d, ws %zu < %zu); nothing launched\n", n_in, n_in > 0 ? in_sizes[0] : -1, out_size, ws_size, (size_t)WS_END); grid = -1; return; }
        int dev = 0, cus = 0, per_cu = 0;
        if (hipGetDevice(&dev) != hipSuccess || hipDeviceGetAttribute(&cus, hipDeviceAttributeMultiprocessorCount, dev) != hipSuccess) { grid = -1; return; }
        if (hipFuncSetAttribute((const void*)mega, hipFuncAttributeMaxDynamicSharedMemorySize, LDS_BYTES) != hipSuccess) { fprintf(stderr, "kernel_launch: hipFuncSetAttribute failed\n"); grid = -1; return; }
        if (hipOccupancyMaxActiveBlocksPerMultiprocessor(&per_cu, (const void*)mega, NTHREADS, LDS_BYTES) != hipSuccess || per_cu < 1) fprintf(stderr, "kernel_launch: occupancy query reports %d\n", per_cu);
        (void)hipGetLastError();
        grid = cus;
    }
    if (grid < 0) return;
    (void)hipMemsetAsync((char*)d_ws + WS_CTL, 0, CTL_ZERO_BYTES, stream);
    Args a{};
    for (int i = 0; i < 24; ++i) a.in[i] = (const float*)d_in[i];
    a.out = (float*)d_out; a.ws = (unsigned char*)d_ws;
#if MK_LAUNCH_PER_PHASE
    for (int p = 0; p < N_PHASES; ++p) { a.ph_lo = p; a.ph_hi = p + 1; hipLaunchKernelGGL(mega, dim3(grid), dim3(NTHREADS), LDS_BYTES, stream, a); }
#else
    a.ph_lo = 0; a.ph_hi = N_PHASES; hipLaunchKernelGGL(mega, dim3(grid), dim3(NTHREADS), LDS_BYTES, stream, a);
#endif
}
```

```cpp
#include <hip/hip_runtime.h>
#include <cstdio>
#include <cstdint>

#define LAS __attribute__((address_space(3)))
#define GAS __attribute__((address_space(1)))
typedef unsigned short bf16;
typedef short bf16x8 __attribute__((ext_vector_type(8)));
typedef short s16x4 __attribute__((ext_vector_type(4)));
typedef float f32x2 __attribute__((ext_vector_type(2)));
typedef float f32x4 __attribute__((ext_vector_type(4)));
typedef float f32x16 __attribute__((ext_vector_type(16)));
typedef unsigned u32x2 __attribute__((ext_vector_type(2)));
typedef unsigned u32x4 __attribute__((ext_vector_type(4)));

__device__ __forceinline__ unsigned cvt_pk_bf16(float lo, float hi) { unsigned r; asm volatile("v_cvt_pk_bf16_f32 %0, %1, %2" : "=v"(r) : "v"(lo), "v"(hi)); return r; }
__device__ __forceinline__ float bf2f(unsigned short b) { return __uint_as_float(((unsigned)b) << 16); }
__device__ __forceinline__ float bflo(unsigned w) { return __uint_as_float(w << 16); }
__device__ __forceinline__ float bfhi(unsigned w) { return __uint_as_float(w & 0xffff0000u); }
__device__ __forceinline__ float wave_sum(float v) {
#pragma unroll
    for (int o = 1; o < 64; o <<= 1) v += __shfl_xor(v, o);
    return v;
}
__device__ __forceinline__ float fast_silu(float g) { return g * __builtin_amdgcn_rcpf(1.0f + __builtin_amdgcn_exp2f(-1.4426950408889634f * g)); }

namespace pg8 {
constexpr int BM = 256, BK = 64, HALF = 128, HTB = HALF * BK * 2, STAGE_BYTES = 8 * HTB, NXCD = 8, WGM = 4;
__host__ __device__ __forceinline__ int lds_byte(int r, int c) { const int st = (r >> 4) * 2 + (c >> 5), rr = r & 15, cc = c & 31, ob = rr * 64 + cc * 2; return st * 1024 + (ob ^ (((ob >> 9) & 1) << 5)); }
__host__ __device__ __forceinline__ void stage_rc(int b, int& R, int& C) { const int st = b / 1024, sb = b % 1024, swz = sb ^ (((sb >> 9) & 1) << 5); R = (st >> 1) * 16 + swz / 64; C = (st & 1) * 32 + (swz % 64) / 2; }
__host__ __device__ __forceinline__ int perm32(int rho) { const int n = rho >> 4, i = rho & 15; return 8 * (i >> 2) + 4 * n + (i & 3); }

struct Unit { int pm, pn, e, qm = 15; };
struct Gemm { const bf16* A; const bf16* Bt; int lda, K; size_t estride; const float* rs; const float* cs; int cs_estride; unsigned long long* diag; const int* gidx = nullptr; };

struct StaticOrder {
    const LAS unsigned* tab;
    __device__ __forceinline__ void init(int M, int N, int G, int c, LAS unsigned* table, int cap) {
        const int tid = threadIdx.x; const int nM = M / BM, nN = N / BM, nwg = nM * nN;
        if (tid < cap) {
            unsigned w = 0u; const long L = (long)tid * G + c;
            if (L < nwg) {
                int wgid = (int)L; { const int q = nwg / NXCD, r = nwg % NXCD, xcd = wgid % NXCD, off = wgid / NXCD; wgid = (xcd < r ? xcd * (q + 1) : r * (q + 1) + (xcd - r) * q) + off; }
                const int nig = WGM * nN, gid = wgid / nig, fm = gid * WGM, gsz = (nM - fm) < WGM ? (nM - fm) : WGM;
                w = (unsigned)(fm + ((wgid % nig) % gsz)) | ((unsigned)((wgid % nig) / gsz) << 12) | 0x80000000u;
            }
            table[tid] = w;
        }
        tab = table;
        __syncthreads();
    }
    __device__ __forceinline__ bool next(int i, Unit& u) const {
        const unsigned w = (unsigned)__builtin_amdgcn_readfirstlane((int)tab[i]);
        u.pm = (int)(w & 0xfffu); u.pn = (int)((w >> 12) & 0xfffu); u.e = 0; return (w >> 31) != 0u;
    }
};
template <bool QSPLIT = false>
struct GroupedOrderT {
    const LAS unsigned* tab;
    __device__ __forceinline__ void init(const unsigned* pbase, int N, int G, int c, LAS unsigned* table, int cap) {
        const int tid = threadIdx.x;
        int pb[9];
#pragma unroll
        for (int i = 0; i < 9; ++i) pb[i] = (int)__hip_atomic_load(pbase + i, __ATOMIC_RELAXED, __HIP_MEMORY_SCOPE_AGENT);
        const int nM = pb[8], nN = N / BM, nwg = nM * nN;
        const int per = nwg / G, left = nwg - per * G; const bool qs = QSPLIT && left > 0 && 4 * left <= G && per < cap;
        if (tid < cap) {
            unsigned w = 0u; long L = (long)tid * G + c; unsigned qm = 15u;
            if (qs && tid >= per) { L = (tid == per && c < 4 * left) ? (long)per * G + (c >> 2) : (long)nwg; qm = 1u << (c & 3); }
            if (L < nwg) {
                int wgid = (int)L; { const int q = nwg / NXCD, r = nwg % NXCD, xcd = wgid % NXCD, off = wgid / NXCD; wgid = (xcd < r ? xcd * (q + 1) : r * (q + 1) + (xcd - r) * q) + off; }
                const int nig = WGM * nN, gid = wgid / nig, fm = gid * WGM, gsz = (nM - fm) < WGM ? (nM - fm) : WGM;
                const int pm = fm + ((wgid % nig) % gsz), pn = (wgid % nig) / gsz;
                int e = 0;
#pragma unroll
                for (int j = 1; j < 8; ++j) e += (pm >= pb[j]) ? 1 : 0;
                w = (unsigned)pm | ((unsigned)pn << 12) | ((unsigned)e << 20) | (qm << 24) | 0x80000000u;
            }
            table[tid] = w;
        }
        tab = table;
        __syncthreads();
    }
    __device__ __forceinline__ bool next(int i, Unit& u) const {
        const unsigned w = (unsigned)__builtin_amdgcn_readfirstlane((int)tab[i]);
        u.pm = (int)(w & 0xfffu); u.pn = (int)((w >> 12) & 0xffu); u.e = (int)((w >> 20) & 0xfu); u.qm = (int)((w >> 24) & 0xfu); return (w >> 31) != 0u;
    }
};
typedef GroupedOrderT<false> GroupedOrder;

struct EpiBf16 {
    static constexpr bool PERM = true;
    bf16* O; int ldc; const float* bias; float scale;
    __device__ __forceinline__ void operator()(const f32x4 (&acc)[2][2][4][2], const Unit& u, int wr, int wc, int fr, int fq) const {
        const int row0 = u.pm * BM + wr * 64 + fr, col0 = u.pn * BM + wc * 32 + 8 * fq;
        f32x4 bv[2][2];
#pragma unroll
        for (int bj = 0; bj < 2; ++bj)
#pragma unroll
            for (int n = 0; n < 2; ++n) bv[bj][n] = bias ? *(const f32x4*)(bias + col0 + bj * HALF + 4 * n) : (f32x4){0.f, 0.f, 0.f, 0.f};
#pragma unroll
        for (int ai = 0; ai < 2; ++ai)
#pragma unroll
            for (int m = 0; m < 4; ++m) { bf16* rowp = O + (size_t)(row0 + ai * HALF + m * 16) * ldc + col0;
#pragma unroll
                for (int bj = 0; bj < 2; ++bj) { const f32x4 v0 = acc[ai][bj][m][0] * scale + bv[bj][0], v1 = acc[ai][bj][m][1] * scale + bv[bj][1];
                    u32x4 w; w.x = cvt_pk_bf16(v0[0], v0[1]); w.y = cvt_pk_bf16(v0[2], v0[3]); w.z = cvt_pk_bf16(v1[0], v1[1]); w.w = cvt_pk_bf16(v1[2], v1[3]);
                    *(u32x4*)(rowp + bj * HALF) = w; } }
    }
};
__device__ __forceinline__ f32x2 swiglu2(f32x2 a, f32x2 b, float c1  , float c2  ) {
    const float inv = __builtin_amdgcn_rcpf(c2), k = __builtin_amdgcn_logf(inv);
    const f32x2 t = a * c1 + k; f32x2 e; e.x = __builtin_amdgcn_exp2f(t.x); e.y = __builtin_amdgcn_exp2f(t.y);
    const f32x2 d = e + inv; f32x2 r; r.x = __builtin_amdgcn_rcpf(d.x); r.y = __builtin_amdgcn_rcpf(d.y);
    return (a * b) * r;
}
#ifndef HW_SAT8
#define HW_SAT8 1
#endif
#if HW_SAT8
#define SAT8(x) (x)
#else
#define SAT8(x) fminf(fmaxf((x), -448.f), 448.f)
#endif
struct EpiF8 {
    static constexpr bool PERM = true;
    unsigned char* O; int ldc; float scale;
    __device__ __forceinline__ void operator()(const f32x4 (&acc)[2][2][4][2], const Unit& u, int wr, int wc, int fr, int fq) const {
        const int row0 = u.pm * BM + wr * 64 + fr, col0 = u.pn * BM + wc * 32 + 8 * fq;
#pragma unroll
        for (int ai = 0; ai < 2; ++ai)
#pragma unroll
            for (int m = 0; m < 4; ++m) { unsigned char* rowp = O + (size_t)(row0 + ai * HALF + m * 16) * ldc + col0;
#pragma unroll
                for (int bj = 0; bj < 2; ++bj) { if (!((u.qm >> (2 * ai + bj)) & 1)) continue;
                    const f32x4 v0 = acc[ai][bj][m][0] * scale, v1 = acc[ai][bj][m][1] * scale; u32x2 w;
                    int t0 = __builtin_amdgcn_cvt_pk_fp8_f32(SAT8(v0[0]), SAT8(v0[1]), 0, false); t0 = __builtin_amdgcn_cvt_pk_fp8_f32(SAT8(v0[2]), SAT8(v0[3]), t0, true);
                    int t1 = __builtin_amdgcn_cvt_pk_fp8_f32(SAT8(v1[0]), SAT8(v1[1]), 0, false); t1 = __builtin_amdgcn_cvt_pk_fp8_f32(SAT8(v1[2]), SAT8(v1[3]), t1, true);
                    w.x = (unsigned)t0; w.y = (unsigned)t1; *(u32x2*)(rowp + bj * HALF) = w; } }
    }
};
template <int ACT  > struct EpiPair {
    static constexpr bool PERM = true;
    bf16* O; int ldc; float sin;
    __device__ __forceinline__ void operator()(const f32x4 (&acc)[2][2][4][2], const Unit& u, int wr, int wc, int fr, int fq) const {
        const int row0 = u.pm * BM + wr * 64 + fr, col0 = u.pn * HALF + wc * 32 + 8 * fq;
#pragma unroll
        for (int ai = 0; ai < 2; ++ai)
#pragma unroll
            for (int m = 0; m < 4; ++m) { bf16* rowp = O + (size_t)(row0 + ai * HALF + m * 16) * ldc + col0;
                f32x4 r[2];
#pragma unroll
                for (int n = 0; n < 2; ++n) { const f32x4 a = acc[ai][0][m][n], b = acc[ai][1][m][n];
                    if (ACT == 1) { const f32x2 lo = swiglu2((f32x2){a[0], a[1]}, (f32x2){b[0], b[1]}, -1.4426950408889634f * sin, sin * sin), hi = swiglu2((f32x2){a[2], a[3]}, (f32x2){b[2], b[3]}, -1.4426950408889634f * sin, sin * sin);
                        r[n] = (f32x4){lo.x, lo.y, hi.x, hi.y}; }
                    else r[n] = (a * b) * (sin * sin); }
                u32x4 w; w.x = cvt_pk_bf16(r[0][0], r[0][1]); w.y = cvt_pk_bf16(r[0][2], r[0][3]); w.z = cvt_pk_bf16(r[1][0], r[1][1]); w.w = cvt_pk_bf16(r[1][2], r[1][3]);
                *(u32x4*)rowp = w; }
    }
};
struct EpiPair8 {
    static constexpr bool PERM = true;
    unsigned char* O; int ldc; float sin, sout;
    __device__ __forceinline__ void operator()(const f32x4 (&acc)[2][2][4][2], const Unit& u, int wr, int wc, int fr, int fq) const {
        const int row0 = u.pm * BM + wr * 64 + fr, col0 = u.pn * HALF + wc * 32 + 8 * fq;
#pragma unroll
        for (int ai = 0; ai < 2; ++ai)
#pragma unroll
            for (int m = 0; m < 4; ++m) { unsigned char* rowp = O + (size_t)(row0 + ai * HALF + m * 16) * ldc + col0;
                float r[8];
#pragma unroll
                for (int n = 0; n < 2; ++n) { const f32x4 a = acc[ai][0][m][n], b = acc[ai][1][m][n];
                    const f32x2 lo = swiglu2((f32x2){a[0], a[1]}, (f32x2){b[0], b[1]}, -1.4426950408889634f * sin, sin * sin * sout), hi = swiglu2((f32x2){a[2], a[3]}, (f32x2){b[2], b[3]}, -1.4426950408889634f * sin, sin * sin * sout);
                    r[4 * n + 0] = SAT8(lo.x); r[4 * n + 1] = SAT8(lo.y); r[4 * n + 2] = SAT8(hi.x); r[4 * n + 3] = SAT8(hi.y); }
                u32x2 w; int t = __builtin_amdgcn_cvt_pk_fp8_f32(r[0], r[1], 0, false); t = __builtin_amdgcn_cvt_pk_fp8_f32(r[2], r[3], t, true); w.x = (unsigned)t;
                t = __builtin_amdgcn_cvt_pk_fp8_f32(r[4], r[5], 0, false); t = __builtin_amdgcn_cvt_pk_fp8_f32(r[6], r[7], t, true); w.y = (unsigned)t;
                *(u32x2*)rowp = w; }
    }
};
struct EpiRes {
    static constexpr bool PERM = false;
    const float* src; float* dst; int ldc; const float* bias; float scale;
    __device__ __forceinline__ void operator()(const f32x4 (&acc)[2][2][4][2], const Unit& u, int wr, int wc, int fr, int fq) const {
        const int row0 = u.pm * BM + wr * 64 + fr, col0 = u.pn * BM + wc * 32 + 4 * fq;
        f32x4 bv[2][2];
#pragma unroll
        for (int bj = 0; bj < 2; ++bj)
#pragma unroll
            for (int n = 0; n < 2; ++n) bv[bj][n] = bias ? *(const f32x4*)(bias + col0 + bj * HALF + n * 16) : (f32x4){0.f, 0.f, 0.f, 0.f};
#pragma unroll
        for (int ai = 0; ai < 2; ++ai)
#pragma unroll
            for (int m = 0; m < 4; ++m) { const size_t off = (size_t)(row0 + ai * HALF + m * 16) * ldc + col0;
                f32x4 s[2][2];
#pragma unroll
                for (int bj = 0; bj < 2; ++bj)
#pragma unroll
                    for (int n = 0; n < 2; ++n) s[bj][n] = *(const f32x4*)(src + off + bj * HALF + n * 16);
#pragma unroll
                for (int bj = 0; bj < 2; ++bj)
#pragma unroll
                    for (int n = 0; n < 2; ++n) *(f32x4*)(dst + off + bj * HALF + n * 16) = s[bj][n] + acc[ai][bj][m][n] * scale + bv[bj][n];
                if (m == 3) asm volatile("" ::: "memory"); }
    }
};
template <bool SRCF>
struct EpiResB {
    static constexpr bool PERM = false;
    const void* src; bf16* dst; int ldc; const float* bias; float scale;
    __device__ __forceinline__ void operator()(const f32x4 (&acc)[2][2][4][2], const Unit& u, int wr, int wc, int fr, int fq) const {
        const int row0 = u.pm * BM + wr * 64 + fr, col0 = u.pn * BM + wc * 32 + 4 * fq;
        f32x4 bv[2][2];
#pragma unroll
        for (int bj = 0; bj < 2; ++bj)
#pragma unroll
            for (int n = 0; n < 2; ++n) bv[bj][n] = bias ? *(const f32x4*)(bias + col0 + bj * HALF + n * 16) : (f32x4){0.f, 0.f, 0.f, 0.f};
#pragma unroll
        for (int ai = 0; ai < 2; ++ai)
#pragma unroll
            for (int m = 0; m < 4; ++m) { const size_t off = (size_t)(row0 + ai * HALF + m * 16) * ldc + col0;
                f32x4 s[2][2];
#pragma unroll
                for (int bj = 0; bj < 2; ++bj)
#pragma unroll
                    for (int n = 0; n < 2; ++n) {
                        if constexpr (SRCF) s[bj][n] = *(const f32x4*)((const float*)src + off + bj * HALF + n * 16);
                        else { const u32x2 w = *(const u32x2*)((const bf16*)src + off + bj * HALF + n * 16); s[bj][n] = (f32x4){bflo(w.x), bfhi(w.x), bflo(w.y), bfhi(w.y)}; } }
#pragma unroll
                for (int bj = 0; bj < 2; ++bj)
#pragma unroll
                    for (int n = 0; n < 2; ++n) { const f32x4 r = s[bj][n] + acc[ai][bj][m][n] * scale + bv[bj][n];
                        u32x2 w; w.x = cvt_pk_bf16(r[0], r[1]); w.y = cvt_pk_bf16(r[2], r[3]); *(u32x2*)(dst + off + bj * HALF + n * 16) = w; }
                if (m == 3) asm volatile("" ::: "memory"); }
    }
};
struct EpiF32 {
    static constexpr bool PERM = false;
    float* C; int ldc; float scale;
    __device__ __forceinline__ void operator()(const f32x4 (&acc)[2][2][4][2], const Unit& u, int wr, int wc, int fr, int fq) const {
        const int row0 = u.pm * BM + wr * 64 + fr, col0 = u.pn * BM + wc * 32 + 4 * fq;
#pragma unroll
        for (int ai = 0; ai < 2; ++ai)
#pragma unroll
            for (int m = 0; m < 4; ++m) { float* rowp = C + (size_t)(row0 + ai * HALF + m * 16) * ldc + col0;
#pragma unroll
                for (int bj = 0; bj < 2; ++bj)
#pragma unroll
                    for (int n = 0; n < 2; ++n) *(f32x4*)(rowp + bj * HALF + n * 16) = acc[ai][bj][m][n] * scale; }
    }
};
template <int K8> struct EpiKVT {
    static constexpr bool PERM = true;
    bf16* Kf; bf16* V; float kscale;
    __device__ __forceinline__ void operator()(const f32x4 (&acc)[2][2][4][2], const Unit& u, int wr, int wc, int fr, int fq) const {
        const int row0 = u.pm * BM + wr * 64 + fr, col0 = wc * 32 + 8 * fq, h = u.pn;
#pragma unroll
        for (int ai = 0; ai < 2; ++ai)
#pragma unroll
            for (int m = 0; m < 4; ++m) { const int row = row0 + ai * HALF + m * 16, b = row >> 13, s = row & 8191; const size_t hr = (size_t)(b * 8 + h) * 8192 + s;
#pragma unroll
                for (int bj = 0; bj < 2; ++bj) { const f32x4 v0 = acc[ai][bj][m][0], v1 = acc[ai][bj][m][1];
                    u32x4 w; w.x = cvt_pk_bf16(v0[0], v0[1]); w.y = cvt_pk_bf16(v0[2], v0[3]); w.z = cvt_pk_bf16(v1[0], v1[1]); w.w = cvt_pk_bf16(v1[2], v1[3]);
                    if (bj == 0) { if (K8) { const int c = col0 >> 6, dl = col0 & 63, a_ = dl >> 4, h_ = (dl >> 3) & 1; u32x2 w8;
                            int t0 = __builtin_amdgcn_cvt_pk_fp8_f32(fminf(fmaxf(v0[0] * kscale, -448.f), 448.f), fminf(fmaxf(v0[1] * kscale, -448.f), 448.f), 0, false); t0 = __builtin_amdgcn_cvt_pk_fp8_f32(fminf(fmaxf(v0[2] * kscale, -448.f), 448.f), fminf(fmaxf(v0[3] * kscale, -448.f), 448.f), t0, true);
                            int t1 = __builtin_amdgcn_cvt_pk_fp8_f32(fminf(fmaxf(v1[0] * kscale, -448.f), 448.f), fminf(fmaxf(v1[1] * kscale, -448.f), 448.f), 0, false); t1 = __builtin_amdgcn_cvt_pk_fp8_f32(fminf(fmaxf(v1[2] * kscale, -448.f), 448.f), fminf(fmaxf(v1[3] * kscale, -448.f), 448.f), t1, true);
                            w8.x = (unsigned)t0; w8.y = (unsigned)t1; *(u32x2*)((unsigned char*)Kf + hr * 192 + 64 * c + 32 * h_ + 8 * a_) = w8; }
                        else *(u32x4*)(Kf + hr * 192 + col0) = w; }
                    else *(u32x4*)(V + hr * 128 + col0) = w; } }
    }
};
typedef EpiKVT<0> EpiKV;

struct EpiK8 {
    static constexpr bool PERM = true;
    unsigned char* K8; float kscale;
    __device__ __forceinline__ void operator()(const f32x4 (&acc)[2][2][4][2], const Unit& u, int wr, int wc, int fr, int fq) const {
        const int row0 = u.pm * BM + wr * 64 + fr, col0 = wc * 32 + 8 * fq, c = col0 >> 6, dl = col0 & 63, a_ = dl >> 4, h_ = (dl >> 3) & 1;
#pragma unroll
        for (int ai = 0; ai < 2; ++ai)
#pragma unroll
            for (int m = 0; m < 4; ++m) { const int row = row0 + ai * HALF + m * 16, b = row >> 13, s = row & 8191;
#pragma unroll
                for (int bj = 0; bj < 2; ++bj) { const size_t hr = (size_t)(b * 8 + 2 * u.pn + bj) * 8192 + s; const f32x4 v0 = acc[ai][bj][m][0] * kscale, v1 = acc[ai][bj][m][1] * kscale; u32x2 w8;
                    int t0 = __builtin_amdgcn_cvt_pk_fp8_f32(SAT8(v0[0]), SAT8(v0[1]), 0, false); t0 = __builtin_amdgcn_cvt_pk_fp8_f32(SAT8(v0[2]), SAT8(v0[3]), t0, true);
                    int t1 = __builtin_amdgcn_cvt_pk_fp8_f32(SAT8(v1[0]), SAT8(v1[1]), 0, false); t1 = __builtin_amdgcn_cvt_pk_fp8_f32(SAT8(v1[2]), SAT8(v1[3]), t1, true);
                    w8.x = (unsigned)t0; w8.y = (unsigned)t1; *(u32x2*)(K8 + hr * 192 + 64 * c + 32 * h_ + 8 * a_) = w8; } }
    }
};
struct EpiVT8 {
    static constexpr bool PERM = true;
    unsigned char* VT; size_t ldt; float vscale;
    __device__ __forceinline__ void operator()(const f32x4 (&acc)[2][2][4][2], const Unit& u, int wr, int wc, int fr, int fq) const {
        const int row0 = u.pm * BM + wr * 64 + fr;
#pragma unroll
        for (int ai = 0; ai < 2; ++ai)
#pragma unroll
            for (int m = 0; m < 4; ++m) { unsigned char* rowp = VT + (size_t)(row0 + ai * HALF + m * 16) * ldt;
#pragma unroll
                for (int bj = 0; bj < 2; ++bj) { const int tok0 = u.pn * BM + bj * HALF + wc * 32 + 8 * fq, k0 = tok0 & 63, pos = (tok0 & ~63) + 16 * (k0 >> 5) + 4 * ((k0 >> 3) & 3);
                    const f32x4 v0 = acc[ai][bj][m][0] * vscale, v1 = acc[ai][bj][m][1] * vscale;
                    int t0 = __builtin_amdgcn_cvt_pk_fp8_f32(SAT8(v0[0]), SAT8(v0[1]), 0, false); t0 = __builtin_amdgcn_cvt_pk_fp8_f32(SAT8(v0[2]), SAT8(v0[3]), t0, true);
                    int t1 = __builtin_amdgcn_cvt_pk_fp8_f32(SAT8(v1[0]), SAT8(v1[1]), 0, false); t1 = __builtin_amdgcn_cvt_pk_fp8_f32(SAT8(v1[2]), SAT8(v1[3]), t1, true);
                    *(unsigned*)(rowp + pos) = (unsigned)t0; *(unsigned*)(rowp + pos + 32) = (unsigned)t1; } }
    }
};

typedef int v8i32 __attribute__((ext_vector_type(8)));
__device__ __forceinline__ v8i32 cat8(bf16x8 a, bf16x8 b) { typedef int v4i32 __attribute__((ext_vector_type(4))); const v4i32 x = __builtin_bit_cast(v4i32, a), y = __builtin_bit_cast(v4i32, b); return __builtin_shufflevector(x, y, 0, 1, 2, 3, 4, 5, 6, 7); }
typedef int v4i32 __attribute__((ext_vector_type(4)));
template <bool B_> struct BoolC { static constexpr bool value = B_; };
template <class Epi, class Sched, int PREC = 0, bool GATH = false, bool QS = false  >
__device__ __forceinline__ void gemm_phase(LAS unsigned char* lds, const Gemm g, const Sched& S, const Epi& E) {
    constexpr bool F8 = (PREC == 1), I8 = (PREC == 2);
    int tid = threadIdx.x; asm volatile("" : "+v"(tid));
    const int wid = __builtin_amdgcn_readfirstlane(tid >> 6), lane = tid & 63, wr = wid >> 2, wc = wid & 3, fr = lane & 15, fq = lane >> 4;
    const int K = g.K, nt = K / BK, lda = g.lda;
    unsigned voffA[2], voffB[2];
#pragma unroll
    for (int i = 0; i < 2; ++i) { int R, C; stage_rc(tid * 16 + i * 8192, R, C); const int Rb = Epi::PERM ? ((R & ~31) + perm32(R & 31)) : R;
        voffA[i] = (unsigned)(R * lda + C) * 2u; voffB[i] = (unsigned)(Rb * K + C) * 2u; }
    unsigned gvc[2][2], gvn[2][2];
#define PG8_GIDX(dst, pm_) do { _Pragma("unroll") for (int h_ = 0; h_ < 2; ++h_) _Pragma("unroll") for (int i_ = 0; i_ < 2; ++i_) { int R_, C_; stage_rc(tid * 16 + i_ * 8192, R_, C_); \
        const unsigned t_ = (unsigned)g.gidx[(pm_) * BM + h_ * HALF + R_]; dst[h_][i_] = ((t_ < 65536u ? t_ : 65535u) * (unsigned)lda + (unsigned)C_) * 2u; } } while (0)
    const size_t kstep = (size_t)(BK * 2);
    const size_t hstepA = (size_t)HALF * lda * 2, hstepB = (size_t)HALF * K * 2;
    const size_t tstepA = 2 * hstepA, tstepB = 2 * hstepB;
    const unsigned ldsw = (unsigned)wid * 1024u;
    const int aoff = lds_byte(wr * 64 + fr, fq * 8), boff = lds_byte(wc * 32 + fr, fq * 8);
#define PG8_SA(b, h) (((b) * 2 + (h)) * HTB)
#define PG8_SB(b, h) ((4 + (b) * 2 + (h)) * HTB)
#define PG8_STAGE(bufoff, gbase, voff) do { _Pragma("unroll") for (int _i = 0; _i < 2; ++_i) \
        __builtin_amdgcn_global_load_lds((const unsigned*)((const char*)(gbase) + (voff)[_i]), (LAS unsigned*)(lds + (bufoff) + ldsw + _i * 8192), 16, 0, 0); } while (0)
#define PG8_STAGE_A(bufoff, gbase, h, nx) do { if constexpr (GATH) { if (nx) PG8_STAGE(bufoff, gbase, gvn[h]); else PG8_STAGE(bufoff, gbase, gvc[h]); } else PG8_STAGE(bufoff, (gbase) + (h) * hstepA, voffA); } while (0)
#define PG8_LDA(dst, b, h) do { _Pragma("unroll") for (int m = 0; m < 4; ++m) _Pragma("unroll") for (int k = 0; k < 2; ++k) dst[m][k] = *(const LAS bf16x8*)(lds + PG8_SA(b, h) + aoff + m * 2048 + k * 1024); } while (0)
#define PG8_LDB(dst, b, h) do { _Pragma("unroll") for (int n = 0; n < 2; ++n) _Pragma("unroll") for (int k = 0; k < 2; ++k) dst[n][k] = *(const LAS bf16x8*)(lds + PG8_SB(b, h) + boff + n * 2048 + k * 1024); } while (0)
#define PG8_MMA(ai, bj, At, Bt) do { __builtin_amdgcn_s_setprio(1); asm volatile("s_nop 1"); _Pragma("unroll") for (int m = 0; m < 4; ++m) _Pragma("unroll") for (int n = 0; n < 2; ++n) { \
        if constexpr (F8) { const v8i32 b8_ = cat8(Bt[n][0], Bt[n][1]), a8_ = cat8(At[m][0], At[m][1]); asm("v_mfma_f32_16x16x128_f8f6f4 %0, %1, %2, %0" : "+v"(acc[ai][bj][m][n]) : "v"(b8_), "v"(a8_)); } \
        else if constexpr (I8) { _Pragma("unroll") for (int k = 0; k < 2; ++k) asm("v_mfma_i32_16x16x64_i8 %0, %1, %2, %0" : "+v"(acc[ai][bj][m][n]) : "v"(Bt[n][k]), "v"(At[m][k])); } \
        else { _Pragma("unroll") for (int k = 0; k < 2; ++k) asm("v_mfma_f32_16x16x32_bf16 %0, %1, %2, %0" : "+v"(acc[ai][bj][m][n]) : "v"(Bt[n][k]), "v"(At[m][k])); } } __builtin_amdgcn_s_setprio(0); } while (0)
#define PG8_MMAZ(ai, bj, At, Bt) do { __builtin_amdgcn_s_setprio(1); asm volatile("s_nop 1"); _Pragma("unroll") for (int m = 0; m < 4; ++m) _Pragma("unroll") for (int n = 0; n < 2; ++n) { \
        if constexpr (F8) { const v8i32 b8_ = cat8(Bt[n][0], Bt[n][1]), a8_ = cat8(At[m][0], At[m][1]); asm("v_mfma_f32_16x16x128_f8f6f4 %0, %1, %2, 0" : "=v"(acc[ai][bj][m][n]) : "v"(b8_), "v"(a8_)); } \
        else if constexpr (I8) { asm("v_mfma_i32_16x16x64_i8 %0, %1, %2, 0" : "=v"(acc[ai][bj][m][n]) : "v"(Bt[n][0]), "v"(At[m][0])); \
            asm("v_mfma_i32_16x16x64_i8 %0, %1, %2, %0" : "+v"(acc[ai][bj][m][n]) : "v"(Bt[n][1]), "v"(At[m][1])); } \
        else { asm("v_mfma_f32_16x16x32_bf16 %0, %1, %2, 0" : "=v"(acc[ai][bj][m][n]) : "v"(Bt[n][0]), "v"(At[m][0])); \
            asm("v_mfma_f32_16x16x32_bf16 %0, %1, %2, %0" : "+v"(acc[ai][bj][m][n]) : "v"(Bt[n][1]), "v"(At[m][1])); } } __builtin_amdgcn_s_setprio(0); } while (0)
#define PG8_WAIT_V(n) asm volatile("s_waitcnt vmcnt(" #n ")" ::: "memory")
#define PG8_WAIT_L(n) asm volatile("s_waitcnt lgkmcnt(" #n ")" ::: "memory")
#define PG8_BAR __builtin_amdgcn_s_barrier()
#define PG8_SCHED __builtin_amdgcn_sched_barrier(0)
    Unit cur, nxt; int ui = 0;
#ifdef DIAG_GEMM
    unsigned long long dg_k = 0, dg_b = 0, dg_e = 0, dg_t = __builtin_amdgcn_s_memrealtime(); const unsigned long long dg_w0 = dg_t, dg_c0 = __builtin_readcyclecounter();
#endif
    if (!S.next(0, cur)) return;
    f32x4 acc[2][2][4][2];
#pragma unroll
    for (int a = 0; a < 2; ++a)
#pragma unroll
        for (int b = 0; b < 2; ++b)
#pragma unroll
            for (int m = 0; m < 4; ++m)
#pragma unroll
                for (int n = 0; n < 2; ++n) acc[a][b][m][n] = (f32x4){0.f, 0.f, 0.f, 0.f};
    bf16x8 At[4][2], B0[2][2], B1[2][2];
    const char* cA = (const char*)g.A + (GATH ? (size_t)0 : (size_t)cur.pm * tstepA); const char* cB = (const char*)g.Bt + (size_t)cur.e * g.estride + (size_t)cur.pn * tstepB;
    if constexpr (GATH) PG8_GIDX(gvc, cur.pm);
    PG8_STAGE(PG8_SB(0, 0), cB, voffB); PG8_STAGE(PG8_SB(0, 1), cB + hstepB, voffB); PG8_STAGE_A(PG8_SA(0, 0), cA, 0, false); PG8_STAGE_A(PG8_SA(0, 1), cA, 1, false);
    if (wr == 1) PG8_BAR;
    PG8_WAIT_V(2); PG8_BAR;
    PG8_STAGE(PG8_SB(1, 0), cB + kstep, voffB); PG8_STAGE_A(PG8_SA(1, 0), cA + kstep, 0, false); PG8_STAGE(PG8_SB(1, 1), cB + hstepB + kstep, voffB);
    PG8_WAIT_V(6); PG8_BAR;
    for (;;) {
        const bool has_next = S.next(ui + 1, nxt);
        const char* nA = (has_next && !GATH) ? (const char*)g.A + (size_t)nxt.pm * tstepA : cA; const char* nB = has_next ? (const char*)g.Bt + (size_t)nxt.e * g.estride + (size_t)nxt.pn * tstepB : cB;
        if constexpr (I8) {
            const float* sp_ = (tid < 256) ? g.rs + (size_t)cur.pm * BM + tid : g.cs + (size_t)cur.e * g.cs_estride + (size_t)cur.pn * BM + (tid - 256);
            __builtin_amdgcn_global_load_lds((const unsigned*)sp_, (LAS unsigned*)(lds + 131072 + 4096 + (ui & 1) * 2048 + wid * 256), 4, 0, 0); }
        if constexpr (GATH) { if (has_next && nxt.pm != cur.pm) PG8_GIDX(gvn, nxt.pm); else {
#pragma unroll
            for (int h_ = 0; h_ < 2; ++h_) { gvn[h_][0] = gvc[h_][0]; gvn[h_][1] = gvc[h_][1]; } } }
        const int qm_ = QS ? cur.qm : 15;
        const bool Q00 = qm_ & 1, Q01 = qm_ & 2, Q10 = qm_ & 4, Q11 = qm_ & 8, QB0 = qm_ & 5, QB1 = qm_ & 10, QA0 = qm_ & 3, QA1 = qm_ & 12;
        auto kbody = [&](const int t, auto zc_) __attribute__((always_inline)) {
            constexpr bool ZC = decltype(zc_)::value;
            const bool last = (t == nt - 2);
            const char* a1 = cA + (size_t)(t + 1) * kstep;
            const char* a2 = last ? nA : cA + (size_t)(t + 2) * kstep; const char* b2 = last ? nB : cB + (size_t)(t + 2) * kstep;
            const char* a3 = a2 + kstep; const char* b3 = b2 + kstep;
            if (QB0) PG8_LDB(B0, 0, 0); if (QB1) PG8_LDB(B1, 0, 1); PG8_SCHED; if (QA0) PG8_LDA(At, 0, 0); PG8_STAGE_A(PG8_SA(1, 1), a1, 1, false);
            PG8_WAIT_V(8); PG8_WAIT_L(0); PG8_BAR; if constexpr (ZC) { if (Q00) PG8_MMAZ(0, 0, At, B0); if (Q01) PG8_MMAZ(0, 1, At, B1); } else { if (Q00) PG8_MMA(0, 0, At, B0); if (Q01) PG8_MMA(0, 1, At, B1); } PG8_BAR; PG8_SCHED;
            if (QA1) PG8_LDA(At, 0, 1); PG8_STAGE(PG8_SB(0, 0), b2, voffB); PG8_STAGE(PG8_SB(0, 1), b2 + hstepB, voffB); PG8_STAGE_A(PG8_SA(0, 0), a2, 0, last);
            PG8_WAIT_V(8); PG8_WAIT_L(0); PG8_BAR; if constexpr (ZC) { if (Q10) PG8_MMAZ(1, 0, At, B0); if (Q11) PG8_MMAZ(1, 1, At, B1); } else { if (Q10) PG8_MMA(1, 0, At, B0); if (Q11) PG8_MMA(1, 1, At, B1); } PG8_BAR; PG8_SCHED;
            if (QB0) PG8_LDB(B0, 1, 0); if (QB1) PG8_LDB(B1, 1, 1); PG8_SCHED; if (QA0) PG8_LDA(At, 1, 0); PG8_STAGE_A(PG8_SA(0, 1), a2, 1, last);
            PG8_WAIT_V(8); PG8_WAIT_L(0); PG8_BAR; if (Q00) PG8_MMA(0, 0, At, B0); if (Q01) PG8_MMA(0, 1, At, B1); PG8_BAR; PG8_SCHED;
            if (QA1) PG8_LDA(At, 1, 1); PG8_STAGE(PG8_SB(1, 0), b3, voffB); PG8_STAGE(PG8_SB(1, 1), b3 + hstepB, voffB); PG8_STAGE_A(PG8_SA(1, 0), a3, 0, last);
            PG8_WAIT_V(8); PG8_WAIT_L(0); PG8_BAR; if (Q10) PG8_MMA(1, 0, At, B0); if (Q11) PG8_MMA(1, 1, At, B1); PG8_BAR; PG8_SCHED;
        };
        kbody(0, BoolC<true>{});
#pragma nounroll
        for (int t = 2; t < nt; t += 2) kbody(t, BoolC<false>{});
        asm volatile("s_nop 15\n\ts_nop 15" ::: "memory");
#ifdef DIAG_GEMM
        { const unsigned long long c = __builtin_amdgcn_s_memrealtime(); dg_k += c - dg_t; dg_t = c; }
#endif
        if (wr == 0) PG8_BAR;
#ifdef DIAG_GEMM
        { const unsigned long long c = __builtin_amdgcn_s_memrealtime(); dg_b += c - dg_t; dg_t = c; }
#endif
        if constexpr (I8) {
            const LAS float* rsl = (const LAS float*)(lds + 131072 + 4096 + (ui & 1) * 2048); const LAS float* csb = rsl + 256 + wc * 32;
            f32x4 cv[2][2];
#pragma unroll
            for (int bj = 0; bj < 2; ++bj)
#pragma unroll
                for (int n = 0; n < 2; ++n) cv[bj][n] = *(const LAS f32x4*)(csb + bj * HALF + (Epi::PERM ? 8 * fq + 4 * n : 16 * n + 4 * fq));
#pragma unroll
            for (int ai = 0; ai < 2; ++ai)
#pragma unroll
                for (int m = 0; m < 4; ++m) { const float rv = rsl[ai * HALF + wr * 64 + m * 16 + fr];
#pragma unroll
                    for (int bj = 0; bj < 2; ++bj)
#pragma unroll
                        for (int n = 0; n < 2; ++n) { const v4i32 iv = __builtin_bit_cast(v4i32, acc[ai][bj][m][n]);
                            acc[ai][bj][m][n] = (f32x4){(float)iv[0], (float)iv[1], (float)iv[2], (float)iv[3]} * cv[bj][n] * rv; } }
        }
        E(acc, cur, wr, wc, fr, fq);
#ifdef DIAG_GEMM
        { const unsigned long long c = __builtin_amdgcn_s_memrealtime(); dg_e += c - dg_t; dg_t = c; }
#endif
        if (!has_next) break;
        cur = nxt; cA = nA; cB = nB; ++ui;
        if constexpr (GATH) {
#pragma unroll
            for (int h_ = 0; h_ < 2; ++h_) { gvc[h_][0] = gvn[h_][0]; gvc[h_][1] = gvn[h_][1]; } }
        if (wr == 1) PG8_BAR;
    }
    PG8_WAIT_V(0);
    PG8_BAR;
#ifdef DIAG_GEMM
    if (g.diag && blockIdx.x == DIAG_BLOCK && tid == 0) { g.diag[0] = dg_k; g.diag[1] = dg_b; g.diag[2] = dg_e; g.diag[3] = __builtin_readcyclecounter() - dg_c0; g.diag[4] = __builtin_amdgcn_s_memrealtime() - dg_w0; g.diag[5] = (unsigned long long)(ui + 1); }
#endif
#undef PG8_SA
#undef PG8_SB
#undef PG8_STAGE
#undef PG8_MMAZ
#undef PG8_STAGE_A
#undef PG8_GIDX
#undef PG8_LDA
#undef PG8_LDB
#undef PG8_MMA
#undef PG8_WAIT_V
#undef PG8_WAIT_L
#undef PG8_BAR
#undef PG8_SCHED
}
}
namespace att {
constexpr int NW = 8, QBLK = 32, KVBLK = 64, QB = NW * QBLK;
__device__ __forceinline__ int crow(int r, int hi) { return (r & 3) + 8 * (r >> 2) + 4 * hi; }
template <int NCB> __device__ __forceinline__ int v_st(int k, int c) { const int kk = (k & ~0xC) | ((k & 4) << 1) | ((k & 8) >> 1); return ((kk >> 3) * NCB + (c >> 5)) * 512 + ((kk & 7) * 32 + (c & 31)) * 2; }
__device__ __forceinline__ int v_rd_base(int lane) { return ((lane & 3) << 3) | (((lane >> 2) & 3) << 6) | (((lane >> 4) & 1) << 5) | (((lane >> 5) & 1) << 8); }

struct Params {
    const bf16* Q; int ldq;
    const bf16* K; int ldk;
    const bf16* V; int ldv;
    bf16* O; int ldo;
    int P0;
    int j_lo, j_hi;
    const float* rope;
    const int* pos;
    float slope_over_scale, sink_l2;
    const float* sinks; int qh0;
};

constexpr float QK8_SCALE = 8.f;
typedef int v8i32a __attribute__((ext_vector_type(8)));
typedef int v4i32a __attribute__((ext_vector_type(4)));
constexpr float O8_SCALE = 32.f;
template <int DQK, int DV, int KIND, int W, bool QK8 = false, bool O8 = false  , bool RES = false>
__device__ __forceinline__ void attn_block(const Params& p, char* lds) {
    constexpr bool PAIR = QK8 && !RES;
    constexpr int NBUF = RES ? 6 : (PAIR ? 4 : 2), NH = RES ? 8 : 1;
    constexpr int NKS = DQK / 64, ND0 = DQK / 16, NCB = DV / 32, NVP = DV / 64;
    constexpr int KT = QK8 ? NKS * 4096 : NKS * 8192, VT = QK8 ? KVBLK * DV : KVBLK * DV * 2;
    constexpr int OFF_K = NBUF * VT, OFF_KP = OFF_K + NBUF * KT, OFF_WS = OFF_KP + NBUF * 256;
    const float SCALE = ((DQK == 192) ? 0.07216878364870322f : 0.125f) * (QK8 ? 1.0f / (QK8_SCALE * QK8_SCALE) : 1.0f);
    const float C2 = 1.4426950408889634f * SCALE;
    constexpr float THR = QK8 ? 2.f : 8.f;
    int tid = threadIdx.x; asm volatile("" : "+v"(tid));
    const int wid = __builtin_amdgcn_readfirstlane(tid >> 6), lane = tid & 63, r32 = lane & 31, hi = lane >> 5;
    LAS unsigned char* lds3 = (LAS unsigned char*)lds; char* V_lds = lds; char* K_lds = lds + OFF_K; float* kp_lds = (float*)(lds + OFF_KP);
    float* ws = (float*)(lds + OFF_WS) + wid * 64; float* li_l = ws, * al_l = ws + 32;
    const int NT = p.j_hi - p.j_lo;
    const int qlo = p.P0 + wid * QBLK, qm = qlo + r32 - 4 * hi;
    unsigned kofs, vofs[NVP];
    if (QK8) { const int key = lane >> 2, lc = (lane & 3) ^ ((key >> 2) & 3); kofs = (unsigned)(key * p.ldk + 16 * lc); }
    else { const int q = wid * 64 + lane, key = q >> 3, c = (q & 7) ^ ((key >> 1) & 7); kofs = (unsigned)(key * p.ldk + c * 8) * 2u; }
    if (QK8) { const int lc = (lane & 3) ^ ((lane >> 4) & 3); vofs[0] = (unsigned)((lane >> 2) * p.ldv + 16 * lc); }
    else
#pragma unroll
    for (int i = 0; i < NVP; ++i) { const int bo = (wid + 8 * i) * 1024 + lane * 16, sub = bo >> 9, within = bo & 511, kk = (sub / NCB) * 8 + (within >> 6), c = (sub % NCB) * 32 + ((within & 63) >> 1);
        const int k = (kk & ~0xC) | ((kk & 4) << 1) | ((kk & 8) >> 1); vofs[i] = (unsigned)(k * p.ldv + c) * 2u; }
    float st_p = 0.f;
#define ST_LOAD(kb, bf) do { \
        const char* kb_ = (const char*)p.K + (size_t)(kb) * (size_t)(QK8 ? p.ldk : p.ldk * 2); const char* vb_ = (const char*)p.V + (size_t)(kb) * (size_t)(p.ldv * 2); \
        if constexpr (QK8) {   \
            { const int pc_ = wid; __builtin_amdgcn_global_load_lds((const unsigned*)(kb_ + kofs + (pc_ & 3) * 16 * p.ldk + (pc_ >> 2) * 64), (LAS unsigned*)(lds3 + OFF_K + (bf) * KT + pc_ * 1024), 16, 0, 0); } \
            if (wid < 4) { const int pc_ = 8 + wid; __builtin_amdgcn_global_load_lds((const unsigned*)(kb_ + kofs + (pc_ & 3) * 16 * p.ldk + (pc_ >> 2) * 64), (LAS unsigned*)(lds3 + OFF_K + (bf) * KT + pc_ * 1024), 16, 0, 0); } \
        } else { _Pragma("unroll") for (int s_ = 0; s_ < NKS; ++s_) __builtin_amdgcn_global_load_lds((const unsigned*)(kb_ + kofs + s_ * 128), (LAS unsigned*)(lds3 + OFF_K + (bf) * KT + s_ * 8192 + wid * 1024), 16, 0, 0); } \
        if constexpr (QK8) __builtin_amdgcn_global_load_lds((const unsigned*)((const char*)p.V + (size_t)(kb) + (size_t)(16 * wid) * (size_t)p.ldv + vofs[0]), (LAS unsigned*)(lds3 + (bf) * VT + wid * 1024), 16, 0, 0); \
        else { _Pragma("unroll") for (int i_ = 0; i_ < NVP; ++i_) __builtin_amdgcn_global_load_lds((const unsigned*)(vb_ + vofs[i_]), (LAS unsigned*)(lds3 + (bf) * VT + (wid + 8 * i_) * 1024), 16, 0, 0); } \
        if (KIND == 1 && !RES && tid < 64) st_p = (float)p.pos[(kb) + tid]; } while (0)
#define ST_WRITE(bf) do { if (KIND == 1 && tid < 64) kp_lds[(bf) * 64 + tid] = st_p; } while (0)
    bf16x8 qr[ND0];
    if constexpr (RES) {
#pragma unroll
        for (int t_ = 0; t_ < NBUF; ++t_) if (t_ < NT) ST_LOAD((p.j_lo + t_) * KVBLK, t_);
        if (tid < NT * KVBLK) kp_lds[tid] = (float)p.pos[p.j_lo * KVBLK + tid];
    } else { ST_LOAD(p.j_lo * KVBLK, 0); if constexpr (PAIR) ST_LOAD((p.j_lo + 1) * KVBLK, 1); }
    { const bf16* qrow = p.Q + (size_t)(wid * QBLK + r32) * p.ldq + hi * 8;
#pragma unroll
      for (int d0 = 0; d0 < ND0; ++d0) qr[d0] = *(const bf16x8*)(qrow + d0 * 16); }
    float pq = 0.f;
    if (KIND == 0) {
        const float* rt = p.rope + (size_t)(wid * QBLK + r32) * 64;
#pragma unroll
        for (int dd = 0; dd < 2; ++dd) {
            const int i0 = dd * 16 + hi * 8;
            const f32x4 c0 = *(const f32x4*)(rt + i0), c1 = *(const f32x4*)(rt + i0 + 4), s0 = *(const f32x4*)(rt + 32 + i0), s1 = *(const f32x4*)(rt + 32 + i0 + 4);
            bf16x8 a = qr[8 + dd], b = qr[10 + dd]; u32x4 ra, rb; float x1[8], x2[8], cs[8], sn[8];
#pragma unroll
            for (int j = 0; j < 4; ++j) { cs[j] = c0[j]; cs[4 + j] = c1[j]; sn[j] = s0[j]; sn[4 + j] = s1[j]; }
#pragma unroll
            for (int j = 0; j < 8; ++j) { x1[j] = bf2f((unsigned short)a[j]); x2[j] = bf2f((unsigned short)b[j]); }
#pragma unroll
            for (int j = 0; j < 4; ++j) { ra[j] = cvt_pk_bf16(x1[2 * j] * cs[2 * j] - x2[2 * j] * sn[2 * j], x1[2 * j + 1] * cs[2 * j + 1] - x2[2 * j + 1] * sn[2 * j + 1]);
                                          rb[j] = cvt_pk_bf16(x2[2 * j] * cs[2 * j] + x1[2 * j] * sn[2 * j], x2[2 * j + 1] * cs[2 * j + 1] + x1[2 * j + 1] * sn[2 * j + 1]); }
            qr[8 + dd] = *reinterpret_cast<bf16x8*>(&ra); qr[10 + dd] = *reinterpret_cast<bf16x8*>(&rb);
        }
    } else { pq = (float)p.pos[qlo + r32]; }
    int ka[4];
#pragma unroll
    for (int j = 0; j < 4; ++j) ka[j] = r32 * 128 + (((2 * j + hi) ^ ((r32 >> 1) & 7)) << 4);
    v8i32a q8[NKS];
    if (QK8) {
#pragma unroll
        for (int c = 0; c < NKS; ++c) {
#pragma unroll
            for (int a_ = 0; a_ < 4; ++a_) { const bf16x8 f = qr[4 * c + a_]; float x[8];
#pragma unroll
                for (int j = 0; j < 8; ++j) x[j] = fminf(fmaxf(bf2f((unsigned short)f[j]) * QK8_SCALE, -448.f), 448.f);
                int t0 = __builtin_amdgcn_cvt_pk_fp8_f32(x[0], x[1], 0, false); t0 = __builtin_amdgcn_cvt_pk_fp8_f32(x[2], x[3], t0, true);
                int t1 = __builtin_amdgcn_cvt_pk_fp8_f32(x[4], x[5], 0, false); t1 = __builtin_amdgcn_cvt_pk_fp8_f32(x[6], x[7], t1, true);
                q8[c][2 * a_] = t0; q8[c][2 * a_ + 1] = t1; } }
        ka[0] = r32 * 64 + (((2 * hi) ^ ((r32 >> 2) & 3)) << 4); ka[1] = r32 * 64 + (((2 * hi + 1) ^ ((r32 >> 2) & 3)) << 4);
    }
    const int vb0 = (int)(uintptr_t)V_lds + v_rd_base(lane);
    float m_reg = -1e30f, l_reg = 0.f; f32x16 o[NCB];
#pragma unroll
    for (int d = 0; d < NCB; ++d) o[d] = f32x16{};
    asm volatile("s_waitcnt vmcnt(0)" ::: "memory");
    if constexpr (!RES) ST_WRITE(0);
    __syncthreads();
    float slope_c = p.slope_over_scale, sink_c = p.sink_l2;
#pragma nounroll
    for (int g = 0; g < NH; ++g) {
    bf16x8 qn[ND0];
    if constexpr (RES) {
        if (g + 1 < NH) { const bf16* qrow = p.Q + (size_t)(wid * QBLK + r32) * p.ldq + hi * 8 + (g + 1) * DQK;
#pragma unroll
            for (int d0 = 0; d0 < ND0; ++d0) qn[d0] = *(const bf16x8*)(qrow + d0 * 16); }
        slope_c = __builtin_amdgcn_exp2f(-0.5f * (float)(p.qh0 + g + 1)) * 8.0f; sink_c = p.sinks[p.qh0 + g] * 1.4426950408889634f;
        m_reg = -1e30f; l_reg = 0.f;
#pragma unroll
        for (int d = 0; d < NCB; ++d) o[d] = f32x16{};
    }
#define TRRD(dst, off) asm volatile("ds_read_b64_tr_b16 %0, %1 offset:%2" : "=&v"(dst) : "v"(vb0), "i"(off) : "memory")
#define TILE(t, BF) do { \
        const int kb_ = (p.j_lo + (t)) * KVBLK; \
        if constexpr (!RES && !PAIR) { if ((t) + 1 < NT) { const int kn_ = kb_ + KVBLK; ST_LOAD(kn_, (BF) ^ 1); } } \
        const bool act_ = (kb_ <= qlo + QBLK - 1) && (kb_ + KVBLK - 1 >= qlo - W + 1); \
        if (act_) { \
            f32x16 p0 = f32x16{}, p1 = f32x16{}; \
            if constexpr (QK8) { \
              _Pragma("unroll") for (int c_ = 0; c_ < NKS; ++c_) { const char* a0_ = K_lds + (BF) * KT + c_ * 4096 + ka[0]; const char* a1_ = K_lds + (BF) * KT + c_ * 4096 + ka[1]; \
                const v8i32a k0 = __builtin_shufflevector(*(const v4i32a*)a0_, *(const v4i32a*)a1_, 0, 1, 2, 3, 4, 5, 6, 7), k1 = __builtin_shufflevector(*(const v4i32a*)(a0_ + 2048), *(const v4i32a*)(a1_ + 2048), 0, 1, 2, 3, 4, 5, 6, 7); \
                p0 = __builtin_amdgcn_mfma_scale_f32_32x32x64_f8f6f4(k0, q8[c_], p0, 0, 0, 0, 0, 0, 0); p1 = __builtin_amdgcn_mfma_scale_f32_32x32x64_f8f6f4(k1, q8[c_], p1, 0, 0, 0, 0, 0, 0); } \
            } else \
            { bf16x8 kf[2][4];                                                  \
              _Pragma("unroll") for (int s_ = 0; s_ < 2; ++s_) { const char* a_ = K_lds + (BF) * KT + ka[s_]; kf[0][2 * s_] = *(const bf16x8*)a_; kf[0][2 * s_ + 1] = *(const bf16x8*)(a_ + 4096); } \
              _Pragma("unroll") for (int g_ = 0; g_ < ND0 / 2; ++g_) { \
                if (g_ + 1 < ND0 / 2) { _Pragma("unroll") for (int s_ = 0; s_ < 2; ++s_) { const int d0 = 2 * (g_ + 1) + s_; const char* a_ = K_lds + (BF) * KT + (d0 >> 2) * 8192 + ka[d0 & 3]; \
                    kf[(g_ + 1) & 1][2 * s_] = *(const bf16x8*)a_; kf[(g_ + 1) & 1][2 * s_ + 1] = *(const bf16x8*)(a_ + 4096); } } \
                __builtin_amdgcn_sched_barrier(0); \
                _Pragma("unroll") for (int s_ = 0; s_ < 2; ++s_) { const int d0 = 2 * g_ + s_; \
                    p0 = __builtin_amdgcn_mfma_f32_32x32x16_bf16(kf[g_ & 1][2 * s_], qr[d0], p0, 0, 0, 0); p1 = __builtin_amdgcn_mfma_f32_32x32x16_bf16(kf[g_ & 1][2 * s_ + 1], qr[d0], p1, 0, 0, 0); } \
                __builtin_amdgcn_sched_barrier(0); } } \
            if (KIND == 1) { const float* kq = kp_lds + (BF) * 64 + 4 * hi; \
                _Pragma("unroll") for (int g_ = 0; g_ < 4; ++g_) { const f32x4 k0 = *(const f32x4*)(kq + 8 * g_), k1 = *(const f32x4*)(kq + 32 + 8 * g_); \
                    _Pragma("unroll") for (int c_ = 0; c_ < 4; ++c_) { p0[4 * g_ + c_] = fmaf(-slope_c, fabsf(pq - k0[c_]), p0[4 * g_ + c_]); p1[4 * g_ + c_] = fmaf(-slope_c, fabsf(pq - k1[c_]), p1[4 * g_ + c_]); } } } \
            if (kb_ + KVBLK - 1 > qlo || kb_ <= qlo + QBLK - 1 - W) { const int dq_ = qm - kb_; const float NEG = -__builtin_inff(); \
                _Pragma("unroll") for (int r = 0; r < 16; ++r) { const int c_ = (r & 3) + 8 * (r >> 2); \
                    if ((unsigned)(dq_ - c_) >= (unsigned)W) p0[r] = NEG; if ((unsigned)(dq_ - c_ - 32) >= (unsigned)W) p1[r] = NEG; } } \
            float pmax; { float m_[4];   \
              _Pragma("unroll") for (int q_ = 0; q_ < 4; ++q_) { m_[q_] = __builtin_fmaxf(__builtin_fmaxf(p0[4 * q_], p0[4 * q_ + 1]), p0[4 * q_ + 2]); m_[q_] = __builtin_fmaxf(__builtin_fmaxf(m_[q_], p0[4 * q_ + 3]), p1[4 * q_]); \
                  m_[q_] = __builtin_fmaxf(__builtin_fmaxf(m_[q_], p1[4 * q_ + 1]), p1[4 * q_ + 2]); m_[q_] = __builtin_fmaxf(m_[q_], p1[4 * q_ + 3]); } \
              pmax = __builtin_fmaxf(__builtin_fmaxf(m_[0], m_[1]), __builtin_fmaxf(m_[2], m_[3])); } \
            { auto rr = __builtin_amdgcn_permlane32_swap(__float_as_uint(pmax), __float_as_uint(pmax), false, false); pmax = fmaxf(__uint_as_float(rr[0]), __uint_as_float(rr[1])); } \
            float mn, alpha; \
            if (__all((pmax - m_reg) * SCALE <= THR)) { mn = m_reg; alpha = 1.f; } \
            else { mn = fmaxf(m_reg, pmax); alpha = __builtin_amdgcn_exp2f((m_reg - mn) * C2); m_reg = mn; } \
            const float mnL = -mn * C2 + (QK8 ? 5.0f : 0.0f); float ps = 0.f;     \
            _Pragma("unroll") for (int r = 0; r < 16; ++r) { p0[r] = __builtin_amdgcn_exp2f(fmaf(p0[r], C2, mnL)); p1[r] = __builtin_amdgcn_exp2f(fmaf(p1[r], C2, mnL)); } \
            { float s_[4] = {0.f, 0.f, 0.f, 0.f}; _Pragma("unroll") for (int r = 0; r < 16; ++r) s_[r & 3] += p0[r] + p1[r]; ps = (s_[0] + s_[1]) + (s_[2] + s_[3]); } \
            { auto rr = __builtin_amdgcn_permlane32_swap(__float_as_uint(ps), __float_as_uint(ps), false, false); ps = __uint_as_float(rr[0]) + __uint_as_float(rr[1]); } \
            l_reg = l_reg * alpha + ps; \
            if constexpr (QK8) { \
                if (__any(alpha < 1.f)) { _Pragma("unroll") for (int d_ = 0; d_ < NCB; ++d_) o[d_] = o[d_] * alpha; }            \
                v8i32a p8; \
                _Pragma("unroll") for (int g_ = 0; g_ < 4; ++g_) { int t0 = __builtin_amdgcn_cvt_pk_fp8_f32(p0[4 * g_], p0[4 * g_ + 1], 0, false); t0 = __builtin_amdgcn_cvt_pk_fp8_f32(p0[4 * g_ + 2], p0[4 * g_ + 3], t0, true); \
                    int t1 = __builtin_amdgcn_cvt_pk_fp8_f32(p1[4 * g_], p1[4 * g_ + 1], 0, false); t1 = __builtin_amdgcn_cvt_pk_fp8_f32(p1[4 * g_ + 2], p1[4 * g_ + 3], t1, true); p8[g_] = t0; p8[4 + g_] = t1; } \
                _Pragma("unroll") for (int d_ = 0; d_ < NCB; ++d_) { const char* a0_ = V_lds + (BF) * VT + d_ * 2048 + ka[0]; const char* a1_ = V_lds + (BF) * VT + d_ * 2048 + ka[1]; \
                    const v8i32a vf = __builtin_shufflevector(*(const v4i32a*)a0_, *(const v4i32a*)a1_, 0, 1, 2, 3, 4, 5, 6, 7); \
                    o[d_] = __builtin_amdgcn_mfma_scale_f32_32x32x64_f8f6f4(vf, p8, o[d_], 0, 0, 0, 0, 0, 0); } \
            } else { \
            bf16x8 pa[4]; \
            _Pragma("unroll") for (int q_ = 0; q_ < 4; ++q_) { const f32x16& P = (q_ < 2) ? p0 : p1; const int B_ = (q_ & 1) * 8; \
                const unsigned a0 = cvt_pk_bf16(P[B_ + 0], P[B_ + 1]), a1 = cvt_pk_bf16(P[B_ + 2], P[B_ + 3]), b0 = cvt_pk_bf16(P[B_ + 4], P[B_ + 5]), b1 = cvt_pk_bf16(P[B_ + 6], P[B_ + 7]); \
                auto r0 = __builtin_amdgcn_permlane32_swap(a0, b0, false, false); auto r1 = __builtin_amdgcn_permlane32_swap(a1, b1, false, false); \
                u32x4 w_ = {r0[0], r1[0], r0[1], r1[1]}; pa[q_] = *reinterpret_cast<bf16x8*>(&w_); } \
            if (__any(alpha < 1.f)) { if (hi == 0) al_l[r32] = alpha; asm volatile("s_waitcnt lgkmcnt(0)" ::: "memory"); \
                _Pragma("unroll") for (int r = 0; r < 16; ++r) { const float a_ = al_l[crow(r, hi)]; _Pragma("unroll") for (int d_ = 0; d_ < NCB; ++d_) o[d_][r] *= a_; } } \
            { s16x4 l_[2][2], h_[2][2]; constexpr int b_ = (BF) * VT;            \
              _Pragma("unroll") for (int k2 = 0; k2 < 2; ++k2) { TRRD(l_[0][k2], b_ + k2 * (1024 * NCB)); TRRD(h_[0][k2], b_ + k2 * (1024 * NCB) + 512 * NCB); } \
              _Pragma("unroll") for (int i_ = 0; i_ < 2 * NCB; ++i_) { \
                if (i_ + 1 < 2 * NCB) { \
                    _Pragma("unroll") for (int k2 = 0; k2 < 2; ++k2) { TRRD(l_[(i_ + 1) & 1][k2], b_ + ((i_ + 1) >> 1) * 512 + (2 * ((i_ + 1) & 1) + k2) * (1024 * NCB)); TRRD(h_[(i_ + 1) & 1][k2], b_ + ((i_ + 1) >> 1) * 512 + (2 * ((i_ + 1) & 1) + k2) * (1024 * NCB) + 512 * NCB); } \
                    asm volatile("s_waitcnt lgkmcnt(4)" ::: "memory"); } \
                else asm volatile("s_waitcnt lgkmcnt(0)" ::: "memory"); \
                __builtin_amdgcn_sched_barrier(0); \
                _Pragma("unroll") for (int k2 = 0; k2 < 2; ++k2) \
                    o[i_ >> 1] = __builtin_amdgcn_mfma_f32_32x32x16_bf16(pa[2 * (i_ & 1) + k2], (bf16x8){l_[i_ & 1][k2][0], l_[i_ & 1][k2][1], l_[i_ & 1][k2][2], l_[i_ & 1][k2][3], h_[i_ & 1][k2][0], h_[i_ & 1][k2][1], h_[i_ & 1][k2][2], h_[i_ & 1][k2][3]}, o[i_ >> 1], 0, 0, 0); \
                __builtin_amdgcn_sched_barrier(0); } } \
            } \
        } \
        if constexpr (!RES && !PAIR) { if ((t) + 1 < NT) { asm volatile("s_waitcnt vmcnt(0)" ::: "memory"); ST_WRITE((BF) ^ 1); } \
        __syncthreads(); } } while (0)
    if constexpr (RES) {
        TILE(0, 0); TILE(1, 1); TILE(2, 2); TILE(3, 3);
        if (NT > 4) { TILE(4, 4); TILE(5, 5); }
    } else if constexpr (PAIR) {
        for (int t = 0; t < NT; t += 4) {
            ST_LOAD((p.j_lo + t + 2) * KVBLK, 2); ST_LOAD((p.j_lo + t + 3) * KVBLK, 3);
            TILE(t, 0); TILE(t + 1, 1);
            asm volatile("s_waitcnt vmcnt(0)" ::: "memory"); __syncthreads();
            if (t + 4 < NT) { ST_LOAD((p.j_lo + t + 4) * KVBLK, 0); ST_LOAD((p.j_lo + t + 5) * KVBLK, 1); }
            TILE(t + 2, 2); TILE(t + 3, 3);
            if (t + 4 < NT) asm volatile("s_waitcnt vmcnt(0)" ::: "memory");
            __syncthreads();
        }
    } else
    for (int t = 0; t < NT; t += 2) {
        TILE(t, 0);
        if (t + 1 < NT) TILE(t + 1, 1);
    }
    if constexpr (QK8) {
        const float rl = __builtin_amdgcn_rcpf(l_reg * QK8_SCALE) * (O8 ? O8_SCALE : 1.0f);
        if (O8) { unsigned char* orow8 = (unsigned char*)p.O + (size_t)(wid * QBLK + r32) * p.ldo + 4 * hi;
#pragma unroll
            for (int d_ = 0; d_ < NCB; ++d_)
#pragma unroll
                for (int g_ = 0; g_ < 4; ++g_) { int t = __builtin_amdgcn_cvt_pk_fp8_f32(o[d_][4 * g_] * rl, o[d_][4 * g_ + 1] * rl, 0, false); t = __builtin_amdgcn_cvt_pk_fp8_f32(o[d_][4 * g_ + 2] * rl, o[d_][4 * g_ + 3] * rl, t, true);
                    *(unsigned*)(orow8 + 32 * d_ + 8 * g_) = (unsigned)t; }
        } else { bf16* orow = p.O + (size_t)(wid * QBLK + r32) * p.ldo + 4 * hi;
#pragma unroll
        for (int d_ = 0; d_ < NCB; ++d_)
#pragma unroll
            for (int g_ = 0; g_ < 4; ++g_) { u32x2 w; w.x = cvt_pk_bf16(o[d_][4 * g_] * rl, o[d_][4 * g_ + 1] * rl); w.y = cvt_pk_bf16(o[d_][4 * g_ + 2] * rl, o[d_][4 * g_ + 3] * rl);
                *(u32x2*)(orow + 32 * d_ + 8 * g_) = w; } }
        __syncthreads();
        return;
    }
    if (KIND == 1) l_reg += __builtin_amdgcn_exp2f(sink_c - m_reg * C2);
    if (hi == 0) li_l[r32] = l_reg;
    asm volatile("s_waitcnt lgkmcnt(0)" ::: "memory");
    bf16* Ow = p.O + (size_t)(wid * QBLK) * p.ldo + (RES && !O8 ? g * DV : 0);
    const int ocol = (RES && O8) ? g * DV : 0;
#pragma unroll
    for (int r = 0; r < 16; ++r) { const int orow = crow(r, hi); const float rl = __builtin_amdgcn_rcpf(li_l[orow]);
#pragma unroll
        for (int d0 = 0; d0 < NCB; ++d0) { const float v = o[d0][r] * rl;
            if (O8) { const float v8 = v * O8_SCALE, v1 = __shfl_down(v8, 1), v2 = __shfl_down(v8, 2), v3 = __shfl_down(v8, 3);
                if ((r32 & 3) == 0) { int t = __builtin_amdgcn_cvt_pk_fp8_f32(v8, v1, 0, false); t = __builtin_amdgcn_cvt_pk_fp8_f32(v2, v3, t, true); *(unsigned*)((unsigned char*)p.O + (size_t)(wid * QBLK + orow) * p.ldo + ocol + d0 * 32 + r32) = (unsigned)t; } }
            else { const float vn = __shfl_xor(v, 1);
            if ((r32 & 1) == 0) *(unsigned*)(Ow + (size_t)orow * p.ldo + d0 * 32 + r32) = cvt_pk_bf16(v, vn); } } }
    if constexpr (RES) { if (g + 1 < NH) {
#pragma unroll
        for (int d0 = 0; d0 < ND0; ++d0) qr[d0] = qn[d0]; } }
    }
    __syncthreads();
#undef TILE
#undef TRRD
#undef ST_LOAD
#undef ST_WRITE
}
constexpr int LDS_MLA = 2 * (64 * 128 * 2) + 2 * (3 * 8192) + 512 + 8 * 256;
constexpr int LDS_SWA = 2 * (64 * 64 * 2) + 2 * 8192 + 512 + 8 * 256;
}
constexpr int NWAVES = 8, NTHREADS = NWAVES * 64;
constexpr int D = 1024, NB = 8, SEQ = 8192, T = NB * SEQ;
constexpr int FF = 2816, NE = 8, FE = 3584;
constexpr int QL = 384, KVL = 256, MH = 8, DQKM = 192, DVM = 128;
constexpr int MDN = 704, MDNP = 768;
constexpr int SQKV = 1280;
constexpr int MAXPAN = 520, MAXSLOT = MAXPAN * 256;
constexpr float EPS = 1e-6f;
constexpr float ACT_SCALE8 = 8.f, HID_SCALE8 = 8.f, W_SCALE8 = 256.f, YC_SCALE8 = 4.f, Y_SCALE8 = 16.f;
constexpr size_t MiB = 1u << 20;
constexpr size_t WS_CTL = 0, CTL_ZERO_BYTES = 1024 * 1024;
constexpr size_t WS_RT = 1 * MiB;
constexpr size_t RT_E = WS_RT, RT_W0 = RT_E + (size_t)T * 4, RT_W1 = RT_W0 + (size_t)T * 4, RT_S0 = RT_W1 + (size_t)T * 4, RT_S1 = RT_S0 + (size_t)T * 4, RT_CNT = RT_S1 + (size_t)T * 4, RT_PB = RT_CNT + 256 * 8 * 4, RT_TOK = RT_PB + 4096;
constexpr size_t WS_RS = 3 * MiB;
constexpr size_t WS_CS = 4 * MiB;
constexpr size_t WS_ROPE = 8 * MiB;
constexpr size_t WS_W = 24 * MiB;
constexpr size_t W_CINB = WS_W, W_CINCU = W_CINB + 2 * (size_t)1024 * 1024 * 2, W_COUT = W_CINCU + 2 * (size_t)2048 * 1024 * 2;
constexpr size_t W_MDN = W_COUT + 2 * (size_t)1024 * 1024 * 2, W_MUQ = W_MDN + (size_t)MDNP * 1024 * 2, W_MUKV = W_MUQ + (size_t)1536 * QL * 2, W_MO = W_MUKV + (size_t)2048 * KVL * 2;
constexpr size_t W_SQKV = W_MO + (size_t)1024 * 1024 * 2, W_SO = W_SQKV + (size_t)SQKV * 1024 * 2;
constexpr size_t W_FGU = W_SO + (size_t)1024 * 1024 * 2, W_FD = W_FGU + 2 * (size_t)(2 * FF) * 1024 * 2;
constexpr size_t W_MGU = W_FD + 2 * (size_t)1024 * FF * 2, W_MD = W_MGU + 16 * (size_t)(2 * FE) * 1024 * 2, W_RT = W_MD + 16 * (size_t)1024 * FE * 2;
constexpr size_t W_END = W_RT + 2 * (size_t)8 * 1024 * 4;
constexpr size_t WS_XN = 420 * MiB;
constexpr size_t WS_XG = 548 * MiB;
constexpr size_t WS_BIG = 808 * MiB;
constexpr size_t WS_END = WS_BIG + (size_t)MAXSLOT * FE * 2;
static_assert(W_END <= WS_XN && WS_XN + (size_t)T * D * 2 <= WS_XG && WS_XG + (size_t)MAXSLOT * D * 2 <= WS_BIG, "d_ws map");
constexpr size_t B_CONV_B = 0, B_CONV_V = 128 * MiB, B_CONV_Y = 256 * MiB;
constexpr size_t B_HMID = 0;
constexpr size_t B_MC = 0, B_MO = 0, B_MCQ = 192 * MiB, B_MCKV = 240 * MiB, B_MQ = 272 * MiB, B_MK = 464 * MiB, B_MV = 656 * MiB;
constexpr size_t B_SQKV = 0, B_SO = 160 * MiB;
constexpr int CW_DBG = 8;
constexpr int CW_BAR = 1024;
constexpr int CW_CMAX = 8192, CM_CIN = 0, CM_FGU = CM_CIN + 2 * 3072, CM_MDN = CM_FGU + 2 * 5632, CM_SQKV = CM_MDN + 768, CM_MGU = 24576, CM_END = CM_MGU + 16 * 7168;
static_assert(CM_SQKV + 1280 <= CM_MGU && (CW_CMAX + CM_END) * 4 <= (int)CTL_ZERO_BYTES, "column-max words inside the memset region");
constexpr int RING_BYTES = 131072, MISC_OFF = RING_BYTES, LDS_BYTES = 147456;

#define RLX_AGENT __ATOMIC_RELAXED, __HIP_MEMORY_SCOPE_AGENT
#define XB_TMO      128
#define XB_XCNT(j)  (256  + 64 * (j))
#define XB_XSUB(j)  (1280 + 64 * (j))
#define XB_XGEN(j)  (2304 + 64 * (j))
#define XB_TOP      3328
#define XB_TOPGEN   3392
#define XCD_BAR_WORDS 3456
#define XB_SPIN_CAP (1u << 18)
__device__ __forceinline__ unsigned xb_ld(unsigned* p)              { return __hip_atomic_load(p, __ATOMIC_RELAXED, __HIP_MEMORY_SCOPE_AGENT); }
__device__ __forceinline__ unsigned xb_add(unsigned* p, unsigned v) { return __hip_atomic_fetch_add(p, v, __ATOMIC_RELAXED, __HIP_MEMORY_SCOPE_AGENT); }
__device__ __forceinline__ unsigned xb_xcc_id() { return (unsigned)__builtin_amdgcn_s_getreg((3 << 11) | 20) & 0xFu; }
#define XB_SPIN(cond, bar) do { unsigned _sp = 0; while (cond) { __builtin_amdgcn_s_sleep(1); \
    if ((++_sp & 255u) == 0u) { if (xb_ld(&(bar)[XB_TMO])) break; if (_sp > XB_SPIN_CAP) { atomicAdd(&(bar)[XB_TMO], 1u); break; } } } } while (0)
struct XcdBarrier { unsigned* bar; unsigned x; volatile LAS unsigned* st; };
__device__ __forceinline__ XcdBarrier xcd_barrier_post(unsigned* bar, volatile LAS unsigned* st) {
    XcdBarrier b; b.bar = bar; b.x = xb_xcc_id(); b.st = st;
    if (threadIdx.x == 0) (void)xb_add(&bar[XB_XCNT(b.x)], 1u);
    return b;
}
__device__ __forceinline__ void xcd_barrier_complete(unsigned* bar, unsigned x, unsigned& nloc, unsigned& nx) {
    const unsigned G = gridDim.x * gridDim.y * gridDim.z;
    unsigned sum, cnt, mine, sp = 0u;
    for (;;) {
        sum = 0u; cnt = 0u; mine = 0u;
#pragma unroll
        for (unsigned j = 0; j < 16; ++j) { const unsigned c = xb_ld(&bar[XB_XCNT(j)]); sum += c; cnt += (c > 0u) ? 1u : 0u; mine = (j == x) ? c : mine; }
        if (sum == G) break;
        __builtin_amdgcn_s_sleep(1);
        if ((++sp & 255u) == 0u) { if (xb_ld(&bar[XB_TMO])) break; if (sp > XB_SPIN_CAP) { atomicAdd(&bar[XB_TMO], 1u); break; } }
    }
    nloc = mine > 0u ? mine : 1u; nx = cnt > 0u ? cnt : 1u;
}
__device__ __forceinline__ void xcd_barrier(const XcdBarrier& b) {
    asm volatile("s_waitcnt vmcnt(0)" ::: "memory");
    __syncthreads();
    if (threadIdx.x == 0) {
        unsigned* bar = b.bar;
        __builtin_amdgcn_s_waitcnt(0);
        unsigned nloc = b.st[0], nx = b.st[1];
        if (nloc == 0u) { xcd_barrier_complete(bar, b.x, nloc, nx); b.st[0] = nloc; b.st[1] = nx; }
        const unsigned old = xb_add(&bar[XB_XSUB(b.x)], 1u);
        const unsigned gen = old / nloc;
        if (old + 1u == (gen + 1u) * nloc) {
            __builtin_amdgcn_fence(__ATOMIC_RELEASE, "agent");
            asm volatile("s_waitcnt vmcnt(0)" ::: "memory");
            const unsigned og = xb_add(&bar[XB_TOP], 1u);
            const unsigned tg = og / nx;
            if (og + 1u == (tg + 1u) * nx) xb_add(&bar[XB_TOPGEN], 1u);
            else XB_SPIN(xb_ld(&bar[XB_TOPGEN]) == tg, bar);
            __builtin_amdgcn_fence(__ATOMIC_ACQUIRE, "agent");
            xb_add(&bar[XB_XGEN(b.x)], 1u);
            asm volatile("s_waitcnt vmcnt(0)" ::: "memory");
        } else {
            XB_SPIN(xb_ld(&bar[XB_XGEN(b.x)]) == gen, bar);
            __builtin_amdgcn_fence(__ATOMIC_ACQUIRE, "agent");
            asm volatile("s_waitcnt vmcnt(0)" ::: "memory");
        }
    }
    __syncthreads();
}

struct TC { int tid, lane, wave; };
__device__ __forceinline__ TC tc_get() { TC t; int x = threadIdx.x; asm volatile("" : "+v"(x)); t.tid = x; t.lane = x & 63; t.wave = __builtin_amdgcn_readfirstlane(x >> 6); return t; }
struct Frame {
    char* lds; int vcu, G;
    unsigned char* ws; float* out;
    const float* const* in;
};
__device__ __forceinline__ float clamp8(float v) { return fminf(fmaxf(v, -448.f), 448.f); }
__device__ __forceinline__ unsigned pk4_fp8(float a, float b, float c, float d, float sc) {
    int t = __builtin_amdgcn_cvt_pk_fp8_f32(clamp8(a * sc), clamp8(b * sc), 0, false); t = __builtin_amdgcn_cvt_pk_fp8_f32(clamp8(c * sc), clamp8(d * sc), t, true); return (unsigned)t; }
#define LDS_WAIT() asm volatile("s_waitcnt lgkmcnt(0)" ::: "memory")
#define VM_WAIT() asm volatile("s_waitcnt vmcnt(0)" ::: "memory")

template <int MAP>
__device__ __forceinline__ void tr_item(const float* W, int K, int N, int ldw, bf16* WT, float* scr, int item, int lane) {
    const int nblk = N / 32, kb = item / nblk, nb = item % nblk, k0 = 64 * kb, n0 = 32 * nb;
    int r0 = n0;
    if (MAP == 1) { const int F = N / 2; r0 = (n0 < F) ? 256 * (n0 / 128) + (n0 % 128) : 256 * ((n0 - F) / 128) + 128 + ((n0 - F) % 128); }
    const float* src = W + (size_t)(k0 + (lane >> 5)) * ldw + n0 + (lane & 31);
#pragma unroll 16
    for (int i = 0; i < 32; ++i) scr[(2 * i + (lane >> 5)) * 33 + (lane & 31)] = src[(size_t)(2 * i) * ldw];
    LDS_WAIT(); asm volatile("" ::: "memory");
    const int c = lane & 7;
#pragma unroll
    for (int j = 0; j < 4; ++j) { const int n = (lane >> 3) + 8 * j; const float* s = scr + (8 * c) * 33 + n;
        u32x4 o; o.x = cvt_pk_bf16(s[0 * 33], s[1 * 33]); o.y = cvt_pk_bf16(s[2 * 33], s[3 * 33]); o.z = cvt_pk_bf16(s[4 * 33], s[5 * 33]); o.w = cvt_pk_bf16(s[6 * 33], s[7 * 33]);
        *(u32x4*)(WT + (size_t)(r0 + n) * K + k0 + 8 * c) = o; }
    LDS_WAIT(); asm volatile("" ::: "memory");
}
template <int MAP>
__device__ __forceinline__ void tr_item8(const float* W, int K, int N, int ldw, unsigned char* WT, float* scr, int item, int lane, float sw) {
    const int nblk = N / 32, kb = item / nblk, nb = item % nblk, k0 = 64 * kb, n0 = 32 * nb;
    int r0 = n0;
    if (MAP == 1) { const int F = N / 2; r0 = (n0 < F) ? 256 * (n0 / 128) + (n0 % 128) : 256 * ((n0 - F) / 128) + 128 + ((n0 - F) % 128); }
    const float* src = W + (size_t)(k0 + (lane >> 5)) * ldw + n0 + (lane & 31);
#pragma unroll 16
    for (int i = 0; i < 32; ++i) scr[(2 * i + (lane >> 5)) * 33 + (lane & 31)] = src[(size_t)(2 * i) * ldw];
    LDS_WAIT(); asm volatile("" ::: "memory");
    const int c = lane & 7;
#pragma unroll
    for (int j = 0; j < 4; ++j) { const int n = (lane >> 3) + 8 * j; const float* s = scr + (8 * c) * 33 + n;
        u32x2 o; int t = __builtin_amdgcn_cvt_pk_fp8_f32(s[0 * 33] * sw, s[1 * 33] * sw, 0, false); t = __builtin_amdgcn_cvt_pk_fp8_f32(s[2 * 33] * sw, s[3 * 33] * sw, t, true); o.x = (unsigned)t;
        t = __builtin_amdgcn_cvt_pk_fp8_f32(s[4 * 33] * sw, s[5 * 33] * sw, 0, false); t = __builtin_amdgcn_cvt_pk_fp8_f32(s[6 * 33] * sw, s[7 * 33] * sw, t, true); o.y = (unsigned)t;
        *(u32x2*)(WT + (size_t)(r0 + n) * K + k0 + 8 * c) = o; }
    LDS_WAIT(); asm volatile("" ::: "memory");
}
template <int MAP>
__device__ __forceinline__ void tr_matrix8(Frame& F, const float* W, int K, int N, int ldw, unsigned char* WT, int rot, float sw) {
    const TC tc = tc_get();
    float* scr = (float*)(F.lds + tc.wave * 8448);
    const int NGW = F.G * NWAVES, gw = (F.vcu * NWAVES + tc.wave + rot) % NGW, nitems = (K / 64) * (N / 32);
    for (int it = gw; it < nitems; it += NGW) tr_item8<MAP>(W, K, N, ldw, WT, scr, it, tc.lane, sw);
}
__device__ __forceinline__ void cmax_matrix(Frame& F, const float* W, int K, int N, int ldw, unsigned* cmax, int rot) {
    const TC tc = tc_get();
    const int NGW = F.G * NWAVES, gw = (F.vcu * NWAVES + tc.wave + rot) % NGW, ncb = (N + 255) / 256, nitems = (K / 64) * ncb;
    for (int it = gw; it < nitems; it += NGW) { const int kb = it / ncb, cb = it % ncb, col = cb * 256 + 4 * tc.lane;
        if (col < N) { const float* src = W + (size_t)(kb * 64) * ldw + col; f32x4 m = {0.f, 0.f, 0.f, 0.f};
#pragma unroll 16
            for (int r = 0; r < 64; ++r) { const f32x4 v = *(const f32x4*)(src + (size_t)r * ldw); m.x = fmaxf(m.x, fabsf(v.x)); m.y = fmaxf(m.y, fabsf(v.y)); m.z = fmaxf(m.z, fabsf(v.z)); m.w = fmaxf(m.w, fabsf(v.w)); }
            atomicMax(cmax + col, __float_as_uint(m.x)); atomicMax(cmax + col + 1, __float_as_uint(m.y)); atomicMax(cmax + col + 2, __float_as_uint(m.z)); atomicMax(cmax + col + 3, __float_as_uint(m.w)); } }
}
template <int MAP>
__device__ __forceinline__ void tr_item_i8(const float* W, int K, int N, int ldw, unsigned char* WT, float* scr, int item, int lane, const unsigned* cmax, float* cs) {
    const int nblk = N / 32, kb = item / nblk, nb = item % nblk, k0 = 64 * kb, n0 = 32 * nb;
    int r0 = n0;
    if (MAP == 1) { const int F = N / 2; r0 = (n0 < F) ? 256 * (n0 / 128) + (n0 % 128) : 256 * ((n0 - F) / 128) + 128 + ((n0 - F) % 128); }
    const float* src = W + (size_t)(k0 + (lane >> 5)) * ldw + n0 + (lane & 31);
#pragma unroll 16
    for (int i = 0; i < 32; ++i) scr[(2 * i + (lane >> 5)) * 33 + (lane & 31)] = src[(size_t)(2 * i) * ldw];
    LDS_WAIT(); asm volatile("" ::: "memory");
    const int c = lane & 7;
#pragma unroll
    for (int j = 0; j < 4; ++j) { const int n = (lane >> 3) + 8 * j; const float* s = scr + (8 * c) * 33 + n;
        const float cm = __uint_as_float(cmax[n0 + n]), inv = cm > 0.f ? 127.0f / cm : 0.f;
        if (kb == 0 && c == 0) cs[r0 + n] = cm * (1.0f / 127.0f);
        unsigned w[2];
#pragma unroll
        for (int h = 0; h < 2; ++h) { const int q0 = __float2int_rn(s[(4 * h + 0) * 33] * inv), q1 = __float2int_rn(s[(4 * h + 1) * 33] * inv), q2 = __float2int_rn(s[(4 * h + 2) * 33] * inv), q3 = __float2int_rn(s[(4 * h + 3) * 33] * inv);
            w[h] = (unsigned)(q0 & 0xff) | ((unsigned)(q1 & 0xff) << 8) | ((unsigned)(q2 & 0xff) << 16) | ((unsigned)q3 << 24); }
        u32x2 o; o.x = w[0]; o.y = w[1];
        *(u32x2*)(WT + (size_t)(r0 + n) * K + k0 + 8 * c) = o; }
    LDS_WAIT(); asm volatile("" ::: "memory");
}
template <int MAP>
__device__ __forceinline__ void tr_matrix_i8(Frame& F, const float* W, int K, int N, int ldw, unsigned char* WT, int rot, const unsigned* cmax, float* cs) {
    const TC tc = tc_get();
    float* scr = (float*)(F.lds + tc.wave * 8448);
    const int NGW = F.G * NWAVES, gw = (F.vcu * NWAVES + tc.wave + rot) % NGW, nitems = (K / 64) * (N / 32);
    for (int it = gw; it < nitems; it += NGW) tr_item_i8<MAP>(W, K, N, ldw, WT, scr, it, tc.lane, cmax, cs);
}
template <int MAP>
__device__ __forceinline__ void tr_matrix(Frame& F, const float* W, int K, int N, int ldw, bf16* WT, int rot) {
    const TC tc = tc_get();
    float* scr = (float*)(F.lds + tc.wave * 8448);
    const int NGW = F.G * NWAVES, gw = (F.vcu * NWAVES + tc.wave + rot) % NGW, nitems = (K / 64) * (N / 32);
    for (int it = gw; it < nitems; it += NGW) tr_item<MAP>(W, K, N, ldw, WT, scr, it, tc.lane);
}

struct RowArgs { const bf16* Xsb; bf16* Xdb; const float* Xsrc; float* Xdst; const float* g; bf16* XN; float* outF; const bf16* Y; const int* s0; const int* s1; const float* w0; const float* w1;
                 const float* routerT; unsigned* rt_e; float* rt_w0; float* rt_w1; unsigned* cnt; float* rs; };
template <int MODE, bool COMBINE, int OUTM = 0  , bool Y8 = false  , bool XBF = false  >
__device__ __forceinline__ void row_pass(Frame& F, const RowArgs& a) {
    const TC tc = tc_get();
    const int lane = tc.lane;
    float* rtab = (float*)F.lds;
    unsigned* wcnt = (unsigned*)(F.lds + 32768);
    if (MODE == 1) { for (int i = tc.tid; i < 8 * 1024; i += NTHREADS) rtab[i] = a.routerT[i]; }
    f32x4 gv[4];
#pragma unroll
    for (int j = 0; j < 4; ++j) gv[j] = *(const f32x4*)(a.g + 4 * lane + 256 * j);
    for (int tb = blockIdx.x; tb < T / 256; tb += F.G) {
        if (MODE == 1) { if (tc.tid < 64) wcnt[tc.tid] = 0u; __syncthreads(); }
        unsigned myc[8] = {0u, 0u, 0u, 0u, 0u, 0u, 0u, 0u};
        for (int rr = 0; rr < 32; ++rr) {
            const int row = tb * 256 + tc.wave * 32 + rr;
            f32x4 v[4];
            if constexpr (XBF) { const u32x2* xr = (const u32x2*)(a.Xsb + (size_t)row * D) + lane;
#pragma unroll
                for (int j = 0; j < 4; ++j) { const u32x2 w = xr[64 * j]; v[j] = (f32x4){bflo(w.x), bfhi(w.x), bflo(w.y), bfhi(w.y)}; }
            } else { const f32x4* xr = (const f32x4*)(a.Xsrc + (size_t)row * D) + lane;
#pragma unroll
                for (int j = 0; j < 4; ++j) v[j] = xr[64 * j]; }
            if (COMBINE) {
                const int sa = a.s0[row], sb = a.s1[row]; const float wa = a.w0[row], wb = a.w1[row];
                if (Y8) { const unsigned* ya = (const unsigned*)((const unsigned char*)a.Y + (size_t)sa * D) + lane; const unsigned* yb = (const unsigned*)((const unsigned char*)a.Y + (size_t)sb * D) + lane;
                    const float wa8 = wa * (1.0f / Y_SCALE8), wb8 = wb * (1.0f / Y_SCALE8);
#pragma unroll
                    for (int j = 0; j < 4; ++j) { const int pa = (int)ya[64 * j], pb = (int)yb[64 * j];
                        v[j].x += wa8 * __builtin_amdgcn_cvt_f32_fp8(pa, 0) + wb8 * __builtin_amdgcn_cvt_f32_fp8(pb, 0); v[j].y += wa8 * __builtin_amdgcn_cvt_f32_fp8(pa, 1) + wb8 * __builtin_amdgcn_cvt_f32_fp8(pb, 1);
                        v[j].z += wa8 * __builtin_amdgcn_cvt_f32_fp8(pa, 2) + wb8 * __builtin_amdgcn_cvt_f32_fp8(pb, 2); v[j].w += wa8 * __builtin_amdgcn_cvt_f32_fp8(pa, 3) + wb8 * __builtin_amdgcn_cvt_f32_fp8(pb, 3); }
                } else {
                const u32x2* ya = (const u32x2*)(a.Y + (size_t)sa * D) + lane; const u32x2* yb = (const u32x2*)(a.Y + (size_t)sb * D) + lane;
#pragma unroll
                for (int j = 0; j < 4; ++j) { const u32x2 pa = ya[64 * j], pb = yb[64 * j];
                    v[j].x += wa * bflo(pa.x) + wb * bflo(pb.x); v[j].y += wa * bfhi(pa.x) + wb * bfhi(pb.x);
                    v[j].z += wa * bflo(pa.y) + wb * bflo(pb.y); v[j].w += wa * bfhi(pa.y) + wb * bfhi(pb.y); } }
                if (MODE != 2) {
                    if constexpr (XBF) { u32x2* xd = (u32x2*)(a.Xdb + (size_t)row * D) + lane;
#pragma unroll
                        for (int j = 0; j < 4; ++j) { u32x2 w; w.x = cvt_pk_bf16(v[j].x, v[j].y); w.y = cvt_pk_bf16(v[j].z, v[j].w); xd[64 * j] = w; }
                    } else { f32x4* xd = (f32x4*)(a.Xdst + (size_t)row * D) + lane;
#pragma unroll
                        for (int j = 0; j < 4; ++j) xd[64 * j] = v[j]; } }
            }
            float ss = 0.f;
#pragma unroll
            for (int j = 0; j < 4; ++j) ss += (v[j].x * v[j].x + v[j].y * v[j].y) + (v[j].z * v[j].z + v[j].w * v[j].w);
            const float rstd = 1.0f / sqrtf(wave_sum(ss) * (1.f / D) + EPS);
#pragma unroll
            for (int j = 0; j < 4; ++j) v[j] = v[j] * rstd * gv[j];
            if (MODE == 2) { f32x4* od = (f32x4*)(a.outF + (size_t)row * D) + lane;
#pragma unroll
                for (int j = 0; j < 4; ++j) od[64 * j] = v[j];
            } else if (OUTM == 2) { float am = 0.f;
#pragma unroll
                for (int j = 0; j < 4; ++j) am = fmaxf(fmaxf(am, fmaxf(fabsf(v[j].x), fabsf(v[j].y))), fmaxf(fabsf(v[j].z), fabsf(v[j].w)));
#pragma unroll
                for (int o = 1; o < 64; o <<= 1) am = fmaxf(am, __shfl_xor(am, o));
                const float inv = am > 0.f ? 127.0f / am : 0.f;
                unsigned* o4 = (unsigned*)((unsigned char*)a.XN + (size_t)row * D) + lane;
#pragma unroll
                for (int j = 0; j < 4; ++j) { const int q0 = __float2int_rn(v[j].x * inv), q1 = __float2int_rn(v[j].y * inv), q2 = __float2int_rn(v[j].z * inv), q3 = __float2int_rn(v[j].w * inv);
                    o4[64 * j] = (unsigned)(q0 & 0xff) | ((unsigned)(q1 & 0xff) << 8) | ((unsigned)(q2 & 0xff) << 16) | ((unsigned)q3 << 24); }
                if (lane == 0) a.rs[row] = am * (1.0f / 127.0f);
            } else if (OUTM == 1) { unsigned* o4 = (unsigned*)((unsigned char*)a.XN + (size_t)row * D) + lane;
#pragma unroll
                for (int j = 0; j < 4; ++j) o4[64 * j] = pk4_fp8(v[j].x, v[j].y, v[j].z, v[j].w, ACT_SCALE8);
            } else { u32x2* o8 = (u32x2*)(a.XN + (size_t)row * D) + lane;
#pragma unroll
                for (int j = 0; j < 4; ++j) { u32x2 w; w.x = cvt_pk_bf16(v[j].x, v[j].y); w.y = cvt_pk_bf16(v[j].z, v[j].w); o8[64 * j] = w; } }
            if (MODE == 1) {
                float lg[8];
#pragma unroll
                for (int e = 0; e < 8; ++e) { float s = 0.f;
#pragma unroll
                    for (int j = 0; j < 4; ++j) { const f32x4 r = *(const f32x4*)(rtab + e * 1024 + 256 * j + 4 * lane); s += (v[j].x * r.x + v[j].y * r.y) + (v[j].z * r.z + v[j].w * r.w); }
                    lg[e] = wave_sum(s); }
                int e0 = 0; float v0 = lg[0];
#pragma unroll
                for (int e = 1; e < 8; ++e) if (lg[e] > v0) { v0 = lg[e]; e0 = e; }
                int e1 = -1; float v1 = -3.0e38f;
#pragma unroll
                for (int e = 0; e < 8; ++e) if (e != e0 && lg[e] > v1) { v1 = lg[e]; e1 = e; }
                const float w0 = 1.0f / (1.0f + __expf(v1 - v0)), w1 = 1.0f - w0;
                if (lane == 0) { a.rt_e[row] = (unsigned)e0 | ((unsigned)e1 << 8); a.rt_w0[row] = w0; a.rt_w1[row] = w1; }
#pragma unroll
                for (int e = 0; e < 8; ++e) myc[e] += (e == e0 || e == e1) ? 1u : 0u;
            }
        }
        if (MODE == 1) {
            if (lane < 8) { unsigned c = 0;
#pragma unroll
                for (int e = 0; e < 8; ++e) c = (lane == e) ? myc[e] : c;
                wcnt[tc.wave * 8 + lane] = c; }
            __syncthreads();
            if (tc.tid < 8) { unsigned c = 0; for (int w = 0; w < 8; ++w) c += wcnt[w * 8 + tc.tid]; a.cnt[tb * 8 + tc.tid] = c; }
            __syncthreads();
        }
    }
}

template <bool F8>
__device__ __forceinline__ void moe_assign(Frame& F, const unsigned* cnt, const unsigned* rt_e, int* s0, int* s1, unsigned* pbase_out, const bf16* XN, bf16* XG, int* tok = nullptr  ) {
    const TC tc = tc_get();
    unsigned* tot = (unsigned*)F.lds;
    unsigned* pre = tot + 64;
    unsigned long long* msk = (unsigned long long*)(F.lds + 1024);
    int* slt = (int*)(F.lds + 2048);
    if (tc.tid < 8) tot[tc.tid] = 0u;
    __syncthreads();
    { unsigned part[8] = {0, 0, 0, 0, 0, 0, 0, 0};
      if (tc.tid < 256) {
#pragma unroll
          for (int e = 0; e < 8; ++e) part[e] = __hip_atomic_load(cnt + tc.tid * 8 + e, RLX_AGENT); }
#pragma unroll
      for (int e = 0; e < 8; ++e) { unsigned s = part[e];
#pragma unroll
          for (int o = 1; o < 64; o <<= 1) s += __shfl_xor(s, o);
          if (tc.lane == 0 && tc.wave < 4) atomicAdd(&tot[e], s); } }
    __syncthreads();
    if (tc.tid == 0) { unsigned p = 0; for (int e = 0; e < 8; ++e) { tot[8 + e] = p; p += (tot[e] + 255u) / 256u; } tot[16] = p;
        if (blockIdx.x == 0) for (int e = 0; e < 9; ++e) __hip_atomic_store(pbase_out + e, tot[8 + e], RLX_AGENT); }
    __syncthreads();
    for (int tb = blockIdx.x; tb < T / 256; tb += F.G) {
        if (tc.tid < 8) { unsigned s = 0; for (int b = 0; b < tb; ++b) s += __hip_atomic_load(cnt + b * 8 + tc.tid, RLX_AGENT); pre[tc.tid] = s; }
        int e0 = 0, e1 = 0;
        if (tc.tid < 256) { const unsigned pe = rt_e[tb * 256 + tc.tid]; e0 = pe & 0xff; e1 = (pe >> 8) & 0xff;
#pragma unroll
            for (int e = 0; e < 8; ++e) { const unsigned long long m = __ballot(e0 == e || e1 == e); if (tc.lane == 0) msk[e * 4 + tc.wave] = m; } }
        __syncthreads();
        if (tc.tid < 256) {
            int sl[2];
#pragma unroll
            for (int k = 0; k < 2; ++k) { const int e = k ? e1 : e0; unsigned rank = 0;
                for (int w = 0; w < tc.wave; ++w) rank += __popcll(msk[e * 4 + w]);
                rank += __popcll(msk[e * 4 + tc.wave] & ((1ull << tc.lane) - 1ull));
                sl[k] = (int)(tot[8 + e] * 256u + pre[e] + rank); }
            s0[tb * 256 + tc.tid] = sl[0]; s1[tb * 256 + tc.tid] = sl[1]; slt[2 * tc.tid] = sl[0]; slt[2 * tc.tid + 1] = sl[1];
            if (F8 && tok) { tok[sl[0]] = tb * 256 + tc.tid; tok[sl[1]] = tb * 256 + tc.tid; }
        }
        __syncthreads();
        if (!(F8 && tok))
        for (int rr = 0; rr < 32; ++rr) { const int i = tc.wave * 32 + rr; const int row = tb * 256 + i; const int sa = slt[2 * i], sb = slt[2 * i + 1];
            if (F8) {
                const u32x4 o = ((const u32x4*)((const unsigned char*)XN + (size_t)row * D))[tc.lane];
                ((u32x4*)((unsigned char*)XG + (size_t)sa * D))[tc.lane] = o; ((u32x4*)((unsigned char*)XG + (size_t)sb * D))[tc.lane] = o;
            } else {
            const u32x4* src = (const u32x4*)(XN + (size_t)row * D) + tc.lane; const u32x4 a = src[0], b = src[64];
            u32x4* d0 = (u32x4*)(XG + (size_t)sa * D) + tc.lane; u32x4* d1 = (u32x4*)(XG + (size_t)sb * D) + tc.lane;
            d0[0] = a; d0[64] = b; d1[0] = a; d1[64] = b; } }
        __syncthreads();
    }
}

template <bool OUT8>
__device__ __forceinline__ void conv_pass(Frame& F, const bf16* Bc, const bf16* Vc, const float* wconv, bf16* Yc) {
    const TC tc = tc_get();
    const int sub = tc.tid >> 7, ch = (tc.tid & 127) * 8;
    float w[3][8];
#pragma unroll
    for (int j = 0; j < 3; ++j) { const f32x4 a = *(const f32x4*)(wconv + j * D + ch), b = *(const f32x4*)(wconv + j * D + ch + 4);
#pragma unroll
        for (int c = 0; c < 4; ++c) { w[j][c] = a[c]; w[j][4 + c] = b[c]; } }
    for (int run = blockIdx.x * 4 + sub; run < T / 32; run += F.G * 4) {
        const int t0 = run * 32, s0 = t0 & (SEQ - 1);
        float p2[8], p1[8];
        { u32x4 a = {0, 0, 0, 0}, b = {0, 0, 0, 0};
          if (s0 >= 2) { a = *(const u32x4*)(Vc + (size_t)(t0 - 2) * D + ch); b = *(const u32x4*)(Vc + (size_t)(t0 - 1) * D + ch); }
#pragma unroll
          for (int c = 0; c < 4; ++c) { p2[2 * c] = bflo(a[c]); p2[2 * c + 1] = bfhi(a[c]); p1[2 * c] = bflo(b[c]); p1[2 * c + 1] = bfhi(b[c]); } }
#pragma unroll 4
        for (int i = 0; i < 32; ++i) { const size_t o = (size_t)(t0 + i) * D + ch;
            const u32x4 vv = *(const u32x4*)(Vc + o), bb = *(const u32x4*)(Bc + o); float cur[8], y[8];
#pragma unroll
            for (int c = 0; c < 4; ++c) { cur[2 * c] = bflo(vv[c]); cur[2 * c + 1] = bfhi(vv[c]); }
#pragma unroll
            for (int c = 0; c < 8; ++c) { const float bq = (c & 1) ? bfhi(bb[c >> 1]) : bflo(bb[c >> 1]); y[c] = bq * (w[0][c] * p2[c] + w[1][c] * p1[c] + w[2][c] * cur[c]); p2[c] = p1[c]; p1[c] = cur[c]; }
            if (OUT8) { u32x2 r; r.x = pk4_fp8(y[0], y[1], y[2], y[3], YC_SCALE8); r.y = pk4_fp8(y[4], y[5], y[6], y[7], YC_SCALE8); *(u32x2*)((unsigned char*)Yc + o) = r; }
            else { u32x4 r; r.x = cvt_pk_bf16(y[0], y[1]); r.y = cvt_pk_bf16(y[2], y[3]); r.z = cvt_pk_bf16(y[4], y[5]); r.w = cvt_pk_bf16(y[6], y[7]);
            *(u32x4*)(Yc + o) = r; } }
    }
}

__device__ __forceinline__ void rope_table(Frame& F, const int* pos, float* tab) {
    const TC tc = tc_get();
    const int i = tc.lane & 31; const float inv = __builtin_amdgcn_exp2f(-(float)i * (13.287712379549449f / 32.0f));
    const int NGW = F.G * NWAVES, gw = F.vcu * NWAVES + tc.wave;
    for (int t = gw * 2 + (tc.lane >> 5); t < T; t += NGW * 2) {
        const float ang = (float)pos[t] * inv;
        const float k = rintf(ang * 0.15915494309189535f);
        float r = fmaf(-k, 6.28125f, ang); r = fmaf(-k, 1.9353071795864769e-3f, r);
        tab[(size_t)t * 64 + i] = __cosf(r); tab[(size_t)t * 64 + 32 + i] = __sinf(r);
    }
}

template <int K8  >
__device__ __forceinline__ void mla_mid(Frame& F, const float* C, const float* gq, const float* gkv, const float* tab, bf16* cqn, bf16* ckvn, bf16* Kf, float kscale) {
    const TC tc = tc_get();
    const int lane = tc.lane, NGW = F.G * NWAVES, gw = F.vcu * NWAVES + tc.wave;
    f32x2 gqv[3];
#pragma unroll
    for (int j = 0; j < 3; ++j) gqv[j] = *(const f32x2*)(gq + 2 * lane + 128 * j);
    const f32x4 gk = *(const f32x4*)(gkv + 4 * lane);
    for (int t = gw; t < T; t += NGW) {
        const bf16* c = (const bf16*)C + (size_t)t * MDNP;
        f32x2 q[3]; float ss = 0.f;
#pragma unroll
        for (int j = 0; j < 3; ++j) { const unsigned w = *(const unsigned*)(c + 2 * lane + 128 * j); q[j] = (f32x2){bflo(w), bfhi(w)}; ss += q[j].x * q[j].x + q[j].y * q[j].y; }
        f32x4 kv; { const u32x2 w = *(const u32x2*)(c + QL + 4 * lane); kv = (f32x4){bflo(w.x), bfhi(w.x), bflo(w.y), bfhi(w.y)}; }
        const float x = bf2f(c[QL + KVL + lane]);
        const float rq = 1.0f / sqrtf(wave_sum(ss) * (1.f / QL) + EPS);
        const float rk = 1.0f / sqrtf(wave_sum((kv.x * kv.x + kv.y * kv.y) + (kv.z * kv.z + kv.w * kv.w)) * (1.f / KVL) + EPS);
#pragma unroll
        for (int j = 0; j < 3; ++j) *(unsigned*)(cqn + (size_t)t * QL + 2 * lane + 128 * j) = cvt_pk_bf16(q[j].x * rq * gqv[j].x, q[j].y * rq * gqv[j].y);
        { u32x2 w; w.x = cvt_pk_bf16(kv.x * rk * gk.x, kv.y * rk * gk.y); w.y = cvt_pk_bf16(kv.z * rk * gk.z, kv.w * rk * gk.w); *(u32x2*)(ckvn + (size_t)t * KVL + 4 * lane) = w; }
        const float other = __shfl_xor(x, 32); const int i = lane & 31;
        const float cs = tab[(size_t)t * 64 + i], sn = tab[(size_t)t * 64 + 32 + i];
        const float r = (lane < 32) ? (x * cs - other * sn) : (x * cs + other * sn);
        if (K8) { const float rs_ = fminf(fmaxf(r * kscale, -448.f), 448.f); const float r1 = __shfl_down(rs_, 1), r2 = __shfl_down(rs_, 2), r3 = __shfl_down(rs_, 3);
            if ((lane & 3) == 0) { int tq = __builtin_amdgcn_cvt_pk_fp8_f32(rs_, r1, 0, false); tq = __builtin_amdgcn_cvt_pk_fp8_f32(r2, r3, tq, true);
                const int b = t >> 13, s = t & (SEQ - 1), a_ = lane >> 4, h_ = (lane >> 3) & 1, j_ = lane & 7;
#pragma unroll
                for (int h = 0; h < MH; ++h) *(unsigned*)((unsigned char*)Kf + ((size_t)(b * MH + h) * SEQ + s) * DQKM + 128 + 32 * h_ + 8 * a_ + j_) = (unsigned)tq; }
        } else {
        const float rn = __shfl_xor(r, 1);
        if ((lane & 1) == 0) { const unsigned pk = cvt_pk_bf16(r, rn); const int b = t >> 13, s = t & (SEQ - 1);
#pragma unroll
            for (int h = 0; h < MH; ++h) *(unsigned*)(Kf + ((size_t)(b * MH + h) * SEQ + s) * DQKM + 128 + lane) = pk; } }
    }
}
#ifndef PC_CONV_IN
#define PC_CONV_IN 2
#endif
#ifndef PC_FFN_GU
#define PC_FFN_GU 2
#endif
#ifndef PC_MDN
#define PC_MDN 2
#endif
#ifndef PC_SQKV
#define PC_SQKV 2
#endif
#ifndef PC_CONV_OUT
#define PC_CONV_OUT 0
#endif
#ifndef PC_ATT_O
#define PC_ATT_O 1
#endif
#ifndef PC_FFN_DN
#define PC_FFN_DN 1
#endif
#ifdef DIAG_GEMM
#define DIAG_PTR(N_, P_) (((N_) == DIAG_N && (P_) == DIAG_PREC) ? (unsigned long long*)(F.ws + WS_CTL + 24000) : nullptr)
#else
#define DIAG_PTR(N_, P_) nullptr
#endif
#ifndef STAGGER_TICKS
#define STAGGER_TICKS 0
#endif
template <int PREC = 0, class Epi>
__device__ __forceinline__ void gemm_static(Frame& F, const void* A, int lda, int K, const void* Bt, int N, const Epi& E, const float* rs = nullptr, const float* cs = nullptr, int stagger = 0, int M = T) {
    if (stagger && ((blockIdx.x >> 3) & 1)) { const unsigned long long t0 = __builtin_amdgcn_s_memrealtime(); while (__builtin_amdgcn_s_memrealtime() - t0 < (unsigned long long)stagger) __builtin_amdgcn_s_sleep(8); }
    pg8::Gemm g{(const bf16*)A, (const bf16*)Bt, PREC ? lda / 2 : lda, PREC ? K / 2 : K, 0, rs, cs, 0, DIAG_PTR(N, PREC)}; pg8::StaticOrder S; S.init(M, N, F.G, (int)blockIdx.x, (LAS unsigned*)((LAS unsigned char*)F.lds + MISC_OFF + 512), 128);
    pg8::gemm_phase<Epi, pg8::StaticOrder, PREC>((LAS unsigned char*)F.lds, g, S, E);
}
template <bool F8, class Epi, bool GATH = false, bool QS = false>
__device__ __forceinline__ void gemm_grouped(Frame& F, const void* A, int lda, int K, const void* Bt, size_t estride, int N, const unsigned* pbase, const Epi& E, const int* gidx = nullptr) {
    pg8::Gemm g{(const bf16*)A, (const bf16*)Bt, lda, K, estride, nullptr, nullptr, 0, DIAG_PTR(N, F8 ? 1 : 0), gidx}; pg8::GroupedOrderT<QS> S; S.init(pbase, N, F.G, (int)blockIdx.x, (LAS unsigned*)((LAS unsigned char*)F.lds + MISC_OFF + 512), 128);
    pg8::gemm_phase<Epi, pg8::GroupedOrderT<QS>, F8 ? 1 : 0, GATH, QS>((LAS unsigned char*)F.lds, g, S, E);
}
#ifndef MOE_F8_A
#define MOE_F8_A 1
#endif
#ifndef MOE_F8_B
#define MOE_F8_B 1
#endif
template <bool F8>
__device__ __forceinline__ void moe_gemm1(Frame& F, int l, const unsigned* pb) {
    unsigned char* ws = F.ws; unsigned char* big = ws + WS_BIG;
    if (F8) gemm_grouped<true, pg8::EpiPair8, true>(F, ws + WS_XN, D / 2, D / 2, ws + W_MGU + (size_t)l * 8 * 2 * FE * 1024 * 2, (size_t)2 * FE * 1024, 2 * FE, pb, pg8::EpiPair8{big, FE, 1.0f / (ACT_SCALE8 * W_SCALE8), HID_SCALE8}, (const int*)(ws + RT_TOK));
    else gemm_grouped<false>(F, ws + WS_XG, D, D, ws + W_MGU + (size_t)l * 8 * 2 * FE * 1024 * 2, (size_t)2 * FE * 1024 * 2, 2 * FE, pb, pg8::EpiPair<1>{(bf16*)big, FE, 1.0f});
}
template <bool F8, bool Y8 = false>
__device__ __forceinline__ void moe_gemm2(Frame& F, int l, const unsigned* pb) {
    unsigned char* ws = F.ws; unsigned char* big = ws + WS_BIG;
    if (F8 && Y8) gemm_grouped<true, pg8::EpiF8, false, true>(F, big, FE / 2, FE / 2, ws + W_MD + (size_t)l * 8 * 1024 * FE * 2, (size_t)1024 * FE, 1024, pb, pg8::EpiF8{ws + WS_XG, D, Y_SCALE8 / (HID_SCALE8 * W_SCALE8)});
    else if (F8) gemm_grouped<true>(F, big, FE / 2, FE / 2, ws + W_MD + (size_t)l * 8 * 1024 * FE * 2, (size_t)1024 * FE, 1024, pb, pg8::EpiBf16{(bf16*)(ws + WS_XG), D, nullptr, 1.0f / (HID_SCALE8 * W_SCALE8)});
    else gemm_grouped<false>(F, big, FE, FE, ws + W_MD + (size_t)l * 8 * 1024 * FE * 2, (size_t)1024 * FE * 2, 1024, pb, pg8::EpiBf16{(bf16*)(ws + WS_XG), D, nullptr, 1.0f});
}
#define W_DENSE_LIST(X) \
    for (int j = 0; j < 2; ++j) { \
        X(PC_CONV_IN, 0, in[5] + (size_t)j * 1024 * 3072, 1024, 1024, 3072, W_CINB + (size_t)j * 1024 * 1024 * 2, CM_CIN + j * 3072) \
        X(PC_CONV_IN, 1, in[5] + (size_t)j * 1024 * 3072 + 1024, 1024, 2048, 3072, W_CINCU + (size_t)j * 2048 * 1024 * 2, CM_CIN + j * 3072 + 1024) \
        X(PC_CONV_OUT, 0, in[7] + (size_t)j * 1024 * 1024, 1024, 1024, 1024, W_COUT + (size_t)j * 1024 * 1024 * 2, 0) \
        X(PC_FFN_GU, 1, in[19] + (size_t)j * 1024 * 2 * FF, 1024, 2 * FF, 2 * FF, W_FGU + (size_t)j * 2 * FF * 1024 * 2, CM_FGU + j * 5632) \
        X(PC_FFN_DN, 0, in[20] + (size_t)j * FF * 1024, FF, 1024, 1024, W_FD + (size_t)j * 1024 * FF * 2, 0) \
    } \
    X(PC_MDN, 0, in[8], 1024, MDN, MDN, W_MDN, CM_MDN) \
    X(0, 0, in[10], QL, 1536, 1536, W_MUQ, 0) \
    for (int h = 0; h < MH; ++h) {   \
        X(0, 0, in[12] + h * 256, KVL, 128, 2048, W_MUKV + (size_t)h * 128 * KVL * 2, 0) \
        X(0, 0, in[12] + h * 256 + 128, KVL, 128, 2048, W_MUKV + (size_t)(1024 + h * 128) * KVL * 2, 0) \
    } \
    X(PC_ATT_O, 0, in[13], 1024, 1024, 1024, W_MO, 0) \
    X(PC_SQKV, 0, in[14], 1024, SQKV, SQKV, W_SQKV, CM_SQKV) \
    X(PC_ATT_O, 0, in[17], 1024, 1024, 1024, W_SO, 0)
__device__ __forceinline__ void prologue_a(Frame& F) {
    const float* const* in = F.in; unsigned char* ws = F.ws; unsigned* cmw = (unsigned*)(ws + WS_CTL) + CW_CMAX;
    int rot = 0;
#define XA(PC, MAP, W, K, N, ldw, dst, cm) { if ((PC) == 2) cmax_matrix(F, (W), (K), (N), (ldw), cmw + (cm), rot); else if ((PC) == 1) tr_matrix8<MAP>(F, (W), (K), (N), (ldw), ws + (dst), rot, W_SCALE8); else tr_matrix<MAP>(F, (W), (K), (N), (ldw), (bf16*)(ws + (dst)), rot); rot += 37; }
    W_DENSE_LIST(XA)
#undef XA
    for (int le = 0; le < 16; ++le) {
        const bool f8 = (le < 8) ? (MOE_F8_A != 0) : (MOE_F8_B != 0);
        const size_t l = le >> 3, e = le & 7;
        if (f8) { tr_matrix8<1>(F, in[22] + (size_t)le * 1024 * 2 * FE, 1024, 2 * FE, 2 * FE, ws + W_MGU + l * 8 * 2 * FE * 1024 * 2 + e * 2 * FE * 1024, rot, W_SCALE8); rot += 37;
                  tr_matrix8<0>(F, in[23] + (size_t)le * FE * 1024, FE, 1024, 1024, ws + W_MD + l * 8 * 1024 * FE * 2 + e * 1024 * FE, rot, W_SCALE8); rot += 37; }
        else { tr_matrix<1>(F, in[22] + (size_t)le * 1024 * 2 * FE, 1024, 2 * FE, 2 * FE, (bf16*)(ws + W_MGU + (size_t)le * 2 * FE * 1024 * 2), rot); rot += 37;
               tr_matrix<0>(F, in[23] + (size_t)le * FE * 1024, FE, 1024, 1024, (bf16*)(ws + W_MD + (size_t)le * 1024 * FE * 2), rot); rot += 37; }
    }
    const TC tc = tc_get();
    const int gt = F.vcu * NTHREADS + tc.tid, NGT = F.G * NTHREADS;
    { const int esz = PC_MDN ? 1 : 2; for (int i = gt; i < (MDNP - MDN) * 1024 * esz / 4; i += NGT) ((unsigned*)(ws + W_MDN + (size_t)MDN * 1024 * esz))[i] = 0u;
      if (PC_MDN == 2) for (int i = gt; i < MDNP - MDN; i += NGT) ((float*)(ws + WS_CS))[CM_MDN + MDN + i] = 0.f; }
    for (int i = gt; i < 2 * 8 * 1024; i += NGT) { const int l = i >> 13, e = (i >> 10) & 7, k = i & 1023; ((float*)(ws + W_RT))[i] = in[21][(size_t)l * 1024 * 8 + k * 8 + e]; }
    rope_table(F, (const int*)in[1], (float*)(ws + WS_ROPE));
}
__device__ __forceinline__ void prologue_b(Frame& F) {
    const float* const* in = F.in; unsigned char* ws = F.ws; const unsigned* cmw = (const unsigned*)(ws + WS_CTL) + CW_CMAX; float* csw = (float*)(ws + WS_CS);
    int rot = 0;
#define XB(PC, MAP, W, K, N, ldw, dst, cm) { if ((PC) == 2) tr_matrix_i8<MAP>(F, (W), (K), (N), (ldw), ws + (dst), rot, cmw + (cm), csw + (cm)); rot += 37; }
    W_DENSE_LIST(XB)
#undef XB
}

#ifndef MLA_QK8
#define MLA_QK8 1
#endif
__device__ __forceinline__ void mla_attention(Frame& F) {
    unsigned char* big = F.ws + WS_BIG;
    const bf16* Q = (const bf16*)(big + B_MQ); const bf16* Kf = (const bf16*)(big + B_MK); const bf16* V = (const bf16*)(big + B_MV); bf16* O = (bf16*)(big + B_MO);
    const float* tab = (const float*)(F.ws + WS_ROPE);
    for (int L = blockIdx.x; L < NB * MH * 16; L += F.G) {
        const int xcd = L & 7, kk = L >> 3, bh = xcd * 8 + (kk >> 4), x = kk & 15, b = bh >> 3, h = bh & 7;
        for (int pass = 0; pass < 2; ++pass) {
            const int qb = pass ? 31 - x : x; const size_t row0 = (size_t)b * SEQ + qb * 256;
            att::Params p;
            p.Q = Q + row0 * 1536 + h * DQKM; p.ldq = 1536;
            p.K = MLA_QK8 ? (const bf16*)((const unsigned char*)Kf + (size_t)bh * SEQ * DQKM) : Kf + (size_t)bh * SEQ * DQKM; p.ldk = DQKM;
            if (MLA_QK8) { p.V = (const bf16*)((const unsigned char*)V + (size_t)(h * DVM) * T + (size_t)b * SEQ); p.ldv = T; }
            else { p.V = V + (size_t)bh * SEQ * DVM; p.ldv = DVM; }
            p.O = PC_ATT_O ? (bf16*)((unsigned char*)O + row0 * 1024 + h * DVM) : O + row0 * 1024 + h * DVM; p.ldo = 1024; p.P0 = qb * 256; p.j_lo = 0; p.j_hi = 4 * (qb + 1);
            p.rope = tab + row0 * 64; p.pos = nullptr; p.slope_over_scale = 0.f; p.sink_l2 = 0.f;
            att::attn_block<192, 128, 0, (1 << 30), MLA_QK8 != 0, PC_ATT_O != 0>(p, F.lds);
        }
    }
}
#ifndef SWA_RES
#define SWA_RES 1
#endif
__device__ __forceinline__ void swa_attention(Frame& F) {
    unsigned char* big = F.ws + WS_BIG;
    const bf16* QKV = (const bf16*)(big + B_SQKV); bf16* O = (bf16*)(big + B_SO);
    const int* pos = (const int*)F.in[1]; const float* sinks = F.in[16];
#if SWA_RES
    for (int L = blockIdx.x; L < NB * 2 * 32; L += F.G) {
        const int qb = L & 31, pair = L >> 5, b = pair >> 1, kvh = pair & 1, qh = kvh * 8;
        const size_t row0 = (size_t)b * SEQ + qb * 256;
        att::Params p;
        p.Q = QKV + row0 * SQKV + qh * 64; p.ldq = SQKV;
        p.K = QKV + (size_t)b * SEQ * SQKV + 1024 + kvh * 64; p.ldk = SQKV; p.V = QKV + (size_t)b * SEQ * SQKV + 1152 + kvh * 64; p.ldv = SQKV;
        p.O = PC_ATT_O ? (bf16*)((unsigned char*)O + row0 * 1024 + qh * 64) : O + row0 * 1024 + qh * 64; p.ldo = 1024; p.P0 = qb * 256; p.j_lo = qb ? 4 * qb - 2 : 0; p.j_hi = 4 * qb + 4;
        p.rope = nullptr; p.pos = pos + (size_t)b * SEQ; p.slope_over_scale = 0.f; p.sink_l2 = 0.f; p.sinks = sinks; p.qh0 = qh;
        att::attn_block<64, 64, 1, 128, false, PC_ATT_O != 0, true>(p, F.lds);
    }
#else
    for (int L = blockIdx.x; L < NB * 16 * 32; L += F.G) {
        const int xcd = L & 7, kk = L >> 3, pair = xcd * 2 + (kk >> 8), u = kk & 255, qb = u >> 3, g = u & 7, b = pair >> 1, kvh = pair & 1, qh = kvh * 8 + g;
        const size_t row0 = (size_t)b * SEQ + qb * 256;
        att::Params p;
        p.Q = QKV + row0 * SQKV + qh * 64; p.ldq = SQKV;
        p.K = QKV + (size_t)b * SEQ * SQKV + 1024 + kvh * 64; p.ldk = SQKV; p.V = QKV + (size_t)b * SEQ * SQKV + 1152 + kvh * 64; p.ldv = SQKV;
        p.O = PC_ATT_O ? (bf16*)((unsigned char*)O + row0 * 1024 + qh * 64) : O + row0 * 1024 + qh * 64; p.ldo = 1024; p.P0 = qb * 256; p.j_lo = qb ? 4 * qb - 2 : 0; p.j_hi = 4 * qb + 4;
        p.rope = nullptr; p.pos = pos + (size_t)b * SEQ; p.sinks = sinks; p.qh0 = qh;
        p.slope_over_scale = __builtin_amdgcn_exp2f(-0.5f * (float)(qh + 1)) * 8.0f;
        p.sink_l2 = sinks[qh] * 1.4426950408889634f;
        att::attn_block<64, 64, 1, 128, false, PC_ATT_O != 0>(p, F.lds);
    }
#endif
}

struct Args { const float* in[24]; float* out; unsigned char* ws; int ph_lo, ph_hi; };
constexpr int N_PHASES = 33;
__global__ void __launch_bounds__(NTHREADS, 2) mega(Args args) {
    extern __shared__ __attribute__((aligned(16))) unsigned char lds_raw[];
#if HW_SAT8
    __builtin_amdgcn_s_setreg(1 | (23 << 6), 1);
#endif
    Frame F;
    F.lds = (char*)lds_raw;
    F.G = gridDim.x; { const int bx = blockIdx.x; F.vcu = (F.G % 8 == 0) ? (bx % 8) * (F.G / 8) + bx / 8 : bx; }
    F.ws = args.ws; F.out = args.out; F.in = args.in;
    unsigned char* ws = args.ws; unsigned char* big = ws + WS_BIG;
    unsigned* ctl = (unsigned*)(ws + WS_CTL);
    volatile LAS unsigned* misc = (volatile LAS unsigned*)((LAS unsigned char*)lds_raw + MISC_OFF);
    if (threadIdx.x < 32) misc[threadIdx.x] = 0u;
    __syncthreads();
    const int lo = args.ph_lo, hi = args.ph_hi;
    XcdBarrier bar; bar.bar = ctl + CW_BAR; bar.x = 0; bar.st = nullptr;
    if (hi - lo > 1) bar = xcd_barrier_post(ctl + CW_BAR, misc + 8);
#ifndef PH_SEL
#define PH_SEL -1
#endif
#define IN(k) ((PH_SEL < 0 || PH_SEL == (k)) && lo <= (k) && (k) < hi)
#ifndef PROBE_MASK
#define PROBE_MASK 0ull
#endif
#define REP(k) for (int rep_ = 0, nrep_ = (((PROBE_MASK >> (k)) & 1ull) ? 2 : 1); rep_ < nrep_; ++rep_)
#define XDST ((rep_ + 1 < nrep_) ? (float*)(ws + WS_XG) : X)
#define XBDST ((rep_ + 1 < nrep_) ? (bf16*)args.out : XB)
#ifndef XBF16
#define XBF16 1
#endif
#if XBF16
static_assert(MOE_F8_A && MOE_F8_B, "the bf16 residual stream lives in the half of the XG region that fp8 MoE rows leave free");
#define RES_EPI(srcf32, srcp, ...) pg8::EpiResB<srcf32>{(srcf32) ? (const void*)(srcp) : (const void*)XB, XBDST, __VA_ARGS__}
#else
#define RES_EPI(srcf32, srcp, ...) pg8::EpiRes{(srcf32) ? (const float*)(srcp) : (const float*)X, XDST, __VA_ARGS__}
#endif
#ifdef DIAG_GEMM
    unsigned long long dgw_wait = 0, dgw_sel = 0;
#define SEAM(k) do { if (IN(k) && IN((k) + 1)) { const unsigned long long t_ = __builtin_amdgcn_s_memrealtime(); xcd_barrier(bar); const unsigned long long d_ = __builtin_amdgcn_s_memrealtime() - t_; dgw_wait += d_; if ((k) == DIAG_SEAM) dgw_sel = d_; } } while (0)
#else
#define SEAM(k) do { if (IN(k) && IN((k) + 1)) { xcd_barrier(bar); if ((PROBE_MASK >> 40) & 1ull) xcd_barrier(bar); } } while (0)
#endif
    const float* x_in = args.in[0]; float* X = args.out; bf16* XB = (bf16*)(ws + WS_XG + (size_t)MAXSLOT * D);
    bf16* XN = (bf16*)(ws + WS_XN); bf16* XG = (bf16*)(ws + WS_XG);
    unsigned* rt_e = (unsigned*)(ws + RT_E); float* rt_w0 = (float*)(ws + RT_W0); float* rt_w1 = (float*)(ws + RT_W1); int* rt_s0 = (int*)(ws + RT_S0); int* rt_s1 = (int*)(ws + RT_S1);
    unsigned* rt_cnt = (unsigned*)(ws + RT_CNT); unsigned* rt_pb = (unsigned*)(ws + RT_PB);
    const float* nmix = args.in[2]; const float* nffn = args.in[3];

    constexpr float S_AW = 1.0f / (ACT_SCALE8 * W_SCALE8), S_HW = 1.0f / (HID_SCALE8 * W_SCALE8);
    constexpr bool MA8 = MOE_F8_A != 0, MB8 = MOE_F8_B != 0;
    bf16* Bc = (bf16*)(big + B_CONV_B); bf16* Vc = (bf16*)(big + B_CONV_V); bf16* Yc = (bf16*)(big + B_CONV_Y);
    float* rsA = (float*)(ws + WS_RS); const float* csw = (const float*)(ws + WS_CS);
#define ASC(PC) ((PC) == 1 ? S_AW : 1.0f)
#define ROWPASS(MODE, COMB, OM, ...) do { RowArgs a{}; a.Xsrc = X; a.Xsb = XB; a.Xdb = XB; a.XN = XN; a.rs = rsA; __VA_ARGS__; row_pass<MODE, COMB, OM, false, XBF16 != 0>(F, a); } while (0)
#define ROWPASS_Y8(MODE, COMB, OM, ...) do { RowArgs a{}; a.Xsrc = X; a.Xsb = XB; a.Xdb = XB; a.XN = XN; a.rs = rsA; __VA_ARGS__; row_pass<MODE, COMB, OM, true, XBF16 != 0>(F, a); } while (0)
#define CONV_IN(j) do { gemm_static<PC_CONV_IN>(F, XN, D, D, ws + W_CINB + (size_t)(j) * 1024 * 1024 * 2, 1024, pg8::EpiBf16{Bc, D, nullptr, ASC(PC_CONV_IN)}, rsA, csw + CM_CIN + (j) * 3072); \
                        gemm_static<PC_CONV_IN>(F, XN, D, D, ws + W_CINCU + (size_t)(j) * 2048 * 1024 * 2, 2048, pg8::EpiPair<0>{Vc, D, ASC(PC_CONV_IN)}, rsA, csw + CM_CIN + (j) * 3072 + 1024); } while (0)
#define CONV_OUT(j, srcin) gemm_static<PC_CONV_OUT>(F, Yc, D, D, ws + W_COUT + (size_t)(j) * 1024 * 1024 * 2, 1024, RES_EPI(srcin, x_in, D, nullptr, PC_CONV_OUT == 1 ? 1.0f / (YC_SCALE8 * W_SCALE8) : 1.0f), nullptr, nullptr, STAGGER_TICKS)
#define FFN_GU(f) do { if constexpr (PC_FFN_DN == 1) gemm_static<PC_FFN_GU>(F, XN, D, D, ws + W_FGU + (size_t)(f) * 2 * FF * 1024 * 2, 2 * FF, pg8::EpiPair8{big + B_HMID, FF, ASC(PC_FFN_GU), HID_SCALE8}, rsA, csw + CM_FGU + (f) * 5632); \
                       else gemm_static<PC_FFN_GU>(F, XN, D, D, ws + W_FGU + (size_t)(f) * 2 * FF * 1024 * 2, 2 * FF, pg8::EpiPair<1>{(bf16*)(big + B_HMID), FF, ASC(PC_FFN_GU)}, rsA, csw + CM_FGU + (f) * 5632); } while (0)
#define FFN_DN(f) gemm_static<PC_FFN_DN>(F, big + B_HMID, FF, FF, ws + W_FD + (size_t)(f) * 1024 * FF * 2, 1024, RES_EPI(false, x_in, D, nullptr, PC_FFN_DN == 1 ? S_HW : 1.0f), nullptr, nullptr, STAGGER_TICKS)

    if (IN(0)) REP(0) { prologue_a(F); xcd_barrier(bar); prologue_b(F); __syncthreads(); { RowArgs a{}; a.Xsrc = x_in; a.XN = XN; a.rs = rsA; a.g = nmix; row_pass<0, false, PC_CONV_IN, false, false>(F, a); } }
    SEAM(0);
    if (IN(1)) REP(1) CONV_IN(0);
    if (IN(1) && ((PROBE_MASK >> 41) & 1ull)) CONV_IN(0);
    SEAM(1);
    if (IN(2)) REP(2) conv_pass<PC_CONV_OUT == 1>(F, Bc, Vc, args.in[6], Yc);
    SEAM(2);
    if (IN(3)) REP(3) CONV_OUT(0, true);
    SEAM(3);
    if (IN(4)) REP(4) ROWPASS(0, false, PC_FFN_GU, a.g = nffn);
    SEAM(4);
    if (IN(5)) REP(5) FFN_GU(0);
    if (IN(5) && ((PROBE_MASK >> 42) & 1ull)) FFN_GU(0);
    SEAM(5);
    if (IN(6)) REP(6) FFN_DN(0);
    SEAM(6);
    if (IN(7)) REP(7) ROWPASS(0, false, PC_MDN, a.g = nmix + D);
    SEAM(7);
    if (IN(8)) REP(8) gemm_static<PC_MDN>(F, XN, D, D, ws + W_MDN, MDNP, pg8::EpiBf16{(bf16*)(big + B_MC), MDNP, nullptr, ASC(PC_MDN)}, rsA, csw + CM_MDN);
    SEAM(8);
    if (IN(9)) REP(9) mla_mid<MLA_QK8>(F, (const float*)(big + B_MC), args.in[9], args.in[11], (const float*)(ws + WS_ROPE), (bf16*)(big + B_MCQ), (bf16*)(big + B_MCKV), (bf16*)(big + B_MK), att::QK8_SCALE);
    SEAM(9);
    if (IN(10)) REP(10) {
        gemm_static(F, big + B_MCQ, QL, QL, ws + W_MUQ, 1536, pg8::EpiBf16{(bf16*)(big + B_MQ), 1536, nullptr, 1.0f});
#if MLA_QK8
        gemm_static(F, big + B_MCKV, KVL, KVL, ws + W_MUKV, 1024, pg8::EpiK8{big + B_MK, att::QK8_SCALE});
        gemm_static(F, ws + W_MUKV + (size_t)1024 * KVL * 2, KVL, KVL, big + B_MCKV, T, pg8::EpiVT8{big + B_MV, (size_t)T, att::QK8_SCALE}, nullptr, nullptr, 0, 1024);
#else
        gemm_static(F, big + B_MCKV, KVL, KVL, ws + W_MUKV, 2048, pg8::EpiKVT<0>{(bf16*)(big + B_MK), (bf16*)(big + B_MV), 1.0f});
#endif
    }
    SEAM(10);
#ifdef DIAG_GEMM
    unsigned long long dph_c = __builtin_readcyclecounter(), dph_w = __builtin_amdgcn_s_memrealtime();
#endif
    if (IN(11)) REP(11) mla_attention(F);
#ifdef DIAG_GEMM
    if (DIAG_N == -11 && blockIdx.x == DIAG_BLOCK && threadIdx.x == 0) { unsigned long long* dg = (unsigned long long*)(ws + WS_CTL + 24000); dg[3] = __builtin_readcyclecounter() - dph_c; dg[4] = __builtin_amdgcn_s_memrealtime() - dph_w; }
#endif
    SEAM(11);
    if (IN(12)) REP(12) gemm_static<PC_ATT_O>(F, big + B_MO, D, D, ws + W_MO, 1024, RES_EPI(false, x_in, D, nullptr, PC_ATT_O ? 1.0f / (att::O8_SCALE * W_SCALE8) : 1.0f), nullptr, nullptr, STAGGER_TICKS);
    SEAM(12);
    if (IN(13)) REP(13) ROWPASS(1, false, MA8 ? 1 : 0, a.g = nffn + D; a.routerT = (const float*)(ws + W_RT); a.rt_e = rt_e; a.rt_w0 = rt_w0; a.rt_w1 = rt_w1; a.cnt = rt_cnt);
    SEAM(13);
    if (IN(14)) REP(14) moe_assign<MA8>(F, rt_cnt, rt_e, rt_s0, rt_s1, rt_pb, XN, XG, MA8 ? (int*)(ws + RT_TOK) : nullptr);
    SEAM(14);
    if (IN(15)) REP(15) moe_gemm1<MA8>(F, 0, rt_pb);
    SEAM(15);
    if (IN(16)) REP(16) moe_gemm2<MA8, MA8>(F, 0, rt_pb);
    SEAM(16);
    if (IN(17)) REP(17) ROWPASS_Y8(0, true, PC_SQKV, a.Xdst = X; a.g = nmix + 2 * D; a.Y = XG; a.s0 = rt_s0; a.s1 = rt_s1; a.w0 = rt_w0; a.w1 = rt_w1);
    SEAM(17);
    if (IN(18)) REP(18) gemm_static<PC_SQKV>(F, XN, D, D, ws + W_SQKV, SQKV, pg8::EpiBf16{(bf16*)(big + B_SQKV), SQKV, args.in[15], ASC(PC_SQKV)}, rsA, csw + CM_SQKV);
    SEAM(18);
    if (IN(19)) REP(19) swa_attention(F);
    SEAM(19);
    if (IN(20)) REP(20) gemm_static<PC_ATT_O>(F, big + B_SO, D, D, ws + W_SO, 1024, RES_EPI(false, x_in, D, args.in[18], PC_ATT_O ? 1.0f / (att::O8_SCALE * W_SCALE8) : 1.0f), nullptr, nullptr, STAGGER_TICKS);
    SEAM(20);
    if (IN(21)) REP(21) ROWPASS(0, false, PC_FFN_GU, a.g = nffn + 2 * D);
    SEAM(21);
    if (IN(22)) REP(22) FFN_GU(1);
    SEAM(22);
    if (IN(23)) REP(23) FFN_DN(1);
    SEAM(23);
    if (IN(24)) REP(24) ROWPASS(0, false, PC_CONV_IN, a.g = nmix + 3 * D);
    SEAM(24);
    if (IN(25)) REP(25) CONV_IN(1);
    SEAM(25);
    if (IN(26)) REP(26) conv_pass<PC_CONV_OUT == 1>(F, Bc, Vc, args.in[6] + 3 * D, Yc);
    SEAM(26);
    if (IN(27)) REP(27) CONV_OUT(1, false);
    SEAM(27);
    if (IN(28)) REP(28) ROWPASS(1, false, MB8 ? 1 : 0, a.g = nffn + 3 * D; a.routerT = (const float*)(ws + W_RT) + 8 * 1024; a.rt_e = rt_e; a.rt_w0 = rt_w0; a.rt_w1 = rt_w1; a.cnt = rt_cnt);
    SEAM(28);
    if (IN(29)) REP(29) moe_assign<MB8>(F, rt_cnt, rt_e, rt_s0, rt_s1, rt_pb + 16, XN, XG, MB8 ? (int*)(ws + RT_TOK) : nullptr);
    SEAM(29);
    if (IN(30)) REP(30) moe_gemm1<MB8>(F, 1, rt_pb + 16);
    SEAM(30);
    if (IN(31)) REP(31) moe_gemm2<MB8, MB8>(F, 1, rt_pb + 16);
    SEAM(31);
    if (IN(32)) REP(32) ROWPASS_Y8(2, true, 0, a.g = args.in[4]; a.outF = X; a.Y = XG; a.s0 = rt_s0; a.s1 = rt_s1; a.w0 = rt_w0; a.w1 = rt_w1);
#ifdef DIAG_GEMM
    if (blockIdx.x == DIAG_BLOCK && threadIdx.x == 0) { const unsigned long long* dg = (const unsigned long long*)(ws + WS_CTL + 24000);
        unsigned long long q = dg[DIAG_SEL < 6 ? DIAG_SEL : 0]; if (DIAG_SEL == 3) q = q / 200ull;
        if (DIAG_SEL == 6) q = dgw_wait; if (DIAG_SEL == 7) q = dgw_sel;
        const unsigned long long t0 = __builtin_amdgcn_s_memrealtime(), tgt = q * DIAG_MUL;
        while (__builtin_amdgcn_s_memrealtime() - t0 < tgt) __builtin_amdgcn_s_sleep(20); }
#endif
#undef IN
#undef SEAM
}

#ifndef MK_LAUNCH_PER_PHASE
#define MK_LAUNCH_PER_PHASE 0
#endif
extern "C" void kernel_launch(void* const* d_in, const int* in_sizes, int n_in, void* d_out, int out_size, void* d_ws, size_t ws_size, hipStream_t stream) {
    static int grid = 0;
    if (grid == 0) {
        if (n_in != 24 || in_sizes[0] != T * D || out_size != T * D || ws_size < WS_END) { fprintf(stderr, "kernel_launch: unexpected shapes (n_in %d, in0 %d, out %d, ws %zu < %zu); nothing launched\n", n_in, n_in > 0 ? in_sizes[0] : -1, out_size, ws_size, (size_t)WS_END); grid = -1; return; }
        int dev = 0, cus = 0, per_cu = 0;
        if (hipGetDevice(&dev) != hipSuccess || hipDeviceGetAttribute(&cus, hipDeviceAttributeMultiprocessorCount, dev) != hipSuccess) { grid = -1; return; }
        if (hipFuncSetAttribute((const void*)mega, hipFuncAttributeMaxDynamicSharedMemorySize, LDS_BYTES) != hipSuccess) { fprintf(stderr, "kernel_launch: hipFuncSetAttribute failed\n"); grid = -1; return; }
        if (hipOccupancyMaxActiveBlocksPerMultiprocessor(&per_cu, (const void*)mega, NTHREADS, LDS_BYTES) != hipSuccess || per_cu < 1) fprintf(stderr, "kernel_launch: occupancy query reports %d\n", per_cu);
        (void)hipGetLastError();
        grid = cus;
    }
    if (grid < 0) return;
    (void)hipMemsetAsync((char*)d_ws + WS_CTL, 0, CTL_ZERO_BYTES, stream);
    Args a{};
    for (int i = 0; i < 24; ++i) a.in[i] = (const float*)d_in[i];
    a.out = (float*)d_out; a.ws = (unsigned char*)d_ws;
#if MK_LAUNCH_PER_PHASE
    for (int p = 0; p < N_PHASES; ++p) { a.ph_lo = p; a.ph_hi = p + 1; hipLaunchKernelGGL(mega, dim3(grid), dim3(NTHREADS), LDS_BYTES, stream, a); }
#else
    a.ph_lo = 0; a.ph_hi = N_PHASES; hipLaunchKernelGGL(mega, dim3(grid), dim3(NTHREADS), LDS_BYTES, stream, a);
#endif
}
```

```cpp
#include <hip/hip_runtime.h>
#include <cstdio>
#include <cstdint>

#define LAS __attribute__((address_space(3)))
#define GAS __attribute__((address_space(1)))
typedef unsigned short bf16;
typedef short bf16x8 __attribute__((ext_vector_type(8)));
typedef short s16x4 __attribute__((ext_vector_type(4)));
typedef float f32x2 __attribute__((ext_vector_type(2)));
typedef float f32x4 __attribute__((ext_vector_type(4)));
typedef float f32x16 __attribute__((ext_vector_type(16)));
typedef unsigned u32x2 __attribute__((ext_vector_type(2)));
typedef unsigned u32x4 __attribute__((ext_vector_type(4)));

__device__ __forceinline__ unsigned cvt_pk_bf16(float lo, float hi) { unsigned r; asm volatile("v_cvt_pk_bf16_f32 %0, %1, %2" : "=v"(r) : "v"(lo), "v"(hi)); return r; }
__device__ __forceinline__ float bf2f(unsigned short b) { return __uint_as_float(((unsigned)b) << 16); }
__device__ __forceinline__ float bflo(unsigned w) { return __uint_as_float(w << 16); }
__device__ __forceinline__ float bfhi(unsigned w) { return __uint_as_float(w & 0xffff0000u); }
__device__ __forceinline__ float wave_sum(float v) {
#pragma unroll
    for (int o = 1; o < 64; o <<= 1) v += __shfl_xor(v, o);
    return v;
}
__device__ __forceinline__ float fast_silu(float g) { return g * __builtin_amdgcn_rcpf(1.0f + __builtin_amdgcn_exp2f(-1.4426950408889634f * g)); }

namespace pg8 {
constexpr int BM = 256, BK = 64, HALF = 128, HTB = HALF * BK * 2, STAGE_BYTES = 8 * HTB, NXCD = 8, WGM = 8;
__host__ __device__ __forceinline__ int lds_byte(int r, int c) { const int st = (r >> 4) * 2 + (c >> 5), rr = r & 15, cc = c & 31, ob = rr * 64 + cc * 2; return st * 1024 + (ob ^ (((ob >> 9) & 1) << 5)); }
__host__ __device__ __forceinline__ void stage_rc(int b, int& R, int& C) { const int st = b / 1024, sb = b % 1024, swz = sb ^ (((sb >> 9) & 1) << 5); R = (st >> 1) * 16 + swz / 64; C = (st & 1) * 32 + (swz % 64) / 2; }
__host__ __device__ __forceinline__ int perm32(int rho) { const int n = rho >> 4, i = rho & 15; return 8 * (i >> 2) + 4 * n + (i & 3); }

struct Unit { int pm, pn, e, qm = 15; };
struct Gemm { const bf16* A; const bf16* Bt; int lda, K; size_t estride; const float* rs; const float* cs; int cs_estride; unsigned long long* diag; const int* gidx = nullptr; };

struct StaticOrder {
    const LAS unsigned* tab;
    __device__ __forceinline__ void init(int M, int N, int G, int c, LAS unsigned* table, int cap) {
        const int tid = threadIdx.x; const int nM = M / BM, nN = N / BM, nwg = nM * nN;
        if (tid < cap) {
            unsigned w = 0u; const long L = (long)tid * G + c;
            if (L < nwg) {
                int wgid = (int)L; { const int q = nwg / NXCD, r = nwg % NXCD, xcd = wgid % NXCD, off = wgid / NXCD; wgid = (xcd < r ? xcd * (q + 1) : r * (q + 1) + (xcd - r) * q) + off; }
                const int nig = WGM * nN, gid = wgid / nig, fm = gid * WGM, gsz = (nM - fm) < WGM ? (nM - fm) : WGM;
                w = (unsigned)(fm + ((wgid % nig) % gsz)) | ((unsigned)((wgid % nig) / gsz) << 12) | 0x80000000u;
            }
            table[tid] = w;
        }
        tab = table;
        __syncthreads();
    }
    __device__ __forceinline__ bool next(int i, Unit& u) const {
        const unsigned w = (unsigned)__builtin_amdgcn_readfirstlane((int)tab[i]);
        u.pm = (int)(w & 0xfffu); u.pn = (int)((w >> 12) & 0xfffu); u.e = 0; return (w >> 31) != 0u;
    }
};
template <bool QSPLIT = false>
struct GroupedOrderT {
    const LAS unsigned* tab;
    __device__ __forceinline__ void init(const unsigned* pbase, int N, int G, int c, LAS unsigned* table, int cap) {
        const int tid = threadIdx.x;
        int pb[9];
#pragma unroll
        for (int i = 0; i < 9; ++i) pb[i] = (int)__hip_atomic_load(pbase + i, __ATOMIC_RELAXED, __HIP_MEMORY_SCOPE_AGENT);
        const int nM = pb[8], nN = N / BM, nwg = nM * nN;
        const int per = nwg / G, left = nwg - per * G; const bool qs = QSPLIT && left > 0 && 4 * left <= G && per < cap;
        if (tid < cap) {
            unsigned w = 0u; long L = (long)tid * G + c; unsigned qm = 15u;
            if (qs && tid >= per) { L = (tid == per && c < 4 * left) ? (long)per * G + (c >> 2) : (long)nwg; qm = 1u << (c & 3); }
            if (L < nwg) {
                int wgid = (int)L; { const int q = nwg / NXCD, r = nwg % NXCD, xcd = wgid % NXCD, off = wgid / NXCD; wgid = (xcd < r ? xcd * (q + 1) : r * (q + 1) + (xcd - r) * q) + off; }
                const int nig = WGM * nN, gid = wgid / nig, fm = gid * WGM, gsz = (nM - fm) < WGM ? (nM - fm) : WGM;
                const int pm = fm + ((wgid % nig) % gsz), pn = (wgid % nig) / gsz;
                int e = 0;
#pragma unroll
                for (int j = 1; j < 8; ++j) e += (pm >= pb[j]) ? 1 : 0;
                w = (unsigned)pm | ((unsigned)pn << 12) | ((unsigned)e << 20) | (qm << 24) | 0x80000000u;
            }
            table[tid] = w;
        }
        tab = table;
        __syncthreads();
    }
    __device__ __forceinline__ bool next(int i, Unit& u) const {
        const unsigned w = (unsigned)__builtin_amdgcn_readfirstlane((int)tab[i]);
        u.pm = (int)(w & 0xfffu); u.pn = (int)((w >> 12) & 0xffu); u.e = (int)((w >> 20) & 0xfu); u.qm = (int)((w >> 24) & 0xfu); return (w >> 31) != 0u;
    }
};
typedef GroupedOrderT<false> GroupedOrder;

struct EpiBf16 {
    static constexpr bool PERM = true;
    bf16* O; int ldc; const float* bias; float scale;
    __device__ __forceinline__ void operator()(const f32x4 (&acc)[2][2][4][2], const Unit& u, int wr, int wc, int fr, int fq) const {
        const int row0 = u.pm * BM + wr * 64 + fr, col0 = u.pn * BM + wc * 32 + 8 * fq;
        f32x4 bv[2][2];
#pragma unroll
        for (int bj = 0; bj < 2; ++bj)
#pragma unroll
            for (int n = 0; n < 2; ++n) bv[bj][n] = bias ? *(const f32x4*)(bias + col0 + bj * HALF + 4 * n) : (f32x4){0.f, 0.f, 0.f, 0.f};
#pragma unroll
        for (int ai = 0; ai < 2; ++ai)
#pragma unroll
            for (int m = 0; m < 4; ++m) { bf16* rowp = O + (size_t)(row0 + ai * HALF + m * 16) * ldc + col0;
#pragma unroll
                for (int bj = 0; bj < 2; ++bj) { const f32x4 v0 = acc[ai][bj][m][0] * scale + bv[bj][0], v1 = acc[ai][bj][m][1] * scale + bv[bj][1];
                    u32x4 w; w.x = cvt_pk_bf16(v0[0], v0[1]); w.y = cvt_pk_bf16(v0[2], v0[3]); w.z = cvt_pk_bf16(v1[0], v1[1]); w.w = cvt_pk_bf16(v1[2], v1[3]);
                    *(u32x4*)(rowp + bj * HALF) = w; } }
    }
};
__device__ __forceinline__ f32x2 swiglu2(f32x2 a, f32x2 b, float c1  , float c2  ) {
    const float inv = __builtin_amdgcn_rcpf(c2), k = __builtin_amdgcn_logf(inv);
    const f32x2 t = a * c1 + k; f32x2 e; e.x = __builtin_amdgcn_exp2f(t.x); e.y = __builtin_amdgcn_exp2f(t.y);
    const f32x2 d = e + inv; f32x2 r; r.x = __builtin_amdgcn_rcpf(d.x); r.y = __builtin_amdgcn_rcpf(d.y);
    return (a * b) * r;
}
#ifndef HW_SAT8
#define HW_SAT8 1
#endif
#if HW_SAT8
#define SAT8(x) (x)
#else
#define SAT8(x) fminf(fmaxf((x), -448.f), 448.f)
#endif
struct EpiF8 {
    static constexpr bool PERM = true;
    unsigned char* O; int ldc; float scale;
    __device__ __forceinline__ void operator()(const f32x4 (&acc)[2][2][4][2], const Unit& u, int wr, int wc, int fr, int fq) const {
        const int row0 = u.pm * BM + wr * 64 + fr, col0 = u.pn * BM + wc * 32 + 8 * fq;
#pragma unroll
        for (int ai = 0; ai < 2; ++ai)
#pragma unroll
            for (int m = 0; m < 4; ++m) { unsigned char* rowp = O + (size_t)(row0 + ai * HALF + m * 16) * ldc + col0;
#pragma unroll
                for (int bj = 0; bj < 2; ++bj) { if (!((u.qm >> (2 * ai + bj)) & 1)) continue;
                    const f32x4 v0 = acc[ai][bj][m][0] * scale, v1 = acc[ai][bj][m][1] * scale; u32x2 w;
                    int t0 = __builtin_amdgcn_cvt_pk_fp8_f32(SAT8(v0[0]), SAT8(v0[1]), 0, false); t0 = __builtin_amdgcn_cvt_pk_fp8_f32(SAT8(v0[2]), SAT8(v0[3]), t0, true);
                    int t1 = __builtin_amdgcn_cvt_pk_fp8_f32(SAT8(v1[0]), SAT8(v1[1]), 0, false); t1 = __builtin_amdgcn_cvt_pk_fp8_f32(SAT8(v1[2]), SAT8(v1[3]), t1, true);
                    w.x = (unsigned)t0; w.y = (unsigned)t1; *(u32x2*)(rowp + bj * HALF) = w; } }
    }
};
template <int ACT  > struct EpiPair {
    static constexpr bool PERM = true;
    bf16* O; int ldc; float sin;
    __device__ __forceinline__ void operator()(const f32x4 (&acc)[2][2][4][2], const Unit& u, int wr, int wc, int fr, int fq) const {
        const int row0 = u.pm * BM + wr * 64 + fr, col0 = u.pn * HALF + wc * 32 + 8 * fq;
#pragma unroll
        for (int ai = 0; ai < 2; ++ai)
#pragma unroll
            for (int m = 0; m < 4; ++m) { bf16* rowp = O + (size_t)(row0 + ai * HALF + m * 16) * ldc + col0;
                f32x4 r[2];
#pragma unroll
                for (int n = 0; n < 2; ++n) { const f32x4 a = acc[ai][0][m][n], b = acc[ai][1][m][n];
                    if (ACT == 1) { const f32x2 lo = swiglu2((f32x2){a[0], a[1]}, (f32x2){b[0], b[1]}, -1.4426950408889634f * sin, sin * sin), hi = swiglu2((f32x2){a[2], a[3]}, (f32x2){b[2], b[3]}, -1.4426950408889634f * sin, sin * sin);
                        r[n] = (f32x4){lo.x, lo.y, hi.x, hi.y}; }
                    else r[n] = (a * b) * (sin * sin); }
                u32x4 w; w.x = cvt_pk_bf16(r[0][0], r[0][1]); w.y = cvt_pk_bf16(r[0][2], r[0][3]); w.z = cvt_pk_bf16(r[1][0], r[1][1]); w.w = cvt_pk_bf16(r[1][2], r[1][3]);
                *(u32x4*)rowp = w; }
    }
};
struct EpiPair8 {
    static constexpr bool PERM = true;
    unsigned char* O; int ldc; float sin, sout;
    __device__ __forceinline__ void operator()(const f32x4 (&acc)[2][2][4][2], const Unit& u, int wr, int wc, int fr, int fq) const {
        const int row0 = u.pm * BM + wr * 64 + fr, col0 = u.pn * HALF + wc * 32 + 8 * fq;
#pragma unroll
        for (int ai = 0; ai < 2; ++ai)
#pragma unroll
            for (int m = 0; m < 4; ++m) { unsigned char* rowp = O + (size_t)(row0 + ai * HALF + m * 16) * ldc + col0;
                float r[8];
#pragma unroll
                for (int n = 0; n < 2; ++n) { const f32x4 a = acc[ai][0][m][n], b = acc[ai][1][m][n];
                    const f32x2 lo = swiglu2((f32x2){a[0], a[1]}, (f32x2){b[0], b[1]}, -1.4426950408889634f * sin, sin * sin * sout), hi = swiglu2((f32x2){a[2], a[3]}, (f32x2){b[2], b[3]}, -1.4426950408889634f * sin, sin * sin * sout);
                    r[4 * n + 0] = SAT8(lo.x); r[4 * n + 1] = SAT8(lo.y); r[4 * n + 2] = SAT8(hi.x); r[4 * n + 3] = SAT8(hi.y); }
                u32x2 w; int t = __builtin_amdgcn_cvt_pk_fp8_f32(r[0], r[1], 0, false); t = __builtin_amdgcn_cvt_pk_fp8_f32(r[2], r[3], t, true); w.x = (unsigned)t;
                t = __builtin_amdgcn_cvt_pk_fp8_f32(r[4], r[5], 0, false); t = __builtin_amdgcn_cvt_pk_fp8_f32(r[6], r[7], t, true); w.y = (unsigned)t;
                *(u32x2*)rowp = w; }
    }
};
struct EpiRes {
    static constexpr bool PERM = false;
    const float* src; float* dst; int ldc; const float* bias; float scale;
    __device__ __forceinline__ void operator()(const f32x4 (&acc)[2][2][4][2], const Unit& u, int wr, int wc, int fr, int fq) const {
        const int row0 = u.pm * BM + wr * 64 + fr, col0 = u.pn * BM + wc * 32 + 4 * fq;
        f32x4 bv[2][2];
#pragma unroll
        for (int bj = 0; bj < 2; ++bj)
#pragma unroll
            for (int n = 0; n < 2; ++n) bv[bj][n] = bias ? *(const f32x4*)(bias + col0 + bj * HALF + n * 16) : (f32x4){0.f, 0.f, 0.f, 0.f};
#pragma unroll
        for (int ai = 0; ai < 2; ++ai)
#pragma unroll
            for (int m = 0; m < 4; ++m) { const size_t off = (size_t)(row0 + ai * HALF + m * 16) * ldc + col0;
                f32x4 s[2][2];
#pragma unroll
                for (int bj = 0; bj < 2; ++bj)
#pragma unroll
                    for (int n = 0; n < 2; ++n) s[bj][n] = *(const f32x4*)(src + off + bj * HALF + n * 16);
#pragma unroll
                for (int bj = 0; bj < 2; ++bj)
#pragma unroll
                    for (int n = 0; n < 2; ++n) *(f32x4*)(dst + off + bj * HALF + n * 16) = s[bj][n] + acc[ai][bj][m][n] * scale + bv[bj][n];
                if (m == 3) asm volatile("" ::: "memory"); }
    }
};
template <bool SRCF>
struct EpiResB {
    static constexpr bool PERM = false;
    const void* src; bf16* dst; int ldc; const float* bias; float scale;
    __device__ __forceinline__ void operator()(const f32x4 (&acc)[2][2][4][2], const Unit& u, int wr, int wc, int fr, int fq) const {
        const int row0 = u.pm * BM + wr * 64 + fr, col0 = u.pn * BM + wc * 32 + 4 * fq;
        f32x4 bv[2][2];
#pragma unroll
        for (int bj = 0; bj < 2; ++bj)
#pragma unroll
            for (int n = 0; n < 2; ++n) bv[bj][n] = bias ? *(const f32x4*)(bias + col0 + bj * HALF + n * 16) : (f32x4){0.f, 0.f, 0.f, 0.f};
#pragma unroll
        for (int ai = 0; ai < 2; ++ai)
#pragma unroll
            for (int m = 0; m < 4; ++m) { const size_t off = (size_t)(row0 + ai * HALF + m * 16) * ldc + col0;
                f32x4 s[2][2];
#pragma unroll
                for (int bj = 0; bj < 2; ++bj)
#pragma unroll
                    for (int n = 0; n < 2; ++n) {
                        if constexpr (SRCF) s[bj][n] = *(const f32x4*)((const float*)src + off + bj * HALF + n * 16);
                        else { const u32x2 w = *(const u32x2*)((const bf16*)src + off + bj * HALF + n * 16); s[bj][n] = (f32x4){bflo(w.x), bfhi(w.x), bflo(w.y), bfhi(w.y)}; } }
#pragma unroll
                for (int bj = 0; bj < 2; ++bj)
#pragma unroll
                    for (int n = 0; n < 2; ++n) { const f32x4 r = s[bj][n] + acc[ai][bj][m][n] * scale + bv[bj][n];
                        u32x2 w; w.x = cvt_pk_bf16(r[0], r[1]); w.y = cvt_pk_bf16(r[2], r[3]); *(u32x2*)(dst + off + bj * HALF + n * 16) = w; }
                if (m == 3) asm volatile("" ::: "memory"); }
    }
};
struct EpiF32 {
    static constexpr bool PERM = false;
    float* C; int ldc; float scale;
    __device__ __forceinline__ void operator()(const f32x4 (&acc)[2][2][4][2], const Unit& u, int wr, int wc, int fr, int fq) const {
        const int row0 = u.pm * BM + wr * 64 + fr, col0 = u.pn * BM + wc * 32 + 4 * fq;
#pragma unroll
        for (int ai = 0; ai < 2; ++ai)
#pragma unroll
            for (int m = 0; m < 4; ++m) { float* rowp = C + (size_t)(row0 + ai * HALF + m * 16) * ldc + col0;
#pragma unroll
                for (int bj = 0; bj < 2; ++bj)
#pragma unroll
                    for (int n = 0; n < 2; ++n) *(f32x4*)(rowp + bj * HALF + n * 16) = acc[ai][bj][m][n] * scale; }
    }
};
template <int K8> struct EpiKVT {
    static constexpr bool PERM = true;
    bf16* Kf; bf16* V; float kscale;
    __device__ __forceinline__ void operator()(const f32x4 (&acc)[2][2][4][2], const Unit& u, int wr, int wc, int fr, int fq) const {
        const int row0 = u.pm * BM + wr * 64 + fr, col0 = wc * 32 + 8 * fq, h = u.pn;
#pragma unroll
        for (int ai = 0; ai < 2; ++ai)
#pragma unroll
            for (int m = 0; m < 4; ++m) { const int row = row0 + ai * HALF + m * 16, b = row >> 13, s = row & 8191; const size_t hr = (size_t)(b * 8 + h) * 8192 + s;
#pragma unroll
                for (int bj = 0; bj < 2; ++bj) { const f32x4 v0 = acc[ai][bj][m][0], v1 = acc[ai][bj][m][1];
                    u32x4 w; w.x = cvt_pk_bf16(v0[0], v0[1]); w.y = cvt_pk_bf16(v0[2], v0[3]); w.z = cvt_pk_bf16(v1[0], v1[1]); w.w = cvt_pk_bf16(v1[2], v1[3]);
                    if (bj == 0) { if (K8) { const int c = col0 >> 6, dl = col0 & 63, a_ = dl >> 4, h_ = (dl >> 3) & 1; u32x2 w8;
                            int t0 = __builtin_amdgcn_cvt_pk_fp8_f32(fminf(fmaxf(v0[0] * kscale, -448.f), 448.f), fminf(fmaxf(v0[1] * kscale, -448.f), 448.f), 0, false); t0 = __builtin_amdgcn_cvt_pk_fp8_f32(fminf(fmaxf(v0[2] * kscale, -448.f), 448.f), fminf(fmaxf(v0[3] * kscale, -448.f), 448.f), t0, true);
                            int t1 = __builtin_amdgcn_cvt_pk_fp8_f32(fminf(fmaxf(v1[0] * kscale, -448.f), 448.f), fminf(fmaxf(v1[1] * kscale, -448.f), 448.f), 0, false); t1 = __builtin_amdgcn_cvt_pk_fp8_f32(fminf(fmaxf(v1[2] * kscale, -448.f), 448.f), fminf(fmaxf(v1[3] * kscale, -448.f), 448.f), t1, true);
                            w8.x = (unsigned)t0; w8.y = (unsigned)t1; *(u32x2*)((unsigned char*)Kf + hr * 192 + 64 * c + 32 * h_ + 8 * a_) = w8; }
                        else *(u32x4*)(Kf + hr * 192 + col0) = w; }
                    else *(u32x4*)(V + hr * 128 + col0) = w; } }
    }
};
typedef EpiKVT<0> EpiKV;

struct EpiK8 {
    static constexpr bool PERM = true;
    unsigned char* K8; float kscale;
    __device__ __forceinline__ void operator()(const f32x4 (&acc)[2][2][4][2], const Unit& u, int wr, int wc, int fr, int fq) const {
        const int row0 = u.pm * BM + wr * 64 + fr, col0 = wc * 32 + 8 * fq, c = col0 >> 6, dl = col0 & 63, a_ = dl >> 4, h_ = (dl >> 3) & 1;
#pragma unroll
        for (int ai = 0; ai < 2; ++ai)
#pragma unroll
            for (int m = 0; m < 4; ++m) { const int row = row0 + ai * HALF + m * 16, b = row >> 13, s = row & 8191;
#pragma unroll
                for (int bj = 0; bj < 2; ++bj) { const size_t hr = (size_t)(b * 8 + 2 * u.pn + bj) * 8192 + s; const f32x4 v0 = acc[ai][bj][m][0] * kscale, v1 = acc[ai][bj][m][1] * kscale; u32x2 w8;
                    int t0 = __builtin_amdgcn_cvt_pk_fp8_f32(SAT8(v0[0]), SAT8(v0[1]), 0, false); t0 = __builtin_amdgcn_cvt_pk_fp8_f32(SAT8(v0[2]), SAT8(v0[3]), t0, true);
                    int t1 = __builtin_amdgcn_cvt_pk_fp8_f32(SAT8(v1[0]), SAT8(v1[1]), 0, false); t1 = __builtin_amdgcn_cvt_pk_fp8_f32(SAT8(v1[2]), SAT8(v1[3]), t1, true);
                    w8.x = (unsigned)t0; w8.y = (unsigned)t1; *(u32x2*)(K8 + hr * 192 + 64 * c + 32 * h_ + 8 * a_) = w8; } }
    }
};
struct EpiVT8 {
    static constexpr bool PERM = true;
    unsigned char* VT; size_t ldt; float vscale;
    __device__ __forceinline__ void operator()(const f32x4 (&acc)[2][2][4][2], const Unit& u, int wr, int wc, int fr, int fq) const {
        const int row0 = u.pm * BM + wr * 64 + fr;
#pragma unroll
        for (int ai = 0; ai < 2; ++ai)
#pragma unroll
            for (int m = 0; m < 4; ++m) { unsigned char* rowp = VT + (size_t)(row0 + ai * HALF + m * 16) * ldt;
#pragma unroll
                for (int bj = 0; bj < 2; ++bj) { const int tok0 = u.pn * BM + bj * HALF + wc * 32 + 8 * fq, k0 = tok0 & 63, pos = (tok0 & ~63) + 16 * (k0 >> 5) + 4 * ((k0 >> 3) & 3);
                    const f32x4 v0 = acc[ai][bj][m][0] * vscale, v1 = acc[ai][bj][m][1] * vscale;
                    int t0 = __builtin_amdgcn_cvt_pk_fp8_f32(SAT8(v0[0]), SAT8(v0[1]), 0, false); t0 = __builtin_amdgcn_cvt_pk_fp8_f32(SAT8(v0[2]), SAT8(v0[3]), t0, true);
                    int t1 = __builtin_amdgcn_cvt_pk_fp8_f32(SAT8(v1[0]), SAT8(v1[1]), 0, false); t1 = __builtin_amdgcn_cvt_pk_fp8_f32(SAT8(v1[2]), SAT8(v1[3]), t1, true);
                    *(unsigned*)(rowp + pos) = (unsigned)t0; *(unsigned*)(rowp + pos + 32) = (unsigned)t1; } }
    }
};

typedef int v8i32 __attribute__((ext_vector_type(8)));
__device__ __forceinline__ v8i32 cat8(bf16x8 a, bf16x8 b) { typedef int v4i32 __attribute__((ext_vector_type(4))); const v4i32 x = __builtin_bit_cast(v4i32, a), y = __builtin_bit_cast(v4i32, b); return __builtin_shufflevector(x, y, 0, 1, 2, 3, 4, 5, 6, 7); }
typedef int v4i32 __attribute__((ext_vector_type(4)));
template <bool B_> struct BoolC { static constexpr bool value = B_; };
template <class Epi, class Sched, int PREC = 0, bool GATH = false, bool QS = false  >
__device__ __forceinline__ void gemm_phase(LAS unsigned char* lds, const Gemm g, const Sched& S, const Epi& E) {
    constexpr bool F8 = (PREC == 1), I8 = (PREC == 2);
    int tid = threadIdx.x; asm volatile("" : "+v"(tid));
    const int wid = __builtin_amdgcn_readfirstlane(tid >> 6), lane = tid & 63, wr = wid >> 2, wc = wid & 3, fr = lane & 15, fq = lane >> 4;
    const int K = g.K, nt = K / BK, lda = g.lda;
    unsigned voffA[2], voffB[2];
#pragma unroll
    for (int i = 0; i < 2; ++i) { int R, C; stage_rc(tid * 16 + i * 8192, R, C); const int Rb = Epi::PERM ? ((R & ~31) + perm32(R & 31)) : R;
        voffA[i] = (unsigned)(R * lda + C) * 2u; voffB[i] = (unsigned)(Rb * K + C) * 2u; }
    unsigned gvc[2][2], gvn[2][2];
#define PG8_GIDX(dst, pm_) do { _Pragma("unroll") for (int h_ = 0; h_ < 2; ++h_) _Pragma("unroll") for (int i_ = 0; i_ < 2; ++i_) { int R_, C_; stage_rc(tid * 16 + i_ * 8192, R_, C_); \
        const unsigned t_ = (unsigned)g.gidx[(pm_) * BM + h_ * HALF + R_]; dst[h_][i_] = ((t_ < 65536u ? t_ : 65535u) * (unsigned)lda + (unsigned)C_) * 2u; } } while (0)
    const size_t kstep = (size_t)(BK * 2);
    const size_t hstepA = (size_t)HALF * lda * 2, hstepB = (size_t)HALF * K * 2;
    const size_t tstepA = 2 * hstepA, tstepB = 2 * hstepB;
    const unsigned ldsw = (unsigned)wid * 1024u;
    const int aoff = lds_byte(wr * 64 + fr, fq * 8), boff = lds_byte(wc * 32 + fr, fq * 8);
#define PG8_SA(b, h) (((b) * 2 + (h)) * HTB)
#define PG8_SB(b, h) ((4 + (b) * 2 + (h)) * HTB)
#define PG8_STAGE(bufoff, gbase, voff) do { _Pragma("unroll") for (int _i = 0; _i < 2; ++_i) \
        __builtin_amdgcn_global_load_lds((const unsigned*)((const char*)(gbase) + (voff)[_i]), (LAS unsigned*)(lds + (bufoff) + ldsw + _i * 8192), 16, 0, 0); } while (0)
#define PG8_STAGE_A(bufoff, gbase, h, nx) do { if constexpr (GATH) { if (nx) PG8_STAGE(bufoff, gbase, gvn[h]); else PG8_STAGE(bufoff, gbase, gvc[h]); } else PG8_STAGE(bufoff, (gbase) + (h) * hstepA, voffA); } while (0)
#define PG8_LDA(dst, b, h) do { _Pragma("unroll") for (int m = 0; m < 4; ++m) _Pragma("unroll") for (int k = 0; k < 2; ++k) dst[m][k] = *(const LAS bf16x8*)(lds + PG8_SA(b, h) + aoff + m * 2048 + k * 1024); } while (0)
#define PG8_LDB(dst, b, h) do { _Pragma("unroll") for (int n = 0; n < 2; ++n) _Pragma("unroll") for (int k = 0; k < 2; ++k) dst[n][k] = *(const LAS bf16x8*)(lds + PG8_SB(b, h) + boff + n * 2048 + k * 1024); } while (0)
#define PG8_MMA(ai, bj, At, Bt) do { __builtin_amdgcn_s_setprio(1); asm volatile("s_nop 1"); _Pragma("unroll") for (int m = 0; m < 4; ++m) _Pragma("unroll") for (int n = 0; n < 2; ++n) { \
        if constexpr (F8) { const v8i32 b8_ = cat8(Bt[n][0], Bt[n][1]), a8_ = cat8(At[m][0], At[m][1]); asm("v_mfma_f32_16x16x128_f8f6f4 %0, %1, %2, %0" : "+v"(acc[ai][bj][m][n]) : "v"(b8_), "v"(a8_)); } \
        else if constexpr (I8) { _Pragma("unroll") for (int k = 0; k < 2; ++k) asm("v_mfma_i32_16x16x64_i8 %0, %1, %2, %0" : "+v"(acc[ai][bj][m][n]) : "v"(Bt[n][k]), "v"(At[m][k])); } \
        else { _Pragma("unroll") for (int k = 0; k < 2; ++k) asm("v_mfma_f32_16x16x32_bf16 %0, %1, %2, %0" : "+v"(acc[ai][bj][m][n]) : "v"(Bt[n][k]), "v"(At[m][k])); } } __builtin_amdgcn_s_setprio(0); } while (0)
#define PG8_MMAZ(ai, bj, At, Bt) do { __builtin_amdgcn_s_setprio(1); asm volatile("s_nop 1"); _Pragma("unroll") for (int m = 0; m < 4; ++m) _Pragma("unroll") for (int n = 0; n < 2; ++n) { \
        if constexpr (F8) { const v8i32 b8_ = cat8(Bt[n][0], Bt[n][1]), a8_ = cat8(At[m][0], At[m][1]); asm("v_mfma_f32_16x16x128_f8f6f4 %0, %1, %2, 0" : "=v"(acc[ai][bj][m][n]) : "v"(b8_), "v"(a8_)); } \
        else if constexpr (I8) { asm("v_mfma_i32_16x16x64_i8 %0, %1, %2, 0" : "=v"(acc[ai][bj][m][n]) : "v"(Bt[n][0]), "v"(At[m][0])); \
            asm("v_mfma_i32_16x16x64_i8 %0, %1, %2, %0" : "+v"(acc[ai][bj][m][n]) : "v"(Bt[n][1]), "v"(At[m][1])); } \
        else { asm("v_mfma_f32_16x16x32_bf16 %0, %1, %2, 0" : "=v"(acc[ai][bj][m][n]) : "v"(Bt[n][0]), "v"(At[m][0])); \
            asm("v_mfma_f32_16x16x32_bf16 %0, %1, %2, %0" : "+v"(acc[ai][bj][m][n]) : "v"(Bt[n][1]), "v"(At[m][1])); } } __builtin_amdgcn_s_setprio(0); } while (0)
#define PG8_WAIT_V(n) asm volatile("s_waitcnt vmcnt(" #n ")" ::: "memory")
#define PG8_WAIT_L(n) asm volatile("s_waitcnt lgkmcnt(" #n ")" ::: "memory")
#define PG8_BAR __builtin_amdgcn_s_barrier()
#define PG8_SCHED __builtin_amdgcn_sched_barrier(0)
    Unit cur, nxt; int ui = 0;
#ifdef DIAG_GEMM
    unsigned long long dg_k = 0, dg_b = 0, dg_e = 0, dg_t = __builtin_amdgcn_s_memrealtime(); const unsigned long long dg_w0 = dg_t, dg_c0 = __builtin_readcyclecounter();
#endif
    if (!S.next(0, cur)) return;
    f32x4 acc[2][2][4][2];
#pragma unroll
    for (int a = 0; a < 2; ++a)
#pragma unroll
        for (int b = 0; b < 2; ++b)
#pragma unroll
            for (int m = 0; m < 4; ++m)
#pragma unroll
                for (int n = 0; n < 2; ++n) acc[a][b][m][n] = (f32x4){0.f, 0.f, 0.f, 0.f};
    bf16x8 At[4][2], B0[2][2], B1[2][2];
    const char* cA = (const char*)g.A + (GATH ? (size_t)0 : (size_t)cur.pm * tstepA); const char* cB = (const char*)g.Bt + (size_t)cur.e * g.estride + (size_t)cur.pn * tstepB;
    if constexpr (GATH) PG8_GIDX(gvc, cur.pm);
    PG8_STAGE(PG8_SB(0, 0), cB, voffB); PG8_STAGE(PG8_SB(0, 1), cB + hstepB, voffB); PG8_STAGE_A(PG8_SA(0, 0), cA, 0, false); PG8_STAGE_A(PG8_SA(0, 1), cA, 1, false);
    if (wr == 1) PG8_BAR;
    PG8_WAIT_V(2); PG8_BAR;
    PG8_STAGE(PG8_SB(1, 0), cB + kstep, voffB); PG8_STAGE_A(PG8_SA(1, 0), cA + kstep, 0, false); PG8_STAGE(PG8_SB(1, 1), cB + hstepB + kstep, voffB);
    PG8_WAIT_V(6); PG8_BAR;
    for (;;) {
        const bool has_next = S.next(ui + 1, nxt);
        const char* nA = (has_next && !GATH) ? (const char*)g.A + (size_t)nxt.pm * tstepA : cA; const char* nB = has_next ? (const char*)g.Bt + (size_t)nxt.e * g.estride + (size_t)nxt.pn * tstepB : cB;
        if constexpr (I8) {
            const float* sp_ = (tid < 256) ? g.rs + (size_t)cur.pm * BM + tid : g.cs + (size_t)cur.e * g.cs_estride + (size_t)cur.pn * BM + (tid - 256);
            __builtin_amdgcn_global_load_lds((const unsigned*)sp_, (LAS unsigned*)(lds + 131072 + 4096 + (ui & 1) * 2048 + wid * 256), 4, 0, 0); }
        if constexpr (GATH) { if (has_next && nxt.pm != cur.pm) PG8_GIDX(gvn, nxt.pm); else {
#pragma unroll
            for (int h_ = 0; h_ < 2; ++h_) { gvn[h_][0] = gvc[h_][0]; gvn[h_][1] = gvc[h_][1]; } } }
        const int qm_ = QS ? cur.qm : 15;
        const bool Q00 = qm_ & 1, Q01 = qm_ & 2, Q10 = qm_ & 4, Q11 = qm_ & 8, QB0 = qm_ & 5, QB1 = qm_ & 10, QA0 = qm_ & 3, QA1 = qm_ & 12;
        auto kbody = [&](const int t, auto zc_) __attribute__((always_inline)) {
            constexpr bool ZC = decltype(zc_)::value;
            const bool last = (t == nt - 2);
            const char* a1 = cA + (size_t)(t + 1) * kstep;
            const char* a2 = last ? nA : cA + (size_t)(t + 2) * kstep; const char* b2 = last ? nB : cB + (size_t)(t + 2) * kstep;
            const char* a3 = a2 + kstep; const char* b3 = b2 + kstep;
            if (QB0) PG8_LDB(B0, 0, 0); if (QB1) PG8_LDB(B1, 0, 1); PG8_SCHED; if (QA0) PG8_LDA(At, 0, 0); PG8_STAGE_A(PG8_SA(1, 1), a1, 1, false);
            PG8_WAIT_V(8); PG8_WAIT_L(0); PG8_BAR; if constexpr (ZC) { if (Q00) PG8_MMAZ(0, 0, At, B0); if (Q01) PG8_MMAZ(0, 1, At, B1); } else { if (Q00) PG8_MMA(0, 0, At, B0); if (Q01) PG8_MMA(0, 1, At, B1); } PG8_BAR; PG8_SCHED;
            if (QA1) PG8_LDA(At, 0, 1); PG8_STAGE(PG8_SB(0, 0), b2, voffB); PG8_STAGE(PG8_SB(0, 1), b2 + hstepB, voffB); PG8_STAGE_A(PG8_SA(0, 0), a2, 0, last);
            PG8_WAIT_V(8); PG8_WAIT_L(0); PG8_BAR; if constexpr (ZC) { if (Q10) PG8_MMAZ(1, 0, At, B0); if (Q11) PG8_MMAZ(1, 1, At, B1); } else { if (Q10) PG8_MMA(1, 0, At, B0); if (Q11) PG8_MMA(1, 1, At, B1); } PG8_BAR; PG8_SCHED;
            if (QB0) PG8_LDB(B0, 1, 0); if (QB1) PG8_LDB(B1, 1, 1); PG8_SCHED; if (QA0) PG8_LDA(At, 1, 0); PG8_STAGE_A(PG8_SA(0, 1), a2, 1, last);
            PG8_WAIT_V(8); PG8_WAIT_L(0); PG8_BAR; if (Q00) PG8_MMA(0, 0, At, B0); if (Q01) PG8_MMA(0, 1, At, B1); PG8_BAR; PG8_SCHED;
            if (QA1) PG8_LDA(At, 1, 1); PG8_STAGE(PG8_SB(1, 0), b3, voffB); PG8_STAGE(PG8_SB(1, 1), b3 + hstepB, voffB); PG8_STAGE_A(PG8_SA(1, 0), a3, 0, last);
            PG8_WAIT_V(8); PG8_WAIT_L(0); PG8_BAR; if (Q10) PG8_MMA(1, 0, At, B0); if (Q11) PG8_MMA(1, 1, At, B1); PG8_BAR; PG8_SCHED;
        };
        kbody(0, BoolC<true>{});
#pragma nounroll
        for (int t = 2; t < nt; t += 2) kbody(t, BoolC<false>{});
        asm volatile("s_nop 15\n\ts_nop 15" ::: "memory");
#ifdef DIAG_GEMM
        { const unsigned long long c = __builtin_amdgcn_s_memrealtime(); dg_k += c - dg_t; dg_t = c; }
#endif
        if (wr == 0) PG8_BAR;
#ifdef DIAG_GEMM
        { const unsigned long long c = __builtin_amdgcn_s_memrealtime(); dg_b += c - dg_t; dg_t = c; }
#endif
        if constexpr (I8) {
            const LAS float* rsl = (const LAS float*)(lds + 131072 + 4096 + (ui & 1) * 2048); const LAS float* csb = rsl + 256 + wc * 32;
            f32x4 cv[2][2];
#pragma unroll
            for (int bj = 0; bj < 2; ++bj)
#pragma unroll
                for (int n = 0; n < 2; ++n) cv[bj][n] = *(const LAS f32x4*)(csb + bj * HALF + (Epi::PERM ? 8 * fq + 4 * n : 16 * n + 4 * fq));
#pragma unroll
            for (int ai = 0; ai < 2; ++ai)
#pragma unroll
                for (int m = 0; m < 4; ++m) { const float rv = rsl[ai * HALF + wr * 64 + m * 16 + fr];
#pragma unroll
                    for (int bj = 0; bj < 2; ++bj)
#pragma unroll
                        for (int n = 0; n < 2; ++n) { const v4i32 iv = __builtin_bit_cast(v4i32, acc[ai][bj][m][n]);
                            acc[ai][bj][m][n] = (f32x4){(float)iv[0], (float)iv[1], (float)iv[2], (float)iv[3]} * cv[bj][n] * rv; } }
        }
        E(acc, cur, wr, wc, fr, fq);
#ifdef DIAG_GEMM
        { const unsigned long long c = __builtin_amdgcn_s_memrealtime(); dg_e += c - dg_t; dg_t = c; }
#endif
        if (!has_next) break;
        cur = nxt; cA = nA; cB = nB; ++ui;
        if constexpr (GATH) {
#pragma unroll
            for (int h_ = 0; h_ < 2; ++h_) { gvc[h_][0] = gvn[h_][0]; gvc[h_][1] = gvn[h_][1]; } }
        if (wr == 1) PG8_BAR;
    }
    PG8_WAIT_V(0);
    PG8_BAR;
#ifdef DIAG_GEMM
    if (g.diag && blockIdx.x == DIAG_BLOCK && tid == 0) { g.diag[0] = dg_k; g.diag[1] = dg_b; g.diag[2] = dg_e; g.diag[3] = __builtin_readcyclecounter() - dg_c0; g.diag[4] = __builtin_amdgcn_s_memrealtime() - dg_w0; g.diag[5] = (unsigned long long)(ui + 1); }
#endif
#undef PG8_SA
#undef PG8_SB
#undef PG8_STAGE
#undef PG8_MMAZ
#undef PG8_STAGE_A
#undef PG8_GIDX
#undef PG8_LDA
#undef PG8_LDB
#undef PG8_MMA
#undef PG8_WAIT_V
#undef PG8_WAIT_L
#undef PG8_BAR
#undef PG8_SCHED
}
}
namespace att {
constexpr int NW = 8, QBLK = 32, KVBLK = 64, QB = NW * QBLK;
__device__ __forceinline__ int crow(int r, int hi) { return (r & 3) + 8 * (r >> 2) + 4 * hi; }
template <int NCB> __device__ __forceinline__ int v_st(int k, int c) { const int kk = (k & ~0xC) | ((k & 4) << 1) | ((k & 8) >> 1); return ((kk >> 3) * NCB + (c >> 5)) * 512 + ((kk & 7) * 32 + (c & 31)) * 2; }
__device__ __forceinline__ int v_rd_base(int lane) { return ((lane & 3) << 3) | (((lane >> 2) & 3) << 6) | (((lane >> 4) & 1) << 5) | (((lane >> 5) & 1) << 8); }

struct Params {
    const bf16* Q; int ldq;
    const bf16* K; int ldk;
    const bf16* V; int ldv;
    bf16* O; int ldo;
    int P0;
    int j_lo, j_hi;
    const float* rope;
    const int* pos;
    float slope_over_scale, sink_l2;
    const float* sinks; int qh0;
};

constexpr float QK8_SCALE = 8.f;
typedef int v8i32a __attribute__((ext_vector_type(8)));
typedef int v4i32a __attribute__((ext_vector_type(4)));
constexpr float O8_SCALE = 32.f;
template <int DQK, int DV, int KIND, int W, bool QK8 = false, bool O8 = false  , bool RES = false>
__device__ __forceinline__ void attn_block(const Params& p, char* lds) {
    constexpr bool PAIR = QK8 && !RES;
    constexpr int NBUF = RES ? 6 : (PAIR ? 4 : 2), NH = RES ? 8 : 1;
    constexpr int NKS = DQK / 64, ND0 = DQK / 16, NCB = DV / 32, NVP = DV / 64;
    constexpr int KT = QK8 ? NKS * 4096 : NKS * 8192, VT = QK8 ? KVBLK * DV : KVBLK * DV * 2;
    constexpr int OFF_K = NBUF * VT, OFF_KP = OFF_K + NBUF * KT, OFF_WS = OFF_KP + NBUF * 256;
    const float SCALE = ((DQK == 192) ? 0.07216878364870322f : 0.125f) * (QK8 ? 1.0f / (QK8_SCALE * QK8_SCALE) : 1.0f);
    const float C2 = 1.4426950408889634f * SCALE;
    constexpr float THR = QK8 ? 2.f : 8.f;
    int tid = threadIdx.x; asm volatile("" : "+v"(tid));
    const int wid = __builtin_amdgcn_readfirstlane(tid >> 6), lane = tid & 63, r32 = lane & 31, hi = lane >> 5;
    LAS unsigned char* lds3 = (LAS unsigned char*)lds; char* V_lds = lds; char* K_lds = lds + OFF_K; float* kp_lds = (float*)(lds + OFF_KP);
    float* ws = (float*)(lds + OFF_WS) + wid * 64; float* li_l = ws, * al_l = ws + 32;
    const int NT = p.j_hi - p.j_lo;
    const int qlo = p.P0 + wid * QBLK, qm = qlo + r32 - 4 * hi;
    unsigned kofs, vofs[NVP];
    if (QK8) { const int key = lane >> 2, lc = (lane & 3) ^ ((key >> 2) & 3); kofs = (unsigned)(key * p.ldk + 16 * lc); }
    else { const int q = wid * 64 + lane, key = q >> 3, c = (q & 7) ^ ((key >> 1) & 7); kofs = (unsigned)(key * p.ldk + c * 8) * 2u; }
    if (QK8) { const int lc = (lane & 3) ^ ((lane >> 4) & 3); vofs[0] = (unsigned)((lane >> 2) * p.ldv + 16 * lc); }
    else
#pragma unroll
    for (int i = 0; i < NVP; ++i) { const int bo = (wid + 8 * i) * 1024 + lane * 16, sub = bo >> 9, within = bo & 511, kk = (sub / NCB) * 8 + (within >> 6), c = (sub % NCB) * 32 + ((within & 63) >> 1);
        const int k = (kk & ~0xC) | ((kk & 4) << 1) | ((kk & 8) >> 1); vofs[i] = (unsigned)(k * p.ldv + c) * 2u; }
    float st_p = 0.f;
#define ST_LOAD(kb, bf) do { \
        const char* kb_ = (const char*)p.K + (size_t)(kb) * (size_t)(QK8 ? p.ldk : p.ldk * 2); const char* vb_ = (const char*)p.V + (size_t)(kb) * (size_t)(p.ldv * 2); \
        if constexpr (QK8) {   \
            { const int pc_ = wid; __builtin_amdgcn_global_load_lds((const unsigned*)(kb_ + kofs + (pc_ & 3) * 16 * p.ldk + (pc_ >> 2) * 64), (LAS unsigned*)(lds3 + OFF_K + (bf) * KT + pc_ * 1024), 16, 0, 0); } \
            if (wid < 4) { const int pc_ = 8 + wid; __builtin_amdgcn_global_load_lds((const unsigned*)(kb_ + kofs + (pc_ & 3) * 16 * p.ldk + (pc_ >> 2) * 64), (LAS unsigned*)(lds3 + OFF_K + (bf) * KT + pc_ * 1024), 16, 0, 0); } \
        } else { _Pragma("unroll") for (int s_ = 0; s_ < NKS; ++s_) __builtin_amdgcn_global_load_lds((const unsigned*)(kb_ + kofs + s_ * 128), (LAS unsigned*)(lds3 + OFF_K + (bf) * KT + s_ * 8192 + wid * 1024), 16, 0, 0); } \
        if constexpr (QK8) __builtin_amdgcn_global_load_lds((const unsigned*)((const char*)p.V + (size_t)(kb) + (size_t)(16 * wid) * (size_t)p.ldv + vofs[0]), (LAS unsigned*)(lds3 + (bf) * VT + wid * 1024), 16, 0, 0); \
        else { _Pragma("unroll") for (int i_ = 0; i_ < NVP; ++i_) __builtin_amdgcn_global_load_lds((const unsigned*)(vb_ + vofs[i_]), (LAS unsigned*)(lds3 + (bf) * VT + (wid + 8 * i_) * 1024), 16, 0, 0); } \
        if (KIND == 1 && !RES && tid < 64) st_p = (float)p.pos[(kb) + tid]; } while (0)
#define ST_WRITE(bf) do { if (KIND == 1 && tid < 64) kp_lds[(bf) * 64 + tid] = st_p; } while (0)
    bf16x8 qr[ND0];
    if constexpr (RES) {
#pragma unroll
        for (int t_ = 0; t_ < NBUF; ++t_) if (t_ < NT) ST_LOAD((p.j_lo + t_) * KVBLK, t_);
        if (tid < NT * KVBLK) kp_lds[tid] = (float)p.pos[p.j_lo * KVBLK + tid];
    } else { ST_LOAD(p.j_lo * KVBLK, 0); if constexpr (PAIR) ST_LOAD((p.j_lo + 1) * KVBLK, 1); }
    { const bf16* qrow = p.Q + (size_t)(wid * QBLK + r32) * p.ldq + hi * 8;
#pragma unroll
      for (int d0 = 0; d0 < ND0; ++d0) qr[d0] = *(const bf16x8*)(qrow + d0 * 16); }
    float pq = 0.f;
    if (KIND == 0) {
        const float* rt = p.rope + (size_t)(wid * QBLK + r32) * 64;
#pragma unroll
        for (int dd = 0; dd < 2; ++dd) {
            const int i0 = dd * 16 + hi * 8;
            const f32x4 c0 = *(const f32x4*)(rt + i0), c1 = *(const f32x4*)(rt + i0 + 4), s0 = *(const f32x4*)(rt + 32 + i0), s1 = *(const f32x4*)(rt + 32 + i0 + 4);
            bf16x8 a = qr[8 + dd], b = qr[10 + dd]; u32x4 ra, rb; float x1[8], x2[8], cs[8], sn[8];
#pragma unroll
            for (int j = 0; j < 4; ++j) { cs[j] = c0[j]; cs[4 + j] = c1[j]; sn[j] = s0[j]; sn[4 + j] = s1[j]; }
#pragma unroll
            for (int j = 0; j < 8; ++j) { x1[j] = bf2f((unsigned short)a[j]); x2[j] = bf2f((unsigned short)b[j]); }
#pragma unroll
            for (int j = 0; j < 4; ++j) { ra[j] = cvt_pk_bf16(x1[2 * j] * cs[2 * j] - x2[2 * j] * sn[2 * j], x1[2 * j + 1] * cs[2 * j + 1] - x2[2 * j + 1] * sn[2 * j + 1]);
                                          rb[j] = cvt_pk_bf16(x2[2 * j] * cs[2 * j] + x1[2 * j] * sn[2 * j], x2[2 * j + 1] * cs[2 * j + 1] + x1[2 * j + 1] * sn[2 * j + 1]); }
            qr[8 + dd] = *reinterpret_cast<bf16x8*>(&ra); qr[10 + dd] = *reinterpret_cast<bf16x8*>(&rb);
        }
    } else { pq = (float)p.pos[qlo + r32]; }
    int ka[4];
#pragma unroll
    for (int j = 0; j < 4; ++j) ka[j] = r32 * 128 + (((2 * j + hi) ^ ((r32 >> 1) & 7)) << 4);
    v8i32a q8[NKS];
    if (QK8) {
#pragma unroll
        for (int c = 0; c < NKS; ++c) {
#pragma unroll
            for (int a_ = 0; a_ < 4; ++a_) { const bf16x8 f = qr[4 * c + a_]; float x[8];
#pragma unroll
                for (int j = 0; j < 8; ++j) x[j] = fminf(fmaxf(bf2f((unsigned short)f[j]) * QK8_SCALE, -448.f), 448.f);
                int t0 = __builtin_amdgcn_cvt_pk_fp8_f32(x[0], x[1], 0, false); t0 = __builtin_amdgcn_cvt_pk_fp8_f32(x[2], x[3], t0, true);
                int t1 = __builtin_amdgcn_cvt_pk_fp8_f32(x[4], x[5], 0, false); t1 = __builtin_amdgcn_cvt_pk_fp8_f32(x[6], x[7], t1, true);
                q8[c][2 * a_] = t0; q8[c][2 * a_ + 1] = t1; } }
        ka[0] = r32 * 64 + (((2 * hi) ^ ((r32 >> 2) & 3)) << 4); ka[1] = r32 * 64 + (((2 * hi + 1) ^ ((r32 >> 2) & 3)) << 4);
    }
    const int vb0 = (int)(uintptr_t)V_lds + v_rd_base(lane);
    float m_reg = -1e30f, l_reg = 0.f; f32x16 o[NCB];
#pragma unroll
    for (int d = 0; d < NCB; ++d) o[d] = f32x16{};
    asm volatile("s_waitcnt vmcnt(0)" ::: "memory");
    if constexpr (!RES) ST_WRITE(0);
    __syncthreads();
    float slope_c = p.slope_over_scale, sink_c = p.sink_l2;
#pragma nounroll
    for (int g = 0; g < NH; ++g) {
    bf16x8 qn[ND0];
    if constexpr (RES) {
        if (g + 1 < NH) { const bf16* qrow = p.Q + (size_t)(wid * QBLK + r32) * p.ldq + hi * 8 + (g + 1) * DQK;
#pragma unroll
            for (int d0 = 0; d0 < ND0; ++d0) qn[d0] = *(const bf16x8*)(qrow + d0 * 16); }
        slope_c = __builtin_amdgcn_exp2f(-0.5f * (float)(p.qh0 + g + 1)) * 8.0f; sink_c = p.sinks[p.qh0 + g] * 1.4426950408889634f;
        m_reg = -1e30f; l_reg = 0.f;
#pragma unroll
        for (int d = 0; d < NCB; ++d) o[d] = f32x16{};
    }
#define TRRD(dst, off) asm volatile("ds_read_b64_tr_b16 %0, %1 offset:%2" : "=&v"(dst) : "v"(vb0), "i"(off) : "memory")
#define TILE(t, BF) do { \
        const int kb_ = (p.j_lo + (t)) * KVBLK; \
        if constexpr (!RES && !PAIR) { if ((t) + 1 < NT) { const int kn_ = kb_ + KVBLK; ST_LOAD(kn_, (BF) ^ 1); } } \
        const bool act_ = (kb_ <= qlo + QBLK - 1) && (kb_ + KVBLK - 1 >= qlo - W + 1); \
        if (act_) { \
            f32x16 p0 = f32x16{}, p1 = f32x16{}; \
            if constexpr (QK8) { \
              _Pragma("unroll") for (int c_ = 0; c_ < NKS; ++c_) { const char* a0_ = K_lds + (BF) * KT + c_ * 4096 + ka[0]; const char* a1_ = K_lds + (BF) * KT + c_ * 4096 + ka[1]; \
                const v8i32a k0 = __builtin_shufflevector(*(const v4i32a*)a0_, *(const v4i32a*)a1_, 0, 1, 2, 3, 4, 5, 6, 7), k1 = __builtin_shufflevector(*(const v4i32a*)(a0_ + 2048), *(const v4i32a*)(a1_ + 2048), 0, 1, 2, 3, 4, 5, 6, 7); \
                p0 = __builtin_amdgcn_mfma_scale_f32_32x32x64_f8f6f4(k0, q8[c_], p0, 0, 0, 0, 0, 0, 0); p1 = __builtin_amdgcn_mfma_scale_f32_32x32x64_f8f6f4(k1, q8[c_], p1, 0, 0, 0, 0, 0, 0); } \
            } else \
            { bf16x8 kf[2][4];                                                  \
              _Pragma("unroll") for (int s_ = 0; s_ < 2; ++s_) { const char* a_ = K_lds + (BF) * KT + ka[s_]; kf[0][2 * s_] = *(const bf16x8*)a_; kf[0][2 * s_ + 1] = *(const bf16x8*)(a_ + 4096); } \
              _Pragma("unroll") for (int g_ = 0; g_ < ND0 / 2; ++g_) { \
                if (g_ + 1 < ND0 / 2) { _Pragma("unroll") for (int s_ = 0; s_ < 2; ++s_) { const int d0 = 2 * (g_ + 1) + s_; const char* a_ = K_lds + (BF) * KT + (d0 >> 2) * 8192 + ka[d0 & 3]; \
                    kf[(g_ + 1) & 1][2 * s_] = *(const bf16x8*)a_; kf[(g_ + 1) & 1][2 * s_ + 1] = *(const bf16x8*)(a_ + 4096); } } \
                __builtin_amdgcn_sched_barrier(0); \
                _Pragma("unroll") for (int s_ = 0; s_ < 2; ++s_) { const int d0 = 2 * g_ + s_; \
                    p0 = __builtin_amdgcn_mfma_f32_32x32x16_bf16(kf[g_ & 1][2 * s_], qr[d0], p0, 0, 0, 0); p1 = __builtin_amdgcn_mfma_f32_32x32x16_bf16(kf[g_ & 1][2 * s_ + 1], qr[d0], p1, 0, 0, 0); } \
                __builtin_amdgcn_sched_barrier(0); } } \
            if (KIND == 1) { const float* kq = kp_lds + (BF) * 64 + 4 * hi; \
                _Pragma("unroll") for (int g_ = 0; g_ < 4; ++g_) { const f32x4 k0 = *(const f32x4*)(kq + 8 * g_), k1 = *(const f32x4*)(kq + 32 + 8 * g_); \
                    _Pragma("unroll") for (int c_ = 0; c_ < 4; ++c_) { p0[4 * g_ + c_] = fmaf(-slope_c, fabsf(pq - k0[c_]), p0[4 * g_ + c_]); p1[4 * g_ + c_] = fmaf(-slope_c, fabsf(pq - k1[c_]), p1[4 * g_ + c_]); } } } \
            if (kb_ + KVBLK - 1 > qlo || kb_ <= qlo + QBLK - 1 - W) { const int dq_ = qm - kb_; const float NEG = -__builtin_inff(); \
                _Pragma("unroll") for (int r = 0; r < 16; ++r) { const int c_ = (r & 3) + 8 * (r >> 2); \
                    if ((unsigned)(dq_ - c_) >= (unsigned)W) p0[r] = NEG; if ((unsigned)(dq_ - c_ - 32) >= (unsigned)W) p1[r] = NEG; } } \
            float pmax; { float m_[4];   \
              _Pragma("unroll") for (int q_ = 0; q_ < 4; ++q_) { m_[q_] = __builtin_fmaxf(__builtin_fmaxf(p0[4 * q_], p0[4 * q_ + 1]), p0[4 * q_ + 2]); m_[q_] = __builtin_fmaxf(__builtin_fmaxf(m_[q_], p0[4 * q_ + 3]), p1[4 * q_]); \
                  m_[q_] = __builtin_fmaxf(__builtin_fmaxf(m_[q_], p1[4 * q_ + 1]), p1[4 * q_ + 2]); m_[q_] = __builtin_fmaxf(m_[q_], p1[4 * q_ + 3]); } \
              pmax = __builtin_fmaxf(__builtin_fmaxf(m_[0], m_[1]), __builtin_fmaxf(m_[2], m_[3])); } \
            { auto rr = __builtin_amdgcn_permlane32_swap(__float_as_uint(pmax), __float_as_uint(pmax), false, false); pmax = fmaxf(__uint_as_float(rr[0]), __uint_as_float(rr[1])); } \
            float mn, alpha; \
            if (__all((pmax - m_reg) * SCALE <= THR)) { mn = m_reg; alpha = 1.f; } \
            else { mn = fmaxf(m_reg, pmax); alpha = __builtin_amdgcn_exp2f((m_reg - mn) * C2); m_reg = mn; } \
            const float mnL = -mn * C2 + (QK8 ? 5.0f : 0.0f); float ps = 0.f;     \
            _Pragma("unroll") for (int r = 0; r < 16; ++r) { p0[r] = __builtin_amdgcn_exp2f(fmaf(p0[r], C2, mnL)); p1[r] = __builtin_amdgcn_exp2f(fmaf(p1[r], C2, mnL)); } \
            { float s_[4] = {0.f, 0.f, 0.f, 0.f}; _Pragma("unroll") for (int r = 0; r < 16; ++r) s_[r & 3] += p0[r] + p1[r]; ps = (s_[0] + s_[1]) + (s_[2] + s_[3]); } \
            { auto rr = __builtin_amdgcn_permlane32_swap(__float_as_uint(ps), __float_as_uint(ps), false, false); ps = __uint_as_float(rr[0]) + __uint_as_float(rr[1]); } \
            l_reg = l_reg * alpha + ps; \
            if constexpr (QK8) { \
                if (__any(alpha < 1.f)) { _Pragma("unroll") for (int d_ = 0; d_ < NCB; ++d_) o[d_] = o[d_] * alpha; }            \
                v8i32a p8; \
                _Pragma("unroll") for (int g_ = 0; g_ < 4; ++g_) { int t0 = __builtin_amdgcn_cvt_pk_fp8_f32(p0[4 * g_], p0[4 * g_ + 1], 0, false); t0 = __builtin_amdgcn_cvt_pk_fp8_f32(p0[4 * g_ + 2], p0[4 * g_ + 3], t0, true); \
                    int t1 = __builtin_amdgcn_cvt_pk_fp8_f32(p1[4 * g_], p1[4 * g_ + 1], 0, false); t1 = __builtin_amdgcn_cvt_pk_fp8_f32(p1[4 * g_ + 2], p1[4 * g_ + 3], t1, true); p8[g_] = t0; p8[4 + g_] = t1; } \
                _Pragma("unroll") for (int d_ = 0; d_ < NCB; ++d_) { const char* a0_ = V_lds + (BF) * VT + d_ * 2048 + ka[0]; const char* a1_ = V_lds + (BF) * VT + d_ * 2048 + ka[1]; \
                    const v8i32a vf = __builtin_shufflevector(*(const v4i32a*)a0_, *(const v4i32a*)a1_, 0, 1, 2, 3, 4, 5, 6, 7); \
                    o[d_] = __builtin_amdgcn_mfma_scale_f32_32x32x64_f8f6f4(vf, p8, o[d_], 0, 0, 0, 0, 0, 0); } \
            } else { \
            bf16x8 pa[4]; \
            _Pragma("unroll") for (int q_ = 0; q_ < 4; ++q_) { const f32x16& P = (q_ < 2) ? p0 : p1; const int B_ = (q_ & 1) * 8; \
                const unsigned a0 = cvt_pk_bf16(P[B_ + 0], P[B_ + 1]), a1 = cvt_pk_bf16(P[B_ + 2], P[B_ + 3]), b0 = cvt_pk_bf16(P[B_ + 4], P[B_ + 5]), b1 = cvt_pk_bf16(P[B_ + 6], P[B_ + 7]); \
                auto r0 = __builtin_amdgcn_permlane32_swap(a0, b0, false, false); auto r1 = __builtin_amdgcn_permlane32_swap(a1, b1, false, false); \
                u32x4 w_ = {r0[0], r1[0], r0[1], r1[1]}; pa[q_] = *reinterpret_cast<bf16x8*>(&w_); } \
            if (__any(alpha < 1.f)) { if (hi == 0) al_l[r32] = alpha; asm volatile("s_waitcnt lgkmcnt(0)" ::: "memory"); \
                _Pragma("unroll") for (int r = 0; r < 16; ++r) { const float a_ = al_l[crow(r, hi)]; _Pragma("unroll") for (int d_ = 0; d_ < NCB; ++d_) o[d_][r] *= a_; } } \
            { s16x4 l_[2][2], h_[2][2]; constexpr int b_ = (BF) * VT;            \
              _Pragma("unroll") for (int k2 = 0; k2 < 2; ++k2) { TRRD(l_[0][k2], b_ + k2 * (1024 * NCB)); TRRD(h_[0][k2], b_ + k2 * (1024 * NCB) + 512 * NCB); } \
              _Pragma("unroll") for (int i_ = 0; i_ < 2 * NCB; ++i_) { \
                if (i_ + 1 < 2 * NCB) { \
                    _Pragma("unroll") for (int k2 = 0; k2 < 2; ++k2) { TRRD(l_[(i_ + 1) & 1][k2], b_ + ((i_ + 1) >> 1) * 512 + (2 * ((i_ + 1) & 1) + k2) * (1024 * NCB)); TRRD(h_[(i_ + 1) & 1][k2], b_ + ((i_ + 1) >> 1) * 512 + (2 * ((i_ + 1) & 1) + k2) * (1024 * NCB) + 512 * NCB); } \
                    asm volatile("s_waitcnt lgkmcnt(4)" ::: "memory"); } \
                else asm volatile("s_waitcnt lgkmcnt(0)" ::: "memory"); \
                __builtin_amdgcn_sched_barrier(0); \
                _Pragma("unroll") for (int k2 = 0; k2 < 2; ++k2) \
                    o[i_ >> 1] = __builtin_amdgcn_mfma_f32_32x32x16_bf16(pa[2 * (i_ & 1) + k2], (bf16x8){l_[i_ & 1][k2][0], l_[i_ & 1][k2][1], l_[i_ & 1][k2][2], l_[i_ & 1][k2][3], h_[i_ & 1][k2][0], h_[i_ & 1][k2][1], h_[i_ & 1][k2][2], h_[i_ & 1][k2][3]}, o[i_ >> 1], 0, 0, 0); \
                __builtin_amdgcn_sched_barrier(0); } } \
            } \
        } \
        if constexpr (!RES && !PAIR) { if ((t) + 1 < NT) { asm volatile("s_waitcnt vmcnt(0)" ::: "memory"); ST_WRITE((BF) ^ 1); } \
        __syncthreads(); } } while (0)
    if constexpr (RES) {
        TILE(0, 0); TILE(1, 1); TILE(2, 2); TILE(3, 3);
        if (NT > 4) { TILE(4, 4); TILE(5, 5); }
    } else if constexpr (PAIR) {
        for (int t = 0; t < NT; t += 4) {
            ST_LOAD((p.j_lo + t + 2) * KVBLK, 2); ST_LOAD((p.j_lo + t + 3) * KVBLK, 3);
            TILE(t, 0); TILE(t + 1, 1);
            asm volatile("s_waitcnt vmcnt(0)" ::: "memory"); __syncthreads();
            if (t + 4 < NT) { ST_LOAD((p.j_lo + t + 4) * KVBLK, 0); ST_LOAD((p.j_lo + t + 5) * KVBLK, 1); }
            TILE(t + 2, 2); TILE(t + 3, 3);
            if (t + 4 < NT) asm volatile("s_waitcnt vmcnt(0)" ::: "memory");
            __syncthreads();
        }
    } else
    for (int t = 0; t < NT; t += 2) {
        TILE(t, 0);
        if (t + 1 < NT) TILE(t + 1, 1);
    }
    if constexpr (QK8) {
        const float rl = __builtin_amdgcn_rcpf(l_reg * QK8_SCALE) * (O8 ? O8_SCALE : 1.0f);
        if (O8) { unsigned char* orow8 = (unsigned char*)p.O + (size_t)(wid * QBLK + r32) * p.ldo + 4 * hi;
#pragma unroll
            for (int d_ = 0; d_ < NCB; ++d_)
#pragma unroll
                for (int g_ = 0; g_ < 4; ++g_) { int t = __builtin_amdgcn_cvt_pk_fp8_f32(o[d_][4 * g_] * rl, o[d_][4 * g_ + 1] * rl, 0, false); t = __builtin_amdgcn_cvt_pk_fp8_f32(o[d_][4 * g_ + 2] * rl, o[d_][4 * g_ + 3] * rl, t, true);
                    *(unsigned*)(orow8 + 32 * d_ + 8 * g_) = (unsigned)t; }
        } else { bf16* orow = p.O + (size_t)(wid * QBLK + r32) * p.ldo + 4 * hi;
#pragma unroll
        for (int d_ = 0; d_ < NCB; ++d_)
#pragma unroll
            for (int g_ = 0; g_ < 4; ++g_) { u32x2 w; w.x = cvt_pk_bf16(o[d_][4 * g_] * rl, o[d_][4 * g_ + 1] * rl); w.y = cvt_pk_bf16(o[d_][4 * g_ + 2] * rl, o[d_][4 * g_ + 3] * rl);
                *(u32x2*)(orow + 32 * d_ + 8 * g_) = w; } }
        __syncthreads();
        return;
    }
    if (KIND == 1) l_reg += __builtin_amdgcn_exp2f(sink_c - m_reg * C2);
    if (hi == 0) li_l[r32] = l_reg;
    asm volatile("s_waitcnt lgkmcnt(0)" ::: "memory");
    bf16* Ow = p.O + (size_t)(wid * QBLK) * p.ldo + (RES && !O8 ? g * DV : 0);
    const int ocol = (RES && O8) ? g * DV : 0;
#pragma unroll
    for (int r = 0; r < 16; ++r) { const int orow = crow(r, hi); const float rl = __builtin_amdgcn_rcpf(li_l[orow]);
#pragma unroll
        for (int d0 = 0; d0 < NCB; ++d0) { const float v = o[d0][r] * rl;
            if (O8) { const float v8 = v * O8_SCALE, v1 = __shfl_down(v8, 1), v2 = __shfl_down(v8, 2), v3 = __shfl_down(v8, 3);
                if ((r32 & 3) == 0) { int t = __builtin_amdgcn_cvt_pk_fp8_f32(v8, v1, 0, false); t = __builtin_amdgcn_cvt_pk_fp8_f32(v2, v3, t, true); *(unsigned*)((unsigned char*)p.O + (size_t)(wid * QBLK + orow) * p.ldo + ocol + d0 * 32 + r32) = (unsigned)t; } }
            else { const float vn = __shfl_xor(v, 1);
            if ((r32 & 1) == 0) *(unsigned*)(Ow + (size_t)orow * p.ldo + d0 * 32 + r32) = cvt_pk_bf16(v, vn); } } }
    if constexpr (RES) { if (g + 1 < NH) {
#pragma unroll
        for (int d0 = 0; d0 < ND0; ++d0) qr[d0] = qn[d0]; } }
    }
    __syncthreads();
#undef TILE
#undef TRRD
#undef ST_LOAD
#undef ST_WRITE
}
constexpr int LDS_MLA = 2 * (64 * 128 * 2) + 2 * (3 * 8192) + 512 + 8 * 256;
constexpr int LDS_SWA = 2 * (64 * 64 * 2) + 2 * 8192 + 512 + 8 * 256;
}
constexpr int NWAVES = 8, NTHREADS = NWAVES * 64;
constexpr int D = 1024, NB = 8, SEQ = 8192, T = NB * SEQ;
constexpr int FF = 2816, NE = 8, FE = 3584;
constexpr int QL = 384, KVL = 256, MH = 8, DQKM = 192, DVM = 128;
constexpr int MDN = 704, MDNP = 768;
constexpr int SQKV = 1280;
constexpr int MAXPAN = 520, MAXSLOT = MAXPAN * 256;
constexpr float EPS = 1e-6f;
constexpr float ACT_SCALE8 = 8.f, HID_SCALE8 = 8.f, W_SCALE8 = 256.f, YC_SCALE8 = 4.f, Y_SCALE8 = 16.f;
constexpr size_t MiB = 1u << 20;
constexpr size_t WS_CTL = 0, CTL_ZERO_BYTES = 1024 * 1024;
constexpr size_t WS_RT = 1 * MiB;
constexpr size_t RT_E = WS_RT, RT_W0 = RT_E + (size_t)T * 4, RT_W1 = RT_W0 + (size_t)T * 4, RT_S0 = RT_W1 + (size_t)T * 4, RT_S1 = RT_S0 + (size_t)T * 4, RT_CNT = RT_S1 + (size_t)T * 4, RT_PB = RT_CNT + 256 * 8 * 4, RT_TOK = RT_PB + 4096;
constexpr size_t WS_RS = 3 * MiB;
constexpr size_t WS_CS = 4 * MiB;
constexpr size_t WS_ROPE = 8 * MiB;
constexpr size_t WS_W = 24 * MiB;
constexpr size_t W_CINB = WS_W, W_CINCU = W_CINB + 2 * (size_t)1024 * 1024 * 2, W_COUT = W_CINCU + 2 * (size_t)2048 * 1024 * 2;
constexpr size_t W_MDN = W_COUT + 2 * (size_t)1024 * 1024 * 2, W_MUQ = W_MDN + (size_t)MDNP * 1024 * 2, W_MUKV = W_MUQ + (size_t)1536 * QL * 2, W_MO = W_MUKV + (size_t)2048 * KVL * 2;
constexpr size_t W_SQKV = W_MO + (size_t)1024 * 1024 * 2, W_SO = W_SQKV + (size_t)SQKV * 1024 * 2;
constexpr size_t W_FGU = W_SO + (size_t)1024 * 1024 * 2, W_FD = W_FGU + 2 * (size_t)(2 * FF) * 1024 * 2;
constexpr size_t W_MGU = W_FD + 2 * (size_t)1024 * FF * 2, W_MD = W_MGU + 16 * (size_t)(2 * FE) * 1024 * 2, W_RT = W_MD + 16 * (size_t)1024 * FE * 2;
constexpr size_t W_END = W_RT + 2 * (size_t)8 * 1024 * 4;
constexpr size_t WS_XN = 420 * MiB;
constexpr size_t WS_XG = 548 * MiB;
constexpr size_t WS_BIG = 808 * MiB;
constexpr size_t WS_END = WS_BIG + (size_t)MAXSLOT * FE * 2;
static_assert(W_END <= WS_XN && WS_XN + (size_t)T * D * 2 <= WS_XG && WS_XG + (size_t)MAXSLOT * D * 2 <= WS_BIG, "d_ws map");
constexpr size_t B_CONV_B = 0, B_CONV_V = 128 * MiB, B_CONV_Y = 256 * MiB;
constexpr size_t B_HMID = 0;
constexpr size_t B_MC = 0, B_MO = 0, B_MCQ = 192 * MiB, B_MCKV = 240 * MiB, B_MQ = 272 * MiB, B_MK = 464 * MiB, B_MV = 656 * MiB;
constexpr size_t B_SQKV = 0, B_SO = 160 * MiB;
constexpr int CW_DBG = 8;
constexpr int CW_BAR = 1024;
constexpr int CW_CMAX = 8192, CM_CIN = 0, CM_FGU = CM_CIN + 2 * 3072, CM_MDN = CM_FGU + 2 * 5632, CM_SQKV = CM_MDN + 768, CM_MGU = 24576, CM_END = CM_MGU + 16 * 7168;
static_assert(CM_SQKV + 1280 <= CM_MGU && (CW_CMAX + CM_END) * 4 <= (int)CTL_ZERO_BYTES, "column-max words inside the memset region");
constexpr int RING_BYTES = 131072, MISC_OFF = RING_BYTES, LDS_BYTES = 147456;

#define RLX_AGENT __ATOMIC_RELAXED, __HIP_MEMORY_SCOPE_AGENT
#define XB_TMO      128
#define XB_XCNT(j)  (256  + 64 * (j))
#define XB_XSUB(j)  (1280 + 64 * (j))
#define XB_XGEN(j)  (2304 + 64 * (j))
#define XB_TOP      3328
#define XB_TOPGEN   3392
#define XCD_BAR_WORDS 3456
#define XB_SPIN_CAP (1u << 18)
__device__ __forceinline__ unsigned xb_ld(unsigned* p)              { return __hip_atomic_load(p, __ATOMIC_RELAXED, __HIP_MEMORY_SCOPE_AGENT); }
__device__ __forceinline__ unsigned xb_add(unsigned* p, unsigned v) { return __hip_atomic_fetch_add(p, v, __ATOMIC_RELAXED, __HIP_MEMORY_SCOPE_AGENT); }
__device__ __forceinline__ unsigned xb_xcc_id() { return (unsigned)__builtin_amdgcn_s_getreg((3 << 11) | 20) & 0xFu; }
#define XB_SPIN(cond, bar) do { unsigned _sp = 0; while (cond) { __builtin_amdgcn_s_sleep(1); \
    if ((++_sp & 255u) == 0u) { if (xb_ld(&(bar)[XB_TMO])) break; if (_sp > XB_SPIN_CAP) { atomicAdd(&(bar)[XB_TMO], 1u); break; } } } } while (0)
struct XcdBarrier { unsigned* bar; unsigned x; volatile LAS unsigned* st; };
__device__ __forceinline__ XcdBarrier xcd_barrier_post(unsigned* bar, volatile LAS unsigned* st) {
    XcdBarrier b; b.bar = bar; b.x = xb_xcc_id(); b.st = st;
    if (threadIdx.x == 0) (void)xb_add(&bar[XB_XCNT(b.x)], 1u);
    return b;
}
__device__ __forceinline__ void xcd_barrier_complete(unsigned* bar, unsigned x, unsigned& nloc, unsigned& nx) {
    const unsigned G = gridDim.x * gridDim.y * gridDim.z;
    unsigned sum, cnt, mine, sp = 0u;
    for (;;) {
        sum = 0u; cnt = 0u; mine = 0u;
#pragma unroll
        for (unsigned j = 0; j < 16; ++j) { const unsigned c = xb_ld(&bar[XB_XCNT(j)]); sum += c; cnt += (c > 0u) ? 1u : 0u; mine = (j == x) ? c : mine; }
        if (sum == G) break;
        __builtin_amdgcn_s_sleep(1);
        if ((++sp & 255u) == 0u) { if (xb_ld(&bar[XB_TMO])) break; if (sp > XB_SPIN_CAP) { atomicAdd(&bar[XB_TMO], 1u); break; } }
    }
    nloc = mine > 0u ? mine : 1u; nx = cnt > 0u ? cnt : 1u;
}
__device__ __forceinline__ void xcd_barrier(const XcdBarrier& b) {
    asm volatile("s_waitcnt vmcnt(0)" ::: "memory");
    __syncthreads();
    if (threadIdx.x == 0) {
        unsigned* bar = b.bar;
        __builtin_amdgcn_s_waitcnt(0);
        unsigned nloc = b.st[0], nx = b.st[1];
        if (nloc == 0u) { xcd_barrier_complete(bar, b.x, nloc, nx); b.st[0] = nloc; b.st[1] = nx; }
        const unsigned old = xb_add(&bar[XB_XSUB(b.x)], 1u);
        const unsigned gen = old / nloc;
        if (old + 1u == (gen + 1u) * nloc) {
            __builtin_amdgcn_fence(__ATOMIC_RELEASE, "agent");
            asm volatile("s_waitcnt vmcnt(0)" ::: "memory");
            const unsigned og = xb_add(&bar[XB_TOP], 1u);
            const unsigned tg = og / nx;
            if (og + 1u == (tg + 1u) * nx) xb_add(&bar[XB_TOPGEN], 1u);
            else XB_SPIN(xb_ld(&bar[XB_TOPGEN]) == tg, bar);
            __builtin_amdgcn_fence(__ATOMIC_ACQUIRE, "agent");
            xb_add(&bar[XB_XGEN(b.x)], 1u);
            asm volatile("s_waitcnt vmcnt(0)" ::: "memory");
        } else {
            XB_SPIN(xb_ld(&bar[XB_XGEN(b.x)]) == gen, bar);
            __builtin_amdgcn_fence(__ATOMIC_ACQUIRE, "agent");
            asm volatile("s_waitcnt vmcnt(0)" ::: "memory");
        }
    }
    __syncthreads();
}

struct TC { int tid, lane, wave; };
__device__ __forceinline__ TC tc_get() { TC t; int x = threadIdx.x; asm volatile("" : "+v"(x)); t.tid = x; t.lane = x & 63; t.wave = __builtin_amdgcn_readfirstlane(x >> 6); return t; }
struct Frame {
    char* lds; int vcu, G;
    unsigned char* ws; float* out;
    const float* const* in;
};
__device__ __forceinline__ float clamp8(float v) { return fminf(fmaxf(v, -448.f), 448.f); }
__device__ __forceinline__ unsigned pk4_fp8(float a, float b, float c, float d, float sc) {
    int t = __builtin_amdgcn_cvt_pk_fp8_f32(clamp8(a * sc), clamp8(b * sc), 0, false); t = __builtin_amdgcn_cvt_pk_fp8_f32(clamp8(c * sc), clamp8(d * sc), t, true); return (unsigned)t; }
#define LDS_WAIT() asm volatile("s_waitcnt lgkmcnt(0)" ::: "memory")
#define VM_WAIT() asm volatile("s_waitcnt vmcnt(0)" ::: "memory")

template <int MAP>
__device__ __forceinline__ void tr_item(const float* W, int K, int N, int ldw, bf16* WT, float* scr, int item, int lane) {
    const int nblk = N / 32, kb = item / nblk, nb = item % nblk, k0 = 64 * kb, n0 = 32 * nb;
    int r0 = n0;
    if (MAP == 1) { const int F = N / 2; r0 = (n0 < F) ? 256 * (n0 / 128) + (n0 % 128) : 256 * ((n0 - F) / 128) + 128 + ((n0 - F) % 128); }
    const float* src = W + (size_t)(k0 + (lane >> 5)) * ldw + n0 + (lane & 31);
#pragma unroll 16
    for (int i = 0; i < 32; ++i) scr[(2 * i + (lane >> 5)) * 33 + (lane & 31)] = src[(size_t)(2 * i) * ldw];
    LDS_WAIT(); asm volatile("" ::: "memory");
    const int c = lane & 7;
#pragma unroll
    for (int j = 0; j < 4; ++j) { const int n = (lane >> 3) + 8 * j; const float* s = scr + (8 * c) * 33 + n;
        u32x4 o; o.x = cvt_pk_bf16(s[0 * 33], s[1 * 33]); o.y = cvt_pk_bf16(s[2 * 33], s[3 * 33]); o.z = cvt_pk_bf16(s[4 * 33], s[5 * 33]); o.w = cvt_pk_bf16(s[6 * 33], s[7 * 33]);
        *(u32x4*)(WT + (size_t)(r0 + n) * K + k0 + 8 * c) = o; }
    LDS_WAIT(); asm volatile("" ::: "memory");
}
template <int MAP>
__device__ __forceinline__ void tr_item8(const float* W, int K, int N, int ldw, unsigned char* WT, float* scr, int item, int lane, float sw, int pitch = 0  ) {
    const int nblk = N / 32, kb = item / nblk, nb = item % nblk, k0 = 64 * kb, n0 = 32 * nb;
    int r0 = n0;
    if (MAP == 1) { const int F = N / 2; r0 = (n0 < F) ? 256 * (n0 / 128) + (n0 % 128) : 256 * ((n0 - F) / 128) + 128 + ((n0 - F) % 128); }
    const float* src = W + (size_t)(k0 + (lane >> 5)) * ldw + n0 + (lane & 31);
#pragma unroll 16
    for (int i = 0; i < 32; ++i) scr[(2 * i + (lane >> 5)) * 33 + (lane & 31)] = src[(size_t)(2 * i) * ldw];
    LDS_WAIT(); asm volatile("" ::: "memory");
    const int c = lane & 7;
#pragma unroll
    for (int j = 0; j < 4; ++j) { const int n = (lane >> 3) + 8 * j; const float* s = scr + (8 * c) * 33 + n;
        u32x2 o; int t = __builtin_amdgcn_cvt_pk_fp8_f32(s[0 * 33] * sw, s[1 * 33] * sw, 0, false); t = __builtin_amdgcn_cvt_pk_fp8_f32(s[2 * 33] * sw, s[3 * 33] * sw, t, true); o.x = (unsigned)t;
        t = __builtin_amdgcn_cvt_pk_fp8_f32(s[4 * 33] * sw, s[5 * 33] * sw, 0, false); t = __builtin_amdgcn_cvt_pk_fp8_f32(s[6 * 33] * sw, s[7 * 33] * sw, t, true); o.y = (unsigned)t;
        *(u32x2*)(WT + (size_t)(r0 + n) * (pitch ? pitch : K) + k0 + 8 * c) = o; }
    LDS_WAIT(); asm volatile("" ::: "memory");
}
template <int MAP>
__device__ __forceinline__ void tr_matrix8(Frame& F, const float* W, int K, int N, int ldw, unsigned char* WT, int rot, float sw, int pitch = 0) {
    const TC tc = tc_get();
    float* scr = (float*)(F.lds + tc.wave * 8448);
    const int NGW = F.G * NWAVES, gw = (F.vcu * NWAVES + tc.wave + rot) % NGW, nitems = (K / 64) * (N / 32);
    for (int it = gw; it < nitems; it += NGW) tr_item8<MAP>(W, K, N, ldw, WT, scr, it, tc.lane, sw, pitch);
}
__device__ __forceinline__ void cmax_matrix(Frame& F, const float* W, int K, int N, int ldw, unsigned* cmax, int rot) {
    const TC tc = tc_get();
    const int NGW = F.G * NWAVES, gw = (F.vcu * NWAVES + tc.wave + rot) % NGW, ncb = (N + 255) / 256, nitems = (K / 64) * ncb;
    for (int it = gw; it < nitems; it += NGW) { const int kb = it / ncb, cb = it % ncb, col = cb * 256 + 4 * tc.lane;
        if (col < N) { const float* src = W + (size_t)(kb * 64) * ldw + col; f32x4 m = {0.f, 0.f, 0.f, 0.f};
#pragma unroll 16
            for (int r = 0; r < 64; ++r) { const f32x4 v = *(const f32x4*)(src + (size_t)r * ldw); m.x = fmaxf(m.x, fabsf(v.x)); m.y = fmaxf(m.y, fabsf(v.y)); m.z = fmaxf(m.z, fabsf(v.z)); m.w = fmaxf(m.w, fabsf(v.w)); }
            atomicMax(cmax + col, __float_as_uint(m.x)); atomicMax(cmax + col + 1, __float_as_uint(m.y)); atomicMax(cmax + col + 2, __float_as_uint(m.z)); atomicMax(cmax + col + 3, __float_as_uint(m.w)); } }
}
template <int MAP>
__device__ __forceinline__ void tr_item_i8(const float* W, int K, int N, int ldw, unsigned char* WT, float* scr, int item, int lane, const unsigned* cmax, float* cs) {
    const int nblk = N / 32, kb = item / nblk, nb = item % nblk, k0 = 64 * kb, n0 = 32 * nb;
    int r0 = n0;
    if (MAP == 1) { const int F = N / 2; r0 = (n0 < F) ? 256 * (n0 / 128) + (n0 % 128) : 256 * ((n0 - F) / 128) + 128 + ((n0 - F) % 128); }
    const float* src = W + (size_t)(k0 + (lane >> 5)) * ldw + n0 + (lane & 31);
#pragma unroll 16
    for (int i = 0; i < 32; ++i) scr[(2 * i + (lane >> 5)) * 33 + (lane & 31)] = src[(size_t)(2 * i) * ldw];
    LDS_WAIT(); asm volatile("" ::: "memory");
    const int c = lane & 7;
#pragma unroll
    for (int j = 0; j < 4; ++j) { const int n = (lane >> 3) + 8 * j; const float* s = scr + (8 * c) * 33 + n;
        const float cm = __uint_as_float(cmax[n0 + n]), inv = cm > 0.f ? 127.0f / cm : 0.f;
        if (kb == 0 && c == 0) cs[r0 + n] = cm * (1.0f / 127.0f);
        unsigned w[2];
#pragma unroll
        for (int h = 0; h < 2; ++h) { const int q0 = __float2int_rn(s[(4 * h + 0) * 33] * inv), q1 = __float2int_rn(s[(4 * h + 1) * 33] * inv), q2 = __float2int_rn(s[(4 * h + 2) * 33] * inv), q3 = __float2int_rn(s[(4 * h + 3) * 33] * inv);
            w[h] = (unsigned)(q0 & 0xff) | ((unsigned)(q1 & 0xff) << 8) | ((unsigned)(q2 & 0xff) << 16) | ((unsigned)q3 << 24); }
        u32x2 o; o.x = w[0]; o.y = w[1];
        *(u32x2*)(WT + (size_t)(r0 + n) * K + k0 + 8 * c) = o; }
    LDS_WAIT(); asm volatile("" ::: "memory");
}
template <int MAP>
__device__ __forceinline__ void tr_matrix_i8(Frame& F, const float* W, int K, int N, int ldw, unsigned char* WT, int rot, const unsigned* cmax, float* cs) {
    const TC tc = tc_get();
    float* scr = (float*)(F.lds + tc.wave * 8448);
    const int NGW = F.G * NWAVES, gw = (F.vcu * NWAVES + tc.wave + rot) % NGW, nitems = (K / 64) * (N / 32);
    for (int it = gw; it < nitems; it += NGW) tr_item_i8<MAP>(W, K, N, ldw, WT, scr, it, tc.lane, cmax, cs);
}
template <int MAP>
__device__ __forceinline__ void tr_matrix(Frame& F, const float* W, int K, int N, int ldw, bf16* WT, int rot) {
    const TC tc = tc_get();
    float* scr = (float*)(F.lds + tc.wave * 8448);
    const int NGW = F.G * NWAVES, gw = (F.vcu * NWAVES + tc.wave + rot) % NGW, nitems = (K / 64) * (N / 32);
    for (int it = gw; it < nitems; it += NGW) tr_item<MAP>(W, K, N, ldw, WT, scr, it, tc.lane);
}

struct RowArgs { const bf16* Xsb; bf16* Xdb; const float* Xsrc; float* Xdst; const float* g; bf16* XN; float* outF; const bf16* Y; const int* s0; const int* s1; const float* w0; const float* w1;
                 const float* routerT; unsigned* rt_e; float* rt_w0; float* rt_w1; unsigned* cnt; float* rs; };
template <int MODE, bool COMBINE, int OUTM = 0  , bool Y8 = false  , bool XBF = false  >
__device__ __forceinline__ void row_pass(Frame& F, const RowArgs& a) {
    const TC tc = tc_get();
    const int lane = tc.lane;
    float* rtab = (float*)F.lds;
    unsigned* wcnt = (unsigned*)(F.lds + 32768);
    if (MODE == 1) { for (int i = tc.tid; i < 8 * 1024; i += NTHREADS) rtab[i] = a.routerT[i]; }
    f32x4 gv[4];
#pragma unroll
    for (int j = 0; j < 4; ++j) gv[j] = *(const f32x4*)(a.g + 4 * lane + 256 * j);
    for (int tb = blockIdx.x; tb < T / 256; tb += F.G) {
        if (MODE == 1) { if (tc.tid < 64) wcnt[tc.tid] = 0u; __syncthreads(); }
        unsigned myc[8] = {0u, 0u, 0u, 0u, 0u, 0u, 0u, 0u};
        for (int rr = 0; rr < 32; ++rr) {
            const int row = tb * 256 + tc.wave * 32 + rr;
            f32x4 v[4];
            if constexpr (XBF) { const u32x2* xr = (const u32x2*)(a.Xsb + (size_t)row * D) + lane;
#pragma unroll
                for (int j = 0; j < 4; ++j) { const u32x2 w = xr[64 * j]; v[j] = (f32x4){bflo(w.x), bfhi(w.x), bflo(w.y), bfhi(w.y)}; }
            } else { const f32x4* xr = (const f32x4*)(a.Xsrc + (size_t)row * D) + lane;
#pragma unroll
                for (int j = 0; j < 4; ++j) v[j] = xr[64 * j]; }
            if (COMBINE) {
                const int sa = a.s0[row], sb = a.s1[row]; const float wa = a.w0[row], wb = a.w1[row];
                if (Y8) { const unsigned* ya = (const unsigned*)((const unsigned char*)a.Y + (size_t)sa * D) + lane; const unsigned* yb = (const unsigned*)((const unsigned char*)a.Y + (size_t)sb * D) + lane;
                    const float wa8 = wa * (1.0f / Y_SCALE8), wb8 = wb * (1.0f / Y_SCALE8);
#pragma unroll
                    for (int j = 0; j < 4; ++j) { const int pa = (int)ya[64 * j], pb = (int)yb[64 * j];
                        v[j].x += wa8 * __builtin_amdgcn_cvt_f32_fp8(pa, 0) + wb8 * __builtin_amdgcn_cvt_f32_fp8(pb, 0); v[j].y += wa8 * __builtin_amdgcn_cvt_f32_fp8(pa, 1) + wb8 * __builtin_amdgcn_cvt_f32_fp8(pb, 1);
                        v[j].z += wa8 * __builtin_amdgcn_cvt_f32_fp8(pa, 2) + wb8 * __builtin_amdgcn_cvt_f32_fp8(pb, 2); v[j].w += wa8 * __builtin_amdgcn_cvt_f32_fp8(pa, 3) + wb8 * __builtin_amdgcn_cvt_f32_fp8(pb, 3); }
                } else {
                const u32x2* ya = (const u32x2*)(a.Y + (size_t)sa * D) + lane; const u32x2* yb = (const u32x2*)(a.Y + (size_t)sb * D) + lane;
#pragma unroll
                for (int j = 0; j < 4; ++j) { const u32x2 pa = ya[64 * j], pb = yb[64 * j];
                    v[j].x += wa * bflo(pa.x) + wb * bflo(pb.x); v[j].y += wa * bfhi(pa.x) + wb * bfhi(pb.x);
                    v[j].z += wa * bflo(pa.y) + wb * bflo(pb.y); v[j].w += wa * bfhi(pa.y) + wb * bfhi(pb.y); } }
                if (MODE != 2) {
                    if constexpr (XBF) { u32x2* xd = (u32x2*)(a.Xdb + (size_t)row * D) + lane;
#pragma unroll
                        for (int j = 0; j < 4; ++j) { u32x2 w; w.x = cvt_pk_bf16(v[j].x, v[j].y); w.y = cvt_pk_bf16(v[j].z, v[j].w); xd[64 * j] = w; }
                    } else { f32x4* xd = (f32x4*)(a.Xdst + (size_t)row * D) + lane;
#pragma unroll
                        for (int j = 0; j < 4; ++j) xd[64 * j] = v[j]; } }
            }
            float ss = 0.f;
#pragma unroll
            for (int j = 0; j < 4; ++j) ss += (v[j].x * v[j].x + v[j].y * v[j].y) + (v[j].z * v[j].z + v[j].w * v[j].w);
            const float rstd = 1.0f / sqrtf(wave_sum(ss) * (1.f / D) + EPS);
#pragma unroll
            for (int j = 0; j < 4; ++j) v[j] = v[j] * rstd * gv[j];
            if (MODE == 2) { f32x4* od = (f32x4*)(a.outF + (size_t)row * D) + lane;
#pragma unroll
                for (int j = 0; j < 4; ++j) od[64 * j] = v[j];
            } else if (OUTM == 2) { float am = 0.f;
#pragma unroll
                for (int j = 0; j < 4; ++j) am = fmaxf(fmaxf(am, fmaxf(fabsf(v[j].x), fabsf(v[j].y))), fmaxf(fabsf(v[j].z), fabsf(v[j].w)));
#pragma unroll
                for (int o = 1; o < 64; o <<= 1) am = fmaxf(am, __shfl_xor(am, o));
                const float inv = am > 0.f ? 127.0f / am : 0.f;
                unsigned* o4 = (unsigned*)((unsigned char*)a.XN + (size_t)row * D) + lane;
#pragma unroll
                for (int j = 0; j < 4; ++j) { const int q0 = __float2int_rn(v[j].x * inv), q1 = __float2int_rn(v[j].y * inv), q2 = __float2int_rn(v[j].z * inv), q3 = __float2int_rn(v[j].w * inv);
                    o4[64 * j] = (unsigned)(q0 & 0xff) | ((unsigned)(q1 & 0xff) << 8) | ((unsigned)(q2 & 0xff) << 16) | ((unsigned)q3 << 24); }
                if (lane == 0) a.rs[row] = am * (1.0f / 127.0f);
            } else if (OUTM == 1) { unsigned* o4 = (unsigned*)((unsigned char*)a.XN + (size_t)row * D) + lane;
#pragma unroll
                for (int j = 0; j < 4; ++j) o4[64 * j] = pk4_fp8(v[j].x, v[j].y, v[j].z, v[j].w, ACT_SCALE8);
            } else { u32x2* o8 = (u32x2*)(a.XN + (size_t)row * D) + lane;
#pragma unroll
                for (int j = 0; j < 4; ++j) { u32x2 w; w.x = cvt_pk_bf16(v[j].x, v[j].y); w.y = cvt_pk_bf16(v[j].z, v[j].w); o8[64 * j] = w; } }
            if (MODE == 1) {
                float lg[8];
#pragma unroll
                for (int e = 0; e < 8; ++e) { float s = 0.f;
#pragma unroll
                    for (int j = 0; j < 4; ++j) { const f32x4 r = *(const f32x4*)(rtab + e * 1024 + 256 * j + 4 * lane); s += (v[j].x * r.x + v[j].y * r.y) + (v[j].z * r.z + v[j].w * r.w); }
                    lg[e] = wave_sum(s); }
                int e0 = 0; float v0 = lg[0];
#pragma unroll
                for (int e = 1; e < 8; ++e) if (lg[e] > v0) { v0 = lg[e]; e0 = e; }
                int e1 = -1; float v1 = -3.0e38f;
#pragma unroll
                for (int e = 0; e < 8; ++e) if (e != e0 && lg[e] > v1) { v1 = lg[e]; e1 = e; }
                const float w0 = 1.0f / (1.0f + __expf(v1 - v0)), w1 = 1.0f - w0;
                if (lane == 0) { a.rt_e[row] = (unsigned)e0 | ((unsigned)e1 << 8); a.rt_w0[row] = w0; a.rt_w1[row] = w1; }
#pragma unroll
                for (int e = 0; e < 8; ++e) myc[e] += (e == e0 || e == e1) ? 1u : 0u;
            }
        }
        if (MODE == 1) {
            if (lane < 8) { unsigned c = 0;
#pragma unroll
                for (int e = 0; e < 8; ++e) c = (lane == e) ? myc[e] : c;
                wcnt[tc.wave * 8 + lane] = c; }
            __syncthreads();
            if (tc.tid < 8) { unsigned c = 0; for (int w = 0; w < 8; ++w) c += wcnt[w * 8 + tc.tid]; a.cnt[tb * 8 + tc.tid] = c; }
            __syncthreads();
        }
    }
}

template <bool F8>
__device__ __forceinline__ void moe_assign(Frame& F, const unsigned* cnt, const unsigned* rt_e, int* s0, int* s1, unsigned* pbase_out, const bf16* XN, bf16* XG, int* tok = nullptr  ) {
    const TC tc = tc_get();
    unsigned* tot = (unsigned*)F.lds;
    unsigned* pre = tot + 64;
    unsigned long long* msk = (unsigned long long*)(F.lds + 1024);
    int* slt = (int*)(F.lds + 2048);
    if (tc.tid < 8) tot[tc.tid] = 0u;
    __syncthreads();
    { unsigned part[8] = {0, 0, 0, 0, 0, 0, 0, 0};
      if (tc.tid < 256) {
#pragma unroll
          for (int e = 0; e < 8; ++e) part[e] = __hip_atomic_load(cnt + tc.tid * 8 + e, RLX_AGENT); }
#pragma unroll
      for (int e = 0; e < 8; ++e) { unsigned s = part[e];
#pragma unroll
          for (int o = 1; o < 64; o <<= 1) s += __shfl_xor(s, o);
          if (tc.lane == 0 && tc.wave < 4) atomicAdd(&tot[e], s); } }
    __syncthreads();
    if (tc.tid == 0) { unsigned p = 0; for (int e = 0; e < 8; ++e) { tot[8 + e] = p; p += (tot[e] + 255u) / 256u; } tot[16] = p;
        if (blockIdx.x == 0) for (int e = 0; e < 9; ++e) __hip_atomic_store(pbase_out + e, tot[8 + e], RLX_AGENT); }
    __syncthreads();
    for (int tb = blockIdx.x; tb < T / 256; tb += F.G) {
        if (tc.tid < 8) { unsigned s = 0; for (int b = 0; b < tb; ++b) s += __hip_atomic_load(cnt + b * 8 + tc.tid, RLX_AGENT); pre[tc.tid] = s; }
        int e0 = 0, e1 = 0;
        if (tc.tid < 256) { const unsigned pe = rt_e[tb * 256 + tc.tid]; e0 = pe & 0xff; e1 = (pe >> 8) & 0xff;
#pragma unroll
            for (int e = 0; e < 8; ++e) { const unsigned long long m = __ballot(e0 == e || e1 == e); if (tc.lane == 0) msk[e * 4 + tc.wave] = m; } }
        __syncthreads();
        if (tc.tid < 256) {
            int sl[2];
#pragma unroll
            for (int k = 0; k < 2; ++k) { const int e = k ? e1 : e0; unsigned rank = 0;
                for (int w = 0; w < tc.wave; ++w) rank += __popcll(msk[e * 4 + w]);
                rank += __popcll(msk[e * 4 + tc.wave] & ((1ull << tc.lane) - 1ull));
                sl[k] = (int)(tot[8 + e] * 256u + pre[e] + rank); }
            s0[tb * 256 + tc.tid] = sl[0]; s1[tb * 256 + tc.tid] = sl[1]; slt[2 * tc.tid] = sl[0]; slt[2 * tc.tid + 1] = sl[1];
            if (F8 && tok) { tok[sl[0]] = tb * 256 + tc.tid; tok[sl[1]] = tb * 256 + tc.tid; }
        }
        __syncthreads();
        if (!(F8 && tok))
        for (int rr = 0; rr < 32; ++rr) { const int i = tc.wave * 32 + rr; const int row = tb * 256 + i; const int sa = slt[2 * i], sb = slt[2 * i + 1];
            if (F8) {
                const u32x4 o = ((const u32x4*)((const unsigned char*)XN + (size_t)row * D))[tc.lane];
                ((u32x4*)((unsigned char*)XG + (size_t)sa * D))[tc.lane] = o; ((u32x4*)((unsigned char*)XG + (size_t)sb * D))[tc.lane] = o;
            } else {
            const u32x4* src = (const u32x4*)(XN + (size_t)row * D) + tc.lane; const u32x4 a = src[0], b = src[64];
            u32x4* d0 = (u32x4*)(XG + (size_t)sa * D) + tc.lane; u32x4* d1 = (u32x4*)(XG + (size_t)sb * D) + tc.lane;
            d0[0] = a; d0[64] = b; d1[0] = a; d1[64] = b; } }
        __syncthreads();
    }
}

template <bool OUT8>
__device__ __forceinline__ void conv_pass(Frame& F, const bf16* Bc, const bf16* Vc, const float* wconv, bf16* Yc) {
    const TC tc = tc_get();
    const int sub = tc.tid >> 7, ch = (tc.tid & 127) * 8;
    float w[3][8];
#pragma unroll
    for (int j = 0; j < 3; ++j) { const f32x4 a = *(const f32x4*)(wconv + j * D + ch), b = *(const f32x4*)(wconv + j * D + ch + 4);
#pragma unroll
        for (int c = 0; c < 4; ++c) { w[j][c] = a[c]; w[j][4 + c] = b[c]; } }
    for (int run = blockIdx.x * 4 + sub; run < T / 32; run += F.G * 4) {
        const int t0 = run * 32, s0 = t0 & (SEQ - 1);
        float p2[8], p1[8];
        { u32x4 a = {0, 0, 0, 0}, b = {0, 0, 0, 0};
          if (s0 >= 2) { a = *(const u32x4*)(Vc + (size_t)(t0 - 2) * D + ch); b = *(const u32x4*)(Vc + (size_t)(t0 - 1) * D + ch); }
#pragma unroll
          for (int c = 0; c < 4; ++c) { p2[2 * c] = bflo(a[c]); p2[2 * c + 1] = bfhi(a[c]); p1[2 * c] = bflo(b[c]); p1[2 * c + 1] = bfhi(b[c]); } }
#pragma unroll 4
        for (int i = 0; i < 32; ++i) { const size_t o = (size_t)(t0 + i) * D + ch;
            const u32x4 vv = *(const u32x4*)(Vc + o), bb = *(const u32x4*)(Bc + o); float cur[8], y[8];
#pragma unroll
            for (int c = 0; c < 4; ++c) { cur[2 * c] = bflo(vv[c]); cur[2 * c + 1] = bfhi(vv[c]); }
#pragma unroll
            for (int c = 0; c < 8; ++c) { const float bq = (c & 1) ? bfhi(bb[c >> 1]) : bflo(bb[c >> 1]); y[c] = bq * (w[0][c] * p2[c] + w[1][c] * p1[c] + w[2][c] * cur[c]); p2[c] = p1[c]; p1[c] = cur[c]; }
            if (OUT8) { u32x2 r; r.x = pk4_fp8(y[0], y[1], y[2], y[3], YC_SCALE8); r.y = pk4_fp8(y[4], y[5], y[6], y[7], YC_SCALE8); *(u32x2*)((unsigned char*)Yc + o) = r; }
            else { u32x4 r; r.x = cvt_pk_bf16(y[0], y[1]); r.y = cvt_pk_bf16(y[2], y[3]); r.z = cvt_pk_bf16(y[4], y[5]); r.w = cvt_pk_bf16(y[6], y[7]);
            *(u32x4*)(Yc + o) = r; } }
    }
}

__device__ __forceinline__ void rope_table(Frame& F, const int* pos, float* tab) {
    const TC tc = tc_get();
    const int i = tc.lane & 31; const float inv = __builtin_amdgcn_exp2f(-(float)i * (13.287712379549449f / 32.0f));
    const int NGW = F.G * NWAVES, gw = F.vcu * NWAVES + tc.wave;
    for (int t = gw * 2 + (tc.lane >> 5); t < T; t += NGW * 2) {
        const float ang = (float)pos[t] * inv;
        const float k = rintf(ang * 0.15915494309189535f);
        float r = fmaf(-k, 6.28125f, ang); r = fmaf(-k, 1.9353071795864769e-3f, r);
        tab[(size_t)t * 64 + i] = __cosf(r); tab[(size_t)t * 64 + 32 + i] = __sinf(r);
    }
}

constexpr float C8_SCALE = 8.f;
template <int K8  , bool C8 = false  >
__device__ __forceinline__ void mla_mid(Frame& F, const float* C, const float* gq, const float* gkv, const float* tab, bf16* cqn, bf16* ckvn, bf16* Kf, float kscale) {
    const TC tc = tc_get();
    const int lane = tc.lane, NGW = F.G * NWAVES, gw = F.vcu * NWAVES + tc.wave;
    f32x2 gqv[3];
#pragma unroll
    for (int j = 0; j < 3; ++j) gqv[j] = *(const f32x2*)(gq + 2 * lane + 128 * j);
    const f32x4 gk = *(const f32x4*)(gkv + 4 * lane);
    for (int t = gw; t < T; t += NGW) {
        const bf16* c = (const bf16*)C + (size_t)t * MDNP;
        f32x2 q[3]; float ss = 0.f;
#pragma unroll
        for (int j = 0; j < 3; ++j) { const unsigned w = *(const unsigned*)(c + 2 * lane + 128 * j); q[j] = (f32x2){bflo(w), bfhi(w)}; ss += q[j].x * q[j].x + q[j].y * q[j].y; }
        f32x4 kv; { const u32x2 w = *(const u32x2*)(c + QL + 4 * lane); kv = (f32x4){bflo(w.x), bfhi(w.x), bflo(w.y), bfhi(w.y)}; }
        const float x = bf2f(c[QL + KVL + lane]);
        const float rq = 1.0f / sqrtf(wave_sum(ss) * (1.f / QL) + EPS);
        const float rk = 1.0f / sqrtf(wave_sum((kv.x * kv.x + kv.y * kv.y) + (kv.z * kv.z + kv.w * kv.w)) * (1.f / KVL) + EPS);
        if constexpr (C8) {
            unsigned char* cq8 = (unsigned char*)cqn + (size_t)t * 512; unsigned char* ckv8 = (unsigned char*)ckvn + (size_t)t * KVL;
#pragma unroll
            for (int j = 0; j < 3; ++j) { const int pk = __builtin_amdgcn_cvt_pk_fp8_f32(clamp8(q[j].x * rq * gqv[j].x * C8_SCALE), clamp8(q[j].y * rq * gqv[j].y * C8_SCALE), 0, false);
                *(unsigned short*)(cq8 + 2 * lane + 128 * j) = (unsigned short)pk; }
            if (lane < 32) *(unsigned*)(cq8 + QL + 4 * lane) = 0u;
            *(unsigned*)(ckv8 + 4 * lane) = pk4_fp8(kv.x * rk * gk.x, kv.y * rk * gk.y, kv.z * rk * gk.z, kv.w * rk * gk.w, C8_SCALE);
        } else {
#pragma unroll
        for (int j = 0; j < 3; ++j) *(unsigned*)(cqn + (size_t)t * QL + 2 * lane + 128 * j) = cvt_pk_bf16(q[j].x * rq * gqv[j].x, q[j].y * rq * gqv[j].y);
        { u32x2 w; w.x = cvt_pk_bf16(kv.x * rk * gk.x, kv.y * rk * gk.y); w.y = cvt_pk_bf16(kv.z * rk * gk.z, kv.w * rk * gk.w); *(u32x2*)(ckvn + (size_t)t * KVL + 4 * lane) = w; } }
        const float other = __shfl_xor(x, 32); const int i = lane & 31;
        const float cs = tab[(size_t)t * 64 + i], sn = tab[(size_t)t * 64 + 32 + i];
        const float r = (lane < 32) ? (x * cs - other * sn) : (x * cs + other * sn);
        if (K8) { const float rs_ = fminf(fmaxf(r * kscale, -448.f), 448.f); const float r1 = __shfl_down(rs_, 1), r2 = __shfl_down(rs_, 2), r3 = __shfl_down(rs_, 3);
            if ((lane & 3) == 0) { int tq = __builtin_amdgcn_cvt_pk_fp8_f32(rs_, r1, 0, false); tq = __builtin_amdgcn_cvt_pk_fp8_f32(r2, r3, tq, true);
                const int b = t >> 13, s = t & (SEQ - 1), a_ = lane >> 4, h_ = (lane >> 3) & 1, j_ = lane & 7;
#pragma unroll
                for (int h = 0; h < MH; ++h) *(unsigned*)((unsigned char*)Kf + ((size_t)(b * MH + h) * SEQ + s) * DQKM + 128 + 32 * h_ + 8 * a_ + j_) = (unsigned)tq; }
        } else {
        const float rn = __shfl_xor(r, 1);
        if ((lane & 1) == 0) { const unsigned pk = cvt_pk_bf16(r, rn); const int b = t >> 13, s = t & (SEQ - 1);
#pragma unroll
            for (int h = 0; h < MH; ++h) *(unsigned*)(Kf + ((size_t)(b * MH + h) * SEQ + s) * DQKM + 128 + lane) = pk; } }
    }
}
#ifndef PC_CONV_IN
#define PC_CONV_IN 2
#endif
#ifndef PC_FFN_GU
#define PC_FFN_GU 2
#endif
#ifndef PC_MDN
#define PC_MDN 2
#endif
#ifndef PC_SQKV
#define PC_SQKV 2
#endif
#ifndef PC_CONV_OUT
#define PC_CONV_OUT 0
#endif
#ifndef PC_ATT_O
#define PC_ATT_O 1
#endif
#ifndef PC_FFN_DN
#define PC_FFN_DN 1
#endif
#ifdef DIAG_GEMM
#define DIAG_PTR(N_, P_) (((N_) == DIAG_N && (P_) == DIAG_PREC) ? (unsigned long long*)(F.ws + WS_CTL + 24000) : nullptr)
#else
#define DIAG_PTR(N_, P_) nullptr
#endif
#ifndef STAGGER_TICKS
#define STAGGER_TICKS 0
#endif
template <int PREC = 0, class Epi>
__device__ __forceinline__ void gemm_static(Frame& F, const void* A, int lda, int K, const void* Bt, int N, const Epi& E, const float* rs = nullptr, const float* cs = nullptr, int stagger = 0, int M = T) {
    if (stagger && ((blockIdx.x >> 3) & 1)) { const unsigned long long t0 = __builtin_amdgcn_s_memrealtime(); while (__builtin_amdgcn_s_memrealtime() - t0 < (unsigned long long)stagger) __builtin_amdgcn_s_sleep(8); }
    pg8::Gemm g{(const bf16*)A, (const bf16*)Bt, PREC ? lda / 2 : lda, PREC ? K / 2 : K, 0, rs, cs, 0, DIAG_PTR(N, PREC)}; pg8::StaticOrder S; S.init(M, N, F.G, (int)blockIdx.x, (LAS unsigned*)((LAS unsigned char*)F.lds + MISC_OFF + 512), 128);
    pg8::gemm_phase<Epi, pg8::StaticOrder, PREC>((LAS unsigned char*)F.lds, g, S, E);
}
template <bool F8, class Epi, bool GATH = false, bool QS = false>
__device__ __forceinline__ void gemm_grouped(Frame& F, const void* A, int lda, int K, const void* Bt, size_t estride, int N, const unsigned* pbase, const Epi& E, const int* gidx = nullptr) {
    pg8::Gemm g{(const bf16*)A, (const bf16*)Bt, lda, K, estride, nullptr, nullptr, 0, DIAG_PTR(N, F8 ? 1 : 0), gidx}; pg8::GroupedOrderT<QS> S; S.init(pbase, N, F.G, (int)blockIdx.x, (LAS unsigned*)((LAS unsigned char*)F.lds + MISC_OFF + 512), 128);
    pg8::gemm_phase<Epi, pg8::GroupedOrderT<QS>, F8 ? 1 : 0, GATH, QS>((LAS unsigned char*)F.lds, g, S, E);
}
#ifndef MOE_F8_A
#define MOE_F8_A 1
#endif
#ifndef MOE_F8_B
#define MOE_F8_B 1
#endif
template <bool F8>
__device__ __forceinline__ void moe_gemm1(Frame& F, int l, const unsigned* pb) {
    unsigned char* ws = F.ws; unsigned char* big = ws + WS_BIG;
    if (F8) gemm_grouped<true, pg8::EpiPair8, true>(F, ws + WS_XN, D / 2, D / 2, ws + W_MGU + (size_t)l * 8 * 2 * FE * 1024 * 2, (size_t)2 * FE * 1024, 2 * FE, pb, pg8::EpiPair8{big, FE, 1.0f / (ACT_SCALE8 * W_SCALE8), HID_SCALE8}, (const int*)(ws + RT_TOK));
    else gemm_grouped<false>(F, ws + WS_XG, D, D, ws + W_MGU + (size_t)l * 8 * 2 * FE * 1024 * 2, (size_t)2 * FE * 1024 * 2, 2 * FE, pb, pg8::EpiPair<1>{(bf16*)big, FE, 1.0f});
}
template <bool F8, bool Y8 = false>
__device__ __forceinline__ void moe_gemm2(Frame& F, int l, const unsigned* pb) {
    unsigned char* ws = F.ws; unsigned char* big = ws + WS_BIG;
    if (F8 && Y8) gemm_grouped<true, pg8::EpiF8, false, true>(F, big, FE / 2, FE / 2, ws + W_MD + (size_t)l * 8 * 1024 * FE * 2, (size_t)1024 * FE, 1024, pb, pg8::EpiF8{ws + WS_XG, D, Y_SCALE8 / (HID_SCALE8 * W_SCALE8)});
    else if (F8) gemm_grouped<true>(F, big, FE / 2, FE / 2, ws + W_MD + (size_t)l * 8 * 1024 * FE * 2, (size_t)1024 * FE, 1024, pb, pg8::EpiBf16{(bf16*)(ws + WS_XG), D, nullptr, 1.0f / (HID_SCALE8 * W_SCALE8)});
    else gemm_grouped<false>(F, big, FE, FE, ws + W_MD + (size_t)l * 8 * 1024 * FE * 2, (size_t)1024 * FE * 2, 1024, pb, pg8::EpiBf16{(bf16*)(ws + WS_XG), D, nullptr, 1.0f});
}
#ifndef MLA_C8
#define MLA_C8 1
#endif
#define W_DENSE_LIST(X) \
    for (int j = 0; j < 2; ++j) { \
        X(PC_CONV_IN, 0, in[5] + (size_t)j * 1024 * 3072, 1024, 1024, 3072, W_CINB + (size_t)j * 1024 * 1024 * 2, CM_CIN + j * 3072) \
        X(PC_CONV_IN, 1, in[5] + (size_t)j * 1024 * 3072 + 1024, 1024, 2048, 3072, W_CINCU + (size_t)j * 2048 * 1024 * 2, CM_CIN + j * 3072 + 1024) \
        X(PC_CONV_OUT, 0, in[7] + (size_t)j * 1024 * 1024, 1024, 1024, 1024, W_COUT + (size_t)j * 1024 * 1024 * 2, 0) \
        X(PC_FFN_GU, 1, in[19] + (size_t)j * 1024 * 2 * FF, 1024, 2 * FF, 2 * FF, W_FGU + (size_t)j * 2 * FF * 1024 * 2, CM_FGU + j * 5632) \
        X(PC_FFN_DN, 0, in[20] + (size_t)j * FF * 1024, FF, 1024, 1024, W_FD + (size_t)j * 1024 * FF * 2, 0) \
    } \
    X(PC_MDN, 0, in[8], 1024, MDN, MDN, W_MDN, CM_MDN) \
    if (!MLA_C8) { X(0, 0, in[10], QL, 1536, 1536, W_MUQ, 0) } \
    for (int h = 0; h < MH; ++h) {   \
        X(MLA_C8, 0, in[12] + h * 256, KVL, 128, 2048, W_MUKV + (size_t)h * 128 * KVL * (MLA_C8 ? 1 : 2), 0) \
        X(MLA_C8, 0, in[12] + h * 256 + 128, KVL, 128, 2048, W_MUKV + (size_t)(1024 + h * 128) * KVL * (MLA_C8 ? 1 : 2), 0) \
    } \
    X(PC_ATT_O, 0, in[13], 1024, 1024, 1024, W_MO, 0) \
    X(PC_SQKV, 0, in[14], 1024, SQKV, SQKV, W_SQKV, CM_SQKV) \
    X(PC_ATT_O, 0, in[17], 1024, 1024, 1024, W_SO, 0)
__device__ __forceinline__ void prologue_a(Frame& F) {
    const float* const* in = F.in; unsigned char* ws = F.ws; unsigned* cmw = (unsigned*)(ws + WS_CTL) + CW_CMAX;
    int rot = 0;
#define XA(PC, MAP, W, K, N, ldw, dst, cm) { if ((PC) == 2) cmax_matrix(F, (W), (K), (N), (ldw), cmw + (cm), rot); else if ((PC) == 1) tr_matrix8<MAP>(F, (W), (K), (N), (ldw), ws + (dst), rot, W_SCALE8); else tr_matrix<MAP>(F, (W), (K), (N), (ldw), (bf16*)(ws + (dst)), rot); rot += 37; }
    W_DENSE_LIST(XA)
#undef XA
    for (int le = 0; le < 16; ++le) {
        const bool f8 = (le < 8) ? (MOE_F8_A != 0) : (MOE_F8_B != 0);
        const size_t l = le >> 3, e = le & 7;
        if (f8) { tr_matrix8<1>(F, in[22] + (size_t)le * 1024 * 2 * FE, 1024, 2 * FE, 2 * FE, ws + W_MGU + l * 8 * 2 * FE * 1024 * 2 + e * 2 * FE * 1024, rot, W_SCALE8); rot += 37;
                  tr_matrix8<0>(F, in[23] + (size_t)le * FE * 1024, FE, 1024, 1024, ws + W_MD + l * 8 * 1024 * FE * 2 + e * 1024 * FE, rot, W_SCALE8); rot += 37; }
        else { tr_matrix<1>(F, in[22] + (size_t)le * 1024 * 2 * FE, 1024, 2 * FE, 2 * FE, (bf16*)(ws + W_MGU + (size_t)le * 2 * FE * 1024 * 2), rot); rot += 37;
               tr_matrix<0>(F, in[23] + (size_t)le * FE * 1024, FE, 1024, 1024, (bf16*)(ws + W_MD + (size_t)le * 1024 * FE * 2), rot); rot += 37; }
    }
    if (MLA_C8) { tr_matrix8<0>(F, in[10], QL, 1536, 1536, ws + W_MUQ, rot, W_SCALE8, 512); rot += 37; }
    const TC tc = tc_get();
    const int gt = F.vcu * NTHREADS + tc.tid, NGT = F.G * NTHREADS;
    if (MLA_C8) for (int i = gt; i < 1536 * 32; i += NGT) ((unsigned*)(ws + W_MUQ + (size_t)(i >> 5) * 512 + QL))[i & 31] = 0u;
    { const int esz = PC_MDN ? 1 : 2; for (int i = gt; i < (MDNP - MDN) * 1024 * esz / 4; i += NGT) ((unsigned*)(ws + W_MDN + (size_t)MDN * 1024 * esz))[i] = 0u;
      if (PC_MDN == 2) for (int i = gt; i < MDNP - MDN; i += NGT) ((float*)(ws + WS_CS))[CM_MDN + MDN + i] = 0.f; }
    for (int i = gt; i < 2 * 8 * 1024; i += NGT) { const int l = i >> 13, e = (i >> 10) & 7, k = i & 1023; ((float*)(ws + W_RT))[i] = in[21][(size_t)l * 1024 * 8 + k * 8 + e]; }
    rope_table(F, (const int*)in[1], (float*)(ws + WS_ROPE));
}
__device__ __forceinline__ void prologue_b(Frame& F) {
    const float* const* in = F.in; unsigned char* ws = F.ws; const unsigned* cmw = (const unsigned*)(ws + WS_CTL) + CW_CMAX; float* csw = (float*)(ws + WS_CS);
    int rot = 0;
#define XB(PC, MAP, W, K, N, ldw, dst, cm) { if ((PC) == 2) tr_matrix_i8<MAP>(F, (W), (K), (N), (ldw), ws + (dst), rot, cmw + (cm), csw + (cm)); rot += 37; }
    W_DENSE_LIST(XB)
#undef XB
}

#ifndef MLA_QK8
#define MLA_QK8 1
#endif
__device__ __forceinline__ void mla_attention(Frame& F) {
    unsigned char* big = F.ws + WS_BIG;
    const bf16* Q = (const bf16*)(big + B_MQ); const bf16* Kf = (const bf16*)(big + B_MK); const bf16* V = (const bf16*)(big + B_MV); bf16* O = (bf16*)(big + B_MO);
    const float* tab = (const float*)(F.ws + WS_ROPE);
    for (int L = blockIdx.x; L < NB * MH * 16; L += F.G) {
        const int xcd = L & 7, kk = L >> 3, bh = xcd * 8 + (kk >> 4), x = kk & 15, b = bh >> 3, h = bh & 7;
        for (int pass = 0; pass < 2; ++pass) {
            const int qb = pass ? 31 - x : x; const size_t row0 = (size_t)b * SEQ + qb * 256;
            att::Params p;
            p.Q = Q + row0 * 1536 + h * DQKM; p.ldq = 1536;
            p.K = MLA_QK8 ? (const bf16*)((const unsigned char*)Kf + (size_t)bh * SEQ * DQKM) : Kf + (size_t)bh * SEQ * DQKM; p.ldk = DQKM;
            if (MLA_QK8) { p.V = (const bf16*)((const unsigned char*)V + (size_t)(h * DVM) * T + (size_t)b * SEQ); p.ldv = T; }
            else { p.V = V + (size_t)bh * SEQ * DVM; p.ldv = DVM; }
            p.O = PC_ATT_O ? (bf16*)((unsigned char*)O + row0 * 1024 + h * DVM) : O + row0 * 1024 + h * DVM; p.ldo = 1024; p.P0 = qb * 256; p.j_lo = 0; p.j_hi = 4 * (qb + 1);
            p.rope = tab + row0 * 64; p.pos = nullptr; p.slope_over_scale = 0.f; p.sink_l2 = 0.f;
            att::attn_block<192, 128, 0, (1 << 30), MLA_QK8 != 0, PC_ATT_O != 0>(p, F.lds);
        }
    }
}
#ifndef SWA_RES
#define SWA_RES 1
#endif
__device__ __forceinline__ void swa_attention(Frame& F) {
    unsigned char* big = F.ws + WS_BIG;
    const bf16* QKV = (const bf16*)(big + B_SQKV); bf16* O = (bf16*)(big + B_SO);
    const int* pos = (const int*)F.in[1]; const float* sinks = F.in[16];
#if SWA_RES
    for (int L = blockIdx.x; L < NB * 2 * 32; L += F.G) {
        const int qb = L & 31, pair = L >> 5, b = pair >> 1, kvh = pair & 1, qh = kvh * 8;
        const size_t row0 = (size_t)b * SEQ + qb * 256;
        att::Params p;
        p.Q = QKV + row0 * SQKV + qh * 64; p.ldq = SQKV;
        p.K = QKV + (size_t)b * SEQ * SQKV + 1024 + kvh * 64; p.ldk = SQKV; p.V = QKV + (size_t)b * SEQ * SQKV + 1152 + kvh * 64; p.ldv = SQKV;
        p.O = PC_ATT_O ? (bf16*)((unsigned char*)O + row0 * 1024 + qh * 64) : O + row0 * 1024 + qh * 64; p.ldo = 1024; p.P0 = qb * 256; p.j_lo = qb ? 4 * qb - 2 : 0; p.j_hi = 4 * qb + 4;
        p.rope = nullptr; p.pos = pos + (size_t)b * SEQ; p.slope_over_scale = 0.f; p.sink_l2 = 0.f; p.sinks = sinks; p.qh0 = qh;
        att::attn_block<64, 64, 1, 128, false, PC_ATT_O != 0, true>(p, F.lds);
    }
#else
    for (int L = blockIdx.x; L < NB * 16 * 32; L += F.G) {
        const int xcd = L & 7, kk = L >> 3, pair = xcd * 2 + (kk >> 8), u = kk & 255, qb = u >> 3, g = u & 7, b = pair >> 1, kvh = pair & 1, qh = kvh * 8 + g;
        const size_t row0 = (size_t)b * SEQ + qb * 256;
        att::Params p;
        p.Q = QKV + row0 * SQKV + qh * 64; p.ldq = SQKV;
        p.K = QKV + (size_t)b * SEQ * SQKV + 1024 + kvh * 64; p.ldk = SQKV; p.V = QKV + (size_t)b * SEQ * SQKV + 1152 + kvh * 64; p.ldv = SQKV;
        p.O = PC_ATT_O ? (bf16*)((unsigned char*)O + row0 * 1024 + qh * 64) : O + row0 * 1024 + qh * 64; p.ldo = 1024; p.P0 = qb * 256; p.j_lo = qb ? 4 * qb - 2 : 0; p.j_hi = 4 * qb + 4;
        p.rope = nullptr; p.pos = pos + (size_t)b * SEQ; p.sinks = sinks; p.qh0 = qh;
        p.slope_over_scale = __builtin_amdgcn_exp2f(-0.5f * (float)(qh + 1)) * 8.0f;
        p.sink_l2 = sinks[qh] * 1.4426950408889634f;
        att::attn_block<64, 64, 1, 128, false, PC_ATT_O != 0>(p, F.lds);
    }
#endif
}

struct Args { const float* in[24]; float* out; unsigned char* ws; int ph_lo, ph_hi; };
constexpr int N_PHASES = 33;
__global__ void __launch_bounds__(NTHREADS, 2) mega(Args args) {
    extern __shared__ __attribute__((aligned(16))) unsigned char lds_raw[];
#if HW_SAT8
    __builtin_amdgcn_s_setreg(1 | (23 << 6), 1);
#endif
    Frame F;
    F.lds = (char*)lds_raw;
    F.G = gridDim.x; { const int bx = blockIdx.x; F.vcu = (F.G % 8 == 0) ? (bx % 8) * (F.G / 8) + bx / 8 : bx; }
    F.ws = args.ws; F.out = args.out; F.in = args.in;
    unsigned char* ws = args.ws; unsigned char* big = ws + WS_BIG;
    unsigned* ctl = (unsigned*)(ws + WS_CTL);
    volatile LAS unsigned* misc = (volatile LAS unsigned*)((LAS unsigned char*)lds_raw + MISC_OFF);
    if (threadIdx.x < 32) misc[threadIdx.x] = 0u;
    __syncthreads();
    const int lo = args.ph_lo, hi = args.ph_hi;
    XcdBarrier bar; bar.bar = ctl + CW_BAR; bar.x = 0; bar.st = nullptr;
    if (hi - lo > 1) bar = xcd_barrier_post(ctl + CW_BAR, misc + 8);
#ifndef PH_SEL
#define PH_SEL -1
#endif
#define IN(k) ((PH_SEL < 0 || PH_SEL == (k)) && lo <= (k) && (k) < hi)
#ifndef PROBE_MASK
#define PROBE_MASK 0ull
#endif
#define REP(k) for (int rep_ = 0, nrep_ = (((PROBE_MASK >> (k)) & 1ull) ? 2 : 1); rep_ < nrep_; ++rep_)
#define XDST ((rep_ + 1 < nrep_) ? (float*)(ws + WS_XG) : X)
#define XBDST ((rep_ + 1 < nrep_) ? (bf16*)args.out : XB)
#ifndef XBF16
#define XBF16 1
#endif
#if XBF16
static_assert(MOE_F8_A && MOE_F8_B, "the bf16 residual stream lives in the half of the XG region that fp8 MoE rows leave free");
#define RES_EPI(srcf32, srcp, ...) pg8::EpiResB<srcf32>{(srcf32) ? (const void*)(srcp) : (const void*)XB, XBDST, __VA_ARGS__}
#else
#define RES_EPI(srcf32, srcp, ...) pg8::EpiRes{(srcf32) ? (const float*)(srcp) : (const float*)X, XDST, __VA_ARGS__}
#endif
#ifdef DIAG_GEMM
    unsigned long long dgw_wait = 0, dgw_sel = 0;
#define SEAM(k) do { if (IN(k) && IN((k) + 1)) { const unsigned long long t_ = __builtin_amdgcn_s_memrealtime(); xcd_barrier(bar); const unsigned long long d_ = __builtin_amdgcn_s_memrealtime() - t_; dgw_wait += d_; if ((k) == DIAG_SEAM) dgw_sel = d_; } } while (0)
#else
#define SEAM(k) do { if (IN(k) && IN((k) + 1)) { xcd_barrier(bar); if ((PROBE_MASK >> 40) & 1ull) xcd_barrier(bar); } } while (0)
#endif
    const float* x_in = args.in[0]; float* X = args.out; bf16* XB = (bf16*)(ws + WS_XG + (size_t)MAXSLOT * D);
    bf16* XN = (bf16*)(ws + WS_XN); bf16* XG = (bf16*)(ws + WS_XG);
    unsigned* rt_e = (unsigned*)(ws + RT_E); float* rt_w0 = (float*)(ws + RT_W0); float* rt_w1 = (float*)(ws + RT_W1); int* rt_s0 = (int*)(ws + RT_S0); int* rt_s1 = (int*)(ws + RT_S1);
    unsigned* rt_cnt = (unsigned*)(ws + RT_CNT); unsigned* rt_pb = (unsigned*)(ws + RT_PB);
    const float* nmix = args.in[2]; const float* nffn = args.in[3];

    constexpr float S_AW = 1.0f / (ACT_SCALE8 * W_SCALE8), S_HW = 1.0f / (HID_SCALE8 * W_SCALE8);
    constexpr bool MA8 = MOE_F8_A != 0, MB8 = MOE_F8_B != 0;
    bf16* Bc = (bf16*)(big + B_CONV_B); bf16* Vc = (bf16*)(big + B_CONV_V); bf16* Yc = (bf16*)(big + B_CONV_Y);
    float* rsA = (float*)(ws + WS_RS); const float* csw = (const float*)(ws + WS_CS);
#define ASC(PC) ((PC) == 1 ? S_AW : 1.0f)
#define ROWPASS(MODE, COMB, OM, ...) do { RowArgs a{}; a.Xsrc = X; a.Xsb = XB; a.Xdb = XB; a.XN = XN; a.rs = rsA; __VA_ARGS__; row_pass<MODE, COMB, OM, false, XBF16 != 0>(F, a); } while (0)
#define ROWPASS_Y8(MODE, COMB, OM, ...) do { RowArgs a{}; a.Xsrc = X; a.Xsb = XB; a.Xdb = XB; a.XN = XN; a.rs = rsA; __VA_ARGS__; row_pass<MODE, COMB, OM, true, XBF16 != 0>(F, a); } while (0)
#define CONV_IN(j) do { gemm_static<PC_CONV_IN>(F, XN, D, D, ws + W_CINB + (size_t)(j) * 1024 * 1024 * 2, 1024, pg8::EpiBf16{Bc, D, nullptr, ASC(PC_CONV_IN)}, rsA, csw + CM_CIN + (j) * 3072); \
                        gemm_static<PC_CONV_IN>(F, XN, D, D, ws + W_CINCU + (size_t)(j) * 2048 * 1024 * 2, 2048, pg8::EpiPair<0>{Vc, D, ASC(PC_CONV_IN)}, rsA, csw + CM_CIN + (j) * 3072 + 1024); } while (0)
#define CONV_OUT(j, srcin) gemm_static<PC_CONV_OUT>(F, Yc, D, D, ws + W_COUT + (size_t)(j) * 1024 * 1024 * 2, 1024, RES_EPI(srcin, x_in, D, nullptr, PC_CONV_OUT == 1 ? 1.0f / (YC_SCALE8 * W_SCALE8) : 1.0f), nullptr, nullptr, STAGGER_TICKS)
#define FFN_GU(f) do { if constexpr (PC_FFN_DN == 1) gemm_static<PC_FFN_GU>(F, XN, D, D, ws + W_FGU + (size_t)(f) * 2 * FF * 1024 * 2, 2 * FF, pg8::EpiPair8{big + B_HMID, FF, ASC(PC_FFN_GU), HID_SCALE8}, rsA, csw + CM_FGU + (f) * 5632); \
                       else gemm_static<PC_FFN_GU>(F, XN, D, D, ws + W_FGU + (size_t)(f) * 2 * FF * 1024 * 2, 2 * FF, pg8::EpiPair<1>{(bf16*)(big + B_HMID), FF, ASC(PC_FFN_GU)}, rsA, csw + CM_FGU + (f) * 5632); } while (0)
#define FFN_DN(f) gemm_static<PC_FFN_DN>(F, big + B_HMID, FF, FF, ws + W_FD + (size_t)(f) * 1024 * FF * 2, 1024, RES_EPI(false, x_in, D, nullptr, PC_FFN_DN == 1 ? S_HW : 1.0f), nullptr, nullptr, STAGGER_TICKS)

    if (IN(0)) REP(0) { prologue_a(F); xcd_barrier(bar); prologue_b(F); __syncthreads(); { RowArgs a{}; a.Xsrc = x_in; a.XN = XN; a.rs = rsA; a.g = nmix; row_pass<0, false, PC_CONV_IN, false, false>(F, a); } }
    SEAM(0);
    if (IN(1)) REP(1) CONV_IN(0);
    if (IN(1) && ((PROBE_MASK >> 41) & 1ull)) CONV_IN(0);
    SEAM(1);
    if (IN(2)) REP(2) conv_pass<PC_CONV_OUT == 1>(F, Bc, Vc, args.in[6], Yc);
    SEAM(2);
    if (IN(3)) REP(3) CONV_OUT(0, true);
    SEAM(3);
    if (IN(4)) REP(4) ROWPASS(0, false, PC_FFN_GU, a.g = nffn);
    SEAM(4);
    if (IN(5)) REP(5) FFN_GU(0);
    if (IN(5) && ((PROBE_MASK >> 42) & 1ull)) FFN_GU(0);
    SEAM(5);
    if (IN(6)) REP(6) FFN_DN(0);
    SEAM(6);
    if (IN(7)) REP(7) ROWPASS(0, false, PC_MDN, a.g = nmix + D);
    SEAM(7);
    if (IN(8)) REP(8) gemm_static<PC_MDN>(F, XN, D, D, ws + W_MDN, MDNP, pg8::EpiBf16{(bf16*)(big + B_MC), MDNP, nullptr, ASC(PC_MDN)}, rsA, csw + CM_MDN);
    SEAM(8);
    if (IN(9)) REP(9) mla_mid<MLA_QK8, MLA_C8 != 0>(F, (const float*)(big + B_MC), args.in[9], args.in[11], (const float*)(ws + WS_ROPE), (bf16*)(big + B_MCQ), (bf16*)(big + B_MCKV), (bf16*)(big + B_MK), att::QK8_SCALE);
    SEAM(9);
    if (IN(10)) REP(10) {
        if (MLA_C8) gemm_static<1>(F, big + B_MCQ, 512, 512, ws + W_MUQ, 1536, pg8::EpiBf16{(bf16*)(big + B_MQ), 1536, nullptr, 1.0f / (C8_SCALE * W_SCALE8)});
        else gemm_static(F, big + B_MCQ, QL, QL, ws + W_MUQ, 1536, pg8::EpiBf16{(bf16*)(big + B_MQ), 1536, nullptr, 1.0f});
#if MLA_QK8
        if (MLA_C8) gemm_static<1>(F, big + B_MCKV, KVL, KVL, ws + W_MUKV, 1024, pg8::EpiK8{big + B_MK, att::QK8_SCALE / (C8_SCALE * W_SCALE8)});
        else gemm_static(F, big + B_MCKV, KVL, KVL, ws + W_MUKV, 1024, pg8::EpiK8{big + B_MK, att::QK8_SCALE});
        if (MLA_C8) gemm_static<1>(F, ws + W_MUKV + (size_t)1024 * KVL, KVL, KVL, big + B_MCKV, T, pg8::EpiVT8{big + B_MV, (size_t)T, att::QK8_SCALE / (C8_SCALE * W_SCALE8)}, nullptr, nullptr, 0, 1024);
        else gemm_static(F, ws + W_MUKV + (size_t)1024 * KVL * 2, KVL, KVL, big + B_MCKV, T, pg8::EpiVT8{big + B_MV, (size_t)T, att::QK8_SCALE}, nullptr, nullptr, 0, 1024);
#else
        gemm_static(F, big + B_MCKV, KVL, KVL, ws + W_MUKV, 2048, pg8::EpiKVT<0>{(bf16*)(big + B_MK), (bf16*)(big + B_MV), 1.0f});
#endif
    }
    SEAM(10);
#ifdef DIAG_GEMM
    unsigned long long dph_c = __builtin_readcyclecounter(), dph_w = __builtin_amdgcn_s_memrealtime();
#endif
    if (IN(11)) REP(11) mla_attention(F);
#ifdef DIAG_GEMM
    if (DIAG_N == -11 && blockIdx.x == DIAG_BLOCK && threadIdx.x == 0) { unsigned long long* dg = (unsigned long long*)(ws + WS_CTL + 24000); dg[3] = __builtin_readcyclecounter() - dph_c; dg[4] = __builtin_amdgcn_s_memrealtime() - dph_w; }
#endif
    SEAM(11);
    if (IN(12)) REP(12) gemm_static<PC_ATT_O>(F, big + B_MO, D, D, ws + W_MO, 1024, RES_EPI(false, x_in, D, nullptr, PC_ATT_O ? 1.0f / (att::O8_SCALE * W_SCALE8) : 1.0f), nullptr, nullptr, STAGGER_TICKS);
    SEAM(12);
    if (IN(13)) REP(13) ROWPASS(1, false, MA8 ? 1 : 0, a.g = nffn + D; a.routerT = (const float*)(ws + W_RT); a.rt_e = rt_e; a.rt_w0 = rt_w0; a.rt_w1 = rt_w1; a.cnt = rt_cnt);
    SEAM(13);
    if (IN(14)) REP(14) moe_assign<MA8>(F, rt_cnt, rt_e, rt_s0, rt_s1, rt_pb, XN, XG, MA8 ? (int*)(ws + RT_TOK) : nullptr);
    SEAM(14);
    if (IN(15)) REP(15) moe_gemm1<MA8>(F, 0, rt_pb);
    SEAM(15);
    if (IN(16)) REP(16) moe_gemm2<MA8, MA8>(F, 0, rt_pb);
    SEAM(16);
    if (IN(17)) REP(17) ROWPASS_Y8(0, true, PC_SQKV, a.Xdst = X; a.g = nmix + 2 * D; a.Y = XG; a.s0 = rt_s0; a.s1 = rt_s1; a.w0 = rt_w0; a.w1 = rt_w1);
    SEAM(17);
    if (IN(18)) REP(18) gemm_static<PC_SQKV>(F, XN, D, D, ws + W_SQKV, SQKV, pg8::EpiBf16{(bf16*)(big + B_SQKV), SQKV, args.in[15], ASC(PC_SQKV)}, rsA, csw + CM_SQKV);
    SEAM(18);
    if (IN(19)) REP(19) swa_attention(F);
    SEAM(19);
    if (IN(20)) REP(20) gemm_static<PC_ATT_O>(F, big + B_SO, D, D, ws + W_SO, 1024, RES_EPI(false, x_in, D, args.in[18], PC_ATT_O ? 1.0f / (att::O8_SCALE * W_SCALE8) : 1.0f), nullptr, nullptr, STAGGER_TICKS);
    SEAM(20);
    if (IN(21)) REP(21) ROWPASS(0, false, PC_FFN_GU, a.g = nffn + 2 * D);
    SEAM(21);
    if (IN(22)) REP(22) FFN_GU(1);
    SEAM(22);
    if (IN(23)) REP(23) FFN_DN(1);
    SEAM(23);
    if (IN(24)) REP(24) ROWPASS(0, false, PC_CONV_IN, a.g = nmix + 3 * D);
    SEAM(24);
    if (IN(25)) REP(25) CONV_IN(1);
    SEAM(25);
    if (IN(26)) REP(26) conv_pass<PC_CONV_OUT == 1>(F, Bc, Vc, args.in[6] + 3 * D, Yc);
    SEAM(26);
    if (IN(27)) REP(27) CONV_OUT(1, false);
    SEAM(27);
    if (IN(28)) REP(28) ROWPASS(1, false, MB8 ? 1 : 0, a.g = nffn + 3 * D; a.routerT = (const float*)(ws + W_RT) + 8 * 1024; a.rt_e = rt_e; a.rt_w0 = rt_w0; a.rt_w1 = rt_w1; a.cnt = rt_cnt);
    SEAM(28);
    if (IN(29)) REP(29) moe_assign<MB8>(F, rt_cnt, rt_e, rt_s0, rt_s1, rt_pb + 16, XN, XG, MB8 ? (int*)(ws + RT_TOK) : nullptr);
    SEAM(29);
    if (IN(30)) REP(30) moe_gemm1<MB8>(F, 1, rt_pb + 16);
    SEAM(30);
    if (IN(31)) REP(31) moe_gemm2<MB8, MB8>(F, 1, rt_pb + 16);
    SEAM(31);
    if (IN(32)) REP(32) ROWPASS_Y8(2, true, 0, a.g = args.in[4]; a.outF = X; a.Y = XG; a.s0 = rt_s0; a.s1 = rt_s1; a.w0 = rt_w0; a.w1 = rt_w1);
#ifdef DIAG_GEMM
    if (blockIdx.x == DIAG_BLOCK && threadIdx.x == 0) { const unsigned long long* dg = (const unsigned long long*)(ws + WS_CTL + 24000);
        unsigned long long q = dg[DIAG_SEL < 6 ? DIAG_SEL : 0]; if (DIAG_SEL == 3) q = q / 200ull;
        if (DIAG_SEL == 6) q = dgw_wait; if (DIAG_SEL == 7) q = dgw_sel;
        const unsigned long long t0 = __builtin_amdgcn_s_memrealtime(), tgt = q * DIAG_MUL;
        while (__builtin_amdgcn_s_memrealtime() - t0 < tgt) __builtin_amdgcn_s_sleep(20); }
#endif
#undef IN
#undef SEAM
}

#ifndef MK_LAUNCH_PER_PHASE
#define MK_LAUNCH_PER_PHASE 0
#endif
extern "C" void kernel_launch(void* const* d_in, const int* in_sizes, int n_in, void* d_out, int out_size, void* d_ws, size_t ws_size, hipStream_t stream) {
    static int grid = 0;
    if (grid == 0) {
        if (n_in != 24 || in_sizes[0] != T * D || out_size != T * D || ws_size < WS_END) { fprintf(stderr, "kernel_launch: unexpected shapes (n_in %d, in0 %d, out %d, ws %zu < %zu); nothing launched\n", n_in, n_in > 0 ? in_sizes[0] : -1, out_size, ws_size, (size_t)WS_END); grid = -1; return; }
        int dev = 0, cus = 0, per_cu = 0;
        if (hipGetDevice(&dev) != hipSuccess || hipDeviceGetAttribute(&cus, hipDeviceAttributeMultiprocessorCount, dev) != hipSuccess) { grid = -1; return; }
        if (hipFuncSetAttribute((const void*)mega, hipFuncAttributeMaxDynamicSharedMemorySize, LDS_BYTES) != hipSuccess) { fprintf(stderr, "kernel_launch: hipFuncSetAttribute failed\n"); grid = -1; return; }
        if (hipOccupancyMaxActiveBlocksPerMultiprocessor(&per_cu, (const void*)mega, NTHREADS, LDS_BYTES) != hipSuccess || per_cu < 1) fprintf(stderr, "kernel_launch: occupancy query reports %d\n", per_cu);
        (void)hipGetLastError();
        grid = cus;
    }
    if (grid < 0) return;
    (void)hipMemsetAsync((char*)d_ws + WS_CTL, 0, CTL_ZERO_BYTES, stream);
    Args a{};
    for (int i = 0; i < 24; ++i) a.in[i] = (const float*)d_in[i];
    a.out = (float*)d_out; a.ws = (unsigned char*)d_ws;
#if MK_LAUNCH_PER_PHASE
    for (int p = 0; p < N_PHASES; ++p) { a.ph_lo = p; a.ph_hi = p + 1; hipLaunchKernelGGL(mega, dim3(grid), dim3(NTHREADS), LDS_BYTES, stream, a); }
#else
    a.ph_lo = 0; a.ph_hi = N_PHASES; hipLaunchKernelGGL(mega, dim3(grid), dim3(NTHREADS), LDS_BYTES, stream, a);
#endif
}
```
